# Optimizing an MI355X kernel written in HIP

```python
import math
import jax, jax.numpy as jnp
from jax import lax
import numpy as np

D_MODEL = 1024
BATCH = 4
SEQ = 4096
DEPTH = 4

GRID_W = 64
CTX_LEN = 256
D_HY = D_MODEL
N_BANDS = 16
FILTER_EMB = 1 + 2 * N_BANDS
FILTER_ORDER = 64
SHORT_W = 3
GLA_HEADS = 4
GLA_DK = D_MODEL // 8
GLA_DV = D_MODEL // 4
GLA_DK_TOT = GLA_HEADS * GLA_DK
GLA_DV_TOT = GLA_HEADS * GLA_DV
GATE_RANK = 16
GATE_TAU = 16.0
GLA_CHUNK = 64
D_FF = 4 * D_MODEL
EPS = 1e-6
IN_SIZES = (3 * D_HY, GLA_DK_TOT, GLA_DK_TOT, GLA_DV_TOT, GLA_DV_TOT, GATE_RANK, GATE_RANK, D_MODEL, D_MODEL)
IN_WIDTH = sum(IN_SIZES)
IN_SPLITS = tuple(np.cumsum(IN_SIZES)[:-1].tolist())

kernel_name = "hyena_gla_parallel_gated_dit_trunk"


def rmsnorm(x, g):
    xf = x.astype(jnp.float32)
    y = xf * lax.rsqrt(jnp.mean(xf * xf, axis=-1, keepdims=True) + EPS)
    return (y * g.astype(jnp.float32)).astype(x.dtype)


def conv3(x, w, b):
    L = x.shape[-2]
    xp = jnp.pad(x, [(0, 0)] * (x.ndim - 2) + [(1, 1), (0, 0)])
    return xp[..., :L, :] * w[0] + xp[..., 1:L + 1, :] * w[1] + xp[..., 2:, :] * w[2] + b


def hyena_filter(L, w1, b1, w2, b2, w3, freq, decay):
    f32 = jnp.float32
    t = jnp.linspace(0.0, 1.0, L, dtype=f32)[:, None]
    ang = (2.0 * math.pi / L) * jnp.arange(L, dtype=f32)[:, None] * \
        jnp.linspace(1e-4, N_BANDS - 1, N_BANDS, dtype=f32)[None, :]
    z = jnp.concatenate([t, jnp.cos(ang), -jnp.sin(ang)], axis=-1)
    fr = freq.astype(f32)
    a = jnp.sin(fr * (z @ w1.astype(f32) + b1.astype(f32)))
    a = jnp.sin(fr * (a @ w2.astype(f32) + b2.astype(f32)))
    hk = a @ w3.astype(f32)
    window = jnp.exp(-t * jnp.abs(decay.astype(f32))[None, :])
    h_f = hk[:, :D_HY] * window
    h_b = hk[:, D_HY:] * window
    return jnp.concatenate([h_f, jnp.zeros((1, D_HY), f32), h_b[:0:-1]], axis=0)


def long_conv(u, hcirc):
    L = u.shape[1]
    U = jnp.fft.rfft(u.astype(jnp.float32), n=2 * L, axis=1)
    H = jnp.fft.rfft(hcirc, axis=0)
    return jnp.fft.irfft(U * H[None], n=2 * L, axis=1)[:, :L].astype(u.dtype)


def hyena_branch(hy_p, hcirc, conv_w, conv_b, skip, rows):
    B, L, C3 = hy_p.shape
    if rows is None:
        u = conv3(hy_p, conv_w, conv_b)
    else:
        u = conv3(hy_p.reshape(B, rows, GRID_W, C3), conv_w, conv_b).reshape(B, L, C3)
    x0, x1, v = jnp.split(u, 3, axis=-1)
    z = x1 * v
    return x0 * (long_conv(z, hcirc) + skip * z)


def gla_inputs(q, k, v, lr_f, lr_b, gate_w, gate_b):
    B, L, _ = q.shape

    def heads(a):
        return a.reshape(B, L, GLA_HEADS, -1).transpose(0, 2, 1, 3).astype(jnp.float32)

    gf = jax.nn.log_sigmoid((lr_f @ gate_w[0] + gate_b[0]).astype(jnp.float32)) / GATE_TAU
    gb = jax.nn.log_sigmoid((lr_b @ gate_w[1] + gate_b[1]).astype(jnp.float32)) / GATE_TAU
    return heads(q) * (GLA_DK ** -0.5), heads(k), heads(v), heads(gf), heads(gb)


def gla_chunk_scan(q, k, v, g, s0, with_out):
    B, H, L, DK = q.shape
    DV = v.shape[-1]
    n = L // GLA_CHUNK

    def to_chunks(a):
        return jnp.moveaxis(a.reshape(B, H, n, GLA_CHUNK, a.shape[-1]), 2, 0)

    lower = jnp.tril(jnp.ones((GLA_CHUNK, GLA_CHUNK), dtype=bool))

    def step(S, blk):
        qb, kb, vb, gb = blk
        b = jnp.cumsum(gb, axis=2)
        b_end = b[:, :, -1:, :]
        S_next = jnp.exp(b_end)[:, :, 0, :, None] * S + \
            jnp.einsum('bhcd,bhce->bhde', kb * jnp.exp(b_end - b), vb)
        if not with_out:
            return S_next, None
        q_t = qb * jnp.exp(b)
        k_t = kb * jnp.exp(-b)
        att = jnp.where(lower, jnp.einsum('bhtd,bhsd->bhts', q_t, k_t), 0.0)
        o = jnp.einsum('bhts,bhse->bhte', att, vb) + jnp.einsum('bhtd,bhde->bhte', q_t, S)
        return S_next, o

    S_fin, o = lax.scan(step, s0, (to_chunks(q), to_chunks(k), to_chunks(v), to_chunks(g)))
    if with_out:
        o = jnp.moveaxis(o, 0, 2).reshape(B, H, L, DV)
    return S_fin, o


def gla_bidir(q, k, v, gf, gb, s0_f, s0_b, with_out):
    flip = lambda a: jnp.flip(a, axis=2)
    s_f, o_f = gla_chunk_scan(q, k, v, gf, s0_f, with_out)
    s_b, o_b = gla_chunk_scan(flip(q), flip(k), flip(v), flip(gb), s0_b, with_out)
    o = o_f + flip(o_b) if with_out else None
    return o, s_f, s_b


def gla_output(o, r, g):
    B, H, L, DV = o.shape
    on = o * lax.rsqrt(jnp.mean(o * o, axis=-1, keepdims=True) + EPS) * g.astype(jnp.float32)
    on = on.transpose(0, 2, 1, 3).reshape(B, L, H * DV).astype(r.dtype)
    return on * jax.nn.silu(r)


def mixer_output(hy_p, r, gt_hy, gt_gla, o_gla, hcirc, rows, conv_w, conv_b, skip, norm_g, w_bhy, w_bgla, w_o):
    y_hy = hyena_branch(hy_p, hcirc, conv_w, conv_b, skip, rows)
    y_gla = gla_output(o_gla, r, norm_g)
    merged = jax.nn.sigmoid(gt_hy) * (y_hy @ w_bhy) + jax.nn.sigmoid(gt_gla) * (y_gla @ w_bgla)
    return merged @ w_o


def sq_relu_mlp(h, w1, w2):
    return jnp.square(jax.nn.relu(h @ w1)) @ w2


def setup_inputs(seed: int = 0) -> dict:
    key = jax.random.key(seed)
    ks = jax.random.split(key, 32)
    f32 = jnp.float32

    def nrm(k, shape, s):
        return jax.random.normal(k, shape, f32) * s

    decay_base = jnp.linspace(-math.log(1e-2) / 1.5, -math.log(1e-2) / 0.3, D_HY, dtype=f32)
    return {
        "x": nrm(ks[0], (BATCH, SEQ, D_MODEL), 1.0),
        "c": nrm(ks[1], (BATCH, D_MODEL), 1.0),
        "ctx": nrm(ks[2], (BATCH, CTX_LEN, D_MODEL), 1.0),
        "c_ctx": nrm(ks[3], (D_MODEL,), 1.0),
        "ada_w": nrm(ks[4], (DEPTH, D_MODEL, 6 * D_MODEL), 0.5 * D_MODEL ** -0.5),
        "ada_b": nrm(ks[5], (DEPTH, 6 * D_MODEL), 0.02),
        "norm1_g": 1.0 + nrm(ks[6], (DEPTH, D_MODEL), 0.02),
        "norm2_g": 1.0 + nrm(ks[7], (DEPTH, D_MODEL), 0.02),
        "w_in": nrm(ks[8], (DEPTH, D_MODEL, IN_WIDTH), D_MODEL ** -0.5),
        "hy_conv_w": nrm(ks[9], (DEPTH, SHORT_W, 3 * D_HY), SHORT_W ** -0.5),
        "hy_conv_b": nrm(ks[10], (DEPTH, 3 * D_HY), 0.02),
        "hy_filt_w1": nrm(ks[11], (DEPTH, FILTER_EMB, FILTER_ORDER), FILTER_EMB ** -0.5),
        "hy_filt_b1": nrm(ks[12], (DEPTH, FILTER_ORDER), 0.1),
        "hy_filt_w2": nrm(ks[13], (DEPTH, FILTER_ORDER, FILTER_ORDER), FILTER_ORDER ** -0.5),
        "hy_filt_b2": nrm(ks[14], (DEPTH, FILTER_ORDER), 0.1),
        "hy_filt_w3": nrm(ks[15], (DEPTH, FILTER_ORDER, 2 * D_HY), 0.05 * FILTER_ORDER ** -0.5),
        "hy_filt_freq": 1.0 + nrm(ks[16], (DEPTH, FILTER_ORDER), 0.05),
        "hy_decay": decay_base[None, :] * (1.0 + nrm(ks[17], (DEPTH, D_HY), 0.05)),
        "hy_skip": nrm(ks[18], (DEPTH, D_HY), 1.0),
        "gla_gate_w": nrm(ks[19], (DEPTH, 2, GATE_RANK, GLA_DK_TOT), GATE_RANK ** -0.5),
        "gla_gate_b": nrm(ks[20], (DEPTH, 2, GLA_DK_TOT), 0.1),
        "gla_norm_g": 1.0 + nrm(ks[21], (DEPTH, GLA_DV), 0.02),
        "w_branch_hy": nrm(ks[22], (DEPTH, D_HY, D_MODEL), D_HY ** -0.5),
        "w_branch_gla": nrm(ks[23], (DEPTH, GLA_DV_TOT, D_MODEL), GLA_DV_TOT ** -0.5),
        "w_out": nrm(ks[24], (DEPTH, D_MODEL, D_MODEL), D_MODEL ** -0.5),
        "mlp_w1": nrm(ks[25], (DEPTH, D_MODEL, D_FF), D_MODEL ** -0.5),
        "mlp_w2": nrm(ks[26], (DEPTH, D_FF, D_MODEL), D_FF ** -0.5),
        "final_g": 1.0 + nrm(ks[27], (D_MODEL,), 0.02),
    }


def reference(x, c, ctx, c_ctx, ada_w, ada_b, norm1_g, norm2_g, w_in, hy_conv_w, hy_conv_b,
              hy_filt_w1, hy_filt_b1, hy_filt_w2, hy_filt_b2, hy_filt_w3, hy_filt_freq, hy_decay, hy_skip,
              gla_gate_w, gla_gate_b, gla_norm_g, w_branch_hy, w_branch_gla, w_out, mlp_w1, mlp_w2, final_g):
    B, L, _ = x.shape
    L_ctx = ctx.shape[1]
    rows = L // GRID_W
    silu_c = jax.nn.silu(c)
    silu_cc = jax.nn.silu(c_ctx)
    for l in range(DEPTH):
        last = l == DEPTH - 1
        mod = (silu_c @ ada_w[l] + ada_b[l])[:, None, :]
        mod_c = (silu_cc @ ada_w[l] + ada_b[l])[None, None, :]
        sh1, sc1, g1, sh2, sc2, g2 = jnp.split(mod, 6, axis=-1)
        csh1, csc1, cg1, csh2, csc2, cg2 = jnp.split(mod_c, 6, axis=-1)

        h = rmsnorm(x, norm1_g[l]) * (1 + sc1) + sh1
        hc = rmsnorm(ctx, norm1_g[l]) * (1 + csc1) + csh1
        hy_p, q, k, v, r, lr_f, lr_b, gt_hy, gt_gla = jnp.split(h @ w_in[l], IN_SPLITS, axis=-1)
        hy_pc, qc, kc, vc, rc, lr_fc, lr_bc, gt_hyc, gt_glac = jnp.split(hc @ w_in[l], IN_SPLITS, axis=-1)

        zeros_state = jnp.zeros((B, GLA_HEADS, GLA_DK, GLA_DV), jnp.float32)
        q_c, k_c, v_c, gf_c, gb_c = gla_inputs(qc, kc, vc, lr_fc, lr_bc, gla_gate_w[l], gla_gate_b[l])
        o_c, s_f_ctx, s_b_ctx = gla_bidir(q_c, k_c, v_c, gf_c, gb_c, zeros_state, zeros_state, not last)
        q_l, k_l, v_l, gf_l, gb_l = gla_inputs(q, k, v, lr_f, lr_b, gla_gate_w[l], gla_gate_b[l])
        o_l, _, _ = gla_bidir(q_l, k_l, v_l, gf_l, gb_l, s_f_ctx, s_b_ctx, True)

        filt = (hy_filt_w1[l], hy_filt_b1[l], hy_filt_w2[l], hy_filt_b2[l], hy_filt_w3[l], hy_filt_freq[l], hy_decay[l])
        shared = (hy_conv_w[l], hy_conv_b[l], hy_skip[l], gla_norm_g[l], w_branch_hy[l], w_branch_gla[l], w_out[l])
        out = mixer_output(hy_p, r, gt_hy, gt_gla, o_l, hyena_filter(L, *filt), rows, *shared)
        x = x + g1 * out
        if not last:
            out_c = mixer_output(hy_pc, rc, gt_hyc, gt_glac, o_c, hyena_filter(L_ctx, *filt), None, *shared)
            ctx = ctx + cg1 * out_c

        h2 = rmsnorm(x, norm2_g[l]) * (1 + sc2) + sh2
        x = x + g2 * sq_relu_mlp(h2, mlp_w1[l], mlp_w2[l])
        if not last:
            h2c = rmsnorm(ctx, norm2_g[l]) * (1 + csc2) + csh2
            ctx = ctx + cg2 * sq_relu_mlp(h2c, mlp_w1[l], mlp_w2[l])
    return rmsnorm(x, final_g)
```

```cpp
#include <hip/hip_runtime.h>
#include <hip/hip_cooperative_groups.h>
namespace cg = cooperative_groups;
#define DI __device__ __forceinline__

__device__ __forceinline__ int otid() { int t = threadIdx.x; asm volatile("" : "+v"(t)); return t; }
namespace pg8 {
#define PG8_LAS __attribute__((address_space(3)))
typedef unsigned short bf16_t;
typedef short bf16x8 __attribute__((ext_vector_type(8)));
typedef float f32x4 __attribute__((ext_vector_type(4)));
typedef unsigned u32x4 __attribute__((ext_vector_type(4)));
constexpr int BM = 256, BK = 64, HALF = 128, HTB = HALF * BK * 2  , STAGE_BYTES = 8 * HTB, NXCD = 8, WGM = 8;

__host__ __device__ __forceinline__ int lds_byte(int r, int c) { const int st = (r >> 4) * 2 + (c >> 5), rr = r & 15, cc = c & 31, ob = rr * 64 + cc * 2; return st * 1024 + (ob ^ (((ob >> 9) & 1) << 5)); }
__host__ __device__ __forceinline__ void stage_rc(int b, int& R, int& C) { const int st = b / 1024, sb = b % 1024, swz = sb ^ (((sb >> 9) & 1) << 5); R = (st >> 1) * 16 + swz / 64; C = (st & 1) * 32 + (swz % 64) / 2; }
__host__ __device__ __forceinline__ int perm32(int rho) { const int n = rho >> 4, i = rho & 15; return 8 * (i >> 2) + 4 * n + (i & 3); }

struct Unit { int pm, pn; };
struct Gemm { const bf16_t* A; const bf16_t* Bt; int M, N, K; };
struct StaticOrder {
    int nM, nN, nwg, G, c;
    __host__ __device__ void init(int M, int N, int G_, int c_) { nM = M / BM; nN = N / BM; nwg = nM * nN; G = G_; c = c_; }
    __host__ __device__ bool next(int i, Unit& u) const {
        const long L = (long)i * G + c; if (L >= nwg) return false;
        int wgid = (int)L; { const int q = nwg / NXCD, r = nwg % NXCD, xcd = wgid % NXCD, off = wgid / NXCD; wgid = (xcd < r ? xcd * (q + 1) : r * (q + 1) + (xcd - r) * q) + off; }
        const int nig = WGM * nN, gid = wgid / nig, fm = gid * WGM, gsz = (nM - fm) < WGM ? (nM - fm) : WGM;
        u.pm = fm + ((wgid % nig) % gsz); u.pn = (wgid % nig) / gsz; return true;
    }
    __device__ __forceinline__ void a_ready(const Unit&) const {}
    __device__ __forceinline__ void done(const Unit&) const {}
};
__device__ __forceinline__ unsigned cvt_pk_bf16(float lo, float hi) { unsigned r; asm volatile("v_cvt_pk_bf16_f32 %0, %1, %2" : "=v"(r) : "v"(lo), "v"(hi)); return r; }
template <class Epi, class Sched, bool STAMP = false>
__device__ __forceinline__ void gemm_phase(PG8_LAS unsigned char* lds, const Gemm g, const Sched& S, const Epi& E, unsigned long long* stamps) {
    const int tid = otid(), wid = __builtin_amdgcn_readfirstlane(tid >> 6), lane = tid & 63, wr = wid >> 2, wc = wid & 3, fr = lane & 15, fq = lane >> 4;
    const int K = g.K, nt = K / BK;
    int ts_lo = 0, ts_hi = 0, nts = 0; const unsigned long long rt_entry = STAMP ? (unsigned long long)wall_clock64() : 0ull;
#define PG8_STAMP() do { if (STAMP && wid == 0 && nts < 64) { const unsigned long long _c = (unsigned long long)clock64(); \
        ts_lo = (lane == nts) ? (int)(unsigned)_c : ts_lo; ts_hi = (lane == nts) ? (int)(unsigned)(_c >> 32) : ts_hi; ++nts; } } while (0)
    PG8_STAMP();
    unsigned voffA[2], voffB[2];
#pragma unroll
    for (int i = 0; i < 2; ++i) { int R, C; stage_rc(tid * 16 + i * 8192, R, C); const int Rb = Epi::PERM ? ((R & ~31) + perm32(R & 31)) : R;
        voffA[i] = (unsigned)(R * K + C) * 2u; voffB[i] = (unsigned)(Rb * K + C) * 2u; }
    const size_t kstep = (size_t)(BK * 2);
    const size_t hstep = (size_t)HALF * K * 2;
    const size_t tstep = 2 * hstep;
    const unsigned ldsw = (unsigned)wid * 1024u;
    const int aoff = lds_byte(wr * 64 + fr, fq * 8), boff = lds_byte(wc * 32 + fr, fq * 8);
#define PG8_SA(b, h) (((b) * 2 + (h)) * HTB)
#define PG8_SB(b, h) ((4 + (b) * 2 + (h)) * HTB)
#define PG8_STAGE(bufoff, gbase, voff) do { _Pragma("unroll") for (int _i = 0; _i < 2; ++_i) \
        __builtin_amdgcn_global_load_lds((const unsigned*)((const char*)(gbase) + (voff)[_i]), (PG8_LAS unsigned*)(lds + (bufoff) + ldsw + _i * 8192), 16, 0, 0); } while (0)
#define PG8_LDA(dst, b, h) do { _Pragma("unroll") for (int m = 0; m < 4; ++m) _Pragma("unroll") for (int k = 0; k < 2; ++k) dst[m][k] = *(const PG8_LAS bf16x8*)(lds + PG8_SA(b, h) + aoff + m * 2048 + k * 1024); } while (0)
#define PG8_LDB(dst, b, h) do { _Pragma("unroll") for (int n = 0; n < 2; ++n) _Pragma("unroll") for (int k = 0; k < 2; ++k) dst[n][k] = *(const PG8_LAS bf16x8*)(lds + PG8_SB(b, h) + boff + n * 2048 + k * 1024); } while (0)
#define PG8_MMA(ai, bj, At, Bt) do { __builtin_amdgcn_s_setprio(1); _Pragma("unroll") for (int m = 0; m < 4; ++m) _Pragma("unroll") for (int n = 0; n < 2; ++n) _Pragma("unroll") for (int k = 0; k < 2; ++k) \
        acc[ai][bj][m][n] = __builtin_amdgcn_mfma_f32_16x16x32_bf16(Bt[n][k], At[m][k], acc[ai][bj][m][n], 0, 0, 0); __builtin_amdgcn_s_setprio(0); } while (0)
#define PG8_WAIT_V(n) asm volatile("s_waitcnt vmcnt(" #n ")" ::: "memory")
#define PG8_WAIT_L(n) asm volatile("s_waitcnt lgkmcnt(" #n ")" ::: "memory")
#define PG8_BAR __builtin_amdgcn_s_barrier()
#define PG8_SCHED __builtin_amdgcn_sched_barrier(0)
    Unit cur, nxt; int ui = 0;
    if (!S.next(0, cur)) return;
    f32x4 acc[2][2][4][2];
#pragma unroll
    for (int a = 0; a < 2; ++a)
#pragma unroll
        for (int b = 0; b < 2; ++b)
#pragma unroll
            for (int m = 0; m < 4; ++m)
#pragma unroll
                for (int n = 0; n < 2; ++n) acc[a][b][m][n] = (f32x4){0.f, 0.f, 0.f, 0.f};
    bf16x8 At[4][2], B0[2][2], B1[2][2];
    const char* cA = (const char*)g.A + (size_t)cur.pm * tstep; const char* cB = (const char*)g.Bt + (size_t)cur.pn * tstep;
    S.a_ready(cur);
    PG8_STAGE(PG8_SB(0, 0), cB, voffB); PG8_STAGE(PG8_SA(0, 0), cA, voffA); PG8_STAGE(PG8_SB(0, 1), cB + hstep, voffB); PG8_STAGE(PG8_SA(0, 1), cA + hstep, voffA);
    if (wr == 1) PG8_BAR;
    PG8_WAIT_V(4); PG8_BAR;
    PG8_STAGE(PG8_SB(1, 0), cB + kstep, voffB); PG8_STAGE(PG8_SA(1, 0), cA + kstep, voffA); PG8_STAGE(PG8_SB(1, 1), cB + hstep + kstep, voffB);
    PG8_WAIT_V(6); PG8_BAR;
    PG8_STAMP();
    for (;;) {
        const bool has_next = S.next(ui + 1, nxt);
        const char* nA = has_next ? (const char*)g.A + (size_t)nxt.pm * tstep : cA; const char* nB = has_next ? (const char*)g.Bt + (size_t)nxt.pn * tstep : cB;
        for (int t = 0; t < nt; t += 2) {
            const bool last = (t == nt - 2);
            const char* a1 = cA + (size_t)(t + 1) * kstep;
            const char* a2 = last ? nA : cA + (size_t)(t + 2) * kstep; const char* b2 = last ? nB : cB + (size_t)(t + 2) * kstep;
            const char* a3 = a2 + kstep; const char* b3 = b2 + kstep;
            if (last && has_next) S.a_ready(nxt);
            PG8_LDB(B0, 0, 0); PG8_SCHED; PG8_LDA(At, 0, 0); PG8_STAGE(PG8_SA(1, 1), a1 + hstep, voffA);
            PG8_WAIT_L(8); PG8_BAR; PG8_WAIT_L(0); PG8_MMA(0, 0, At, B0); PG8_BAR; PG8_SCHED;
            PG8_LDB(B1, 0, 1); PG8_STAGE(PG8_SB(0, 0), b2, voffB);
            PG8_BAR; PG8_WAIT_L(0); PG8_MMA(0, 1, At, B1); PG8_BAR;
            PG8_LDA(At, 0, 1); PG8_STAGE(PG8_SA(0, 0), a2, voffA);
            PG8_BAR; PG8_WAIT_L(0); PG8_MMA(1, 0, At, B0); PG8_BAR; PG8_SCHED;
            PG8_STAGE(PG8_SB(0, 1), b2 + hstep, voffB);
            PG8_WAIT_V(6); PG8_BAR; PG8_MMA(1, 1, At, B1); PG8_BAR;
            PG8_LDB(B0, 1, 0); PG8_SCHED; PG8_LDA(At, 1, 0); PG8_STAGE(PG8_SA(0, 1), a2 + hstep, voffA);
            PG8_WAIT_L(8); PG8_BAR; PG8_WAIT_L(0); PG8_MMA(0, 0, At, B0); PG8_BAR; PG8_SCHED;
            PG8_LDB(B1, 1, 1); PG8_STAGE(PG8_SB(1, 0), b3, voffB);
            PG8_BAR; PG8_WAIT_L(0); PG8_MMA(0, 1, At, B1); PG8_BAR;
            PG8_LDA(At, 1, 1); PG8_STAGE(PG8_SA(1, 0), a3, voffA);
            PG8_BAR; PG8_WAIT_L(0); PG8_MMA(1, 0, At, B0); PG8_BAR; PG8_SCHED;
            PG8_STAGE(PG8_SB(1, 1), b3 + hstep, voffB);
            PG8_WAIT_V(6); PG8_BAR; PG8_MMA(1, 1, At, B1); PG8_BAR;
        }
        PG8_STAMP();
        if constexpr (!Epi::AFTER_DRAIN) { E(acc, cur, wr, wc, fr, fq); S.done(cur); }
        PG8_STAMP();
        if (!has_next) break;
#pragma unroll
        for (int a = 0; a < 2; ++a)
#pragma unroll
            for (int b = 0; b < 2; ++b)
#pragma unroll
                for (int m = 0; m < 4; ++m)
#pragma unroll
                    for (int n = 0; n < 2; ++n) acc[a][b][m][n] = (f32x4){0.f, 0.f, 0.f, 0.f};
        cur = nxt; cA = nA; cB = nB; ++ui;
    }
    PG8_WAIT_V(0);
    if (wr == 0) PG8_BAR;
    PG8_BAR;
    if constexpr (Epi::AFTER_DRAIN) { E.fused(acc, cur, wr, wc, fr, fq, lds, wid, lane); S.done(cur); }
    PG8_STAMP();
    if (STAMP && wid == 0) { stamps[lane] = lane < nts ? (((unsigned long long)(unsigned)ts_hi << 32) | (unsigned)ts_lo) : 0ull;
        if (lane == 62) stamps[62] = rt_entry; if (lane == 63) stamps[63] = (unsigned long long)wall_clock64(); }
#undef PG8_STAMP
#undef PG8_SA
#undef PG8_SB
#undef PG8_STAGE
#undef PG8_LDA
#undef PG8_LDB
#undef PG8_MMA
#undef PG8_WAIT_V
#undef PG8_WAIT_L
#undef PG8_BAR
#undef PG8_SCHED
}
}

using pg8::bf16_t; using pg8::bf16x8; using pg8::f32x4; using pg8::u32x4;
typedef float f32x16 __attribute__((ext_vector_type(16)));
typedef _Float16 h16x2 __attribute__((ext_vector_type(2)));
typedef unsigned u32x2 __attribute__((ext_vector_type(2)));
#define LAS __attribute__((address_space(3)))

constexpr int NTOK = 17408, NLAT = 16384, DM = 1024, NTH = 512;
constexpr float EPSF = 1e-6f;
constexpr float HSCALE = 64.f;

constexpr size_t SZ_H = (size_t)NTOK * 1024 * 2;
constexpr size_t OFF_X = 0;
constexpr size_t OFF_WIN = OFF_X + SZ_H;
constexpr size_t OFF_WBHY = OFF_WIN + (size_t)8448 * 1024 * 2;
constexpr size_t OFF_WBGLA = OFF_WBHY + 2097152;
constexpr size_t OFF_WOUT = OFF_WBGLA + 2097152;
constexpr size_t OFF_W1 = OFF_WOUT + 2097152;
constexpr size_t OFF_W2 = OFF_W1 + 8388608;
constexpr size_t OFF_XT = OFF_W2 + 8388608;
constexpr size_t SZ_XT = (size_t)4096 * NTOK * 2;
constexpr size_t OFF_PB = OFF_XT + SZ_XT;
constexpr size_t OFF_LR = OFF_PB + SZ_XT;
constexpr size_t OFF_QF = OFF_LR + (size_t)NTOK * 32 * 4;
constexpr size_t SZ_Q = (size_t)NTOK * 512 * 2;
constexpr size_t OFF_QB = OFF_QF + SZ_Q;
constexpr size_t OFF_KEF = OFF_QB + SZ_Q;
constexpr size_t OFF_KEB = OFF_KEF + SZ_Q;
constexpr size_t OFF_ATT = OFF_KEB + SZ_Q;
constexpr size_t OFF_DEC = OFF_ATT + SZ_Q;
constexpr size_t OFF_HP = OFF_DEC + (size_t)272 * 4 * 2 * 128 * 4;
constexpr size_t OFF_CTXS = OFF_HP + (size_t)1024 * 8192 * 4;
constexpr size_t OFF_MOD = OFF_CTXS + 4194304;
constexpr size_t OFF_A2L = OFF_MOD + 491520;
constexpr size_t OFF_A2C = OFF_A2L + 4194304;
constexpr size_t OFF_HTC = OFF_A2C + 262144;
constexpr size_t OFF_CNT = OFF_HTC + 2097152;
constexpr size_t WS_TOTAL = OFF_CNT + 1024;

struct Params {
  const float *x, *c, *ctx, *c_ctx, *ada_w, *ada_b, *norm1_g, *norm2_g, *w_in, *conv_w, *conv_b, *fw1, *fb1, *fw2, *fb2, *fw3, *ffreq,
      *decay, *skip, *gate_w, *gate_b, *gla_ng, *w_bhy, *w_bgla, *w_out, *mlp_w1, *mlp_w2, *final_g;
  float* out; unsigned char* ws;
};

DI bf16_t f2bf(float f) { unsigned u = __float_as_uint(f); u += 0x7FFFu + ((u >> 16) & 1u); return (bf16_t)(u >> 16); }
DI float bf2f(bf16_t b) { return __uint_as_float(((unsigned)b) << 16); }
DI unsigned pk2(float lo, float hi) { return (unsigned)f2bf(lo) | ((unsigned)f2bf(hi) << 16); }
DI float bflo(unsigned w) { return __uint_as_float(w << 16); }
DI float bfhi(unsigned w) { return __uint_as_float(w & 0xffff0000u); }
DI float sigm(float x) { return __builtin_amdgcn_rcpf(1.f + __expf(-x)); }
DI float my_sin(float x) { float r = x * 0.15915494309189535f; r -= rintf(r); return __builtin_amdgcn_sinf(r); }
DI float wave_sum(float v) {
#pragma unroll
  for (int o = 32; o >= 1; o >>= 1) v += __shfl_xor(v, o);
  return v;
}
DI float* xrow(const Params& p, int row) { return row < NLAT ? p.out + (size_t)row * DM : (float*)(p.ws + OFF_CTXS) + (size_t)(row - NLAT) * DM; }
DI const float* modp(const Params& p, int l, int s) { return (const float*)(p.ws + OFF_MOD) + ((size_t)l * 5 + s) * 6144; }

DI void phase_copy(const Params& p) {
  const size_t n4 = (size_t)NLAT * DM / 4, c4 = (size_t)1024 * DM / 4;
  const float4* s = (const float4*)p.x; float4* d = (float4*)p.out;
  for (size_t i = (size_t)blockIdx.x * NTH + otid(); i < n4; i += (size_t)gridDim.x * NTH) d[i] = s[i];
  const float4* s2 = (const float4*)p.ctx; float4* d2 = (float4*)(p.ws + OFF_CTXS);
  for (size_t i = (size_t)blockIdx.x * NTH + otid(); i < c4; i += (size_t)gridDim.x * NTH) d2[i] = s2[i];
  if (blockIdx.x == 0 && otid() < 64) ((unsigned*)(p.ws + OFF_CNT))[otid()] = 0u;
}

DI void phase_mod(const Params& p, LAS unsigned char* lds) {
  LAS float* sv = (LAS float*)lds;
  LAS float* red = sv + 5 * 1024;
  const int tid = otid();
  bool loaded = false;
  for (int it = blockIdx.x; it < 4 * 48; it += gridDim.x) {
    if (!loaded) {
      for (int i = tid; i < 5 * 1024; i += NTH) { const int s = i >> 10, k = i & 1023; const float v = s < 4 ? p.c[s * 1024 + k] : p.c_ctx[k]; sv[i] = v * sigm(v); }
      loaded = true;
    }
    __syncthreads();
    const int l = it / 48, cb = it % 48, col = cb * 128 + (tid & 127), kq = tid >> 7;
    const float* W = p.ada_w + (size_t)l * 1024 * 6144 + col;
    float a0 = 0, a1 = 0, a2 = 0, a3 = 0, a4 = 0;
#pragma unroll 8
    for (int k = kq * 256; k < kq * 256 + 256; ++k) { const float w = W[(size_t)k * 6144]; a0 += sv[k] * w; a1 += sv[1024 + k] * w; a2 += sv[2048 + k] * w; a3 += sv[3072 + k] * w; a4 += sv[4096 + k] * w; }
    LAS float* r = red + kq * 5 * 128 + (tid & 127);
    r[0] = a0; r[128] = a1; r[256] = a2; r[384] = a3; r[512] = a4;
    __syncthreads();
    if (tid < 128) {
      const float bias = p.ada_b[l * 6144 + col];
      float* mo = (float*)(p.ws + OFF_MOD) + (size_t)l * 5 * 6144 + col;
#pragma unroll
      for (int s = 0; s < 5; ++s) { float t = bias; for (int q = 0; q < 4; ++q) t += red[q * 5 * 128 + s * 128 + tid]; mo[(size_t)s * 6144] = t; }
    }
    __syncthreads();
  }
}

DI void phase_a2(const Params& p, LAS unsigned char* lds) {
  LAS float* zf = (LAS float*)lds;
  LAS float* a1s = zf + 8 * 36;
  const int tid = otid(), tl = tid >> 6, m = tid & 63;
  const int per = (4096 + 256) / 8;
  for (int it = blockIdx.x; it < 4 * per; it += gridDim.x) {
    const int l = it / per, r = it % per;
    const bool isc = r >= 512; const int Lq = isc ? 256 : 4096; const int i = (isc ? (r - 512) : r) * 8 + tl;
    if (m < 33) {
      float f;
      if (m == 0) f = (float)i / (float)(Lq - 1);
      else { const int j = (m - 1) & 15; const float band = 1e-4f + (float)j * ((15.f - 1e-4f) / 15.f); float rev = (float)i * band / (float)Lq; rev -= floorf(rev);
             f = (m <= 16) ? __builtin_amdgcn_cosf(rev) : -__builtin_amdgcn_sinf(rev); }
      zf[tl * 36 + m] = f;
    }
    __syncthreads();
    const float fr = p.ffreq[l * 64 + m];
    { const float* w1 = p.fw1 + (size_t)l * 33 * 64 + m; float acc = p.fb1[l * 64 + m];
#pragma unroll
      for (int f = 0; f < 33; ++f) acc += zf[tl * 36 + f] * w1[f * 64];
      a1s[tl * 64 + m] = my_sin(fr * acc); }
    __syncthreads();
    { const float* w2 = p.fw2 + (size_t)l * 64 * 64 + m; float acc = p.fb2[l * 64 + m];
#pragma unroll 16
      for (int j = 0; j < 64; ++j) acc += a1s[tl * 64 + j] * w2[j * 64];
      float* dst = isc ? (float*)(p.ws + OFF_A2C) + ((size_t)l * 256 + i) * 64 : (float*)(p.ws + OFF_A2L) + ((size_t)l * 4096 + i) * 64;
      dst[m] = my_sin(fr * acc); }
    __syncthreads();
  }
}

DI void wt_tile(const float* src, int ld_src, int k0, int n0, bf16_t* dst, int ld_dst, int drow0, LAS unsigned char* lds) {
  LAS bf16_t* t = (LAS bf16_t*)lds;
  const int tid = otid();
#pragma unroll
  for (int q = 0; q < 2; ++q) {
    const int kk = (tid >> 3) + 64 * q, nq = tid & 7;
    const float4 v = *(const float4*)(src + (size_t)(k0 + kk) * ld_src + n0 + 4 * nq);
    t[(4 * nq + 0) * 136 + kk] = f2bf(v.x); t[(4 * nq + 1) * 136 + kk] = f2bf(v.y); t[(4 * nq + 2) * 136 + kk] = f2bf(v.z); t[(4 * nq + 3) * 136 + kk] = f2bf(v.w);
  }
  __syncthreads();
  { const int n = tid >> 4, kq = tid & 15;
    const u32x4 v = *(const LAS u32x4*)(t + n * 136 + 8 * kq);
    *(u32x4*)(dst + (size_t)(drow0 + n) * ld_dst + k0 + 8 * kq) = v; }
  __syncthreads();
}
DI int win_dst_row(int n) {
  if (n < 3072) return n;
  if (n < 4096) return 4096 + (n - 3072);
  if (n < 5120) return 3072 + (n - 4096);
  if (n < 6144) return 4096 + 1024 + (n - 5120);
  if (n < 6176) return 8192 + (n - 6144);
  if (n < 7200) return 4096 + 2048 + (n - 6176);
  return 4096 + 3072 + (n - 7200);
}
DI void phase_wconv(const Params& p, int l, LAS unsigned char* lds) {
  unsigned char* ws = p.ws;
  const int n_win = 8 * 257, n_sq = 8 * 32, n_w1 = 8 * 128, n_w2 = 32 * 32;
  const int total = n_win + 3 * n_sq + n_w1 + n_w2;
  for (int it = blockIdx.x; it < total; it += gridDim.x) {
    int r = it;
    if (r < n_win) { const int kt = r & 7, nt = r >> 3; wt_tile(p.w_in + (size_t)l * 1024 * 8224, 8224, kt * 128, nt * 32, (bf16_t*)(ws + OFF_WIN), 1024, win_dst_row(nt * 32), lds); continue; }
    r -= n_win;
    if (r < 3 * n_sq) { const int which = r / n_sq, q = r % n_sq, kt = q & 7, nt = q >> 3;
      const float* src = (which == 0 ? p.w_bhy : which == 1 ? p.w_bgla : p.w_out) + (size_t)l * 1024 * 1024;
      bf16_t* dst = (bf16_t*)(ws + (which == 0 ? OFF_WBHY : which == 1 ? OFF_WBGLA : OFF_WOUT));
      wt_tile(src, 1024, kt * 128, nt * 32, dst, 1024, nt * 32, lds); continue; }
    r -= 3 * n_sq;
    if (r < n_w1) { const int kt = r & 7, nt = r >> 3; wt_tile(p.mlp_w1 + (size_t)l * 1024 * 4096, 4096, kt * 128, nt * 32, (bf16_t*)(ws + OFF_W1), 1024, nt * 32, lds); continue; }
    r -= n_w1;
    { const int kt = r & 31, nt = r >> 5; wt_tile(p.mlp_w2 + (size_t)l * 4096 * 1024, 1024, kt * 128, nt * 32, (bf16_t*)(ws + OFF_W2), 4096, nt * 32, lds); }
  }
  { u32x4* z = (u32x4*)(ws + OFF_WIN + (size_t)8224 * 1024 * 2); const int n = 224 * 1024 * 2 / 16;
    for (int i = blockIdx.x * NTH + otid(); i < n; i += gridDim.x * NTH) z[i] = (u32x4){0u, 0u, 0u, 0u}; }
}

DI void phase_norm(const Params& p, int l, const float* g, int sh_off, int sc_off, int nrows) {
  const int lane = otid() & 63, gw = blockIdx.x * 8 + (otid() >> 6), nw = gridDim.x * 8;
  bf16_t* hb = (bf16_t*)(p.ws + OFF_X);
  for (int row = gw; row < nrows; row += nw) {
    const float* xr = xrow(p, row);
    float4 v[4]; float ss = 0.f;
#pragma unroll
    for (int i = 0; i < 4; ++i) { v[i] = *(const float4*)(xr + 4 * lane + 256 * i); ss += v[i].x * v[i].x + v[i].y * v[i].y + v[i].z * v[i].z + v[i].w * v[i].w; }
    ss = wave_sum(ss);
    const float rstd = rsqrtf(ss * (1.f / 1024.f) + EPSF);
    const float* mo = modp(p, l, row < NLAT ? (row >> 12) : 4);
#pragma unroll
    for (int i = 0; i < 4; ++i) {
      const int c = 4 * lane + 256 * i;
      const float4 gg = *(const float4*)(g + c), sc = *(const float4*)(mo + sc_off + c), sh = *(const float4*)(mo + sh_off + c);
      const float y0 = v[i].x * rstd * gg.x * (1.f + sc.x) + sh.x, y1 = v[i].y * rstd * gg.y * (1.f + sc.y) + sh.y;
      const float y2 = v[i].z * rstd * gg.z * (1.f + sc.z) + sh.z, y3 = v[i].w * rstd * gg.w * (1.f + sc.w) + sh.w;
      *(u32x2*)(hb + (size_t)row * 1024 + c) = (u32x2){pk2(y0, y1), pk2(y2, y3)};
    }
  }
}
DI void phase_final_norm(const Params& p) {
  const int lane = otid() & 63, gw = blockIdx.x * 8 + (otid() >> 6), nw = gridDim.x * 8;
  for (int row = gw; row < NLAT; row += nw) {
    float* xr = p.out + (size_t)row * DM;
    float4 v[4]; float ss = 0.f;
#pragma unroll
    for (int i = 0; i < 4; ++i) { v[i] = *(const float4*)(xr + 4 * lane + 256 * i); ss += v[i].x * v[i].x + v[i].y * v[i].y + v[i].z * v[i].z + v[i].w * v[i].w; }
    ss = wave_sum(ss);
    const float rstd = rsqrtf(ss * (1.f / 1024.f) + EPSF);
#pragma unroll
    for (int i = 0; i < 4; ++i) { const int c = 4 * lane + 256 * i; const float4 gg = *(const float4*)(p.final_g + c);
      *(float4*)(xr + c) = make_float4(v[i].x * rstd * gg.x, v[i].y * rstd * gg.y, v[i].z * rstd * gg.z, v[i].w * rstd * gg.w); }
  }
}

DI void phase_filt_gemm(const Params& p, int l, LAS unsigned char* lds) {
  LAS float* w3s = (LAS float*)lds;
  LAS float* a2s = w3s + 64 * 64;
  const int tid = otid();
  const int nL = 32 * 32, nC = 32 * 2;
  for (int it = blockIdx.x; it < nL + nC; it += gridDim.x) {
    const bool isc = it >= nL; const int r = isc ? it - nL : it; const int Lq = isc ? 256 : 4096;
    const int ntt = Lq / 128, dt = r / ntt, tt0 = (r % ntt) * 128, d0 = dt * 64;
    const float* A2 = isc ? (const float*)(p.ws + OFF_A2C) + (size_t)l * 256 * 64 : (const float*)(p.ws + OFF_A2L) + (size_t)l * 4096 * 64;
    float* hT = isc ? (float*)(p.ws + OFF_HTC) : (float*)(p.ws + OFF_XT);
    { const int m = tid >> 3, q = tid & 7; const float* s = p.fw3 + ((size_t)l * 64 + m) * 2048 + d0;
      *(LAS f32x4*)(w3s + m * 64 + 4 * q) = *(const f32x4*)(s + 4 * q); *(LAS f32x4*)(w3s + m * 64 + 32 + 4 * q) = *(const f32x4*)(s + 32 + 4 * q); }
    { const int tt = tid >> 2, mq = tid & 3; const float* s = A2 + (size_t)(tt0 + tt) * 64 + 16 * mq;
#pragma unroll
      for (int q = 0; q < 4; ++q) { const float4 v = *(const float4*)(s + 4 * q);
        a2s[(16 * mq + 4 * q + 0) * 132 + tt] = v.x; a2s[(16 * mq + 4 * q + 1) * 132 + tt] = v.y; a2s[(16 * mq + 4 * q + 2) * 132 + tt] = v.z; a2s[(16 * mq + 4 * q + 3) * 132 + tt] = v.w; } }
    __syncthreads();
    const int cx = tid & 15, ty = tid >> 4;
    float acc[4][4];
#pragma unroll
    for (int a = 0; a < 4; ++a)
#pragma unroll
      for (int b = 0; b < 4; ++b) acc[a][b] = 0.f;
#pragma unroll 8
    for (int m = 0; m < 64; ++m) {
      const f32x4 wv = *(const LAS f32x4*)(w3s + m * 64 + 4 * cx), av = *(const LAS f32x4*)(a2s + m * 132 + 4 * ty);
      const float w[4] = {wv.x, wv.y, wv.z, wv.w}, a[4] = {av.x, av.y, av.z, av.w};
#pragma unroll
      for (int ci = 0; ci < 4; ++ci)
#pragma unroll
        for (int ti = 0; ti < 4; ++ti) acc[ci][ti] += w[ci] * a[ti];
    }
    const float inv = 1.f / (float)(Lq - 1);
#pragma unroll
    for (int ci = 0; ci < 4; ++ci) {
      const int dirch = d0 + 4 * cx + ci; const float dc = fabsf(p.decay[l * 1024 + (dirch & 1023)]);
      float o[4];
#pragma unroll
      for (int ti = 0; ti < 4; ++ti) { const float tl = (float)(tt0 + 4 * ty + ti) * inv; o[ti] = acc[ci][ti] * __expf(-tl * dc); }
      *(float4*)(hT + (size_t)dirch * Lq + tt0 + 4 * ty) = make_float4(o[0], o[1], o[2], o[3]);
    }
    __syncthreads();
  }
}

typedef float cplx __attribute__((ext_vector_type(2)));
DI cplx mk2(float a, float b) { cplx r; r.x = a; r.y = b; return r; }
DI constexpr float cos32(int m) { constexpr float t[16] = {1.f, 0.98078528040323043f, 0.92387953251128674f, 0.83146961230254524f, 0.70710678118654752f, 0.55557023301960218f, 0.38268343236508977f, 0.19509032201612825f,
    0.f, -0.19509032201612825f, -0.38268343236508977f, -0.55557023301960218f, -0.70710678118654752f, -0.83146961230254524f, -0.92387953251128674f, -0.98078528040323043f}; return t[m]; }
DI constexpr float sin32(int m) { constexpr float t[16] = {0.f, 0.19509032201612825f, 0.38268343236508977f, 0.55557023301960218f, 0.70710678118654752f, 0.83146961230254524f, 0.92387953251128674f, 0.98078528040323043f,
    1.f, 0.98078528040323043f, 0.92387953251128674f, 0.83146961230254524f, 0.70710678118654752f, 0.55557023301960218f, 0.38268343236508977f, 0.19509032201612825f}; return t[m]; }
DI constexpr int brev(int k, int bits) { int r = 0; for (int i = 0; i < bits; ++i) r |= ((k >> i) & 1) << (bits - 1 - i); return r; }
DI cplx cmul(cplx a, cplx b) { return mk2(a.x * b.x - a.y * b.y, a.x * b.y + a.y * b.x); }
DI cplx cmulc(cplx a, cplx b) { return mk2(a.x * b.x + a.y * b.y, a.y * b.x - a.x * b.y); }

template <int R, bool INV> DI void dft_reg(cplx (&v)[R]) {
#pragma unroll
  for (int len = R; len >= 2; len >>= 1) {
    const int half = len >> 1;
#pragma unroll
    for (int s = 0; s < R; s += len) {
#pragma unroll
      for (int j = 0; j < half; ++j) {
        const cplx a = v[s + j], b = v[s + j + half];
        v[s + j] = mk2(a.x + b.x, a.y + b.y);
        const cplx d = mk2(a.x - b.x, a.y - b.y);
        const int m = j * (32 / len);
        if (m == 0) v[s + j + half] = d;
        else if (m == 8) v[s + j + half] = INV ? mk2(-d.y, d.x) : mk2(d.y, -d.x);
        else { const float c = cos32(m), sn = sin32(m);
          v[s + j + half] = INV ? mk2(d.x * c - d.y * sn, d.x * sn + d.y * c) : mk2(d.x * c + d.y * sn, d.y * c - d.x * sn); }
      }
    }
  }
}
constexpr int FFT_REGION_F2 = 8704;

DI void fft_fwd3(cplx (&v)[16], LAS cplx* L, int tid) {
  dft_reg<16, false>(v);
  { const float rev = (float)tid * (1.f / 8192.f); const cplx w1 = mk2(__builtin_amdgcn_cosf(rev), -__builtin_amdgcn_sinf(rev)); cplx w = mk2(1.f, 0.f);
    const int pb = tid + 2 * (tid >> 5);
#pragma unroll
    for (int k = 0; k < 16; ++k) { L[pb + 544 * k] = cmul(v[brev(k, 4)], w); w = cmul(w, w1); } }
  __syncthreads();
  { const int sb = tid >> 5, ii = tid & 31, pb = 544 * sb + ii;
    cplx u[16];
#pragma unroll
    for (int j = 0; j < 16; ++j) u[j] = L[pb + 34 * j];
    dft_reg<16, false>(u);
    const float rev = (float)ii * (1.f / 512.f); const cplx w1 = mk2(__builtin_amdgcn_cosf(rev), -__builtin_amdgcn_sinf(rev)); cplx w = mk2(1.f, 0.f);
#pragma unroll
    for (int k = 0; k < 16; ++k) { L[pb + 34 * k] = cmul(u[brev(k, 4)], w); w = cmul(w, w1); } }
  __syncthreads();
  { const int sb = tid >> 1, ii = tid & 1, pb = 34 * sb + ii;
    cplx u[16];
#pragma unroll
    for (int j = 0; j < 16; ++j) u[j] = L[pb + 2 * j];
    dft_reg<16, false>(u);
#pragma unroll
    for (int k = 0; k < 16; ++k) { const cplx y = u[brev(k, 4)]; const cplx yw = cmul(y, mk2(cos32(k), -sin32(k))); L[pb + 2 * k] = ii ? yw : y; } }
  __syncthreads();
}
DI void fft_inv3(cplx (&v)[16], LAS cplx* L, int tid) {
  { const int sb = tid >> 1, ii = tid & 1, pb = 34 * sb + ii;
    cplx u[16];
#pragma unroll
    for (int k = 0; k < 16; ++k) { const cplx y = L[pb + 2 * k]; const cplx yw = cmulc(y, mk2(cos32(k), -sin32(k))); u[k] = ii ? yw : y; }
    dft_reg<16, true>(u);
#pragma unroll
    for (int j = 0; j < 16; ++j) L[pb + 2 * j] = u[brev(j, 4)]; }
  __syncthreads();
  { const int sb = tid >> 5, ii = tid & 31, pb = 544 * sb + ii;
    cplx u[16];
    const float rev = (float)ii * (1.f / 512.f); const cplx w1 = mk2(__builtin_amdgcn_cosf(rev), -__builtin_amdgcn_sinf(rev)); cplx w = mk2(1.f, 0.f);
#pragma unroll
    for (int k = 0; k < 16; ++k) { u[k] = cmulc(L[pb + 34 * k], w); w = cmul(w, w1); }
    dft_reg<16, true>(u);
#pragma unroll
    for (int j = 0; j < 16; ++j) L[pb + 34 * j] = u[brev(j, 4)]; }
  __syncthreads();
  { const float rev = (float)tid * (1.f / 8192.f); const cplx w1 = mk2(__builtin_amdgcn_cosf(rev), -__builtin_amdgcn_sinf(rev)); cplx w = mk2(1.f, 0.f);
    const int pb = tid + 2 * (tid >> 5);
#pragma unroll
    for (int k = 0; k < 16; ++k) { v[k] = cmulc(L[pb + 544 * k], w); w = cmul(w, w1); }
    dft_reg<16, true>(v); }
}

DI void phase_filt_fft(const Params& p, LAS unsigned char* lds) {
  const int tid = otid();
  LAS cplx* L = (LAS cplx*)lds;
  const float* hT = (const float*)(p.ws + OFF_XT);
  h16x2* HP = (h16x2*)(p.ws + OFF_HP);
  for (int c = blockIdx.x; c < 1024; c += gridDim.x) {
    cplx v[16];
    const float* hf = hT + (size_t)c * 4096, * hbk = hT + (size_t)(1024 + c) * 4096;
#pragma unroll
    for (int j = 0; j < 8; ++j) v[j] = mk2(hf[tid + 512 * j], 0.f);
#pragma unroll
    for (int j = 8; j < 16; ++j) { const int n = tid + 512 * j; v[j] = mk2(n == 4096 ? 0.f : hbk[n == 4096 ? 0 : 8192 - n], 0.f); }
    fft_fwd3(v, L, tid);
    { const int pb = 16 * tid + 2 * (tid >> 1);
      h16x2* dst = HP + (size_t)c * 8192 + 16 * tid;
#pragma unroll
      for (int m = 0; m < 8; ++m) { const cplx a = L[pb + 2 * m], b = L[pb + 2 * m + 1];
        h16x2 h0, h1; h0.x = (_Float16)((a.x + b.x) * HSCALE); h0.y = (_Float16)((a.y + b.y) * HSCALE); h1.x = (_Float16)((a.x - b.x) * HSCALE); h1.y = (_Float16)((a.y - b.y) * HSCALE);
        dst[2 * m] = h0; dst[2 * m + 1] = h1; } }
    __syncthreads();
  }
}

DI float shl1(float x, int lane) { const float t = __shfl_up(x, 1); return lane == 0 ? 0.f : t; }
DI float shr1(float x, int lane) { const float t = __shfl_down(x, 1); return lane == 63 ? 0.f : t; }
DI void hyena_item(const Params& p, int l, int item, LAS cplx* L, int tid) {
  bf16_t* XT = (bf16_t*)(p.ws + OFF_XT);
  const int lane = tid & 63;
  const int c = item >> 1, bp = item & 1;
  LAS float* ST = (LAS float*)(L + FFT_REGION_F2) + tid;
  cplx v[16];
  {
    float cw[3][3], cb[3];
#pragma unroll
    for (int g = 0; g < 3; ++g) { cb[g] = p.conv_b[l * 3072 + g * 1024 + c];
#pragma unroll
      for (int t = 0; t < 3; ++t) cw[g][t] = p.conv_w[((size_t)l * 3 + t) * 3072 + g * 1024 + c]; }
#pragma unroll
    for (int j = 0; j < 8; ++j) {
      const int t = tid + 512 * j;
      float uu[2][3];
#pragma unroll
      for (int b = 0; b < 2; ++b)
#pragma unroll
        for (int g = 0; g < 3; ++g) {
          const float pv = bf2f(XT[(size_t)(g * 1024 + c) * NTOK + (size_t)(2 * bp + b) * 4096 + t]);
          uu[b][g] = cw[g][0] * shl1(pv, lane) + cw[g][1] * pv + cw[g][2] * shr1(pv, lane) + cb[g];
        }
      const float za = uu[0][1] * uu[0][2], zb = uu[1][1] * uu[1][2];
      ST[(4 * j + 0) * 512] = uu[0][0]; ST[(4 * j + 1) * 512] = uu[1][0]; ST[(4 * j + 2) * 512] = za; ST[(4 * j + 3) * 512] = zb;
      v[j] = mk2(za, zb);
    }
#pragma unroll
    for (int j = 8; j < 16; ++j) v[j] = mk2(0.f, 0.f);
  }
  fft_fwd3(v, L, tid);
  { const h16x2* HP = (const h16x2*)(p.ws + OFF_HP) + (size_t)c * 8192 + 16 * tid;
    const int pb = 16 * tid + 2 * (tid >> 1);
#pragma unroll
    for (int m = 0; m < 8; ++m) { const cplx a = L[pb + 2 * m], b = L[pb + 2 * m + 1];
      const h16x2 h0 = HP[2 * m], h1 = HP[2 * m + 1];
      const cplx y0 = cmul(mk2(a.x + b.x, a.y + b.y), mk2((float)h0.x, (float)h0.y)), y1 = cmul(mk2(a.x - b.x, a.y - b.y), mk2((float)h1.x, (float)h1.y));
      L[pb + 2 * m] = mk2(y0.x + y1.x, y0.y + y1.y); L[pb + 2 * m + 1] = mk2(y0.x - y1.x, y0.y - y1.y); } }
  __syncthreads();
  fft_inv3(v, L, tid);
  { const float sk = p.skip[l * 1024 + c], sc = 1.f / (8192.f * HSCALE);
#pragma unroll
    for (int j = 0; j < 8; ++j) {
      const int t = tid + 512 * j; const cplx cv = v[brev(j, 4)];
      XT[(size_t)c * NTOK + (size_t)(2 * bp) * 4096 + t] = f2bf(ST[(4 * j + 0) * 512] * (cv.x * sc + sk * ST[(4 * j + 2) * 512]));
      XT[(size_t)c * NTOK + (size_t)(2 * bp + 1) * 4096 + t] = f2bf(ST[(4 * j + 1) * 512] * (cv.y * sc + sk * ST[(4 * j + 3) * 512]));
    } }
  __syncthreads();
}

DI void hyena_ctx_item(const Params& p, int l, int c, LAS unsigned char* lds) {
  LAS float* zs = (LAS float*)lds;
  LAS float* hf = zs + 1024;
  LAS float* hbk = hf + 256;
  bf16_t* XT = (bf16_t*)(p.ws + OFF_XT);
  const float* hTc = (const float*)(p.ws + OFF_HTC);
  const int tid = otid(), b = tid >> 7, tq = tid & 127;
  if (tid < 256) hf[tid] = hTc[(size_t)c * 256 + tid]; else hbk[tid - 256] = hTc[(size_t)(1024 + c) * 256 + (tid - 256)];
  float u0[2], zz[2];
#pragma unroll
  for (int e = 0; e < 2; ++e) {
    const int t = tq + 128 * e;
    float uu[3];
#pragma unroll
    for (int g = 0; g < 3; ++g) {
      const bf16_t* row = XT + (size_t)(g * 1024 + c) * NTOK + NLAT + b * 256;
      const float pm = t > 0 ? bf2f(row[t - 1]) : 0.f, p0 = bf2f(row[t]), pp = t < 255 ? bf2f(row[t + 1]) : 0.f;
      const size_t wb = (size_t)l * 3 * 3072 + g * 1024 + c;
      uu[g] = p.conv_w[wb] * pm + p.conv_w[wb + 3072] * p0 + p.conv_w[wb + 6144] * pp + p.conv_b[l * 3072 + g * 1024 + c];
    }
    u0[e] = uu[0]; zz[e] = uu[1] * uu[2]; zs[b * 256 + t] = zz[e];
  }
  __syncthreads();
  const float sk = p.skip[l * 1024 + c];
#pragma unroll
  for (int e = 0; e < 2; ++e) {
    const int t = tq + 128 * e; float acc = 0.f;
    for (int s = 0; s <= t; ++s) acc += hf[t - s] * zs[b * 256 + s];
    for (int s = t + 1; s < 256; ++s) acc += hbk[s - t] * zs[b * 256 + s];
    XT[(size_t)c * NTOK + NLAT + b * 256 + t] = f2bf(u0[e] * (acc + sk * zz[e]));
  }
  __syncthreads();
}

#define MFMA32(a, b, c) __builtin_amdgcn_mfma_f32_32x32x16_bf16((a), (b), (c), 0, 0, 0)
DI float logsig(float x) { return fminf(x, 0.f) - __logf(1.f + __expf(-fabsf(x))); }
DI void phase_gla_prep(const Params& p, int l, LAS unsigned char* lds) {
  LAS float* lrs = (LAS float*)lds;
  LAS float* tots = lrs + 64 * 32;
  LAS bf16_t* qs = (LAS bf16_t*)(tots + 2 * 4 * 128);
  const int tid = otid(), d = tid & 127, tq = tid >> 7, wid = tid >> 6, lane = tid & 63;
  const bf16_t* PB = (const bf16_t*)(p.ws + OFF_PB);
  const float* LR = (const float*)(p.ws + OFF_LR);
  bf16_t* QF = (bf16_t*)(p.ws + OFF_QF); bf16_t* QB = (bf16_t*)(p.ws + OFF_QB);
  bf16_t* KEF = (bf16_t*)(p.ws + OFF_KEF); bf16_t* KEB = (bf16_t*)(p.ws + OFF_KEB);
  bf16_t* ATT = (bf16_t*)(p.ws + OFF_ATT); float* DEC = (float*)(p.ws + OFF_DEC);
  const float qscale = 0.08838834764831845f;
  for (int it = blockIdx.x; it < 272 * 4; it += gridDim.x) {
    const int chunk = it >> 2, h = it & 3, tok0 = chunk * 64;
    *(LAS f32x4*)(lrs + 4 * tid) = *(const f32x4*)(LR + (size_t)tok0 * 32 + 4 * tid);
    float gwf[16], gwb[16];
#pragma unroll
    for (int r = 0; r < 16; ++r) { gwf[r] = p.gate_w[(((size_t)l * 2 + 0) * 16 + r) * 512 + h * 128 + d]; gwb[r] = p.gate_w[(((size_t)l * 2 + 1) * 16 + r) * 512 + h * 128 + d]; }
    const float gbf = p.gate_b[((size_t)l * 2 + 0) * 512 + h * 128 + d], gbb = p.gate_b[((size_t)l * 2 + 1) * 512 + h * 128 + d];
    __syncthreads();
    float cf[16], cb[16];
#pragma unroll
    for (int i = 0; i < 16; ++i) {
      const int t = tq * 16 + i; float pf = gbf, pb = gbb;
#pragma unroll
      for (int r = 0; r < 16; ++r) { pf += lrs[t * 32 + r] * gwf[r]; pb += lrs[t * 32 + 16 + r] * gwb[r]; }
      cf[i] = logsig(pf) * (1.f / 16.f); cb[i] = logsig(pb) * (1.f / 16.f);
    }
    { float run = 0.f;
#pragma unroll
      for (int i = 0; i < 16; ++i) { run += cf[i]; cf[i] = run; }
      tots[(0 * 4 + tq) * 128 + d] = run; run = 0.f;
#pragma unroll
      for (int i = 15; i >= 0; --i) { run += cb[i]; cb[i] = run; }
      tots[(1 * 4 + tq) * 128 + d] = run; }
    __syncthreads();
    float offf = 0.f, offb = 0.f, cendf = 0.f, cendb = 0.f;
#pragma unroll
    for (int q = 0; q < 4; ++q) { const float a = tots[(0 * 4 + q) * 128 + d], b = tots[(1 * 4 + q) * 128 + d]; cendf += a; cendb += b; if (q < tq) offf += a; if (q > tq) offb += b; }
    const int o16 = d & 15, grp = o16 >> 2, ngrp = (grp == 1) ? 2 : (grp == 2) ? 1 : grp, permd = (d & ~15) | (ngrp << 2) | (o16 & 3);
    unsigned kef[8], keb[8];
#pragma unroll
    for (int i = 0; i < 16; ++i) {
      const int t = tq * 16 + i; const size_t tok = (size_t)tok0 + t;
      const float q = bf2f(PB[tok * 4096 + h * 128 + d]), k = bf2f(PB[tok * 4096 + 512 + h * 128 + d]);
      const float a = cf[i] + offf, b = cb[i] + offb;
      const bf16_t qf = f2bf(q * __expf(a) * qscale), kf = f2bf(k * __expf(-a)), qb = f2bf(q * __expf(b) * qscale), kb = f2bf(k * __expf(-b));
      const bf16_t ef = f2bf(k * __expf(cendf - a)), eb = f2bf(k * __expf(cendb - b));
      qs[(0 * 64 + t) * 136 + d] = qf; qs[(1 * 64 + t) * 136 + d] = kf; qs[(2 * 64 + t) * 136 + d] = qb; qs[(3 * 64 + t) * 136 + d] = kb;
      QF[tok * 512 + h * 128 + permd] = qf; QB[tok * 512 + h * 128 + permd] = qb;
      if (i & 1) { kef[i >> 1] |= (unsigned)ef << 16; keb[i >> 1] |= (unsigned)eb << 16; } else { kef[i >> 1] = ef; keb[i >> 1] = eb; }
    }
    { u32x4* d1 = (u32x4*)(KEF + (((size_t)chunk * 4 + h) * 128 + d) * 64 + tq * 16); d1[0] = (u32x4){kef[0], kef[1], kef[2], kef[3]}; d1[1] = (u32x4){kef[4], kef[5], kef[6], kef[7]};
      u32x4* d2 = (u32x4*)(KEB + (((size_t)chunk * 4 + h) * 128 + d) * 64 + tq * 16); d2[0] = (u32x4){keb[0], keb[1], keb[2], keb[3]}; d2[1] = (u32x4){keb[4], keb[5], keb[6], keb[7]}; }
    if (tq == 0) { DEC[(((size_t)chunk * 4 + h) * 2 + 0) * 128 + d] = __expf(cendf); DEC[(((size_t)chunk * 4 + h) * 2 + 1) * 128 + d] = __expf(cendb); }
    __syncthreads();
    {
      const int dir = wid >> 2, ti = (wid >> 1) & 1, si = wid & 1, r = lane & 31, hh = lane >> 5;
      const LAS bf16_t* ka = qs + ((dir * 2 + 1) * 64 + 32 * si + r) * 136 + 8 * hh;
      const LAS bf16_t* qa = qs + ((dir * 2 + 0) * 64 + 32 * ti + r) * 136 + 8 * hh;
      f32x16 acc;
#pragma unroll
      for (int i = 0; i < 16; ++i) acc[i] = 0.f;
#pragma unroll
      for (int ks = 0; ks < 8; ++ks) acc = MFMA32(*(const LAS bf16x8*)(ka + 16 * ks), *(const LAS bf16x8*)(qa + 16 * ks), acc);
      const int t = 32 * ti + r;
      bf16_t* dst = ATT + ((((size_t)chunk * 4 + h) * 2 + dir) * 64 + t) * 64 + 32 * si + 4 * hh;
#pragma unroll
      for (int g = 0; g < 4; ++g) {
        float vv[4];
#pragma unroll
        for (int e = 0; e < 4; ++e) { const int s = 32 * si + 8 * g + 4 * hh + e; const bool keep = dir ? (s >= t) : (s <= t); vv[e] = keep ? acc[4 * g + e] : 0.f; }
        *(u32x2*)(dst + 8 * g) = (u32x2){pk2(vv[0], vv[1]), pk2(vv[2], vv[3])};
      }
    }
    __syncthreads();
  }
}

DI bf16x8 pack8(const f32x16& x, int s) {
  u32x4 r; r[0] = pk2(x[8 * s + 0], x[8 * s + 1]); r[1] = pk2(x[8 * s + 2], x[8 * s + 3]); r[2] = pk2(x[8 * s + 4], x[8 * s + 5]); r[3] = pk2(x[8 * s + 6], x[8 * s + 7]);
  return __builtin_bit_cast(bf16x8, r);
}
DI void phase_gla_scan(const Params& p, LAS unsigned char* lds) {
  LAS bf16_t* QT = (LAS bf16_t*)lds;
  LAS bf16_t* KE = QT + 64 * 136;
  LAS bf16_t* AT = KE + 128 * 72;
  LAS float* DC = (LAS float*)(AT + 64 * 72);
  const int tid = otid(), wid = tid >> 6, lane = tid & 63, r = lane & 31, hh = lane >> 5;
  const int bid = blockIdx.x, b = bid >> 3, h = (bid >> 1) & 3, dir = bid & 1;
  const bf16_t* Qg = (const bf16_t*)(p.ws + (dir ? OFF_QB : OFF_QF));
  const bf16_t* Kg = (const bf16_t*)(p.ws + (dir ? OFF_KEB : OFF_KEF));
  const bf16_t* ATT = (const bf16_t*)(p.ws + OFF_ATT); const float* DEC = (const float*)(p.ws + OFF_DEC);
  const bf16_t* VT = (const bf16_t*)(p.ws + OFF_XT) + (size_t)(3072 + h * 256 + 32 * wid + r) * NTOK;
  bf16_t* Og = dir ? (bf16_t*)(p.ws + OFF_X) : (bf16_t*)(p.ws + OFF_PB);
  const int ldo = dir ? 1024 : 4096;
  f32x16 S[4];
#pragma unroll
  for (int m = 0; m < 4; ++m)
#pragma unroll
    for (int i = 0; i < 16; ++i) S[m][i] = 0.f;
#pragma unroll 1
  for (int step = 0; step < 68; ++step) {
    const int cidx = step < 4 ? (256 + 4 * b + (dir ? 3 - step : step)) : (64 * b + (dir ? 67 - step : step - 4));
    const size_t tok0 = (size_t)cidx * 64;
    const size_t ch = (size_t)cidx * 4 + h;
#pragma unroll
    for (int q = 0; q < 2; ++q) {
      const int pc = tid + 512 * q;
      { const int row = pc >> 4, cc = pc & 15; *(LAS u32x4*)(QT + row * 136 + 8 * cc) = *(const u32x4*)(Qg + (tok0 + row) * 512 + h * 128 + 8 * cc); }
      { const int row = pc >> 3, cc = pc & 7; *(LAS u32x4*)(KE + row * 72 + 8 * cc) = *(const u32x4*)(Kg + (ch * 128 + row) * 64 + 8 * cc); }
    }
    { const int row = tid >> 3, cc = tid & 7; *(LAS u32x4*)(AT + row * 72 + 8 * cc) = *(const u32x4*)(ATT + ((ch * 2 + dir) * 64 + row) * 64 + 8 * cc); }
    if (tid < 128) DC[tid] = DEC[(ch * 2 + dir) * 128 + tid];
    bf16x8 vf[4];
#pragma unroll
    for (int ks = 0; ks < 4; ++ks) vf[ks] = *(const bf16x8*)(VT + tok0 + 16 * ks + 8 * hh);
    __syncthreads();
    bf16x8 sp[8];
#pragma unroll
    for (int m = 0; m < 4; ++m) { sp[2 * m] = pack8(S[m], 0); sp[2 * m + 1] = pack8(S[m], 1); }
    f32x16 o0, o1;
#pragma unroll
    for (int i = 0; i < 16; ++i) { o0[i] = 0.f; o1[i] = 0.f; }
#pragma unroll
    for (int ks = 0; ks < 4; ++ks) {
      o0 = MFMA32(vf[ks], *(const LAS bf16x8*)(AT + r * 72 + 16 * ks + 8 * hh), o0);
      o1 = MFMA32(vf[ks], *(const LAS bf16x8*)(AT + (32 + r) * 72 + 16 * ks + 8 * hh), o1);
    }
#pragma unroll
    for (int k8 = 0; k8 < 8; ++k8) {
      o0 = MFMA32(sp[k8], *(const LAS bf16x8*)(QT + r * 136 + 16 * k8 + 8 * hh), o0);
      o1 = MFMA32(sp[k8], *(const LAS bf16x8*)(QT + (32 + r) * 136 + 16 * k8 + 8 * hh), o1);
    }
    { bf16_t* d0 = Og + (tok0 + r) * ldo + h * 256 + 32 * wid + 4 * hh; bf16_t* d1 = d0 + (size_t)32 * ldo;
#pragma unroll
      for (int g = 0; g < 4; ++g) {
        *(u32x2*)(d0 + 8 * g) = (u32x2){pk2(o0[4 * g], o0[4 * g + 1]), pk2(o0[4 * g + 2], o0[4 * g + 3])};
        *(u32x2*)(d1 + 8 * g) = (u32x2){pk2(o1[4 * g], o1[4 * g + 1]), pk2(o1[4 * g + 2], o1[4 * g + 3])};
      } }
#pragma unroll
    for (int m = 0; m < 4; ++m) {
#pragma unroll
      for (int g = 0; g < 4; ++g) { const f32x4 dv = *(const LAS f32x4*)(DC + 32 * m + 8 * g + 4 * hh);
        S[m][4 * g] *= dv.x; S[m][4 * g + 1] *= dv.y; S[m][4 * g + 2] *= dv.z; S[m][4 * g + 3] *= dv.w; }
#pragma unroll
      for (int ks = 0; ks < 4; ++ks) S[m] = MFMA32(*(const LAS bf16x8*)(KE + (32 * m + r) * 72 + 16 * ks + 8 * hh), vf[ks], S[m]);
    }
    __syncthreads();
  }
}

DI void phase_post(const Params& p, int l, int ntok, LAS unsigned char* lds) {
  const int tid = otid(), lane = tid & 63;
  { const int gw = blockIdx.x * 8 + (tid >> 6), nw = gridDim.x * 8;
    const bf16_t* PB = (const bf16_t*)(p.ws + OFF_PB); bf16_t* HB = (bf16_t*)(p.ws + OFF_X);
    const float4 ng = *(const float4*)(p.gla_ng + l * 256 + 4 * lane);
    for (int it = gw; it < ntok * 4; it += nw) {
      const size_t tok = it >> 2; const int h = it & 3, col = h * 256 + 4 * lane;
      const u32x2 a = *(const u32x2*)(PB + tok * 4096 + col), b = *(const u32x2*)(HB + tok * 1024 + col), rr = *(const u32x2*)(PB + tok * 4096 + 1024 + col);
      const float o0 = bflo(a[0]) + bflo(b[0]), o1 = bfhi(a[0]) + bfhi(b[0]), o2 = bflo(a[1]) + bflo(b[1]), o3 = bfhi(a[1]) + bfhi(b[1]);
      const float ss = wave_sum(o0 * o0 + o1 * o1 + o2 * o2 + o3 * o3);
      const float rstd = rsqrtf(ss * (1.f / 256.f) + EPSF);
      const float r0 = bflo(rr[0]), r1 = bfhi(rr[0]), r2 = bflo(rr[1]), r3 = bfhi(rr[1]);
      const float y0 = o0 * rstd * ng.x * (r0 * sigm(r0)), y1 = o1 * rstd * ng.y * (r1 * sigm(r1));
      const float y2 = o2 * rstd * ng.z * (r2 * sigm(r2)), y3 = o3 * rstd * ng.w * (r3 * sigm(r3));
      *(u32x2*)(HB + tok * 1024 + col) = (u32x2){pk2(y0, y1), pk2(y2, y3)};
    } }
  { LAS bf16_t* t = (LAS bf16_t*)lds;
    const bf16_t* XT = (const bf16_t*)(p.ws + OFF_XT); bf16_t* YH = (bf16_t*)(p.ws + OFF_QF);
    const int ntt = ntok / 64;
    for (int it = blockIdx.x; it < 16 * ntt; it += gridDim.x) {
      const int c0 = (it / ntt) * 64, tok0 = (it % ntt) * 64;
      { const int cc = tid >> 3, q = tid & 7; *(LAS u32x4*)(t + cc * 72 + 8 * q) = *(const u32x4*)(XT + (size_t)(c0 + cc) * NTOK + tok0 + 8 * q); }
      __syncthreads();
      { const int tk = tid >> 3, cq = tid & 7; unsigned w[4];
#pragma unroll
        for (int i = 0; i < 4; ++i) w[i] = (unsigned)t[(8 * cq + 2 * i) * 72 + tk] | ((unsigned)t[(8 * cq + 2 * i + 1) * 72 + tk] << 16);
        *(u32x4*)(YH + (size_t)(tok0 + tk) * 1024 + c0 + 8 * cq) = (u32x4){w[0], w[1], w[2], w[3]}; }
      __syncthreads();
    } }
}

struct SchedG1 : pg8::StaticOrder {
  __device__ bool next(int i, pg8::Unit& u) const {
    pg8::Unit v; if (!pg8::StaticOrder::next(i, v)) return false;
    if (v.pn < 16) { u.pm = 68 + v.pn; u.pn = v.pm; } else { u.pm = v.pm; u.pn = 68 + v.pn; }
    return true;
  }
};
typedef const f32x4 (&AccRef)[2][2][4][2];
DI u32x4 pack_acc8(f32x4 v0, f32x4 v1) { return (u32x4){pk2(v0[0], v0[1]), pk2(v0[2], v0[3]), pk2(v1[0], v1[1]), pk2(v1[2], v1[3])}; }
struct EpiG1 {
  static constexpr bool PERM = true, AFTER_DRAIN = false;
  bf16_t* XT; bf16_t* PB; float* LR;
  DI void operator()(AccRef acc, const pg8::Unit& u, int wr, int wc, int fr, int fq) const {
    if (u.pm >= 68) {
      const int ch0 = (u.pm - 68) * 256 + wr * 64 + fr, tk0 = u.pn * 256 + wc * 32 + 8 * fq;
#pragma unroll
      for (int ai = 0; ai < 2; ++ai)
#pragma unroll
        for (int m = 0; m < 4; ++m) { bf16_t* rp = XT + (size_t)(ch0 + ai * 128 + m * 16) * NTOK + tk0;
#pragma unroll
          for (int bj = 0; bj < 2; ++bj) *(u32x4*)(rp + bj * 128) = pack_acc8(acc[ai][bj][m][0], acc[ai][bj][m][1]); }
    } else {
      const int wp = u.pn - 84, row0 = u.pm * 256 + wr * 64 + fr, col0 = wp * 256 + wc * 32 + 8 * fq;
      if (wp < 16) {
#pragma unroll
        for (int ai = 0; ai < 2; ++ai)
#pragma unroll
          for (int m = 0; m < 4; ++m) { bf16_t* rp = PB + (size_t)(row0 + ai * 128 + m * 16) * 4096 + col0;
#pragma unroll
            for (int bj = 0; bj < 2; ++bj) *(u32x4*)(rp + bj * 128) = pack_acc8(acc[ai][bj][m][0], acc[ai][bj][m][1]); }
      } else if (wc == 0) {
#pragma unroll
        for (int ai = 0; ai < 2; ++ai)
#pragma unroll
          for (int m = 0; m < 4; ++m) { float* rp = LR + (size_t)(row0 + ai * 128 + m * 16) * 32 + 8 * fq; *(f32x4*)rp = acc[ai][0][m][0]; *(f32x4*)(rp + 4) = acc[ai][0][m][1]; }
      }
    }
  }
};
template <int MODE> struct EpiGate {
  static constexpr bool PERM = true, AFTER_DRAIN = false;
  const bf16_t* PB; bf16_t* T1; bf16_t* MG;
  DI void operator()(AccRef acc, const pg8::Unit& u, int wr, int wc, int fr, int fq) const {
    const int row0 = u.pm * 256 + wr * 64 + fr, col0 = u.pn * 256 + wc * 32 + 8 * fq;
#pragma unroll
    for (int ai = 0; ai < 2; ++ai)
#pragma unroll
      for (int m = 0; m < 4; ++m) { const size_t row = (size_t)(row0 + ai * 128 + m * 16);
#pragma unroll
        for (int bj = 0; bj < 2; ++bj) { const int col = col0 + bj * 128;
          const u32x4 g = *(const u32x4*)(PB + row * 4096 + (MODE ? 3072 : 2048) + col);
          const f32x4 v0 = acc[ai][bj][m][0], v1 = acc[ai][bj][m][1];
          float o[8] = {v0[0] * sigm(bflo(g[0])), v0[1] * sigm(bfhi(g[0])), v0[2] * sigm(bflo(g[1])), v0[3] * sigm(bfhi(g[1])),
                        v1[0] * sigm(bflo(g[2])), v1[1] * sigm(bfhi(g[2])), v1[2] * sigm(bflo(g[3])), v1[3] * sigm(bfhi(g[3]))};
          if (MODE) { const u32x4 t = *(const u32x4*)(T1 + row * 1024 + col);
            o[0] += bflo(t[0]); o[1] += bfhi(t[0]); o[2] += bflo(t[1]); o[3] += bfhi(t[1]); o[4] += bflo(t[2]); o[5] += bfhi(t[2]); o[6] += bflo(t[3]); o[7] += bfhi(t[3]); }
          *(u32x4*)((MODE ? MG : T1) + row * 1024 + col) = (u32x4){pk2(o[0], o[1]), pk2(o[2], o[3]), pk2(o[4], o[5]), pk2(o[6], o[7])}; } }
  }
};
struct EpiRes {
  static constexpr bool PERM = false, AFTER_DRAIN = false;
  float* out; float* ctxs; const float* modl; int goff;
  DI void operator()(AccRef acc, const pg8::Unit& u, int wr, int wc, int fr, int fq) const {
    const int row0 = u.pm * 256 + wr * 64 + fr, col0 = u.pn * 256 + wc * 32 + 4 * fq;
    const float* gv = modl + (size_t)(u.pm < 64 ? (u.pm >> 4) : 4) * 6144 + goff + col0;
    f32x4 gg[2][2];
#pragma unroll
    for (int bj = 0; bj < 2; ++bj)
#pragma unroll
      for (int n = 0; n < 2; ++n) gg[bj][n] = *(const f32x4*)(gv + bj * 128 + n * 16);
#pragma unroll
    for (int ai = 0; ai < 2; ++ai)
#pragma unroll
      for (int m = 0; m < 4; ++m) { const int row = row0 + ai * 128 + m * 16;
        float* rp = (row < NLAT ? out + (size_t)row * 1024 : ctxs + (size_t)(row - NLAT) * 1024) + col0;
#pragma unroll
        for (int bj = 0; bj < 2; ++bj)
#pragma unroll
          for (int n = 0; n < 2; ++n) { f32x4* q = (f32x4*)(rp + bj * 128 + n * 16); *q = *q + gg[bj][n] * acc[ai][bj][m][n]; } }
  }
};
struct EpiRelu2 {
  static constexpr bool PERM = true, AFTER_DRAIN = false;
  bf16_t* O;
  DI void operator()(AccRef acc, const pg8::Unit& u, int wr, int wc, int fr, int fq) const {
    const int row0 = u.pm * 256 + wr * 64 + fr, col0 = u.pn * 256 + wc * 32 + 8 * fq;
#pragma unroll
    for (int ai = 0; ai < 2; ++ai)
#pragma unroll
      for (int m = 0; m < 4; ++m) { bf16_t* rp = O + (size_t)(row0 + ai * 128 + m * 16) * 4096 + col0;
#pragma unroll
        for (int bj = 0; bj < 2; ++bj) { f32x4 v0 = acc[ai][bj][m][0], v1 = acc[ai][bj][m][1];
#pragma unroll
          for (int e = 0; e < 4; ++e) { const float a = fmaxf(v0[e], 0.f), b = fmaxf(v1[e], 0.f); v0[e] = a * a; v1[e] = b * b; }
          *(u32x4*)(rp + bj * 128) = pack_acc8(v0, v1); } }
  }
};

__global__ void __launch_bounds__(512, 2) fwd_megakernel(Params p) {
  extern __shared__ __attribute__((aligned(16))) unsigned char shm[];
  LAS unsigned char* lds = (LAS unsigned char*)shm;
  cg::grid_group grid = cg::this_grid();
  unsigned char* ws = p.ws;
  const int G = gridDim.x, cblk = blockIdx.x;
  unsigned* cnt = (unsigned*)(ws + OFF_CNT);
  __shared__ int s_item;

  phase_copy(p); phase_mod(p, lds); phase_a2(p, lds);
  grid.sync();
  for (int l = 0; l < 4; ++l) {
    const bool last = (l == 3);
    const int MR = last ? NLAT : NTOK;
    phase_wconv(p, l, lds);
    phase_norm(p, l, p.norm1_g + l * 1024, 0, 1024, NTOK);
    phase_filt_gemm(p, l, lds);
    grid.sync();
    phase_filt_fft(p, lds);
    grid.sync();
    { pg8::Gemm g{(const bf16_t*)(ws + OFF_X), (const bf16_t*)(ws + OFF_X), NTOK, 8448, 1024};
      SchedG1 S; S.init(NTOK, 8448, G, cblk);
      EpiG1 E{(bf16_t*)(ws + OFF_XT), (bf16_t*)(ws + OFF_PB), (float*)(ws + OFF_LR)};
      pg8::gemm_phase<EpiG1, SchedG1, false>(lds, g, S, E, nullptr); }
    grid.sync();
    phase_gla_prep(p, l, lds);
    grid.sync();
    if (cblk < 32) phase_gla_scan(p, lds);
    { LAS cplx* L = (LAS cplx*)lds;
      for (;;) {
        if (otid() == 0) s_item = (int)atomicAdd(cnt + 2 * l, 1u);
        __syncthreads();
        const int it = s_item;
        __syncthreads();
        if (it >= 2048) break;
        hyena_item(p, l, it, L, otid());
      }
      if (!last) for (;;) {
        if (otid() == 0) s_item = (int)atomicAdd(cnt + 2 * l + 1, 1u);
        __syncthreads();
        const int it = s_item;
        __syncthreads();
        if (it >= 1024) break;
        hyena_ctx_item(p, l, it, lds);
      } }
    grid.sync();
    phase_post(p, l, MR, lds);
    grid.sync();
    { pg8::StaticOrder S; S.init(MR, 1024, G, cblk);
      EpiGate<0> E0{(const bf16_t*)(ws + OFF_PB), (bf16_t*)(ws + OFF_KEF), nullptr};
      pg8::Gemm g0{(const bf16_t*)(ws + OFF_QF), (const bf16_t*)(ws + OFF_WBHY), MR, 1024, 1024};
      pg8::gemm_phase<EpiGate<0>, pg8::StaticOrder, false>(lds, g0, S, E0, nullptr);
      EpiGate<1> E1{(const bf16_t*)(ws + OFF_PB), (bf16_t*)(ws + OFF_KEF), (bf16_t*)(ws + OFF_XT + (size_t)3072 * NTOK * 2)};
      pg8::Gemm g1{(const bf16_t*)(ws + OFF_X), (const bf16_t*)(ws + OFF_WBGLA), MR, 1024, 1024};
      pg8::gemm_phase<EpiGate<1>, pg8::StaticOrder, false>(lds, g1, S, E1, nullptr); }
    grid.sync();
    { pg8::StaticOrder S; S.init(MR, 1024, G, cblk);
      EpiRes E{p.out, (float*)(ws + OFF_CTXS), modp(p, l, 0), 2048};
      pg8::Gemm g{(const bf16_t*)(ws + OFF_XT + (size_t)3072 * NTOK * 2), (const bf16_t*)(ws + OFF_WOUT), MR, 1024, 1024};
      pg8::gemm_phase<EpiRes, pg8::StaticOrder, false>(lds, g, S, E, nullptr); }
    grid.sync();
    phase_norm(p, l, p.norm2_g + l * 1024, 3072, 4096, MR);
    grid.sync();
    { pg8::StaticOrder S; S.init(MR, 4096, G, cblk);
      EpiRelu2 E{(bf16_t*)(ws + OFF_PB)};
      pg8::Gemm g{(const bf16_t*)(ws + OFF_X), (const bf16_t*)(ws + OFF_W1), MR, 4096, 1024};
      pg8::gemm_phase<EpiRelu2, pg8::StaticOrder, false>(lds, g, S, E, nullptr); }
    grid.sync();
    { pg8::StaticOrder S; S.init(MR, 1024, G, cblk);
      EpiRes E{p.out, (float*)(ws + OFF_CTXS), modp(p, l, 0), 5120};
      pg8::Gemm g{(const bf16_t*)(ws + OFF_PB), (const bf16_t*)(ws + OFF_W2), MR, 1024, 4096};
      pg8::gemm_phase<EpiRes, pg8::StaticOrder, false>(lds, g, S, E, nullptr); }
    grid.sync();
  }
  phase_final_norm(p);
}

constexpr size_t DYN_LDS = FFT_REGION_F2 * 8 + 32 * 512 * 4;

extern "C" void kernel_launch(void* const* d_in, const int* in_sizes, int n_in, void* d_out, int out_size, void* d_ws, size_t ws_size, hipStream_t stream) {
  if (ws_size < WS_TOTAL || n_in < 28) return;
  static int grid_blocks = 0;
  if (!grid_blocks) {
    int dev = 0, cus = 0, per_cu = 0;
    hipGetDevice(&dev);
    hipDeviceGetAttribute(&cus, hipDeviceAttributeMultiprocessorCount, dev);
    hipFuncSetAttribute((const void*)fwd_megakernel, hipFuncAttributeMaxDynamicSharedMemorySize, (int)DYN_LDS);
    hipOccupancyMaxActiveBlocksPerMultiprocessor(&per_cu, fwd_megakernel, 512, DYN_LDS);
    if (per_cu < 1) per_cu = 1;
    grid_blocks = cus * 1;
  }
  Params p{};
  const float** pp = (const float**)&p;
  for (int i = 0; i < 28; ++i) pp[i] = (const float*)d_in[i];
  p.out = (float*)d_out; p.ws = (unsigned char*)d_ws;
  void* args[] = {&p};
  hipLaunchCooperativeKernel((const void*)fwd_megakernel, dim3(grid_blocks), dim3(512), args, DYN_LDS, stream);
}
```

```cpp
#include <hip/hip_runtime.h>
#include <hip/hip_cooperative_groups.h>
namespace cg = cooperative_groups;
#define DI __device__ __forceinline__

__device__ __forceinline__ int otid() { int t = threadIdx.x; asm volatile("" : "+v"(t)); return t; }
namespace pg8 {
#define PG8_LAS __attribute__((address_space(3)))
typedef unsigned short bf16_t;
typedef short bf16x8 __attribute__((ext_vector_type(8)));
typedef float f32x4 __attribute__((ext_vector_type(4)));
typedef unsigned u32x4 __attribute__((ext_vector_type(4)));
constexpr int BM = 256, BK = 64, HALF = 128, HTB = HALF * BK * 2  , STAGE_BYTES = 8 * HTB, NXCD = 8, WGM = 8;

__host__ __device__ __forceinline__ int lds_byte(int r, int c) { const int st = (r >> 4) * 2 + (c >> 5), rr = r & 15, cc = c & 31, ob = rr * 64 + cc * 2; return st * 1024 + (ob ^ (((ob >> 9) & 1) << 5)); }
__host__ __device__ __forceinline__ void stage_rc(int b, int& R, int& C) { const int st = b / 1024, sb = b % 1024, swz = sb ^ (((sb >> 9) & 1) << 5); R = (st >> 1) * 16 + swz / 64; C = (st & 1) * 32 + (swz % 64) / 2; }
__host__ __device__ __forceinline__ int perm32(int rho) { const int n = rho >> 4, i = rho & 15; return 8 * (i >> 2) + 4 * n + (i & 3); }

struct Unit { int pm, pn; };
struct Gemm { const bf16_t* A; const bf16_t* Bt; int M, N, K; };
struct StaticOrder {
    int nM, nN, nwg, G, c;
    __host__ __device__ void init(int M, int N, int G_, int c_) { nM = M / BM; nN = N / BM; nwg = nM * nN; G = G_; c = c_; }
    __host__ __device__ bool next(int i, Unit& u) const {
        const long L = (long)i * G + c; if (L >= nwg) return false;
        int wgid = (int)L; { const int q = nwg / NXCD, r = nwg % NXCD, xcd = wgid % NXCD, off = wgid / NXCD; wgid = (xcd < r ? xcd * (q + 1) : r * (q + 1) + (xcd - r) * q) + off; }
        const int nig = WGM * nN, gid = wgid / nig, fm = gid * WGM, gsz = (nM - fm) < WGM ? (nM - fm) : WGM;
        u.pm = fm + ((wgid % nig) % gsz); u.pn = (wgid % nig) / gsz; return true;
    }
    __device__ __forceinline__ void a_ready(const Unit&) const {}
    __device__ __forceinline__ void done(const Unit&) const {}
};
__device__ __forceinline__ unsigned cvt_pk_bf16(float lo, float hi) { unsigned r; asm volatile("v_cvt_pk_bf16_f32 %0, %1, %2" : "=v"(r) : "v"(lo), "v"(hi)); return r; }
template <class Epi, class Sched, bool STAMP = false>
__device__ __forceinline__ void gemm_phase(PG8_LAS unsigned char* lds, const Gemm g, const Sched& S, const Epi& E, unsigned long long* stamps) {
    const int tid = otid(), wid = __builtin_amdgcn_readfirstlane(tid >> 6), lane = tid & 63, wr = wid >> 2, wc = wid & 3, fr = lane & 15, fq = lane >> 4;
    const int K = g.K, nt = K / BK;
    int ts_lo = 0, ts_hi = 0, nts = 0; const unsigned long long rt_entry = STAMP ? (unsigned long long)wall_clock64() : 0ull;
#define PG8_STAMP() do { if (STAMP && wid == 0 && nts < 64) { const unsigned long long _c = (unsigned long long)clock64(); \
        ts_lo = (lane == nts) ? (int)(unsigned)_c : ts_lo; ts_hi = (lane == nts) ? (int)(unsigned)(_c >> 32) : ts_hi; ++nts; } } while (0)
    PG8_STAMP();
    unsigned voffA[2], voffB[2];
#pragma unroll
    for (int i = 0; i < 2; ++i) { int R, C; stage_rc(tid * 16 + i * 8192, R, C); const int Rb = Epi::PERM ? ((R & ~31) + perm32(R & 31)) : R;
        voffA[i] = (unsigned)(R * K + C) * 2u; voffB[i] = (unsigned)(Rb * K + C) * 2u; }
    const size_t kstep = (size_t)(BK * 2);
    const size_t hstep = (size_t)HALF * K * 2;
    const size_t tstep = 2 * hstep;
    const unsigned ldsw = (unsigned)wid * 1024u;
    const int aoff = lds_byte(wr * 64 + fr, fq * 8), boff = lds_byte(wc * 32 + fr, fq * 8);
#define PG8_SA(b, h) (((b) * 2 + (h)) * HTB)
#define PG8_SB(b, h) ((4 + (b) * 2 + (h)) * HTB)
#define PG8_STAGE(bufoff, gbase, voff) do { _Pragma("unroll") for (int _i = 0; _i < 2; ++_i) \
        __builtin_amdgcn_global_load_lds((const unsigned*)((const char*)(gbase) + (voff)[_i]), (PG8_LAS unsigned*)(lds + (bufoff) + ldsw + _i * 8192), 16, 0, 0); } while (0)
#define PG8_LDA(dst, b, h) do { _Pragma("unroll") for (int m = 0; m < 4; ++m) _Pragma("unroll") for (int k = 0; k < 2; ++k) dst[m][k] = *(const PG8_LAS bf16x8*)(lds + PG8_SA(b, h) + aoff + m * 2048 + k * 1024); } while (0)
#define PG8_LDB(dst, b, h) do { _Pragma("unroll") for (int n = 0; n < 2; ++n) _Pragma("unroll") for (int k = 0; k < 2; ++k) dst[n][k] = *(const PG8_LAS bf16x8*)(lds + PG8_SB(b, h) + boff + n * 2048 + k * 1024); } while (0)
#define PG8_MMA(ai, bj, At, Bt) do { __builtin_amdgcn_s_setprio(1); _Pragma("unroll") for (int m = 0; m < 4; ++m) _Pragma("unroll") for (int n = 0; n < 2; ++n) _Pragma("unroll") for (int k = 0; k < 2; ++k) \
        acc[ai][bj][m][n] = __builtin_amdgcn_mfma_f32_16x16x32_bf16(Bt[n][k], At[m][k], acc[ai][bj][m][n], 0, 0, 0); __builtin_amdgcn_s_setprio(0); } while (0)
#define PG8_WAIT_V(n) asm volatile("s_waitcnt vmcnt(" #n ")" ::: "memory")
#define PG8_WAIT_L(n) asm volatile("s_waitcnt lgkmcnt(" #n ")" ::: "memory")
#define PG8_BAR __builtin_amdgcn_s_barrier()
#define PG8_SCHED __builtin_amdgcn_sched_barrier(0)
    Unit cur, nxt; int ui = 0;
    if (!S.next(0, cur)) return;
    f32x4 acc[2][2][4][2];
#pragma unroll
    for (int a = 0; a < 2; ++a)
#pragma unroll
        for (int b = 0; b < 2; ++b)
#pragma unroll
            for (int m = 0; m < 4; ++m)
#pragma unroll
                for (int n = 0; n < 2; ++n) acc[a][b][m][n] = (f32x4){0.f, 0.f, 0.f, 0.f};
    bf16x8 At[4][2], B0[2][2], B1[2][2];
    const char* cA = (const char*)g.A + (size_t)cur.pm * tstep; const char* cB = (const char*)g.Bt + (size_t)cur.pn * tstep;
    S.a_ready(cur);
    PG8_STAGE(PG8_SB(0, 0), cB, voffB); PG8_STAGE(PG8_SA(0, 0), cA, voffA); PG8_STAGE(PG8_SB(0, 1), cB + hstep, voffB); PG8_STAGE(PG8_SA(0, 1), cA + hstep, voffA);
    if (wr == 1) PG8_BAR;
    PG8_WAIT_V(4); PG8_BAR;
    PG8_STAGE(PG8_SB(1, 0), cB + kstep, voffB); PG8_STAGE(PG8_SA(1, 0), cA + kstep, voffA); PG8_STAGE(PG8_SB(1, 1), cB + hstep + kstep, voffB);
    PG8_WAIT_V(6); PG8_BAR;
    PG8_STAMP();
    for (;;) {
        const bool has_next = S.next(ui + 1, nxt);
        const char* nA = has_next ? (const char*)g.A + (size_t)nxt.pm * tstep : cA; const char* nB = has_next ? (const char*)g.Bt + (size_t)nxt.pn * tstep : cB;
        for (int t = 0; t < nt; t += 2) {
            const bool last = (t == nt - 2);
            const char* a1 = cA + (size_t)(t + 1) * kstep;
            const char* a2 = last ? nA : cA + (size_t)(t + 2) * kstep; const char* b2 = last ? nB : cB + (size_t)(t + 2) * kstep;
            const char* a3 = a2 + kstep; const char* b3 = b2 + kstep;
            if (last && has_next) S.a_ready(nxt);
            PG8_LDB(B0, 0, 0); PG8_SCHED; PG8_LDA(At, 0, 0); PG8_STAGE(PG8_SA(1, 1), a1 + hstep, voffA);
            PG8_WAIT_L(8); PG8_BAR; PG8_WAIT_L(0); PG8_MMA(0, 0, At, B0); PG8_BAR; PG8_SCHED;
            PG8_LDB(B1, 0, 1); PG8_STAGE(PG8_SB(0, 0), b2, voffB);
            PG8_BAR; PG8_WAIT_L(0); PG8_MMA(0, 1, At, B1); PG8_BAR;
            PG8_LDA(At, 0, 1); PG8_STAGE(PG8_SA(0, 0), a2, voffA);
            PG8_BAR; PG8_WAIT_L(0); PG8_MMA(1, 0, At, B0); PG8_BAR; PG8_SCHED;
            PG8_STAGE(PG8_SB(0, 1), b2 + hstep, voffB);
            PG8_WAIT_V(6); PG8_BAR; PG8_MMA(1, 1, At, B1); PG8_BAR;
            PG8_LDB(B0, 1, 0); PG8_SCHED; PG8_LDA(At, 1, 0); PG8_STAGE(PG8_SA(0, 1), a2 + hstep, voffA);
            PG8_WAIT_L(8); PG8_BAR; PG8_WAIT_L(0); PG8_MMA(0, 0, At, B0); PG8_BAR; PG8_SCHED;
            PG8_LDB(B1, 1, 1); PG8_STAGE(PG8_SB(1, 0), b3, voffB);
            PG8_BAR; PG8_WAIT_L(0); PG8_MMA(0, 1, At, B1); PG8_BAR;
            PG8_LDA(At, 1, 1); PG8_STAGE(PG8_SA(1, 0), a3, voffA);
            PG8_BAR; PG8_WAIT_L(0); PG8_MMA(1, 0, At, B0); PG8_BAR; PG8_SCHED;
            PG8_STAGE(PG8_SB(1, 1), b3 + hstep, voffB);
            PG8_WAIT_V(6); PG8_BAR; PG8_MMA(1, 1, At, B1); PG8_BAR;
        }
        PG8_STAMP();
        if constexpr (!Epi::AFTER_DRAIN) { E(acc, cur, wr, wc, fr, fq); S.done(cur); }
        PG8_STAMP();
        if (!has_next) break;
#pragma unroll
        for (int a = 0; a < 2; ++a)
#pragma unroll
            for (int b = 0; b < 2; ++b)
#pragma unroll
                for (int m = 0; m < 4; ++m)
#pragma unroll
                    for (int n = 0; n < 2; ++n) acc[a][b][m][n] = (f32x4){0.f, 0.f, 0.f, 0.f};
        cur = nxt; cA = nA; cB = nB; ++ui;
    }
    PG8_WAIT_V(0);
    if (wr == 0) PG8_BAR;
    PG8_BAR;
    if constexpr (Epi::AFTER_DRAIN) { E.fused(acc, cur, wr, wc, fr, fq, lds, wid, lane); S.done(cur); }
    PG8_STAMP();
    if (STAMP && wid == 0) { stamps[lane] = lane < nts ? (((unsigned long long)(unsigned)ts_hi << 32) | (unsigned)ts_lo) : 0ull;
        if (lane == 62) stamps[62] = rt_entry; if (lane == 63) stamps[63] = (unsigned long long)wall_clock64(); }
#undef PG8_STAMP
#undef PG8_SA
#undef PG8_SB
#undef PG8_STAGE
#undef PG8_LDA
#undef PG8_LDB
#undef PG8_MMA
#undef PG8_WAIT_V
#undef PG8_WAIT_L
#undef PG8_BAR
#undef PG8_SCHED
}
}

using pg8::bf16_t; using pg8::bf16x8; using pg8::f32x4; using pg8::u32x4;
typedef float f32x16 __attribute__((ext_vector_type(16)));
typedef _Float16 h16x2 __attribute__((ext_vector_type(2)));
typedef unsigned u32x2 __attribute__((ext_vector_type(2)));
#define LAS __attribute__((address_space(3)))

constexpr int NTOK = 17408, NLAT = 16384, DM = 1024, NTH = 512;
constexpr float EPSF = 1e-6f;
constexpr float HSCALE = 64.f;

constexpr size_t SZ_H = (size_t)NTOK * 1024 * 2;
constexpr size_t OFF_X = 0;
constexpr size_t OFF_WIN = OFF_X + SZ_H;
constexpr size_t OFF_WBHY = OFF_WIN + (size_t)8448 * 1024 * 2;
constexpr size_t OFF_WBGLA = OFF_WBHY + 2097152;
constexpr size_t OFF_WOUT = OFF_WBGLA + 2097152;
constexpr size_t OFF_W1 = OFF_WOUT + 2097152;
constexpr size_t OFF_W2 = OFF_W1 + 8388608;
constexpr size_t OFF_XT = OFF_W2 + 8388608;
constexpr size_t SZ_XT = (size_t)4096 * NTOK * 2;
constexpr size_t OFF_PB = OFF_XT + SZ_XT;
constexpr size_t OFF_LR = OFF_PB + SZ_XT;
constexpr size_t OFF_QF = OFF_LR + (size_t)NTOK * 32 * 4;
constexpr size_t SZ_Q = (size_t)NTOK * 512 * 2;
constexpr size_t OFF_QB = OFF_QF + SZ_Q;
constexpr size_t OFF_KEF = OFF_QB + SZ_Q;
constexpr size_t OFF_KEB = OFF_KEF + SZ_Q;
constexpr size_t OFF_ATT = OFF_KEB + SZ_Q;
constexpr size_t OFF_DEC = OFF_ATT + SZ_Q;
constexpr size_t OFF_HP = OFF_DEC + (size_t)272 * 4 * 2 * 128 * 4;
constexpr size_t OFF_CTXS = OFF_HP + (size_t)1024 * 8192 * 4;
constexpr size_t OFF_MOD = OFF_CTXS + 4194304;
constexpr size_t OFF_A2L = OFF_MOD + 491520;
constexpr size_t OFF_A2C = OFF_A2L + 4194304;
constexpr size_t OFF_HTC = OFF_A2C + 262144;
constexpr size_t OFF_HP2 = OFF_HTC + 2097152;
constexpr size_t OFF_HTC2 = OFF_HP2 + (size_t)1024 * 8192 * 4;
constexpr size_t OFF_CNT = OFF_HTC2 + 2097152;
constexpr size_t OFF_BAR = OFF_CNT + 1024;
constexpr size_t WS_TOTAL = OFF_BAR + 16384;

struct Params {
  const float *x, *c, *ctx, *c_ctx, *ada_w, *ada_b, *norm1_g, *norm2_g, *w_in, *conv_w, *conv_b, *fw1, *fb1, *fw2, *fb2, *fw3, *ffreq,
      *decay, *skip, *gate_w, *gate_b, *gla_ng, *w_bhy, *w_bgla, *w_out, *mlp_w1, *mlp_w2, *final_g;
  float* out; unsigned char* ws;
};

typedef float f32x2_t __attribute__((ext_vector_type(2)));
typedef __bf16 bf16x2_t __attribute__((ext_vector_type(2)));
DI bf16_t f2bf(float f) { const __bf16 b = (__bf16)f; return __builtin_bit_cast(bf16_t, b); }
DI float bf2f(bf16_t b) { return __uint_as_float(((unsigned)b) << 16); }
DI unsigned pk2(float lo, float hi) { f32x2_t v; v.x = lo; v.y = hi; const bf16x2_t b = __builtin_convertvector(v, bf16x2_t); return __builtin_bit_cast(unsigned, b); }
DI float bflo(unsigned w) { return __uint_as_float(w << 16); }
DI float bfhi(unsigned w) { return __uint_as_float(w & 0xffff0000u); }
DI float sigm(float x) { return __builtin_amdgcn_rcpf(1.f + __expf(-x)); }
DI float my_sin(float x) { float r = x * 0.15915494309189535f; r -= rintf(r); return __builtin_amdgcn_sinf(r); }
DI float wave_sum(float v) {
#pragma unroll
  for (int o = 32; o >= 1; o >>= 1) v += __shfl_xor(v, o);
  return v;
}
DI float* xrow(const Params& p, int row) { return row < NLAT ? p.out + (size_t)row * DM : (float*)(p.ws + OFF_CTXS) + (size_t)(row - NLAT) * DM; }
DI const float* xrow_in(const Params& p, int row) { return row < NLAT ? p.x + (size_t)row * DM : p.ctx + (size_t)(row - NLAT) * DM; }
DI const float* modp(const Params& p, int l, int s) { return (const float*)(p.ws + OFF_MOD) + ((size_t)l * 5 + s) * 6144; }

DI void phase_copy(const Params& p) {
  if (blockIdx.x == 0) { unsigned* z = (unsigned*)(p.ws + OFF_CNT); for (int i = otid(); i < (1024 + 16384) / 4; i += NTH) z[i] = 0u; }
}

DI void phase_mod(const Params& p, LAS unsigned char* lds) {
  LAS float* sv = (LAS float*)lds;
  LAS float* red = sv + 5 * 1024;
  const int tid = otid();
  bool loaded = false;
  for (int it = blockIdx.x; it < 4 * 48; it += gridDim.x) {
    if (!loaded) {
      for (int i = tid; i < 5 * 1024; i += NTH) { const int s = i >> 10, k = i & 1023; const float v = s < 4 ? p.c[s * 1024 + k] : p.c_ctx[k]; sv[i] = v * sigm(v); }
      loaded = true;
    }
    __syncthreads();
    const int l = it / 48, cb = it % 48, cg4 = tid & 31, kq = tid >> 5;
    const float* W = p.ada_w + (size_t)l * 1024 * 6144 + cb * 128 + 4 * cg4;
    f32x4 a0 = {0.f, 0.f, 0.f, 0.f}, a1 = a0, a2 = a0, a3 = a0, a4 = a0;
#pragma unroll 8
    for (int k = kq * 64; k < kq * 64 + 64; ++k) { const f32x4 w = __builtin_nontemporal_load((const f32x4*)(W + (size_t)k * 6144)); a0 += w * sv[k]; a1 += w * sv[1024 + k]; a2 += w * sv[2048 + k]; a3 += w * sv[3072 + k]; a4 += w * sv[4096 + k]; }
    LAS float* r = red + kq * 5 * 128 + 4 * cg4;
    *(LAS f32x4*)(r) = a0; *(LAS f32x4*)(r + 128) = a1; *(LAS f32x4*)(r + 256) = a2; *(LAS f32x4*)(r + 384) = a3; *(LAS f32x4*)(r + 512) = a4;
    __syncthreads();
    if (tid < 128) {
      const int col = cb * 128 + tid;
      const float bias = p.ada_b[l * 6144 + col];
      float* mo = (float*)(p.ws + OFF_MOD) + (size_t)l * 5 * 6144 + col;
#pragma unroll
      for (int s = 0; s < 5; ++s) { float t = bias;
#pragma unroll
        for (int q = 0; q < 16; ++q) t += red[q * 5 * 128 + s * 128 + tid]; mo[(size_t)s * 6144] = t; }
    }
    __syncthreads();
  }
}

DI void phase_a2(const Params& p, LAS unsigned char* lds) {
  LAS float* zf = (LAS float*)lds;
  LAS float* a1s = zf + 64 * 36;
  const int tid = otid(), tl = tid >> 6, m = tid & 63;
  const int per = (4096 + 256) / 64;
  for (int it = blockIdx.x; it < 4 * per; it += gridDim.x) {
    const int l = it / per, r = it % per;
    const bool isc = r >= 64; const int Lq = isc ? 256 : 4096; const int i0 = (isc ? (r - 64) : r) * 64;
    for (int e = tid; e < 64 * 33; e += NTH) {
      const int tt = e / 33, f = e % 33, i = i0 + tt; float v;
      if (f == 0) v = (float)i / (float)(Lq - 1);
      else { const int j = (f - 1) & 15; const float band = 1e-4f + (float)j * ((15.f - 1e-4f) / 15.f); float rev = (float)i * band / (float)Lq; rev -= floorf(rev);
             v = (f <= 16) ? __builtin_amdgcn_cosf(rev) : -__builtin_amdgcn_sinf(rev); }
      zf[tt * 36 + f] = v;
    }
    const float fr = p.ffreq[l * 64 + m], b1v = p.fb1[l * 64 + m], b2v = p.fb2[l * 64 + m];
    float w1r[33];
#pragma unroll
    for (int f = 0; f < 33; ++f) w1r[f] = p.fw1[((size_t)l * 33 + f) * 64 + m];
    __syncthreads();
#pragma unroll 1
    for (int q = 0; q < 8; ++q) { const int tt = tl * 8 + q; float acc = b1v;
#pragma unroll
      for (int f = 0; f < 33; ++f) acc += zf[tt * 36 + f] * w1r[f];
      a1s[tt * 64 + m] = my_sin(fr * acc); }
    float w2r[64];
#pragma unroll
    for (int j = 0; j < 64; ++j) w2r[j] = p.fw2[((size_t)l * 64 + j) * 64 + m];
    __syncthreads();
    float* dst = isc ? (float*)(p.ws + OFF_A2C) + ((size_t)l * 256 + i0) * 64 : (float*)(p.ws + OFF_A2L) + ((size_t)l * 4096 + i0) * 64;
#pragma unroll 1
    for (int q = 0; q < 8; ++q) { const int tt = tl * 8 + q; float acc = b2v;
#pragma unroll
      for (int j4 = 0; j4 < 16; ++j4) { const f32x4 a = *(const LAS f32x4*)(a1s + tt * 64 + 4 * j4); acc += a.x * w2r[4 * j4] + a.y * w2r[4 * j4 + 1] + a.z * w2r[4 * j4 + 2] + a.w * w2r[4 * j4 + 3]; }
      dst[(size_t)tt * 64 + m] = my_sin(fr * acc); }
    __syncthreads();
  }
}

DI void wt_load(const float* src, int ld_src, int k0, int n0, f32x4 (&v)[2]) {
  const int tid = otid();
#pragma unroll
  for (int q = 0; q < 2; ++q) { const int kk = (tid >> 3) + 64 * q, nq = tid & 7; v[q] = __builtin_nontemporal_load((const f32x4*)(src + (size_t)(k0 + kk) * ld_src + n0 + 4 * nq)); }
}
DI void wt_store(const f32x4 (&v)[2], int k0, bf16_t* dst, int ld_dst, int drow0, LAS unsigned char* lds) {
  LAS bf16_t* t = (LAS bf16_t*)lds;
  const int tid = otid();
#pragma unroll
  for (int q = 0; q < 2; ++q) {
    const int kk = (tid >> 3) + 64 * q, nq = tid & 7;
    t[(4 * nq + 0) * 136 + kk] = f2bf(v[q].x); t[(4 * nq + 1) * 136 + kk] = f2bf(v[q].y); t[(4 * nq + 2) * 136 + kk] = f2bf(v[q].z); t[(4 * nq + 3) * 136 + kk] = f2bf(v[q].w);
  }
  __syncthreads();
  { const int n = tid >> 4, kq = tid & 15;
    const u32x4 o = *(const LAS u32x4*)(t + n * 136 + 8 * kq);
    *(u32x4*)(dst + (size_t)(drow0 + n) * ld_dst + k0 + 8 * kq) = o; }
  __syncthreads();
}
DI int win_dst_row(int n) {
  if (n < 3072) return n;
  if (n < 4096) return 4096 + (n - 3072);
  if (n < 5120) return 3072 + (n - 4096);
  if (n < 6144) return 4096 + 1024 + (n - 5120);
  if (n < 6176) return 8192 + (n - 6144);
  if (n < 7200) return 4096 + 2048 + (n - 6176);
  return 4096 + 3072 + (n - 7200);
}
struct WtItem { const float* src; int ld_src, k0, n0; bf16_t* dst; int ld_dst, drow0; };
DI WtItem wt_decode(const Params& p, int l, int part, int it) {
  unsigned char* ws = p.ws; WtItem w;
  const int n_win = 8 * 257, n_sq = 8 * 32, n_w1 = 8 * 128;
  if (part == 0) {
    if (it < n_win) { const int kt = it & 7, nt = it >> 3; w.src = p.w_in + (size_t)l * 1024 * 8224; w.ld_src = 8224; w.k0 = kt * 128; w.n0 = nt * 32; w.dst = (bf16_t*)(ws + OFF_WIN); w.ld_dst = 1024; w.drow0 = win_dst_row(nt * 32); }
    else { const int r = it - n_win, which = r / n_sq, q = r % n_sq, kt = q & 7, nt = q >> 3;
      w.src = (which == 0 ? p.w_bhy : which == 1 ? p.w_bgla : p.w_out) + (size_t)l * 1024 * 1024; w.ld_src = 1024; w.k0 = kt * 128; w.n0 = nt * 32;
      w.dst = (bf16_t*)(ws + (which == 0 ? OFF_WBHY : which == 1 ? OFF_WBGLA : OFF_WOUT)); w.ld_dst = 1024; w.drow0 = nt * 32; }
  } else {
    if (it < n_w1) { const int kt = it & 7, nt = it >> 3; w.src = p.mlp_w1 + (size_t)l * 1024 * 4096; w.ld_src = 4096; w.k0 = kt * 128; w.n0 = nt * 32; w.dst = (bf16_t*)(ws + OFF_W1); w.ld_dst = 1024; w.drow0 = nt * 32; }
    else { const int r = it - n_w1, kt = r & 31, nt = r >> 5; w.src = p.mlp_w2 + (size_t)l * 4096 * 1024; w.ld_src = 1024; w.k0 = kt * 128; w.n0 = nt * 32; w.dst = (bf16_t*)(ws + OFF_W2); w.ld_dst = 4096; w.drow0 = nt * 32; }
  }
  return w;
}
DI void phase_wconv(const Params& p, int l, LAS unsigned char* lds, int part, int blk, int nblk) {
  unsigned char* ws = p.ws;
  const int total = part == 0 ? (8 * 257 + 3 * 8 * 32) : (8 * 128 + 32 * 32);
  f32x4 v[2];
  if (blk < total) { const WtItem w = wt_decode(p, l, part, blk); wt_load(w.src, w.ld_src, w.k0, w.n0, v); }
  for (int it = blk; it < total; it += nblk) {
    const WtItem w = wt_decode(p, l, part, it);
    f32x4 cur[2] = {v[0], v[1]};
    if (it + nblk < total) { const WtItem w2 = wt_decode(p, l, part, it + nblk); wt_load(w2.src, w2.ld_src, w2.k0, w2.n0, v); }
    wt_store(cur, w.k0, w.dst, w.ld_dst, w.drow0, lds);
  }
  if (part == 0) { u32x4* z = (u32x4*)(ws + OFF_WIN + (size_t)8224 * 1024 * 2); const int n = 224 * 1024 * 2 / 16;
    for (int i = blk * NTH + otid(); i < n; i += nblk * NTH) z[i] = (u32x4){0u, 0u, 0u, 0u}; }
}

DI void phase_norm(const Params& p, int l, const float* g, int sh_off, int sc_off, int nrows, bool from_input) {
  const int lane = otid() & 63, gw = blockIdx.x * 8 + (otid() >> 6), nw = gridDim.x * 8;
  bf16_t* hb = (bf16_t*)(p.ws + OFF_X);
  const int rp = (nrows + nw - 1) / nw, r0 = gw * rp, r1 = min(nrows, r0 + rp);
  f32x4 A[4], B[4]; int scur = -1;
  f32x4 pa[4], pb2[4];
#define NORM_LOAD(rw) do { const int ra_ = (rw), rb_ = ((rw) + 1 < r1) ? (rw) + 1 : (rw); const float* xa_ = from_input ? xrow_in(p, ra_) : xrow(p, ra_); const float* xb_ = from_input ? xrow_in(p, rb_) : xrow(p, rb_); \
    _Pragma("unroll") for (int i = 0; i < 4; ++i) { pa[i] = *(const f32x4*)(xa_ + 4 * lane + 256 * i); pb2[i] = *(const f32x4*)(xb_ + 4 * lane + 256 * i); } } while (0)
  if (r0 < r1) NORM_LOAD(r0);
  for (int row = r0; row < r1; row += 2) {
    const bool two = row + 1 < r1;
    const int s = row < NLAT ? (row >> 12) : 4;
    if (s != scur) { scur = s; const float* mo = modp(p, l, s);
#pragma unroll
      for (int i = 0; i < 4; ++i) { const int c = 4 * lane + 256 * i; const f32x4 gg = *(const f32x4*)(g + c), sc = *(const f32x4*)(mo + sc_off + c); A[i] = gg * (sc + 1.f); B[i] = *(const f32x4*)(mo + sh_off + c); } }
    f32x4 va[4], vb[4]; float sa = 0.f, sb = 0.f;
#pragma unroll
    for (int i = 0; i < 4; ++i) { va[i] = pa[i]; vb[i] = pb2[i]; }
    if (row + 2 < r1) NORM_LOAD(row + 2);
#pragma unroll
    for (int i = 0; i < 4; ++i) { sa += va[i].x * va[i].x + va[i].y * va[i].y + va[i].z * va[i].z + va[i].w * va[i].w; sb += vb[i].x * vb[i].x + vb[i].y * vb[i].y + vb[i].z * vb[i].z + vb[i].w * vb[i].w; }
#pragma unroll
    for (int o = 32; o >= 1; o >>= 1) { sa += __shfl_xor(sa, o); sb += __shfl_xor(sb, o); }
    const float ra = rsqrtf(sa * (1.f / 1024.f) + EPSF), rb = rsqrtf(sb * (1.f / 1024.f) + EPSF);
    const int s2 = (row + 1) < NLAT ? ((row + 1) >> 12) : 4;
#pragma unroll
    for (int i = 0; i < 4; ++i) { const int c = 4 * lane + 256 * i; const f32x4 ya = va[i] * ra * A[i] + B[i];
      *(u32x2*)(hb + (size_t)row * 1024 + c) = (u32x2){pk2(ya.x, ya.y), pk2(ya.z, ya.w)}; }
    if (two) {
      if (s2 != scur) { scur = s2; const float* mo = modp(p, l, s2);
#pragma unroll
        for (int i = 0; i < 4; ++i) { const int c = 4 * lane + 256 * i; const f32x4 gg = *(const f32x4*)(g + c), sc = *(const f32x4*)(mo + sc_off + c); A[i] = gg * (sc + 1.f); B[i] = *(const f32x4*)(mo + sh_off + c); } }
#pragma unroll
      for (int i = 0; i < 4; ++i) { const int c = 4 * lane + 256 * i; const f32x4 yb = vb[i] * rb * A[i] + B[i];
        *(u32x2*)(hb + (size_t)(row + 1) * 1024 + c) = (u32x2){pk2(yb.x, yb.y), pk2(yb.z, yb.w)}; }
    }
  }
}
#undef NORM_LOAD
DI void phase_final_norm(const Params& p) {
  const int lane = otid() & 63, gw = blockIdx.x * 8 + (otid() >> 6), nw = gridDim.x * 8;
  for (int row = gw; row < NLAT; row += nw) {
    float* xr = p.out + (size_t)row * DM;
    float4 v[4]; float ss = 0.f;
#pragma unroll
    for (int i = 0; i < 4; ++i) { v[i] = *(const float4*)(xr + 4 * lane + 256 * i); ss += v[i].x * v[i].x + v[i].y * v[i].y + v[i].z * v[i].z + v[i].w * v[i].w; }
    ss = wave_sum(ss);
    const float rstd = rsqrtf(ss * (1.f / 1024.f) + EPSF);
#pragma unroll
    for (int i = 0; i < 4; ++i) { const int c = 4 * lane + 256 * i; const float4 gg = *(const float4*)(p.final_g + c);
      *(float4*)(xr + c) = make_float4(v[i].x * rstd * gg.x, v[i].y * rstd * gg.y, v[i].z * rstd * gg.z, v[i].w * rstd * gg.w); }
  }
}

DI void phase_filt_gemm(const Params& p, int l, LAS unsigned char* lds, int blk, int nblk) {
  LAS float* w3s = (LAS float*)lds;
  LAS float* a2s = w3s + 64 * 64;
  const int tid = otid();
  const int nL = 32 * 32, nC = 32 * 2;
  for (int it = blk; it < nL + nC; it += nblk) {
    const bool isc = it >= nL; const int r = isc ? it - nL : it; const int Lq = isc ? 256 : 4096;
    const int ntt = Lq / 128, dt = r / ntt, tt0 = (r % ntt) * 128, d0 = dt * 64;
    const float* A2 = isc ? (const float*)(p.ws + OFF_A2C) + (size_t)l * 256 * 64 : (const float*)(p.ws + OFF_A2L) + (size_t)l * 4096 * 64;
    float* hT = isc ? (float*)(p.ws + ((l & 1) ? OFF_HTC2 : OFF_HTC)) : (float*)(p.ws + ((l & 1) ? OFF_HP2 : OFF_HP));
    { const int m = tid >> 3, q = tid & 7; const float* s = p.fw3 + ((size_t)l * 64 + m) * 2048 + d0;
      *(LAS f32x4*)(w3s + m * 64 + 4 * q) = *(const f32x4*)(s + 4 * q); *(LAS f32x4*)(w3s + m * 64 + 32 + 4 * q) = *(const f32x4*)(s + 32 + 4 * q); }
    { const int tt = tid >> 2, mq = tid & 3; const float* s = A2 + (size_t)(tt0 + tt) * 64 + 16 * mq;
#pragma unroll
      for (int q = 0; q < 4; ++q) { const float4 v = *(const float4*)(s + 4 * q);
        a2s[(16 * mq + 4 * q + 0) * 132 + tt] = v.x; a2s[(16 * mq + 4 * q + 1) * 132 + tt] = v.y; a2s[(16 * mq + 4 * q + 2) * 132 + tt] = v.z; a2s[(16 * mq + 4 * q + 3) * 132 + tt] = v.w; } }
    __syncthreads();
    const int cx = tid & 15, ty = tid >> 4;
    float acc[4][4];
#pragma unroll
    for (int a = 0; a < 4; ++a)
#pragma unroll
      for (int b = 0; b < 4; ++b) acc[a][b] = 0.f;
#pragma unroll 8
    for (int m = 0; m < 64; ++m) {
      const f32x4 wv = *(const LAS f32x4*)(w3s + m * 64 + 4 * cx), av = *(const LAS f32x4*)(a2s + m * 132 + 4 * ty);
      const float w[4] = {wv.x, wv.y, wv.z, wv.w}, a[4] = {av.x, av.y, av.z, av.w};
#pragma unroll
      for (int ci = 0; ci < 4; ++ci)
#pragma unroll
        for (int ti = 0; ti < 4; ++ti) acc[ci][ti] += w[ci] * a[ti];
    }
    const float inv = 1.f / (float)(Lq - 1);
#pragma unroll
    for (int ci = 0; ci < 4; ++ci) {
      const int dirch = d0 + 4 * cx + ci; const float dc = fabsf(p.decay[l * 1024 + (dirch & 1023)]);
      float o[4];
#pragma unroll
      for (int ti = 0; ti < 4; ++ti) { const float tl = (float)(tt0 + 4 * ty + ti) * inv; o[ti] = acc[ci][ti] * __expf(-tl * dc); }
      *(float4*)(hT + (size_t)dirch * Lq + tt0 + 4 * ty) = make_float4(o[0], o[1], o[2], o[3]);
    }
    __syncthreads();
  }
}
#define XB_TMO      128
#define XB_XCNT(j)  (256  + 64 * (j))
#define XB_XSUB(j)  (1280 + 64 * (j))
#define XB_XGEN(j)  (2304 + 64 * (j))
#define XB_TOP      3328
#define XB_TOPGEN   3392
#define XCD_BAR_WORDS 3456
#define XB_SPIN_CAP (1u << 18)

__device__ __forceinline__ unsigned xb_ld(unsigned* p)              { return __hip_atomic_load(p, __ATOMIC_RELAXED, __HIP_MEMORY_SCOPE_AGENT); }
__device__ __forceinline__ unsigned xb_add(unsigned* p, unsigned v) { return __hip_atomic_fetch_add(p, v, __ATOMIC_RELAXED, __HIP_MEMORY_SCOPE_AGENT); }
__device__ __forceinline__ unsigned xb_xcc_id() { return (unsigned)__builtin_amdgcn_s_getreg((3 << 11) | 20) & 0xFu; }
#define XB_SPIN(cond, bar) do { unsigned _sp = 0; while (cond) { __builtin_amdgcn_s_sleep(1); \
    if ((++_sp & 255u) == 0u) { if (xb_ld(&(bar)[XB_TMO])) break; if (_sp > XB_SPIN_CAP) { atomicAdd(&(bar)[XB_TMO], 1u); break; } } } } while (0)
struct XcdBarrier {
    unsigned* bar; unsigned x;
    volatile LAS unsigned* st;
};

__device__ __forceinline__ XcdBarrier xcd_barrier_post(unsigned* bar, volatile LAS unsigned* st) {
    XcdBarrier b; b.bar = bar; b.x = xb_xcc_id(); b.st = st;
    if (threadIdx.x == 0) (void)xb_add(&bar[XB_XCNT(b.x)], 1u);
    return b;
}
__device__ __forceinline__ void xcd_barrier_complete(unsigned* bar, unsigned x, unsigned& nloc, unsigned& nx) {
    const unsigned G = gridDim.x * gridDim.y * gridDim.z;
    unsigned sum, cnt, mine, sp = 0u;
    for (;;) {
        sum = 0u; cnt = 0u; mine = 0u;
#pragma unroll
        for (unsigned j = 0; j < 16; ++j) { const unsigned c = xb_ld(&bar[XB_XCNT(j)]); sum += c; cnt += (c > 0u) ? 1u : 0u; mine = (j == x) ? c : mine; }
        if (sum == G) break;
        __builtin_amdgcn_s_sleep(1);
        if ((++sp & 255u) == 0u) { if (xb_ld(&bar[XB_TMO])) break; if (sp > XB_SPIN_CAP) { atomicAdd(&bar[XB_TMO], 1u); break; } }
    }
    nloc = mine > 0u ? mine : 1u; nx = cnt > 0u ? cnt : 1u;
}

__device__ __forceinline__ void xcd_barrier(const XcdBarrier& b) {
    asm volatile("s_waitcnt vmcnt(0)" ::: "memory");
    __syncthreads();
    if (threadIdx.x == 0) {
        unsigned* bar = b.bar;
        __builtin_amdgcn_s_waitcnt(0);
        unsigned nloc = b.st[0], nx = b.st[1];
        if (nloc == 0u) { xcd_barrier_complete(bar, b.x, nloc, nx); b.st[0] = nloc; b.st[1] = nx; }
        const unsigned old = xb_add(&bar[XB_XSUB(b.x)], 1u);
        const unsigned gen = old / nloc;
        if (old + 1u == (gen + 1u) * nloc) {
            __builtin_amdgcn_fence(__ATOMIC_RELEASE, "agent");
            asm volatile("s_waitcnt vmcnt(0)" ::: "memory");
            const unsigned og = xb_add(&bar[XB_TOP], 1u);
            const unsigned tg = og / nx;
            if (og + 1u == (tg + 1u) * nx) xb_add(&bar[XB_TOPGEN], 1u);
            else XB_SPIN(xb_ld(&bar[XB_TOPGEN]) == tg, bar);
            __builtin_amdgcn_fence(__ATOMIC_ACQUIRE, "agent");
            xb_add(&bar[XB_XGEN(b.x)], 1u);
            asm volatile("s_waitcnt vmcnt(0)" ::: "memory");
        } else {
            XB_SPIN(xb_ld(&bar[XB_XGEN(b.x)]) == gen, bar);
            __builtin_amdgcn_fence(__ATOMIC_ACQUIRE, "agent");
            asm volatile("s_waitcnt vmcnt(0)" ::: "memory");
        }
    }
    __syncthreads();
}

typedef float cplx __attribute__((ext_vector_type(2)));
DI cplx mk2(float a, float b) { cplx r; r.x = a; r.y = b; return r; }
DI constexpr float cos32(int m) { constexpr float t[16] = {1.f, 0.98078528040323043f, 0.92387953251128674f, 0.83146961230254524f, 0.70710678118654752f, 0.55557023301960218f, 0.38268343236508977f, 0.19509032201612825f,
    0.f, -0.19509032201612825f, -0.38268343236508977f, -0.55557023301960218f, -0.70710678118654752f, -0.83146961230254524f, -0.92387953251128674f, -0.98078528040323043f}; return t[m]; }
DI constexpr float sin32(int m) { constexpr float t[16] = {0.f, 0.19509032201612825f, 0.38268343236508977f, 0.55557023301960218f, 0.70710678118654752f, 0.83146961230254524f, 0.92387953251128674f, 0.98078528040323043f,
    1.f, 0.98078528040323043f, 0.92387953251128674f, 0.83146961230254524f, 0.70710678118654752f, 0.55557023301960218f, 0.38268343236508977f, 0.19509032201612825f}; return t[m]; }
DI constexpr int brev(int k, int bits) { int r = 0; for (int i = 0; i < bits; ++i) r |= ((k >> i) & 1) << (bits - 1 - i); return r; }
DI cplx cmul(cplx a, cplx b) { return mk2(a.x * b.x - a.y * b.y, a.x * b.y + a.y * b.x); }
DI cplx cmulc(cplx a, cplx b) { return mk2(a.x * b.x + a.y * b.y, a.y * b.x - a.x * b.y); }

template <int R, bool INV> DI void dft_reg(cplx (&v)[R]) {
#pragma unroll
  for (int len = R; len >= 2; len >>= 1) {
    const int half = len >> 1;
#pragma unroll
    for (int s = 0; s < R; s += len) {
#pragma unroll
      for (int j = 0; j < half; ++j) {
        const cplx a = v[s + j], b = v[s + j + half];
        v[s + j] = mk2(a.x + b.x, a.y + b.y);
        const cplx d = mk2(a.x - b.x, a.y - b.y);
        const int m = j * (32 / len);
        if (m == 0) v[s + j + half] = d;
        else if (m == 8) v[s + j + half] = INV ? mk2(-d.y, d.x) : mk2(d.y, -d.x);
        else { const float c = cos32(m), sn = sin32(m);
          v[s + j + half] = INV ? mk2(d.x * c - d.y * sn, d.x * sn + d.y * c) : mk2(d.x * c + d.y * sn, d.y * c - d.x * sn); }
      }
    }
  }
}
constexpr int FFT_REGION_F2 = 8704;

template <int NV> DI void fft_fwd3(cplx (&v)[NV][16], LAS cplx* L, int tid) {

#pragma unroll
  for (int i = 0; i < NV; ++i) dft_reg<16, false>(v[i]);

  { float rev = (float)tid * (1.f / 8192.f); asm volatile("" : "+v"(rev)); const cplx w1 = mk2(__builtin_amdgcn_cosf(rev), -__builtin_amdgcn_sinf(rev)); cplx w = mk2(1.f, 0.f);
    const int pb = tid + 2 * (tid >> 5);
#pragma unroll
    for (int k = 0; k < 16; ++k) {
#pragma unroll
      for (int i = 0; i < NV; ++i) L[i * FFT_REGION_F2 + pb + 544 * k] = cmul(v[i][brev(k, 4)], w);
      w = cmul(w, w1); } }
  __syncthreads();
  { const int sb = tid >> 5, ii = tid & 31, pb = 544 * sb + ii;
    cplx u[NV][16];
#pragma unroll
    for (int i = 0; i < NV; ++i)
#pragma unroll
      for (int j = 0; j < 16; ++j) u[i][j] = L[i * FFT_REGION_F2 + pb + 34 * j];

#pragma unroll
    for (int i = 0; i < NV; ++i) dft_reg<16, false>(u[i]);

    float rev = (float)ii * (1.f / 512.f); asm volatile("" : "+v"(rev)); const cplx w1 = mk2(__builtin_amdgcn_cosf(rev), -__builtin_amdgcn_sinf(rev)); cplx w = mk2(1.f, 0.f);
#pragma unroll
    for (int k = 0; k < 16; ++k) {
#pragma unroll
      for (int i = 0; i < NV; ++i) L[i * FFT_REGION_F2 + pb + 34 * k] = cmul(u[i][brev(k, 4)], w);
      w = cmul(w, w1); } }
  __syncthreads();
  { const int sb = tid >> 1, ii = tid & 1, pb = 34 * sb + ii;
    cplx u[NV][16];
#pragma unroll
    for (int i = 0; i < NV; ++i)
#pragma unroll
      for (int j = 0; j < 16; ++j) u[i][j] = L[i * FFT_REGION_F2 + pb + 2 * j];

#pragma unroll
    for (int i = 0; i < NV; ++i) dft_reg<16, false>(u[i]);

#pragma unroll
    for (int k = 0; k < 16; ++k)
#pragma unroll
      for (int i = 0; i < NV; ++i) { const cplx y = u[i][brev(k, 4)]; const cplx yw = cmul(y, mk2(cos32(k), -sin32(k))); L[i * FFT_REGION_F2 + pb + 2 * k] = ii ? yw : y; } }
  __syncthreads();
}
template <int NV> DI void fft_inv3(cplx (&v)[NV][16], LAS cplx* L, int tid) {
  { const int sb = tid >> 1, ii = tid & 1, pb = 34 * sb + ii;
    cplx u[NV][16];
#pragma unroll
    for (int i = 0; i < NV; ++i)
#pragma unroll
      for (int k = 0; k < 16; ++k) { const cplx y = L[i * FFT_REGION_F2 + pb + 2 * k]; const cplx yw = cmulc(y, mk2(cos32(k), -sin32(k))); u[i][k] = ii ? yw : y; }

#pragma unroll
    for (int i = 0; i < NV; ++i) dft_reg<16, true>(u[i]);

#pragma unroll
    for (int i = 0; i < NV; ++i)
#pragma unroll
      for (int j = 0; j < 16; ++j) L[i * FFT_REGION_F2 + pb + 2 * j] = u[i][brev(j, 4)]; }
  __syncthreads();
  { const int sb = tid >> 5, ii = tid & 31, pb = 544 * sb + ii;
    cplx u[NV][16];
    float rev = (float)ii * (1.f / 512.f); asm volatile("" : "+v"(rev)); const cplx w1 = mk2(__builtin_amdgcn_cosf(rev), -__builtin_amdgcn_sinf(rev)); cplx w = mk2(1.f, 0.f);
#pragma unroll
    for (int k = 0; k < 16; ++k) {
#pragma unroll
      for (int i = 0; i < NV; ++i) u[i][k] = cmulc(L[i * FFT_REGION_F2 + pb + 34 * k], w);
      w = cmul(w, w1); }

#pragma unroll
    for (int i = 0; i < NV; ++i) dft_reg<16, true>(u[i]);

#pragma unroll
    for (int i = 0; i < NV; ++i)
#pragma unroll
      for (int j = 0; j < 16; ++j) L[i * FFT_REGION_F2 + pb + 34 * j] = u[i][brev(j, 4)]; }
  __syncthreads();
  { float rev = (float)tid * (1.f / 8192.f); asm volatile("" : "+v"(rev)); const cplx w1 = mk2(__builtin_amdgcn_cosf(rev), -__builtin_amdgcn_sinf(rev)); cplx w = mk2(1.f, 0.f);
    const int pb = tid + 2 * (tid >> 5);
#pragma unroll
    for (int k = 0; k < 16; ++k) {
#pragma unroll
      for (int i = 0; i < NV; ++i) v[i][k] = cmulc(L[i * FFT_REGION_F2 + pb + 544 * k], w);
      w = cmul(w, w1); }

#pragma unroll
    for (int i = 0; i < NV; ++i) dft_reg<16, true>(v[i]);
     }
}

DI float shl1(float x, int lane) { const float t = __shfl_up(x, 1); return lane == 0 ? 0.f : t; }
DI float shr1(float x, int lane) { const float t = __shfl_down(x, 1); return lane == 63 ? 0.f : t; }
DI void hy_conv8(const bf16_t* XT, int c, int bt, int tl, int lane, const float (&cw)[3][3], const float (&cb)[3], float (&x0c)[8], float (&zz)[8]) {
  float uc[3][8];
#pragma unroll
  for (int g = 0; g < 3; ++g) {
    const u32x4 raw = *(const u32x4*)(XT + (size_t)(g * 1024 + c) * NTOK + (size_t)bt * 4096 + 8 * tl);
    float pv[10];
#pragma unroll
    for (int q = 0; q < 4; ++q) { pv[1 + 2 * q] = bflo(raw[q]); pv[2 + 2 * q] = bfhi(raw[q]); }
    { const float t0 = __shfl_up(pv[8], 1), t1 = __shfl_down(pv[1], 1); pv[0] = (lane & 7) == 0 ? 0.f : t0; pv[9] = (lane & 7) == 7 ? 0.f : t1; }
#pragma unroll
    for (int e2 = 0; e2 < 8; ++e2) uc[g][e2] = cw[g][0] * pv[e2] + cw[g][1] * pv[e2 + 1] + cw[g][2] * pv[e2 + 2] + cb[g];
  }
#pragma unroll
  for (int e2 = 0; e2 < 8; ++e2) { x0c[e2] = uc[0][e2]; zz[e2] = uc[1][e2] * uc[2][e2]; }
}
template <int NV> DI void hyena_chan(const Params& p, int l, int c, LAS cplx* L, int tid) {
  bf16_t* XT = (bf16_t*)(p.ws + OFF_XT);
  const int lane = tid & 63;
  const int pb4 = 16 * tid + 2 * (tid >> 1);
  h16x2 Hr[5]; LAS h16x2* Hl = (LAS h16x2*)(L + 2 * FFT_REGION_F2) + tid;
  {
    const float* hT = (const float*)(p.ws + ((l & 1) ? OFF_HP2 : OFF_HP));
    const float* hf = hT + (size_t)c * 4096, * hbk = hT + (size_t)(1024 + c) * 4096;
    cplx f[1][16];
#pragma unroll
    for (int j = 0; j < 8; ++j) f[0][j] = mk2(hf[tid + 512 * j], 0.f);
#pragma unroll
    for (int j = 8; j < 16; ++j) { const int n = tid + 512 * j; f[0][j] = mk2(n == 4096 ? 0.f : hbk[n == 4096 ? 0 : 8192 - n], 0.f); }
    fft_fwd3<1>(f, L, tid);
#pragma unroll
    for (int m = 0; m < 8; ++m) { const cplx a = L[pb4 + 2 * m], b = L[pb4 + 2 * m + 1];
      h16x2 h0, h1; h0.x = (_Float16)((a.x + b.x) * HSCALE); h0.y = (_Float16)((a.y + b.y) * HSCALE); h1.x = (_Float16)((a.x - b.x) * HSCALE); h1.y = (_Float16)((a.y - b.y) * HSCALE);
      if (2 * m < 11) Hl[(2 * m) * 512] = h0; else Hr[2 * m - 11 < 0 ? 0 : 2 * m - 11] = h0;
      if (2 * m + 1 < 11) Hl[(2 * m + 1) * 512] = h1; else Hr[2 * m + 1 - 11 < 0 ? 0 : 2 * m + 1 - 11] = h1; }
    __syncthreads();
  }
  float cw[3][3], cb[3];
#pragma unroll
  for (int g = 0; g < 3; ++g) { cb[g] = p.conv_b[l * 3072 + g * 1024 + c];
#pragma unroll
    for (int t = 0; t < 3; ++t) cw[g][t] = p.conv_w[((size_t)l * 3 + t) * 3072 + g * 1024 + c]; }
  const float sk = p.skip[l * 1024 + c], sc = 1.f / (8192.f * HSCALE);
#pragma unroll 1
  for (int bp0 = 0; bp0 < 2; bp0 += NV) {
    int tl = tid; asm volatile("" : "+v"(tl));
#pragma unroll
    for (int i = 0; i < NV; ++i) {
      float xa[8], za[8], xb[8], zb[8];
      hy_conv8(XT, c, 2 * (bp0 + i), tl, lane, cw, cb, xa, za);
      hy_conv8(XT, c, 2 * (bp0 + i) + 1, tl, lane, cw, cb, xb, zb);
      LAS cplx* X = L + i * FFT_REGION_F2 + 8 * tl + 2 * (tl >> 2);
#pragma unroll
      for (int e2 = 0; e2 < 8; ++e2) X[e2] = mk2(za[e2], zb[e2]);

    }
    __syncthreads();
    cplx v[NV][16];
    { const int pb = tl + 2 * (tl >> 5);
#pragma unroll
      for (int i = 0; i < NV; ++i) {
#pragma unroll
        for (int j = 0; j < 8; ++j) v[i][j] = L[i * FFT_REGION_F2 + pb + 544 * j];
#pragma unroll
        for (int j = 8; j < 16; ++j) v[i][j] = mk2(0.f, 0.f); } }
    __syncthreads();

    fft_fwd3<NV>(v, L, tid);

#pragma unroll
    for (int i = 0; i < NV; ++i) {
      LAS cplx* Li = L + i * FFT_REGION_F2;
#pragma unroll
      for (int m = 0; m < 8; ++m) { const cplx a = Li[pb4 + 2 * m], b = Li[pb4 + 2 * m + 1];
        const h16x2 h0 = (2 * m < 11) ? Hl[(2 * m) * 512] : Hr[2 * m - 11 < 0 ? 0 : 2 * m - 11], h1 = (2 * m + 1 < 11) ? Hl[(2 * m + 1) * 512] : Hr[2 * m + 1 - 11 < 0 ? 0 : 2 * m + 1 - 11];
        const cplx y0 = cmul(mk2(a.x + b.x, a.y + b.y), mk2((float)h0.x, (float)h0.y)), y1 = cmul(mk2(a.x - b.x, a.y - b.y), mk2((float)h1.x, (float)h1.y));
        Li[pb4 + 2 * m] = mk2(y0.x + y1.x, y0.y + y1.y); Li[pb4 + 2 * m + 1] = mk2(y0.x - y1.x, y0.y - y1.y); }
       }
    __syncthreads();
    fft_inv3<NV>(v, L, tid);

    { const int pb = tl + 2 * (tl >> 5);
#pragma unroll
      for (int i = 0; i < NV; ++i)
#pragma unroll
        for (int j = 0; j < 8; ++j) L[i * FFT_REGION_F2 + pb + 544 * j] = v[i][brev(j, 4)]; }
    __syncthreads();
#pragma unroll
    for (int i = 0; i < NV; ++i) {
      float xa[8], za[8], xb[8], zb[8];
      hy_conv8(XT, c, 2 * (bp0 + i), tl, lane, cw, cb, xa, za);
      hy_conv8(XT, c, 2 * (bp0 + i) + 1, tl, lane, cw, cb, xb, zb);
      const LAS cplx* X = L + i * FFT_REGION_F2 + 8 * tl + 2 * (tl >> 2);
      float ya[8], yb[8];
#pragma unroll
      for (int e2 = 0; e2 < 8; ++e2) { const cplx cv = X[e2]; ya[e2] = xa[e2] * (cv.x * sc + sk * za[e2]); yb[e2] = xb[e2] * (cv.y * sc + sk * zb[e2]); }
      *(u32x4*)(XT + (size_t)c * NTOK + (size_t)(2 * (bp0 + i)) * 4096 + 8 * tl) = (u32x4){pk2(ya[0], ya[1]), pk2(ya[2], ya[3]), pk2(ya[4], ya[5]), pk2(ya[6], ya[7])};
      *(u32x4*)(XT + (size_t)c * NTOK + (size_t)(2 * (bp0 + i) + 1) * 4096 + 8 * tl) = (u32x4){pk2(yb[0], yb[1]), pk2(yb[2], yb[3]), pk2(yb[4], yb[5]), pk2(yb[6], yb[7])};

    }
    __syncthreads();
  }
}

DI void hyena_ctx_item(const Params& p, int l, int c, LAS unsigned char* lds) {
  LAS float* zs = (LAS float*)lds;
  LAS float* hc = zs + 1024;
  LAS float* part = hc + 512;
  bf16_t* XT = (bf16_t*)(p.ws + OFF_XT);
  const float* hTc = (const float*)(p.ws + ((l & 1) ? OFF_HTC2 : OFF_HTC));
  const int tid = otid();
  { const int i = tid - 256; hc[tid] = i >= 0 ? hTc[(size_t)c * 256 + i] : (tid == 0 ? 0.f : hTc[(size_t)(1024 + c) * 256 + (-i)]); }
  float u0[2];
  { const int b = tid >> 7, tq = tid & 127;
#pragma unroll
    for (int e = 0; e < 2; ++e) {
      const int t = tq + 128 * e;
      float uu[3];
#pragma unroll
      for (int g = 0; g < 3; ++g) {
        const bf16_t* row = XT + (size_t)(g * 1024 + c) * NTOK + NLAT + b * 256;
        const float pm = t > 0 ? bf2f(row[t - 1]) : 0.f, p0 = bf2f(row[t]), pp = t < 255 ? bf2f(row[t + 1]) : 0.f;
        const size_t wb = (size_t)l * 3 * 3072 + g * 1024 + c;
        uu[g] = p.conv_w[wb] * pm + p.conv_w[wb + 3072] * p0 + p.conv_w[wb + 6144] * pp + p.conv_b[l * 3072 + g * 1024 + c];
      }
      u0[e] = uu[0]; zs[b * 256 + t] = uu[1] * uu[2];
    } }
  __syncthreads();
  const int t0 = 4 * (tid & 63), cbatch = (tid >> 6) & 3, sh = tid >> 8;
  float y[4] = {0.f, 0.f, 0.f, 0.f};
#pragma unroll 4
  for (int s0 = 128 * sh; s0 < 128 * sh + 128; s0 += 4) {
    const int base = 256 + t0 - s0 - 4;
    const f32x4 H0 = *(const LAS f32x4*)(hc + base), H1 = *(const LAS f32x4*)(hc + base + 4), z4 = *(const LAS f32x4*)(zs + cbatch * 256 + s0);
    const float hw[8] = {H0.x, H0.y, H0.z, H0.w, H1.x, H1.y, H1.z, H1.w}, zv[4] = {z4.x, z4.y, z4.z, z4.w};
#pragma unroll
    for (int j = 0; j < 4; ++j)
#pragma unroll
      for (int u = 0; u < 4; ++u) y[j] += hw[4 + j - u] * zv[u];
  }
  if (sh) *(LAS f32x4*)(part + cbatch * 256 + t0) = (f32x4){y[0], y[1], y[2], y[3]};
  __syncthreads();
  if (!sh) { const f32x4 o = *(const LAS f32x4*)(part + cbatch * 256 + t0); part[cbatch * 256 + t0] = y[0] + o.x; part[cbatch * 256 + t0 + 1] = y[1] + o.y; part[cbatch * 256 + t0 + 2] = y[2] + o.z; part[cbatch * 256 + t0 + 3] = y[3] + o.w; }
  __syncthreads();
  { const int b = tid >> 7, tq = tid & 127; const float sk = p.skip[l * 1024 + c];
#pragma unroll
    for (int e = 0; e < 2; ++e) { const int t = tq + 128 * e;
      XT[(size_t)c * NTOK + NLAT + b * 256 + t] = f2bf(u0[e] * (part[b * 256 + t] + sk * zs[b * 256 + t])); } }
  __syncthreads();
}

#ifndef HY_NV
#define HY_NV 2
#endif
#define MFMA32(a, b, c) __builtin_amdgcn_mfma_f32_32x32x16_bf16((a), (b), (c), 0, 0, 0)
DI float logsig(float x) { return fminf(x, 0.f) - __logf(1.f + __expf(-fabsf(x))); }
DI void phase_gla_prep(const Params& p, int l, LAS unsigned char* lds) {
  LAS float* lrs = (LAS float*)lds;
  LAS float* tots = lrs + 64 * 32;
  LAS bf16_t* qs = (LAS bf16_t*)(tots + 2 * 4 * 128);
  LAS bf16_t* kes = qs + 4 * 64 * 136;
  LAS bf16_t* ats = kes + 2 * 128 * 72;
  const int tid = otid(), d = tid & 127, tq = tid >> 7, wid = tid >> 6, lane = tid & 63;
  const bf16_t* PB = (const bf16_t*)(p.ws + OFF_PB);
  const float* LR = (const float*)(p.ws + OFF_LR);
  bf16_t* QF = (bf16_t*)(p.ws + OFF_QF); bf16_t* QB = (bf16_t*)(p.ws + OFF_QB);
  bf16_t* KEF = (bf16_t*)(p.ws + OFF_KEF); bf16_t* KEB = (bf16_t*)(p.ws + OFF_KEB);
  bf16_t* ATT = (bf16_t*)(p.ws + OFF_ATT); float* DEC = (float*)(p.ws + OFF_DEC);
  const float qscale = 0.08838834764831845f;
  f32x4 lrv; bf16_t qv[16], kv[16];
#define PREP_LOAD(it_) do { const int ch_ = (it_) >> 2, hh_ = (it_) & 3; const size_t t0_ = (size_t)ch_ * 64; lrv = *(const f32x4*)(LR + t0_ * 32 + 4 * tid); \
    _Pragma("unroll") for (int i = 0; i < 16; ++i) { const size_t tk_ = t0_ + tq * 16 + i; qv[i] = PB[tk_ * 4096 + hh_ * 128 + d]; kv[i] = PB[tk_ * 4096 + 512 + hh_ * 128 + d]; } } while (0)
  float gwf[16], gwb[16], gbf = 0.f, gbb = 0.f;
#define PREP_LOADG(it_) do { const int hh_ = (it_) & 3; \
    _Pragma("unroll") for (int r = 0; r < 16; ++r) { gwf[r] = p.gate_w[(((size_t)l * 2 + 0) * 16 + r) * 512 + hh_ * 128 + d]; gwb[r] = p.gate_w[(((size_t)l * 2 + 1) * 16 + r) * 512 + hh_ * 128 + d]; } \
    gbf = p.gate_b[((size_t)l * 2 + 0) * 512 + hh_ * 128 + d]; gbb = p.gate_b[((size_t)l * 2 + 1) * 512 + hh_ * 128 + d]; } while (0)
  if ((int)blockIdx.x < 272 * 4) PREP_LOAD((int)blockIdx.x);
  for (int it = blockIdx.x; it < 272 * 4; it += gridDim.x) {
    const int chunk = it >> 2, h = it & 3, tok0 = chunk * 64;
    *(LAS f32x4*)(lrs + 4 * tid) = lrv;
    PREP_LOADG(it);
    __syncthreads();
    float cf[16], cb[16];
#pragma unroll
    for (int i = 0; i < 16; ++i) {
      const int t = tq * 16 + i; float pf = gbf, pb = gbb;
#pragma unroll
      for (int r4 = 0; r4 < 4; ++r4) { const f32x4 lf = *(const LAS f32x4*)(lrs + t * 32 + 4 * r4), lb = *(const LAS f32x4*)(lrs + t * 32 + 16 + 4 * r4);
        pf += lf.x * gwf[4 * r4] + lf.y * gwf[4 * r4 + 1] + lf.z * gwf[4 * r4 + 2] + lf.w * gwf[4 * r4 + 3]; pb += lb.x * gwb[4 * r4] + lb.y * gwb[4 * r4 + 1] + lb.z * gwb[4 * r4 + 2] + lb.w * gwb[4 * r4 + 3]; }
      cf[i] = logsig(pf) * (1.f / 16.f); cb[i] = logsig(pb) * (1.f / 16.f);
    }
    { float run = 0.f;
#pragma unroll
      for (int i = 0; i < 16; ++i) { run += cf[i]; cf[i] = run; }
      tots[(0 * 4 + tq) * 128 + d] = run; run = 0.f;
#pragma unroll
      for (int i = 15; i >= 0; --i) { run += cb[i]; cb[i] = run; }
      tots[(1 * 4 + tq) * 128 + d] = run; }
    __syncthreads();
    float offf = 0.f, offb = 0.f, cendf = 0.f, cendb = 0.f;
#pragma unroll
    for (int q = 0; q < 4; ++q) { const float a = tots[(0 * 4 + q) * 128 + d], b = tots[(1 * 4 + q) * 128 + d]; cendf += a; cendb += b; if (q < tq) offf += a; if (q > tq) offb += b; }
    const int o16 = d & 15, grp = o16 >> 2, ngrp = (grp == 1) ? 2 : (grp == 2) ? 1 : grp, permd = (d & ~15) | (ngrp << 2) | (o16 & 3);
    unsigned kef[8], keb[8];
    const float ecf = __expf(cendf), ecb = __expf(cendb);
#pragma unroll
    for (int i = 0; i < 16; ++i) {
      const int t = tq * 16 + i; const size_t tok = (size_t)tok0 + t;
      const float q = bf2f(qv[i]) * qscale, k = bf2f(kv[i]);
      const float ea = __expf(cf[i] + offf), eb2 = __expf(cb[i] + offb);
      const float kia = k * __builtin_amdgcn_rcpf(ea), kib = k * __builtin_amdgcn_rcpf(eb2);
      const bf16_t qf = f2bf(q * ea), kf = f2bf(kia), qb = f2bf(q * eb2), kb = f2bf(kib);
      const bf16_t ef = f2bf(kia * ecf), eb = f2bf(kib * ecb);
      qs[(0 * 64 + t) * 136 + d] = qf; qs[(1 * 64 + t) * 136 + d] = kf; qs[(2 * 64 + t) * 136 + d] = qb; qs[(3 * 64 + t) * 136 + d] = kb;
      QF[tok * 512 + h * 128 + permd] = qf; QB[tok * 512 + h * 128 + permd] = qb;
      if (i & 1) { kef[i >> 1] |= (unsigned)ef << 16; keb[i >> 1] |= (unsigned)eb << 16; } else { kef[i >> 1] = ef; keb[i >> 1] = eb; }
    }
    if (it + (int)gridDim.x < 272 * 4) PREP_LOAD(it + (int)gridDim.x);
    { LAS u32x4* d1 = (LAS u32x4*)(kes + (0 * 128 + d) * 72 + tq * 16); d1[0] = (u32x4){kef[0], kef[1], kef[2], kef[3]}; d1[1] = (u32x4){kef[4], kef[5], kef[6], kef[7]};
      LAS u32x4* d2 = (LAS u32x4*)(kes + (1 * 128 + d) * 72 + tq * 16); d2[0] = (u32x4){keb[0], keb[1], keb[2], keb[3]}; d2[1] = (u32x4){keb[4], keb[5], keb[6], keb[7]}; }
    if (tq == 0) { DEC[(((size_t)chunk * 4 + h) * 2 + 0) * 128 + d] = ecf; DEC[(((size_t)chunk * 4 + h) * 2 + 1) * 128 + d] = ecb; }
    __syncthreads();
    {
      const int dir = wid >> 2, ti = (wid >> 1) & 1, si = wid & 1, r = lane & 31, hh = lane >> 5;
      const LAS bf16_t* ka = qs + ((dir * 2 + 1) * 64 + 32 * si + r) * 136 + 8 * hh;
      const LAS bf16_t* qa = qs + ((dir * 2 + 0) * 64 + 32 * ti + r) * 136 + 8 * hh;
      f32x16 acc;
#pragma unroll
      for (int i = 0; i < 16; ++i) acc[i] = 0.f;
#pragma unroll
      for (int ks = 0; ks < 8; ++ks) acc = MFMA32(*(const LAS bf16x8*)(ka + 16 * ks), *(const LAS bf16x8*)(qa + 16 * ks), acc);
      const int t = 32 * ti + r;
      LAS bf16_t* dst = ats + (dir * 64 + t) * 72 + 32 * si + 4 * hh;
#pragma unroll
      for (int g = 0; g < 4; ++g) {
        float vv[4];
#pragma unroll
        for (int e = 0; e < 4; ++e) { const int s = 32 * si + 8 * g + 4 * hh + e; const bool keep = dir ? (s >= t) : (s <= t); vv[e] = keep ? acc[4 * g + e] : 0.f; }
        *(LAS u32x2*)(dst + 8 * g) = (u32x2){pk2(vv[0], vv[1]), pk2(vv[2], vv[3])};
      }
    }
    __syncthreads();
    {
      const size_t chh = (size_t)chunk * 4 + h;
#pragma unroll
      for (int q = 0; q < 2; ++q) { const int pc = tid + 512 * q, row = pc >> 3, cc = pc & 7;
        *(u32x4*)(KEF + (chh * 128 + row) * 64 + 8 * cc) = *(const LAS u32x4*)(kes + (0 * 128 + row) * 72 + 8 * cc);
        *(u32x4*)(KEB + (chh * 128 + row) * 64 + 8 * cc) = *(const LAS u32x4*)(kes + (1 * 128 + row) * 72 + 8 * cc);
        const int rr = row & 63, dd = row >> 6;
        *(u32x4*)(ATT + ((chh * 2 + dd) * 64 + rr) * 64 + 8 * cc) = *(const LAS u32x4*)(ats + (dd * 64 + rr) * 72 + 8 * cc); }
    }
    __syncthreads();
  }
}

#undef PREP_LOAD
#undef PREP_LOADG
DI bf16x8 pack8(const f32x16& x, int s) {
  u32x4 r; r[0] = pk2(x[8 * s + 0], x[8 * s + 1]); r[1] = pk2(x[8 * s + 2], x[8 * s + 3]); r[2] = pk2(x[8 * s + 4], x[8 * s + 5]); r[3] = pk2(x[8 * s + 6], x[8 * s + 7]);
  return __builtin_bit_cast(bf16x8, r);
}
DI void phase_gla_scan(const Params& p, LAS unsigned char* lds) {
  constexpr int BUFB = 64 * 136 * 2 + 128 * 72 * 2 + 64 * 72 * 2 + 512;
  const int tid = otid(), wid = tid >> 6, lane = tid & 63, r = lane & 31, hh = lane >> 5;
  const int bid = blockIdx.x, b = bid >> 3, h = (bid >> 1) & 3, dir = bid & 1;
  const bf16_t* Qg = (const bf16_t*)(p.ws + (dir ? OFF_QB : OFF_QF));
  const bf16_t* Kg = (const bf16_t*)(p.ws + (dir ? OFF_KEB : OFF_KEF));
  const bf16_t* ATT = (const bf16_t*)(p.ws + OFF_ATT); const float* DEC = (const float*)(p.ws + OFF_DEC);
  const bf16_t* VT = (const bf16_t*)(p.ws + OFF_XT) + (size_t)(3072 + h * 256 + 32 * wid + r) * NTOK + 8 * hh;
  bf16_t* Og = dir ? (bf16_t*)(p.ws + OFF_X) : (bf16_t*)(p.ws + OFF_PB);
  const int ldo = dir ? 1024 : 4096;
  const int qrow0 = tid >> 4, qcc = tid & 15, krow0 = tid >> 3, kcc = tid & 7;
  constexpr int OBUF = 64 * 264 * 2;
  LAS unsigned char* obase = lds + 2 * BUFB;
  f32x16 S[4];
#pragma unroll
  for (int m = 0; m < 4; ++m)
#pragma unroll
    for (int i = 0; i < 16; ++i) S[m][i] = 0.f;
  u32x4 pq0, pq1, pk0, pk1, pa; float pdc = 0.f; bf16x8 vf[4], vn[4];
#define SCAN_CIDX(st) ((st) < 4 ? (256 + 4 * b + (dir ? 3 - (st) : (st))) : (64 * b + (dir ? 67 - (st) : (st) - 4)))
#define SCAN_LOAD(st) do { const int ci_ = SCAN_CIDX(st); const size_t tk_ = (size_t)ci_ * 64, ch_ = (size_t)ci_ * 4 + h; \
    pq0 = *(const u32x4*)(Qg + (tk_ + qrow0) * 512 + h * 128 + 8 * qcc); pq1 = *(const u32x4*)(Qg + (tk_ + qrow0 + 32) * 512 + h * 128 + 8 * qcc); \
    pk0 = *(const u32x4*)(Kg + (ch_ * 128 + krow0) * 64 + 8 * kcc); pk1 = *(const u32x4*)(Kg + (ch_ * 128 + krow0 + 64) * 64 + 8 * kcc); \
    pa = *(const u32x4*)(ATT + ((ch_ * 2 + dir) * 64 + krow0) * 64 + 8 * kcc); if (tid < 128) pdc = DEC[(ch_ * 2 + dir) * 128 + tid]; \
    _Pragma("unroll") for (int ks = 0; ks < 4; ++ks) vn[ks] = *(const bf16x8*)(VT + tk_ + 16 * ks); } while (0)
#define SCAN_STORE(bufi) do { LAS unsigned char* bb_ = lds + (bufi) * BUFB; LAS bf16_t* QT_ = (LAS bf16_t*)bb_; LAS bf16_t* KE_ = QT_ + 64 * 136; LAS bf16_t* AT_ = KE_ + 128 * 72; LAS float* DC_ = (LAS float*)(AT_ + 64 * 72); \
    *(LAS u32x4*)(QT_ + qrow0 * 136 + 8 * qcc) = pq0; *(LAS u32x4*)(QT_ + (qrow0 + 32) * 136 + 8 * qcc) = pq1; \
    *(LAS u32x4*)(KE_ + krow0 * 72 + 8 * kcc) = pk0; *(LAS u32x4*)(KE_ + (krow0 + 64) * 72 + 8 * kcc) = pk1; \
    *(LAS u32x4*)(AT_ + krow0 * 72 + 8 * kcc) = pa; if (tid < 128) DC_[tid] = pdc; } while (0)
#define SCAN_WRITEOUT(st) do { const size_t tk_ = (size_t)SCAN_CIDX(st) * 64; const LAS bf16_t* ob_ = (const LAS bf16_t*)(obase + ((st) & 1) * OBUF); \
    _Pragma("unroll 2") for (int q = 0; q < 4; ++q) { const int pc_ = tid + 512 * q, row_ = pc_ >> 5, cc_ = pc_ & 31; \
      *(u32x4*)(Og + (tk_ + row_) * ldo + h * 256 + 8 * cc_) = *(const LAS u32x4*)(ob_ + row_ * 264 + 8 * cc_); } } while (0)
  SCAN_LOAD(0); SCAN_STORE(0);
#pragma unroll
  for (int ks = 0; ks < 4; ++ks) vf[ks] = vn[ks];
  __syncthreads();
#pragma unroll 1
  for (int step = 0; step < 68; ++step) {
    const size_t tok0 = (size_t)SCAN_CIDX(step) * 64;
    if (step > 0) SCAN_WRITEOUT(step - 1);
    __builtin_amdgcn_sched_barrier(0);
    if (step + 1 < 68) SCAN_LOAD(step + 1);
    LAS unsigned char* bb = lds + (step & 1) * BUFB;
    const LAS bf16_t* QT = (const LAS bf16_t*)bb; const LAS bf16_t* KE = QT + 64 * 136; const LAS bf16_t* AT = KE + 128 * 72; const LAS float* DC = (const LAS float*)(AT + 64 * 72);
    bf16x8 sp[8];
#pragma unroll
    for (int m = 0; m < 4; ++m) { sp[2 * m] = pack8(S[m], 0); sp[2 * m + 1] = pack8(S[m], 1); }
    f32x16 o0, o1;
#pragma unroll
    for (int i = 0; i < 16; ++i) { o0[i] = 0.f; o1[i] = 0.f; }
#pragma unroll
    for (int ks = 0; ks < 4; ++ks) {
      o0 = MFMA32(vf[ks], *(const LAS bf16x8*)(AT + r * 72 + 16 * ks + 8 * hh), o0);
      o1 = MFMA32(vf[ks], *(const LAS bf16x8*)(AT + (32 + r) * 72 + 16 * ks + 8 * hh), o1);
    }
#pragma unroll
    for (int k8 = 0; k8 < 8; ++k8) {
      o0 = MFMA32(sp[k8], *(const LAS bf16x8*)(QT + r * 136 + 16 * k8 + 8 * hh), o0);
      o1 = MFMA32(sp[k8], *(const LAS bf16x8*)(QT + (32 + r) * 136 + 16 * k8 + 8 * hh), o1);
    }
#pragma unroll
    for (int m = 0; m < 4; ++m) {
#pragma unroll
      for (int g = 0; g < 4; ++g) { const f32x4 dv = *(const LAS f32x4*)(DC + 32 * m + 8 * g + 4 * hh);
        S[m][4 * g] *= dv.x; S[m][4 * g + 1] *= dv.y; S[m][4 * g + 2] *= dv.z; S[m][4 * g + 3] *= dv.w; }
#pragma unroll
      for (int ks = 0; ks < 4; ++ks) S[m] = MFMA32(*(const LAS bf16x8*)(KE + (32 * m + r) * 72 + 16 * ks + 8 * hh), vf[ks], S[m]);
    }
    { LAS bf16_t* ob = (LAS bf16_t*)(obase + (step & 1) * OBUF) + r * 264 + 32 * wid + 4 * hh;
#pragma unroll
      for (int g = 0; g < 4; ++g) {
        *(LAS u32x2*)(ob + 8 * g) = (u32x2){pk2(o0[4 * g], o0[4 * g + 1]), pk2(o0[4 * g + 2], o0[4 * g + 3])};
        *(LAS u32x2*)(ob + 32 * 264 + 8 * g) = (u32x2){pk2(o1[4 * g], o1[4 * g + 1]), pk2(o1[4 * g + 2], o1[4 * g + 3])};
      } }
    if (step + 1 < 68) { SCAN_STORE((step + 1) & 1);
#pragma unroll
      for (int ks = 0; ks < 4; ++ks) vf[ks] = vn[ks]; }
    __syncthreads();
  }
  SCAN_WRITEOUT(67);
  __syncthreads();
#undef SCAN_WRITEOUT
#undef SCAN_CIDX
#undef SCAN_LOAD
#undef SCAN_STORE
}

DI void phase_post(const Params& p, int l, int ntok, LAS unsigned char* lds) {
  const int tid = otid(), lane = tid & 63;
  { const int gw = blockIdx.x * 8 + (tid >> 6), nw = gridDim.x * 8, l32 = lane & 31, hsel = lane >> 5;
    const bf16_t* PB = (const bf16_t*)(p.ws + OFF_PB); bf16_t* HB = (bf16_t*)(p.ws + OFF_X);
    const f32x4 ng0 = *(const f32x4*)(p.gla_ng + l * 256 + 8 * l32), ng1 = *(const f32x4*)(p.gla_ng + l * 256 + 8 * l32 + 4);
    u32x4 na, nb, nr;
    if (gw < ntok * 2) { const size_t tk = gw >> 1; const int cl = ((gw & 1) * 2 + hsel) * 256 + 8 * l32; na = *(const u32x4*)(PB + tk * 4096 + cl); nb = *(const u32x4*)(HB + tk * 1024 + cl); nr = *(const u32x4*)(PB + tk * 4096 + 1024 + cl); }
    for (int it = gw; it < ntok * 2; it += nw) {
      const size_t tok = it >> 1; const int col = ((it & 1) * 2 + hsel) * 256 + 8 * l32;
      const u32x4 a = na, b = nb, rr = nr;
      if (it + nw < ntok * 2) { const int i2 = it + nw; const size_t tk = i2 >> 1; const int cl = ((i2 & 1) * 2 + hsel) * 256 + 8 * l32; na = *(const u32x4*)(PB + tk * 4096 + cl); nb = *(const u32x4*)(HB + tk * 1024 + cl); nr = *(const u32x4*)(PB + tk * 4096 + 1024 + cl); }
      float o[8], rv[8];
#pragma unroll
      for (int i = 0; i < 4; ++i) { o[2 * i] = bflo(a[i]) + bflo(b[i]); o[2 * i + 1] = bfhi(a[i]) + bfhi(b[i]); rv[2 * i] = bflo(rr[i]); rv[2 * i + 1] = bfhi(rr[i]); }
      float ss = 0.f;
#pragma unroll
      for (int i = 0; i < 8; ++i) ss += o[i] * o[i];
#pragma unroll
      for (int q = 16; q >= 1; q >>= 1) ss += __shfl_xor(ss, q);
      const float rstd = rsqrtf(ss * (1.f / 256.f) + EPSF);
      const float ngv[8] = {ng0.x, ng0.y, ng0.z, ng0.w, ng1.x, ng1.y, ng1.z, ng1.w};
      float y[8];
#pragma unroll
      for (int i = 0; i < 8; ++i) y[i] = o[i] * rstd * ngv[i] * (rv[i] * sigm(rv[i]));
      *(u32x4*)(HB + tok * 1024 + col) = (u32x4){pk2(y[0], y[1]), pk2(y[2], y[3]), pk2(y[4], y[5]), pk2(y[6], y[7])};
    } }
  { LAS bf16_t* t = (LAS bf16_t*)lds;
    const bf16_t* XT = (const bf16_t*)(p.ws + OFF_XT); bf16_t* YH = (bf16_t*)(p.ws + OFF_QF);
    const int ntt = ntok / 128;
    u32x4 pre[2];
#define POST_TLOAD(it_) do { const int c0_ = ((it_) / ntt) * 64, tk0_ = ((it_) % ntt) * 128; \
      _Pragma("unroll") for (int q = 0; q < 2; ++q) { const int pc = tid + 512 * q, cc = pc >> 4, tq = pc & 15; pre[q] = *(const u32x4*)(XT + (size_t)(c0_ + cc) * NTOK + tk0_ + 8 * tq); } } while (0)
    if ((int)blockIdx.x < 16 * ntt) POST_TLOAD((int)blockIdx.x);
    for (int it = blockIdx.x; it < 16 * ntt; it += gridDim.x) {
      const int c0 = (it / ntt) * 64, tok0 = (it % ntt) * 128;
#pragma unroll
      for (int q = 0; q < 2; ++q) { const int pc = tid + 512 * q, cc = pc >> 4, tq = pc & 15; *(LAS u32x4*)(t + cc * 136 + 8 * tq) = pre[q]; }
      if (it + (int)gridDim.x < 16 * ntt) POST_TLOAD(it + (int)gridDim.x);
      __syncthreads();
#pragma unroll
      for (int q = 0; q < 2; ++q) { const int pc = tid + 512 * q, tk = pc >> 3, cq = pc & 7; unsigned w[4];
#pragma unroll
        for (int i = 0; i < 4; ++i) w[i] = (unsigned)t[(8 * cq + 2 * i) * 136 + tk] | ((unsigned)t[(8 * cq + 2 * i + 1) * 136 + tk] << 16);
        *(u32x4*)(YH + (size_t)(tok0 + tk) * 1024 + c0 + 8 * cq) = (u32x4){w[0], w[1], w[2], w[3]}; }
      __syncthreads();
    } }
}

#undef POST_TLOAD
struct SchedG1 : pg8::StaticOrder {
  __device__ bool next(int i, pg8::Unit& u) const {
    pg8::Unit v; if (!pg8::StaticOrder::next(i, v)) return false;
    if (v.pn < 16) { u.pm = 68 + v.pn; u.pn = v.pm; } else { u.pm = v.pm; u.pn = 68 + v.pn; }
    return true;
  }
};
typedef const f32x4 (&AccRef)[2][2][4][2];
DI u32x4 pack_acc8(f32x4 v0, f32x4 v1) { return (u32x4){pk2(v0[0], v0[1]), pk2(v0[2], v0[3]), pk2(v1[0], v1[1]), pk2(v1[2], v1[3])}; }
struct EpiG1 {
  static constexpr bool PERM = true, AFTER_DRAIN = false;
  bf16_t* XT; bf16_t* PB; float* LR;
  DI void operator()(AccRef acc, const pg8::Unit& u, int wr, int wc, int fr, int fq) const {
    if (u.pm >= 68) {
      const int ch0 = (u.pm - 68) * 256 + wr * 64 + fr, tk0 = u.pn * 256 + wc * 32 + 8 * fq;
#pragma unroll
      for (int ai = 0; ai < 2; ++ai)
#pragma unroll
        for (int m = 0; m < 4; ++m) { bf16_t* rp = XT + (size_t)(ch0 + ai * 128 + m * 16) * NTOK + tk0;
#pragma unroll
          for (int bj = 0; bj < 2; ++bj) __builtin_nontemporal_store(pack_acc8(acc[ai][bj][m][0], acc[ai][bj][m][1]), (u32x4*)(rp + bj * 128)); }
    } else {
      const int wp = u.pn - 84, row0 = u.pm * 256 + wr * 64 + fr, col0 = wp * 256 + wc * 32 + 8 * fq;
      if (wp < 16) {
#pragma unroll
        for (int ai = 0; ai < 2; ++ai)
#pragma unroll
          for (int m = 0; m < 4; ++m) { bf16_t* rp = PB + (size_t)(row0 + ai * 128 + m * 16) * 4096 + col0;
#pragma unroll
            for (int bj = 0; bj < 2; ++bj) __builtin_nontemporal_store(pack_acc8(acc[ai][bj][m][0], acc[ai][bj][m][1]), (u32x4*)(rp + bj * 128)); }
      } else if (wc == 0) {
#pragma unroll
        for (int ai = 0; ai < 2; ++ai)
#pragma unroll
          for (int m = 0; m < 4; ++m) { float* rp = LR + (size_t)(row0 + ai * 128 + m * 16) * 32 + 8 * fq; *(f32x4*)rp = acc[ai][0][m][0]; *(f32x4*)(rp + 4) = acc[ai][0][m][1]; }
      }
    }
  }
};
template <int MODE> struct EpiGate {
  static constexpr bool PERM = true, AFTER_DRAIN = false;
  const bf16_t* PB; bf16_t* T1; bf16_t* MG;
  DI void operator()(AccRef acc, const pg8::Unit& u, int wr, int wc, int fr, int fq) const {
    const int row0 = u.pm * 256 + wr * 64 + fr, col0 = u.pn * 256 + wc * 32 + 8 * fq;
#pragma unroll
    for (int ai = 0; ai < 2; ++ai)
#pragma unroll
      for (int m = 0; m < 4; ++m) { const size_t row = (size_t)(row0 + ai * 128 + m * 16);
#pragma unroll
        for (int bj = 0; bj < 2; ++bj) { const int col = col0 + bj * 128;
          const u32x4 g = *(const u32x4*)(PB + row * 4096 + (MODE ? 3072 : 2048) + col);
          const f32x4 v0 = acc[ai][bj][m][0], v1 = acc[ai][bj][m][1];
          float o[8] = {v0[0] * sigm(bflo(g[0])), v0[1] * sigm(bfhi(g[0])), v0[2] * sigm(bflo(g[1])), v0[3] * sigm(bfhi(g[1])),
                        v1[0] * sigm(bflo(g[2])), v1[1] * sigm(bfhi(g[2])), v1[2] * sigm(bflo(g[3])), v1[3] * sigm(bfhi(g[3]))};
          if (MODE) { const u32x4 t = *(const u32x4*)(T1 + row * 1024 + col);
            o[0] += bflo(t[0]); o[1] += bfhi(t[0]); o[2] += bflo(t[1]); o[3] += bfhi(t[1]); o[4] += bflo(t[2]); o[5] += bfhi(t[2]); o[6] += bflo(t[3]); o[7] += bfhi(t[3]); }
          *(u32x4*)((MODE ? MG : T1) + row * 1024 + col) = (u32x4){pk2(o[0], o[1]), pk2(o[2], o[3]), pk2(o[4], o[5]), pk2(o[6], o[7])}; } }
  }
};
struct EpiRes {
  static constexpr bool PERM = false, AFTER_DRAIN = false;
  float* out; float* ctxs; const float* modl; int goff; const float* src_lat; const float* src_ctx;
  DI void operator()(AccRef acc, const pg8::Unit& u, int wr, int wc, int fr, int fq) const {
    const int row0 = u.pm * 256 + wr * 64 + fr, col0 = u.pn * 256 + wc * 32 + 4 * fq;
    const float* gv = modl + (size_t)(u.pm < 64 ? (u.pm >> 4) : 4) * 6144 + goff + col0;
    f32x4 gg[2][2];
#pragma unroll
    for (int bj = 0; bj < 2; ++bj)
#pragma unroll
      for (int n = 0; n < 2; ++n) gg[bj][n] = *(const f32x4*)(gv + bj * 128 + n * 16);
#pragma unroll
    for (int ai = 0; ai < 2; ++ai)
#pragma unroll
      for (int m = 0; m < 4; ++m) { const int row = row0 + ai * 128 + m * 16;
        float* rp = (row < NLAT ? out + (size_t)row * 1024 : ctxs + (size_t)(row - NLAT) * 1024) + col0;
        const float* sp = (row < NLAT ? src_lat + (size_t)row * 1024 : src_ctx + (size_t)(row - NLAT) * 1024) + col0;
#pragma unroll
        for (int bj = 0; bj < 2; ++bj)
#pragma unroll
          for (int n = 0; n < 2; ++n) { f32x4* q = (f32x4*)(rp + bj * 128 + n * 16); *q = *(const f32x4*)(sp + bj * 128 + n * 16) + gg[bj][n] * acc[ai][bj][m][n]; } }
  }
};
struct EpiRelu2 {
  static constexpr bool PERM = true, AFTER_DRAIN = false;
  bf16_t* O;
  DI void operator()(AccRef acc, const pg8::Unit& u, int wr, int wc, int fr, int fq) const {
    const int row0 = u.pm * 256 + wr * 64 + fr, col0 = u.pn * 256 + wc * 32 + 8 * fq;
#pragma unroll
    for (int ai = 0; ai < 2; ++ai)
#pragma unroll
      for (int m = 0; m < 4; ++m) { bf16_t* rp = O + (size_t)(row0 + ai * 128 + m * 16) * 4096 + col0;
#pragma unroll
        for (int bj = 0; bj < 2; ++bj) { f32x4 v0 = acc[ai][bj][m][0], v1 = acc[ai][bj][m][1];
#pragma unroll
          for (int e = 0; e < 4; ++e) { const float a = fmaxf(v0[e], 0.f), b = fmaxf(v1[e], 0.f); v0[e] = a * a; v1[e] = b * b; }
          __builtin_nontemporal_store(pack_acc8(v0, v1), (u32x4*)(rp + bj * 128)); } }
  }
};

#define MFMA16(a, b, c) __builtin_amdgcn_mfma_f32_16x16x32_bf16((a), (b), (c), 0, 0, 0)
template <class F> DI void ctx_gemm(const bf16_t* A, const bf16_t* Bt, int K, int N, LAS unsigned char* lds, const F& epi) {
  constexpr int LDT = 136, TILEB = 64 * LDT * 2;
  const int tid = otid(), wid = tid >> 6, lane = tid & 63, fr = lane & 15, fq = lane >> 4, wm = wid >> 1, wn = wid & 1;
  const int ntn = N / 64, ntiles = 16 * ntn, nk = K / 128;
  const int lrow = tid >> 4, lcc = tid & 15;
  for (int t0 = blockIdx.x; t0 < ntiles; t0 += gridDim.x) {
    int tile = t0;
    if (ntiles == 256 && gridDim.x == 256) { const int x = t0 & 7, idx = t0 >> 3; tile = (4 * (x >> 1) + (idx >> 3)) * 16 + 8 * (x & 1) + (idx & 7); }
    const int tm = tile / ntn, tn = tile % ntn;
    const bf16_t* Ab = A + (size_t)(tm * 64 + lrow) * K + 8 * lcc; const bf16_t* Bb = Bt + (size_t)(tn * 64 + lrow) * K + 8 * lcc;
    const size_t r32 = (size_t)32 * K;
    u32x4 ra0, ra1, rb0, rb1, sa0, sa1, sb0, sb1;
#define CG_LOAD(x0, x1, y0, y1, kt_) do { const int ko_ = (kt_) * 128; x0 = *(const u32x4*)(Ab + ko_); x1 = *(const u32x4*)(Ab + r32 + ko_); y0 = *(const u32x4*)(Bb + ko_); y1 = *(const u32x4*)(Bb + r32 + ko_); } while (0)
#define CG_STORE(x0, x1, y0, y1, bufi) do { LAS bf16_t* dA_ = (LAS bf16_t*)(lds + (bufi) * 2 * TILEB); LAS bf16_t* dB_ = (LAS bf16_t*)(lds + (bufi) * 2 * TILEB + TILEB); \
    *(LAS u32x4*)(dA_ + lrow * LDT + 8 * lcc) = x0; *(LAS u32x4*)(dA_ + (lrow + 32) * LDT + 8 * lcc) = x1; *(LAS u32x4*)(dB_ + lrow * LDT + 8 * lcc) = y0; *(LAS u32x4*)(dB_ + (lrow + 32) * LDT + 8 * lcc) = y1; } while (0)
#define CG_COMPUTE(bufi) do { const LAS bf16_t* sA_ = (const LAS bf16_t*)(lds + (bufi) * 2 * TILEB); const LAS bf16_t* sB_ = (const LAS bf16_t*)(lds + (bufi) * 2 * TILEB + TILEB); \
    _Pragma("unroll") for (int ks = 0; ks < 4; ++ks) { const bf16x8 af = *(const LAS bf16x8*)(sA_ + (16 * wm + fr) * LDT + 32 * ks + 8 * fq); \
      const bf16x8 b0 = *(const LAS bf16x8*)(sB_ + (32 * wn + fr) * LDT + 32 * ks + 8 * fq), b1 = *(const LAS bf16x8*)(sB_ + (32 * wn + 16 + fr) * LDT + 32 * ks + 8 * fq); \
      acc0 = MFMA16(b0, af, acc0); acc1 = MFMA16(b1, af, acc1); } } while (0)
    CG_LOAD(ra0, ra1, rb0, rb1, 0); CG_LOAD(sa0, sa1, sb0, sb1, 1);
    CG_STORE(ra0, ra1, rb0, rb1, 0);
    __syncthreads();
    f32x4 acc0 = {0.f, 0.f, 0.f, 0.f}, acc1 = {0.f, 0.f, 0.f, 0.f};
#pragma unroll 1
    for (int kt = 0; kt < nk; kt += 2) {
      if (kt + 2 < nk) CG_LOAD(ra0, ra1, rb0, rb1, kt + 2);
      CG_COMPUTE(0);
      CG_STORE(sa0, sa1, sb0, sb1, 1);
      __syncthreads();
      if (kt + 3 < nk) CG_LOAD(sa0, sa1, sb0, sb1, kt + 3);
      CG_COMPUTE(1);
      if (kt + 2 < nk) CG_STORE(ra0, ra1, rb0, rb1, 0);
      __syncthreads();
    }
#undef CG_LOAD
#undef CG_STORE
#undef CG_COMPUTE
    const int row = tm * 64 + 16 * wm + fr, col = tn * 64 + 32 * wn + 4 * fq;
    epi(row, col, acc0); epi(row, col + 16, acc1);
  }
}

__global__ void __launch_bounds__(512, 2) fwd_megakernel(Params p) {
  extern __shared__ __attribute__((aligned(16))) unsigned char shm[];
  LAS unsigned char* lds = (LAS unsigned char*)shm;
  cg::grid_group grid = cg::this_grid();
  unsigned char* ws = p.ws;
  const int G = gridDim.x, cblk = blockIdx.x;
  unsigned* cnt = (unsigned*)(ws + OFF_CNT);
  __shared__ unsigned xbw[4];
#define s_item (*(volatile int*)&xbw[2])
  if (threadIdx.x == 0) { xbw[0] = 0u; xbw[1] = 0u; xbw[2] = 0u; xbw[3] = 0u; }
  __syncthreads();
#ifndef TPROBE
#define TPROBE 0
#endif
  unsigned long long tacc = 0ull, tt0 = 0ull;
#define TB(g) do { if (TPROBE == (g) && blockIdx.x == 0) tt0 = __builtin_amdgcn_s_memrealtime(); } while (0)
#define TE(g) do { if (TPROBE == (g) && blockIdx.x == 0) tacc += __builtin_amdgcn_s_memrealtime() - tt0; } while (0)

  TB(5); phase_copy(p); phase_mod(p, lds); phase_a2(p, lds);
  phase_wconv(p, 0, lds, 0, cblk, G); phase_wconv(p, 0, lds, 1, cblk, G);
  grid.sync(); TE(5);
  const XcdBarrier xb = xcd_barrier_post((unsigned*)(ws + OFF_BAR), (volatile LAS unsigned*)xbw);
  for (int l = 0; l < 4; ++l) {
    const bool last = (l == 3);
    const int MR = last ? NLAT : NTOK;
    TB(3); TB(14); if (l > 0) phase_wconv(p, l, lds, 1, cblk, G);
    phase_norm(p, l, p.norm1_g + l * 1024, 0, 1024, NTOK, l == 0);
    if (l == 0) phase_filt_gemm(p, l, lds, cblk, G);
    xcd_barrier(xb); TE(14); TE(3);
    TB(1); TB(6);
    { pg8::Gemm g{(const bf16_t*)(ws + OFF_X), (const bf16_t*)(ws + OFF_X), NTOK, 8448, 1024};
      SchedG1 S; S.init(NTOK, 8448, G, cblk);
      EpiG1 E{(bf16_t*)(ws + OFF_XT), (bf16_t*)(ws + OFF_PB), (float*)(ws + OFF_LR)};
      pg8::gemm_phase<EpiG1, SchedG1, false>(lds, g, S, E, nullptr); }
    xcd_barrier(xb); TE(1); TE(6);
    TB(4); TB(11); phase_gla_prep(p, l, lds);
    if (!last && cblk >= 64) phase_filt_gemm(p, l + 1, lds, cblk - 64, G - 64);
    xcd_barrier(xb); TE(4); TE(11);
    TB(2); TB(7); if (cblk < 32) phase_gla_scan(p, lds); TE(7);
    { LAS cplx* L = (LAS cplx*)lds;
      if (otid() == 0) s_item = (int)atomicAdd(cnt + 2 * l, 1u);
      for (;;) {
        __syncthreads();
        const int it = s_item;
        __syncthreads();
        if (it >= 1024) break;
        if (otid() == 0) s_item = (int)atomicAdd(cnt + 2 * l, 1u);
        hyena_chan<HY_NV>(p, l, __builtin_amdgcn_readfirstlane(it), L, otid());
      }
      if (!last) for (;;) {
        if (otid() == 0) s_item = (int)atomicAdd(cnt + 2 * l + 1, 1u);
        __syncthreads();
        const int it = s_item;
        __syncthreads();
        if (it >= 1024) break;
        hyena_ctx_item(p, l, it, lds);
      } }
    xcd_barrier(xb);
    TE(2);
    TB(4); TB(12); phase_post(p, l, MR, lds);
    xcd_barrier(xb); TE(4); TE(12);
    TB(1); TB(8);
    { pg8::StaticOrder S; S.init(NLAT, 1024, G, cblk);
      const bf16_t* PBc = (const bf16_t*)(ws + OFF_PB); bf16_t* T1 = (bf16_t*)(ws + OFF_KEF); bf16_t* MGp = (bf16_t*)(ws + OFF_XT + (size_t)3072 * NTOK * 2);
      EpiGate<0> E0{PBc, T1, nullptr};
      pg8::Gemm g0{(const bf16_t*)(ws + OFF_QF), (const bf16_t*)(ws + OFF_WBHY), NLAT, 1024, 1024};
      pg8::gemm_phase<EpiGate<0>, pg8::StaticOrder, false>(lds, g0, S, E0, nullptr);
      EpiGate<1> E1{PBc, T1, MGp};
      pg8::Gemm g1{(const bf16_t*)(ws + OFF_X), (const bf16_t*)(ws + OFF_WBGLA), NLAT, 1024, 1024};
      pg8::gemm_phase<EpiGate<1>, pg8::StaticOrder, false>(lds, g1, S, E1, nullptr);
      if (!last) {
        ctx_gemm((const bf16_t*)(ws + OFF_QF) + (size_t)NLAT * 1024, (const bf16_t*)(ws + OFF_WBHY), 1024, 1024, lds, [&](int r, int c, f32x4 v) {
          const size_t row = (size_t)NLAT + r; const u32x2 gt = *(const u32x2*)(PBc + row * 4096 + 2048 + c);
          *(u32x2*)(T1 + row * 1024 + c) = (u32x2){pk2(v[0] * sigm(bflo(gt[0])), v[1] * sigm(bfhi(gt[0]))), pk2(v[2] * sigm(bflo(gt[1])), v[3] * sigm(bfhi(gt[1])))}; });
        ctx_gemm((const bf16_t*)(ws + OFF_X) + (size_t)NLAT * 1024, (const bf16_t*)(ws + OFF_WBGLA), 1024, 1024, lds, [&](int r, int c, f32x4 v) {
          const size_t row = (size_t)NLAT + r; const u32x2 gt = *(const u32x2*)(PBc + row * 4096 + 3072 + c); const u32x2 t1 = *(const u32x2*)(T1 + row * 1024 + c);
          *(u32x2*)(MGp + row * 1024 + c) = (u32x2){pk2(bflo(t1[0]) + v[0] * sigm(bflo(gt[0])), bfhi(t1[0]) + v[1] * sigm(bfhi(gt[0]))), pk2(bflo(t1[1]) + v[2] * sigm(bflo(gt[1])), bfhi(t1[1]) + v[3] * sigm(bfhi(gt[1])))}; });
      } }
    xcd_barrier(xb); TE(8);
    { pg8::StaticOrder S; S.init(NLAT, 1024, G, cblk);
      EpiRes E{p.out, (float*)(ws + OFF_CTXS), modp(p, l, 0), 2048, l == 0 ? p.x : p.out, l == 0 ? p.ctx : (const float*)(ws + OFF_CTXS)};
      pg8::Gemm g{(const bf16_t*)(ws + OFF_XT + (size_t)3072 * NTOK * 2), (const bf16_t*)(ws + OFF_WOUT), NLAT, 1024, 1024};
      pg8::gemm_phase<EpiRes, pg8::StaticOrder, false>(lds, g, S, E, nullptr);
      if (!last) { float* cs = (float*)(ws + OFF_CTXS); const float* gv = modp(p, l, 4) + 2048; const float* csrc = l == 0 ? p.ctx : (const float*)cs;
        ctx_gemm((const bf16_t*)(ws + OFF_XT + (size_t)3072 * NTOK * 2) + (size_t)NLAT * 1024, (const bf16_t*)(ws + OFF_WOUT), 1024, 1024, lds, [&](int r, int c, f32x4 v) {
          *(f32x4*)(cs + (size_t)r * 1024 + c) = *(const f32x4*)(csrc + (size_t)r * 1024 + c) + *(const f32x4*)(gv + c) * v; }); } }
    xcd_barrier(xb); TE(1);
    TB(4); TB(13); phase_norm(p, l, p.norm2_g + l * 1024, 3072, 4096, MR, false);
    xcd_barrier(xb); TE(4); TE(13);
    if (TPROBE == 20) { for (int q = 0; q < 8; ++q) xcd_barrier(xb); }
    TB(1); TB(9);
    { pg8::StaticOrder S; S.init(MR, 4096, G, cblk);
      EpiRelu2 E{(bf16_t*)(ws + OFF_PB)};
      pg8::Gemm g{(const bf16_t*)(ws + OFF_X), (const bf16_t*)(ws + OFF_W1), MR, 4096, 1024};
      pg8::gemm_phase<EpiRelu2, pg8::StaticOrder, false>(lds, g, S, E, nullptr);
      if (!last && cblk >= 64) phase_wconv(p, l + 1, lds, 0, cblk - 64, G - 64); }
    xcd_barrier(xb); TE(9); TB(10);
    { pg8::StaticOrder S; S.init(NLAT, 1024, G, cblk);
      EpiRes E{p.out, (float*)(ws + OFF_CTXS), modp(p, l, 0), 5120, p.out, (const float*)(ws + OFF_CTXS)};
      pg8::Gemm g{(const bf16_t*)(ws + OFF_PB), (const bf16_t*)(ws + OFF_W2), NLAT, 1024, 4096};
      pg8::gemm_phase<EpiRes, pg8::StaticOrder, false>(lds, g, S, E, nullptr);
      if (!last) { float* cs = (float*)(ws + OFF_CTXS); const float* gv = modp(p, l, 4) + 5120;
        ctx_gemm((const bf16_t*)(ws + OFF_PB) + (size_t)NLAT * 4096, (const bf16_t*)(ws + OFF_W2), 4096, 1024, lds, [&](int r, int c, f32x4 v) {
          f32x4* q = (f32x4*)(cs + (size_t)r * 1024 + c); *q = *q + *(const f32x4*)(gv + c) * v; }); } }
    xcd_barrier(xb); TE(1); TE(10);
  }
  phase_final_norm(p);
  if (TPROBE && TPROBE != 20 && blockIdx.x == 0) { const unsigned long long s0 = __builtin_amdgcn_s_memrealtime(); while (__builtin_amdgcn_s_memrealtime() - s0 < tacc) __builtin_amdgcn_s_sleep(8); }
}

#ifndef HY_NV
#define HY_NV 2
#endif
constexpr size_t DYN_LDS = 2 * FFT_REGION_F2 * 8 + 11 * 512 * 4;

extern "C" void kernel_launch(void* const* d_in, const int* in_sizes, int n_in, void* d_out, int out_size, void* d_ws, size_t ws_size, hipStream_t stream) {
  if (ws_size < WS_TOTAL || n_in < 28) return;
  static int grid_blocks = 0;
  if (!grid_blocks) {
    int dev = 0, cus = 0, per_cu = 0;
    hipGetDevice(&dev);
    hipDeviceGetAttribute(&cus, hipDeviceAttributeMultiprocessorCount, dev);
    hipFuncSetAttribute((const void*)fwd_megakernel, hipFuncAttributeMaxDynamicSharedMemorySize, (int)DYN_LDS);
    hipOccupancyMaxActiveBlocksPerMultiprocessor(&per_cu, fwd_megakernel, 512, DYN_LDS);
    if (per_cu < 1) per_cu = 1;
    grid_blocks = cus * 1;
  }
  Params p{};
  const float** pp = (const float**)&p;
  for (int i = 0; i < 28; ++i) pp[i] = (const float*)d_in[i];
  p.out = (float*)d_out; p.ws = (unsigned char*)d_ws;
  void* args[] = {&p};
  hipLaunchCooperativeKernel((const void*)fwd_megakernel, dim3(grid_blocks), dim3(512), args, DYN_LDS, stream);
}
```

```cpp
#include <hip/hip_runtime.h>
#include <hip/hip_cooperative_groups.h>
namespace cg = cooperative_groups;
#define DI __device__ __forceinline__

__device__ __forceinline__ int otid() { int t = threadIdx.x; asm volatile("" : "+v"(t)); return t; }
namespace pg8 {
#define PG8_LAS __attribute__((address_space(3)))
typedef unsigned short bf16_t;
typedef short bf16x8 __attribute__((ext_vector_type(8)));
typedef float f32x4 __attribute__((ext_vector_type(4)));
typedef unsigned u32x4 __attribute__((ext_vector_type(4)));
constexpr int BM = 256, BK = 64, HALF = 128, HTB = HALF * BK * 2  , STAGE_BYTES = 8 * HTB, NXCD = 8, WGM = 8;

__host__ __device__ __forceinline__ int lds_byte(int r, int c) { const int st = (r >> 4) * 2 + (c >> 5), rr = r & 15, cc = c & 31, ob = rr * 64 + cc * 2; return st * 1024 + (ob ^ (((ob >> 9) & 1) << 5)); }
__host__ __device__ __forceinline__ void stage_rc(int b, int& R, int& C) { const int st = b / 1024, sb = b % 1024, swz = sb ^ (((sb >> 9) & 1) << 5); R = (st >> 1) * 16 + swz / 64; C = (st & 1) * 32 + (swz % 64) / 2; }
__host__ __device__ __forceinline__ int perm32(int rho) { const int n = rho >> 4, i = rho & 15; return 8 * (i >> 2) + 4 * n + (i & 3); }

struct Unit { int pm, pn; };
struct Gemm { const bf16_t* A; const bf16_t* Bt; int M, N, K; };
struct StaticOrder {
    int nM, nN, nwg, G, c;
    __host__ __device__ void init(int M, int N, int G_, int c_) { nM = M / BM; nN = N / BM; nwg = nM * nN; G = G_; c = c_; }
    __host__ __device__ bool next(int i, Unit& u) const {
        const long L = (long)i * G + c; if (L >= nwg) return false;
        int wgid = (int)L; { const int q = nwg / NXCD, r = nwg % NXCD, xcd = wgid % NXCD, off = wgid / NXCD; wgid = (xcd < r ? xcd * (q + 1) : r * (q + 1) + (xcd - r) * q) + off; }
        const int nig = WGM * nN, gid = wgid / nig, fm = gid * WGM, gsz = (nM - fm) < WGM ? (nM - fm) : WGM;
        u.pm = fm + ((wgid % nig) % gsz); u.pn = (wgid % nig) / gsz; return true;
    }
    __device__ __forceinline__ void a_ready(const Unit&) const {}
    __device__ __forceinline__ void done(const Unit&) const {}
};
__device__ __forceinline__ unsigned cvt_pk_bf16(float lo, float hi) { unsigned r; asm volatile("v_cvt_pk_bf16_f32 %0, %1, %2" : "=v"(r) : "v"(lo), "v"(hi)); return r; }
template <class Epi, class Sched, bool STAMP = false>
__device__ __forceinline__ void gemm_phase(PG8_LAS unsigned char* lds, const Gemm g, const Sched& S, const Epi& E, unsigned long long* stamps) {
    const int tid = otid(), wid = __builtin_amdgcn_readfirstlane(tid >> 6), lane = tid & 63, wr = wid >> 2, wc = wid & 3, fr = lane & 15, fq = lane >> 4;
    const int K = g.K, nt = K / BK;
    int ts_lo = 0, ts_hi = 0, nts = 0; const unsigned long long rt_entry = STAMP ? (unsigned long long)wall_clock64() : 0ull;
#define PG8_STAMP() do { if (STAMP && wid == 0 && nts < 64) { const unsigned long long _c = (unsigned long long)clock64(); \
        ts_lo = (lane == nts) ? (int)(unsigned)_c : ts_lo; ts_hi = (lane == nts) ? (int)(unsigned)(_c >> 32) : ts_hi; ++nts; } } while (0)
    PG8_STAMP();
    unsigned voffA[2], voffB[2];
#pragma unroll
    for (int i = 0; i < 2; ++i) { int R, C; stage_rc(tid * 16 + i * 8192, R, C); const int Rb = Epi::PERM ? ((R & ~31) + perm32(R & 31)) : R;
        voffA[i] = (unsigned)(R * K + C) * 2u; voffB[i] = (unsigned)(Rb * K + C) * 2u; }
    const size_t kstep = (size_t)(BK * 2);
    const size_t hstep = (size_t)HALF * K * 2;
    const size_t tstep = 2 * hstep;
    const unsigned ldsw = (unsigned)wid * 1024u;
    const int aoff = lds_byte(wr * 64 + fr, fq * 8), boff = lds_byte(wc * 32 + fr, fq * 8);
#define PG8_SA(b, h) (((b) * 2 + (h)) * HTB)
#define PG8_SB(b, h) ((4 + (b) * 2 + (h)) * HTB)
#define PG8_STAGE(bufoff, gbase, voff) do { _Pragma("unroll") for (int _i = 0; _i < 2; ++_i) \
        __builtin_amdgcn_global_load_lds((const unsigned*)((const char*)(gbase) + (voff)[_i]), (PG8_LAS unsigned*)(lds + (bufoff) + ldsw + _i * 8192), 16, 0, 0); } while (0)
#define PG8_LDA(dst, b, h) do { _Pragma("unroll") for (int m = 0; m < 4; ++m) _Pragma("unroll") for (int k = 0; k < 2; ++k) dst[m][k] = *(const PG8_LAS bf16x8*)(lds + PG8_SA(b, h) + aoff + m * 2048 + k * 1024); } while (0)
#define PG8_LDB(dst, b, h) do { _Pragma("unroll") for (int n = 0; n < 2; ++n) _Pragma("unroll") for (int k = 0; k < 2; ++k) dst[n][k] = *(const PG8_LAS bf16x8*)(lds + PG8_SB(b, h) + boff + n * 2048 + k * 1024); } while (0)
#define PG8_MMA(ai, bj, At, Bt) do { __builtin_amdgcn_s_setprio(1); _Pragma("unroll") for (int m = 0; m < 4; ++m) _Pragma("unroll") for (int n = 0; n < 2; ++n) _Pragma("unroll") for (int k = 0; k < 2; ++k) \
        acc[ai][bj][m][n] = __builtin_amdgcn_mfma_f32_16x16x32_bf16(Bt[n][k], At[m][k], acc[ai][bj][m][n], 0, 0, 0); __builtin_amdgcn_s_setprio(0); } while (0)
#define PG8_WAIT_V(n) asm volatile("s_waitcnt vmcnt(" #n ")" ::: "memory")
#define PG8_WAIT_L(n) asm volatile("s_waitcnt lgkmcnt(" #n ")" ::: "memory")
#define PG8_BAR __builtin_amdgcn_s_barrier()
#define PG8_SCHED __builtin_amdgcn_sched_barrier(0)
    Unit cur, nxt; int ui = 0;
    if (!S.next(0, cur)) return;
    f32x4 acc[2][2][4][2];
#pragma unroll
    for (int a = 0; a < 2; ++a)
#pragma unroll
        for (int b = 0; b < 2; ++b)
#pragma unroll
            for (int m = 0; m < 4; ++m)
#pragma unroll
                for (int n = 0; n < 2; ++n) acc[a][b][m][n] = (f32x4){0.f, 0.f, 0.f, 0.f};
    bf16x8 At[4][2], B0[2][2], B1[2][2];
    const char* cA = (const char*)g.A + (size_t)cur.pm * tstep; const char* cB = (const char*)g.Bt + (size_t)cur.pn * tstep;
    S.a_ready(cur);
    PG8_STAGE(PG8_SB(0, 0), cB, voffB); PG8_STAGE(PG8_SA(0, 0), cA, voffA); PG8_STAGE(PG8_SB(0, 1), cB + hstep, voffB); PG8_STAGE(PG8_SA(0, 1), cA + hstep, voffA);
    if (wr == 1) PG8_BAR;
    PG8_WAIT_V(4); PG8_BAR;
    PG8_STAGE(PG8_SB(1, 0), cB + kstep, voffB); PG8_STAGE(PG8_SA(1, 0), cA + kstep, voffA); PG8_STAGE(PG8_SB(1, 1), cB + hstep + kstep, voffB);
    PG8_WAIT_V(6); PG8_BAR;
    PG8_STAMP();
    for (;;) {
        const bool has_next = S.next(ui + 1, nxt);
        const char* nA = has_next ? (const char*)g.A + (size_t)nxt.pm * tstep : cA; const char* nB = has_next ? (const char*)g.Bt + (size_t)nxt.pn * tstep : cB;
        for (int t = 0; t < nt; t += 2) {
            const bool last = (t == nt - 2);
            const char* a1 = cA + (size_t)(t + 1) * kstep;
            const char* a2 = last ? nA : cA + (size_t)(t + 2) * kstep; const char* b2 = last ? nB : cB + (size_t)(t + 2) * kstep;
            const char* a3 = a2 + kstep; const char* b3 = b2 + kstep;
            if (last && has_next) S.a_ready(nxt);
            PG8_LDB(B0, 0, 0); PG8_SCHED; PG8_LDA(At, 0, 0); PG8_STAGE(PG8_SA(1, 1), a1 + hstep, voffA);
            PG8_WAIT_L(8); PG8_BAR; PG8_WAIT_L(0); PG8_MMA(0, 0, At, B0); PG8_BAR; PG8_SCHED;
            PG8_LDB(B1, 0, 1); PG8_STAGE(PG8_SB(0, 0), b2, voffB);
            PG8_BAR; PG8_WAIT_L(0); PG8_MMA(0, 1, At, B1); PG8_BAR;
            PG8_LDA(At, 0, 1); PG8_STAGE(PG8_SA(0, 0), a2, voffA);
            PG8_BAR; PG8_WAIT_L(0); PG8_MMA(1, 0, At, B0); PG8_BAR; PG8_SCHED;
            PG8_STAGE(PG8_SB(0, 1), b2 + hstep, voffB);
            PG8_WAIT_V(6); PG8_BAR; PG8_MMA(1, 1, At, B1); PG8_BAR;
            PG8_LDB(B0, 1, 0); PG8_SCHED; PG8_LDA(At, 1, 0); PG8_STAGE(PG8_SA(0, 1), a2 + hstep, voffA);
            PG8_WAIT_L(8); PG8_BAR; PG8_WAIT_L(0); PG8_MMA(0, 0, At, B0); PG8_BAR; PG8_SCHED;
            PG8_LDB(B1, 1, 1); PG8_STAGE(PG8_SB(1, 0), b3, voffB);
            PG8_BAR; PG8_WAIT_L(0); PG8_MMA(0, 1, At, B1); PG8_BAR;
            PG8_LDA(At, 1, 1); PG8_STAGE(PG8_SA(1, 0), a3, voffA);
            PG8_BAR; PG8_WAIT_L(0); PG8_MMA(1, 0, At, B0); PG8_BAR; PG8_SCHED;
            PG8_STAGE(PG8_SB(1, 1), b3 + hstep, voffB);
            PG8_WAIT_V(6); PG8_BAR; PG8_MMA(1, 1, At, B1); PG8_BAR;
        }
        PG8_STAMP();
        if constexpr (!Epi::AFTER_DRAIN) { E(acc, cur, wr, wc, fr, fq); S.done(cur); }
        PG8_STAMP();
        if (!has_next) break;
#pragma unroll
        for (int a = 0; a < 2; ++a)
#pragma unroll
            for (int b = 0; b < 2; ++b)
#pragma unroll
                for (int m = 0; m < 4; ++m)
#pragma unroll
                    for (int n = 0; n < 2; ++n) acc[a][b][m][n] = (f32x4){0.f, 0.f, 0.f, 0.f};
        cur = nxt; cA = nA; cB = nB; ++ui;
    }
    PG8_WAIT_V(0);
    if (wr == 0) PG8_BAR;
    PG8_BAR;
    if constexpr (Epi::AFTER_DRAIN) { E.fused(acc, cur, wr, wc, fr, fq, lds, wid, lane); S.done(cur); }
    PG8_STAMP();
    if (STAMP && wid == 0) { stamps[lane] = lane < nts ? (((unsigned long long)(unsigned)ts_hi << 32) | (unsigned)ts_lo) : 0ull;
        if (lane == 62) stamps[62] = rt_entry; if (lane == 63) stamps[63] = (unsigned long long)wall_clock64(); }
#undef PG8_STAMP
#undef PG8_SA
#undef PG8_SB
#undef PG8_STAGE
#undef PG8_LDA
#undef PG8_LDB
#undef PG8_MMA
#undef PG8_WAIT_V
#undef PG8_WAIT_L
#undef PG8_BAR
#undef PG8_SCHED
}
}

using pg8::bf16_t; using pg8::bf16x8; using pg8::f32x4; using pg8::u32x4;
typedef float f32x16 __attribute__((ext_vector_type(16)));
typedef _Float16 h16x2 __attribute__((ext_vector_type(2)));
typedef unsigned u32x2 __attribute__((ext_vector_type(2)));
#define LAS __attribute__((address_space(3)))

constexpr int NTOK = 17408, NLAT = 16384, DM = 1024, NTH = 512;
constexpr float EPSF = 1e-6f;
constexpr float HSCALE = 64.f;

constexpr size_t SZ_H = (size_t)NTOK * 1024 * 2;
constexpr size_t OFF_X = 0;
constexpr size_t OFF_WIN = OFF_X + SZ_H;
constexpr size_t OFF_WBHY = OFF_WIN + (size_t)8448 * 1024 * 2;
constexpr size_t OFF_WBGLA = OFF_WBHY + 2097152;
constexpr size_t OFF_WOUT = OFF_WBGLA + 2097152;
constexpr size_t OFF_W1 = OFF_WOUT + 2097152;
constexpr size_t OFF_W2 = OFF_W1 + 8388608;
constexpr size_t OFF_XT = OFF_W2 + 8388608;
constexpr size_t SZ_XT = (size_t)4096 * NTOK * 2;
constexpr size_t OFF_PB = OFF_XT + SZ_XT;
constexpr size_t OFF_LR = OFF_PB + SZ_XT;
constexpr size_t OFF_QF = OFF_LR + (size_t)NTOK * 32 * 4;
constexpr size_t SZ_Q = (size_t)NTOK * 512 * 2;
constexpr size_t OFF_QB = OFF_QF + SZ_Q;
constexpr size_t OFF_KEF = OFF_QB + SZ_Q;
constexpr size_t OFF_KEB = OFF_KEF + SZ_Q;
constexpr size_t OFF_ATT = OFF_KEB + SZ_Q;
constexpr size_t OFF_DEC = OFF_ATT + SZ_Q;
constexpr size_t OFF_HP = OFF_DEC + (size_t)272 * 4 * 2 * 128 * 4;
constexpr size_t OFF_CTXS = OFF_HP + (size_t)1024 * 8192 * 4;
constexpr size_t OFF_MOD = OFF_CTXS + 4194304;
constexpr size_t OFF_A2L = OFF_MOD + 491520;
constexpr size_t OFF_A2C = OFF_A2L + 4194304;
constexpr size_t OFF_HTC = OFF_A2C + 262144;
constexpr size_t OFF_HP2 = OFF_HTC + 2097152;
constexpr size_t OFF_HTC2 = OFF_HP2 + (size_t)1024 * 8192 * 4;
constexpr size_t OFF_CNT = OFF_HTC2 + 2097152;
constexpr size_t OFF_BAR = OFF_CNT + 1024;
constexpr size_t WS_TOTAL = OFF_BAR + 16384;

struct Params {
  const float *x, *c, *ctx, *c_ctx, *ada_w, *ada_b, *norm1_g, *norm2_g, *w_in, *conv_w, *conv_b, *fw1, *fb1, *fw2, *fb2, *fw3, *ffreq,
      *decay, *skip, *gate_w, *gate_b, *gla_ng, *w_bhy, *w_bgla, *w_out, *mlp_w1, *mlp_w2, *final_g;
  float* out; unsigned char* ws;
};

typedef float f32x2_t __attribute__((ext_vector_type(2)));
typedef __bf16 bf16x2_t __attribute__((ext_vector_type(2)));
DI bf16_t f2bf(float f) { const __bf16 b = (__bf16)f; return __builtin_bit_cast(bf16_t, b); }
DI float bf2f(bf16_t b) { return __uint_as_float(((unsigned)b) << 16); }
DI unsigned pk2(float lo, float hi) { f32x2_t v; v.x = lo; v.y = hi; const bf16x2_t b = __builtin_convertvector(v, bf16x2_t); return __builtin_bit_cast(unsigned, b); }
DI float bflo(unsigned w) { return __uint_as_float(w << 16); }
DI float bfhi(unsigned w) { return __uint_as_float(w & 0xffff0000u); }
DI float sigm(float x) { return __builtin_amdgcn_rcpf(1.f + __expf(-x)); }
DI float my_sin(float x) { float r = x * 0.15915494309189535f; r -= rintf(r); return __builtin_amdgcn_sinf(r); }
DI float wave_sum(float v) {
#pragma unroll
  for (int o = 32; o >= 1; o >>= 1) v += __shfl_xor(v, o);
  return v;
}
DI float* xrow(const Params& p, int row) { return row < NLAT ? p.out + (size_t)row * DM : (float*)(p.ws + OFF_CTXS) + (size_t)(row - NLAT) * DM; }
DI const float* xrow_in(const Params& p, int row) { return row < NLAT ? p.x + (size_t)row * DM : p.ctx + (size_t)(row - NLAT) * DM; }
DI const float* modp(const Params& p, int l, int s) { return (const float*)(p.ws + OFF_MOD) + ((size_t)l * 5 + s) * 6144; }

DI void phase_copy(const Params& p) {
  if (blockIdx.x == 0) { unsigned* z = (unsigned*)(p.ws + OFF_CNT); for (int i = otid(); i < (1024 + 16384) / 4; i += NTH) z[i] = 0u; }
}

DI void phase_mod(const Params& p, LAS unsigned char* lds) {
  LAS float* sv = (LAS float*)lds;
  LAS float* red = sv + 5 * 1024;
  const int tid = otid();
  bool loaded = false;
  for (int it = blockIdx.x; it < 4 * 48; it += gridDim.x) {
    if (!loaded) {
      for (int i = tid; i < 5 * 1024; i += NTH) { const int s = i >> 10, k = i & 1023; const float v = s < 4 ? p.c[s * 1024 + k] : p.c_ctx[k]; sv[i] = v * sigm(v); }
      loaded = true;
    }
    __syncthreads();
    const int l = it / 48, cb = it % 48, cg4 = tid & 31, kq = tid >> 5;
    const float* W = p.ada_w + (size_t)l * 1024 * 6144 + cb * 128 + 4 * cg4;
    f32x4 a0 = {0.f, 0.f, 0.f, 0.f}, a1 = a0, a2 = a0, a3 = a0, a4 = a0;
#pragma unroll 8
    for (int k = kq * 64; k < kq * 64 + 64; ++k) { const f32x4 w = __builtin_nontemporal_load((const f32x4*)(W + (size_t)k * 6144)); a0 += w * sv[k]; a1 += w * sv[1024 + k]; a2 += w * sv[2048 + k]; a3 += w * sv[3072 + k]; a4 += w * sv[4096 + k]; }
    LAS float* r = red + kq * 5 * 128 + 4 * cg4;
    *(LAS f32x4*)(r) = a0; *(LAS f32x4*)(r + 128) = a1; *(LAS f32x4*)(r + 256) = a2; *(LAS f32x4*)(r + 384) = a3; *(LAS f32x4*)(r + 512) = a4;
    __syncthreads();
    if (tid < 128) {
      const int col = cb * 128 + tid;
      const float bias = p.ada_b[l * 6144 + col];
      float* mo = (float*)(p.ws + OFF_MOD) + (size_t)l * 5 * 6144 + col;
#pragma unroll
      for (int s = 0; s < 5; ++s) { float t = bias;
#pragma unroll
        for (int q = 0; q < 16; ++q) t += red[q * 5 * 128 + s * 128 + tid]; mo[(size_t)s * 6144] = t; }
    }
    __syncthreads();
  }
}

DI void phase_a2(const Params& p, LAS unsigned char* lds) {
  LAS float* zf = (LAS float*)lds;
  LAS float* a1s = zf + 64 * 36;
  const int tid = otid(), tl = tid >> 6, m = tid & 63;
  const int per = (4096 + 256) / 64;
  for (int it = blockIdx.x; it < 4 * per; it += gridDim.x) {
    const int l = it / per, r = it % per;
    const bool isc = r >= 64; const int Lq = isc ? 256 : 4096; const int i0 = (isc ? (r - 64) : r) * 64;
    for (int e = tid; e < 64 * 33; e += NTH) {
      const int tt = e / 33, f = e % 33, i = i0 + tt; float v;
      if (f == 0) v = (float)i / (float)(Lq - 1);
      else { const int j = (f - 1) & 15; const float band = 1e-4f + (float)j * ((15.f - 1e-4f) / 15.f); float rev = (float)i * band / (float)Lq; rev -= floorf(rev);
             v = (f <= 16) ? __builtin_amdgcn_cosf(rev) : -__builtin_amdgcn_sinf(rev); }
      zf[tt * 36 + f] = v;
    }
    const float fr = p.ffreq[l * 64 + m], b1v = p.fb1[l * 64 + m], b2v = p.fb2[l * 64 + m];
    float w1r[33];
#pragma unroll
    for (int f = 0; f < 33; ++f) w1r[f] = p.fw1[((size_t)l * 33 + f) * 64 + m];
    __syncthreads();
#pragma unroll 1
    for (int q = 0; q < 8; ++q) { const int tt = tl * 8 + q; float acc = b1v;
#pragma unroll
      for (int f = 0; f < 33; ++f) acc += zf[tt * 36 + f] * w1r[f];
      a1s[tt * 64 + m] = my_sin(fr * acc); }
    float w2r[64];
#pragma unroll
    for (int j = 0; j < 64; ++j) w2r[j] = p.fw2[((size_t)l * 64 + j) * 64 + m];
    __syncthreads();
    float* dst = isc ? (float*)(p.ws + OFF_A2C) + ((size_t)l * 256 + i0) * 64 : (float*)(p.ws + OFF_A2L) + ((size_t)l * 4096 + i0) * 64;
#pragma unroll 1
    for (int q = 0; q < 8; ++q) { const int tt = tl * 8 + q; float acc = b2v;
#pragma unroll
      for (int j4 = 0; j4 < 16; ++j4) { const f32x4 a = *(const LAS f32x4*)(a1s + tt * 64 + 4 * j4); acc += a.x * w2r[4 * j4] + a.y * w2r[4 * j4 + 1] + a.z * w2r[4 * j4 + 2] + a.w * w2r[4 * j4 + 3]; }
      dst[(size_t)tt * 64 + m] = my_sin(fr * acc); }
    __syncthreads();
  }
}

DI void wt_load(const float* src, int ld_src, int k0, int n0, f32x4 (&v)[2]) {
  const int tid = otid();
#pragma unroll
  for (int q = 0; q < 2; ++q) { const int kk = (tid >> 3) + 64 * q, nq = tid & 7; v[q] = __builtin_nontemporal_load((const f32x4*)(src + (size_t)(k0 + kk) * ld_src + n0 + 4 * nq)); }
}
DI void wt_store(const f32x4 (&v)[2], int k0, bf16_t* dst, int ld_dst, int drow0, LAS unsigned char* lds) {
  LAS bf16_t* t = (LAS bf16_t*)lds;
  const int tid = otid();
#pragma unroll
  for (int q = 0; q < 2; ++q) {
    const int kk = (tid >> 3) + 64 * q, nq = tid & 7;
    t[(4 * nq + 0) * 136 + kk] = f2bf(v[q].x); t[(4 * nq + 1) * 136 + kk] = f2bf(v[q].y); t[(4 * nq + 2) * 136 + kk] = f2bf(v[q].z); t[(4 * nq + 3) * 136 + kk] = f2bf(v[q].w);
  }
  __syncthreads();
  { const int n = tid >> 4, kq = tid & 15;
    const u32x4 o = *(const LAS u32x4*)(t + n * 136 + 8 * kq);
    *(u32x4*)(dst + (size_t)(drow0 + n) * ld_dst + k0 + 8 * kq) = o; }
  __syncthreads();
}
DI int win_dst_row(int n) {
  if (n < 3072) return n;
  if (n < 4096) return 4096 + (n - 3072);
  if (n < 5120) return 3072 + (n - 4096);
  if (n < 6144) return 4096 + 1024 + (n - 5120);
  if (n < 6176) return 8192 + (n - 6144);
  if (n < 7200) return 4096 + 2048 + (n - 6176);
  return 4096 + 3072 + (n - 7200);
}
struct WtItem { const float* src; int ld_src, k0, n0; bf16_t* dst; int ld_dst, drow0; };
DI WtItem wt_decode(const Params& p, int l, int part, int it) {
  unsigned char* ws = p.ws; WtItem w;
  const int n_win = 8 * 257, n_sq = 8 * 32, n_w1 = 8 * 128;
  if (part == 0) {
    if (it < n_win) { const int kt = it & 7, nt = it >> 3; w.src = p.w_in + (size_t)l * 1024 * 8224; w.ld_src = 8224; w.k0 = kt * 128; w.n0 = nt * 32; w.dst = (bf16_t*)(ws + OFF_WIN); w.ld_dst = 1024; w.drow0 = win_dst_row(nt * 32); }
    else { const int r = it - n_win, which = r / n_sq, q = r % n_sq, kt = q & 7, nt = q >> 3;
      w.src = (which == 0 ? p.w_bhy : which == 1 ? p.w_bgla : p.w_out) + (size_t)l * 1024 * 1024; w.ld_src = 1024; w.k0 = kt * 128; w.n0 = nt * 32;
      w.dst = (bf16_t*)(ws + (which == 0 ? OFF_WBHY : which == 1 ? OFF_WBGLA : OFF_WOUT)); w.ld_dst = 1024; w.drow0 = nt * 32; }
  } else {
    if (it < n_w1) { const int kt = it & 7, nt = it >> 3; w.src = p.mlp_w1 + (size_t)l * 1024 * 4096; w.ld_src = 4096; w.k0 = kt * 128; w.n0 = nt * 32; w.dst = (bf16_t*)(ws + OFF_W1); w.ld_dst = 1024; w.drow0 = nt * 32; }
    else { const int r = it - n_w1, kt = r & 31, nt = r >> 5; w.src = p.mlp_w2 + (size_t)l * 4096 * 1024; w.ld_src = 1024; w.k0 = kt * 128; w.n0 = nt * 32; w.dst = (bf16_t*)(ws + OFF_W2); w.ld_dst = 4096; w.drow0 = nt * 32; }
  }
  return w;
}
DI void phase_wconv(const Params& p, int l, LAS unsigned char* lds, int part, int blk, int nblk) {
  unsigned char* ws = p.ws;
  const int total = part == 0 ? (8 * 257 + 3 * 8 * 32) : (8 * 128 + 32 * 32);
  f32x4 v[2];
  if (blk < total) { const WtItem w = wt_decode(p, l, part, blk); wt_load(w.src, w.ld_src, w.k0, w.n0, v); }
  for (int it = blk; it < total; it += nblk) {
    const WtItem w = wt_decode(p, l, part, it);
    f32x4 cur[2] = {v[0], v[1]};
    if (it + nblk < total) { const WtItem w2 = wt_decode(p, l, part, it + nblk); wt_load(w2.src, w2.ld_src, w2.k0, w2.n0, v); }
    wt_store(cur, w.k0, w.dst, w.ld_dst, w.drow0, lds);
  }
  if (part == 0) { u32x4* z = (u32x4*)(ws + OFF_WIN + (size_t)8224 * 1024 * 2); const int n = 224 * 1024 * 2 / 16;
    for (int i = blk * NTH + otid(); i < n; i += nblk * NTH) z[i] = (u32x4){0u, 0u, 0u, 0u}; }
}

DI void phase_norm(const Params& p, int l, const float* g, int sh_off, int sc_off, int nrows, bool from_input) {
  const int lane = otid() & 63, gw = blockIdx.x * 8 + (otid() >> 6), nw = gridDim.x * 8;
  bf16_t* hb = (bf16_t*)(p.ws + OFF_X);
  const int rp = (nrows + nw - 1) / nw, r0 = gw * rp, r1 = min(nrows, r0 + rp);
  f32x4 A[4], B[4]; int scur = -1;
  f32x4 pa[4], pb2[4];
#define NORM_LOAD(rw) do { const int ra_ = (rw), rb_ = ((rw) + 1 < r1) ? (rw) + 1 : (rw); const float* xa_ = from_input ? xrow_in(p, ra_) : xrow(p, ra_); const float* xb_ = from_input ? xrow_in(p, rb_) : xrow(p, rb_); \
    _Pragma("unroll") for (int i = 0; i < 4; ++i) { pa[i] = *(const f32x4*)(xa_ + 4 * lane + 256 * i); pb2[i] = *(const f32x4*)(xb_ + 4 * lane + 256 * i); } } while (0)
  if (r0 < r1) NORM_LOAD(r0);
  for (int row = r0; row < r1; row += 2) {
    const bool two = row + 1 < r1;
    const int s = row < NLAT ? (row >> 12) : 4;
    if (s != scur) { scur = s; const float* mo = modp(p, l, s);
#pragma unroll
      for (int i = 0; i < 4; ++i) { const int c = 4 * lane + 256 * i; const f32x4 gg = *(const f32x4*)(g + c), sc = *(const f32x4*)(mo + sc_off + c); A[i] = gg * (sc + 1.f); B[i] = *(const f32x4*)(mo + sh_off + c); } }
    f32x4 va[4], vb[4]; float sa = 0.f, sb = 0.f;
#pragma unroll
    for (int i = 0; i < 4; ++i) { va[i] = pa[i]; vb[i] = pb2[i]; }
    if (row + 2 < r1) NORM_LOAD(row + 2);
#pragma unroll
    for (int i = 0; i < 4; ++i) { sa += va[i].x * va[i].x + va[i].y * va[i].y + va[i].z * va[i].z + va[i].w * va[i].w; sb += vb[i].x * vb[i].x + vb[i].y * vb[i].y + vb[i].z * vb[i].z + vb[i].w * vb[i].w; }
#pragma unroll
    for (int o = 32; o >= 1; o >>= 1) { sa += __shfl_xor(sa, o); sb += __shfl_xor(sb, o); }
    const float ra = rsqrtf(sa * (1.f / 1024.f) + EPSF), rb = rsqrtf(sb * (1.f / 1024.f) + EPSF);
    const int s2 = (row + 1) < NLAT ? ((row + 1) >> 12) : 4;
#pragma unroll
    for (int i = 0; i < 4; ++i) { const int c = 4 * lane + 256 * i; const f32x4 ya = va[i] * ra * A[i] + B[i];
      *(u32x2*)(hb + (size_t)row * 1024 + c) = (u32x2){pk2(ya.x, ya.y), pk2(ya.z, ya.w)}; }
    if (two) {
      if (s2 != scur) { scur = s2; const float* mo = modp(p, l, s2);
#pragma unroll
        for (int i = 0; i < 4; ++i) { const int c = 4 * lane + 256 * i; const f32x4 gg = *(const f32x4*)(g + c), sc = *(const f32x4*)(mo + sc_off + c); A[i] = gg * (sc + 1.f); B[i] = *(const f32x4*)(mo + sh_off + c); } }
#pragma unroll
      for (int i = 0; i < 4; ++i) { const int c = 4 * lane + 256 * i; const f32x4 yb = vb[i] * rb * A[i] + B[i];
        *(u32x2*)(hb + (size_t)(row + 1) * 1024 + c) = (u32x2){pk2(yb.x, yb.y), pk2(yb.z, yb.w)}; }
    }
  }
}
#undef NORM_LOAD
DI void phase_final_norm(const Params& p) {
  const int lane = otid() & 63, gw = blockIdx.x * 8 + (otid() >> 6), nw = gridDim.x * 8;
  for (int row = gw; row < NLAT; row += nw) {
    float* xr = p.out + (size_t)row * DM;
    float4 v[4]; float ss = 0.f;
#pragma unroll
    for (int i = 0; i < 4; ++i) { v[i] = *(const float4*)(xr + 4 * lane + 256 * i); ss += v[i].x * v[i].x + v[i].y * v[i].y + v[i].z * v[i].z + v[i].w * v[i].w; }
    ss = wave_sum(ss);
    const float rstd = rsqrtf(ss * (1.f / 1024.f) + EPSF);
#pragma unroll
    for (int i = 0; i < 4; ++i) { const int c = 4 * lane + 256 * i; const float4 gg = *(const float4*)(p.final_g + c);
      *(float4*)(xr + c) = make_float4(v[i].x * rstd * gg.x, v[i].y * rstd * gg.y, v[i].z * rstd * gg.z, v[i].w * rstd * gg.w); }
  }
}

DI void phase_filt_gemm(const Params& p, int l, LAS unsigned char* lds, int blk, int nblk) {
  LAS float* w3s = (LAS float*)lds;
  LAS float* a2s = w3s + 64 * 64;
  const int tid = otid();
  const int nL = 32 * 32, nC = 32 * 2;
  for (int it = blk; it < nL + nC; it += nblk) {
    const bool isc = it >= nL; const int r = isc ? it - nL : it; const int Lq = isc ? 256 : 4096;
    const int ntt = Lq / 128, dt = r / ntt, tt0 = (r % ntt) * 128, d0 = dt * 64;
    const float* A2 = isc ? (const float*)(p.ws + OFF_A2C) + (size_t)l * 256 * 64 : (const float*)(p.ws + OFF_A2L) + (size_t)l * 4096 * 64;
    float* hT = isc ? (float*)(p.ws + ((l & 1) ? OFF_HTC2 : OFF_HTC)) : (float*)(p.ws + ((l & 1) ? OFF_HP2 : OFF_HP));
    { const int m = tid >> 3, q = tid & 7; const float* s = p.fw3 + ((size_t)l * 64 + m) * 2048 + d0;
      *(LAS f32x4*)(w3s + m * 64 + 4 * q) = *(const f32x4*)(s + 4 * q); *(LAS f32x4*)(w3s + m * 64 + 32 + 4 * q) = *(const f32x4*)(s + 32 + 4 * q); }
    { const int tt = tid >> 2, mq = tid & 3; const float* s = A2 + (size_t)(tt0 + tt) * 64 + 16 * mq;
#pragma unroll
      for (int q = 0; q < 4; ++q) { const float4 v = *(const float4*)(s + 4 * q);
        a2s[(16 * mq + 4 * q + 0) * 132 + tt] = v.x; a2s[(16 * mq + 4 * q + 1) * 132 + tt] = v.y; a2s[(16 * mq + 4 * q + 2) * 132 + tt] = v.z; a2s[(16 * mq + 4 * q + 3) * 132 + tt] = v.w; } }
    __syncthreads();
    const int cx = tid & 15, ty = tid >> 4;
    float acc[4][4];
#pragma unroll
    for (int a = 0; a < 4; ++a)
#pragma unroll
      for (int b = 0; b < 4; ++b) acc[a][b] = 0.f;
#pragma unroll 8
    for (int m = 0; m < 64; ++m) {
      const f32x4 wv = *(const LAS f32x4*)(w3s + m * 64 + 4 * cx), av = *(const LAS f32x4*)(a2s + m * 132 + 4 * ty);
      const float w[4] = {wv.x, wv.y, wv.z, wv.w}, a[4] = {av.x, av.y, av.z, av.w};
#pragma unroll
      for (int ci = 0; ci < 4; ++ci)
#pragma unroll
        for (int ti = 0; ti < 4; ++ti) acc[ci][ti] += w[ci] * a[ti];
    }
    const float inv = 1.f / (float)(Lq - 1);
#pragma unroll
    for (int ci = 0; ci < 4; ++ci) {
      const int dirch = d0 + 4 * cx + ci; const float dc = fabsf(p.decay[l * 1024 + (dirch & 1023)]);
      float o[4];
#pragma unroll
      for (int ti = 0; ti < 4; ++ti) { const float tl = (float)(tt0 + 4 * ty + ti) * inv; o[ti] = acc[ci][ti] * __expf(-tl * dc); }
      *(float4*)(hT + (size_t)dirch * Lq + tt0 + 4 * ty) = make_float4(o[0], o[1], o[2], o[3]);
    }
    __syncthreads();
  }
}
#define XB_TMO      128
#define XB_XCNT(j)  (256  + 64 * (j))
#define XB_XSUB(j)  (1280 + 64 * (j))
#define XB_XGEN(j)  (2304 + 64 * (j))
#define XB_TOP      3328
#define XB_TOPGEN   3392
#define XCD_BAR_WORDS 3456
#define XB_SPIN_CAP (1u << 18)

__device__ __forceinline__ unsigned xb_ld(unsigned* p)              { return __hip_atomic_load(p, __ATOMIC_RELAXED, __HIP_MEMORY_SCOPE_AGENT); }
__device__ __forceinline__ unsigned xb_add(unsigned* p, unsigned v) { return __hip_atomic_fetch_add(p, v, __ATOMIC_RELAXED, __HIP_MEMORY_SCOPE_AGENT); }
__device__ __forceinline__ unsigned xb_xcc_id() { return (unsigned)__builtin_amdgcn_s_getreg((3 << 11) | 20) & 0xFu; }
#define XB_SPIN(cond, bar) do { unsigned _sp = 0; while (cond) { __builtin_amdgcn_s_sleep(1); \
    if ((++_sp & 255u) == 0u) { if (xb_ld(&(bar)[XB_TMO])) break; if (_sp > XB_SPIN_CAP) { atomicAdd(&(bar)[XB_TMO], 1u); break; } } } } while (0)
struct XcdBarrier {
    unsigned* bar; unsigned x;
    volatile LAS unsigned* st;
};

__device__ __forceinline__ XcdBarrier xcd_barrier_post(unsigned* bar, volatile LAS unsigned* st) {
    XcdBarrier b; b.bar = bar; b.x = xb_xcc_id(); b.st = st;
    if (threadIdx.x == 0) (void)xb_add(&bar[XB_XCNT(b.x)], 1u);
    return b;
}
__device__ __forceinline__ void xcd_barrier_complete(unsigned* bar, unsigned x, unsigned& nloc, unsigned& nx) {
    const unsigned G = gridDim.x * gridDim.y * gridDim.z;
    unsigned sum, cnt, mine, sp = 0u;
    for (;;) {
        sum = 0u; cnt = 0u; mine = 0u;
#pragma unroll
        for (unsigned j = 0; j < 16; ++j) { const unsigned c = xb_ld(&bar[XB_XCNT(j)]); sum += c; cnt += (c > 0u) ? 1u : 0u; mine = (j == x) ? c : mine; }
        if (sum == G) break;
        __builtin_amdgcn_s_sleep(1);
        if ((++sp & 255u) == 0u) { if (xb_ld(&bar[XB_TMO])) break; if (sp > XB_SPIN_CAP) { atomicAdd(&bar[XB_TMO], 1u); break; } }
    }
    nloc = mine > 0u ? mine : 1u; nx = cnt > 0u ? cnt : 1u;
}

__device__ __forceinline__ void xcd_barrier(const XcdBarrier& b) {
    asm volatile("s_waitcnt vmcnt(0)" ::: "memory");
    __syncthreads();
    if (threadIdx.x == 0) {
        unsigned* bar = b.bar;
        __builtin_amdgcn_s_waitcnt(0);
        unsigned nloc = b.st[0], nx = b.st[1];
        if (nloc == 0u) { xcd_barrier_complete(bar, b.x, nloc, nx); b.st[0] = nloc; b.st[1] = nx; }
        const unsigned old = xb_add(&bar[XB_XSUB(b.x)], 1u);
        const unsigned gen = old / nloc;
        if (old + 1u == (gen + 1u) * nloc) {
            __builtin_amdgcn_fence(__ATOMIC_RELEASE, "agent");
            asm volatile("s_waitcnt vmcnt(0)" ::: "memory");
            const unsigned og = xb_add(&bar[XB_TOP], 1u);
            const unsigned tg = og / nx;
            if (og + 1u == (tg + 1u) * nx) xb_add(&bar[XB_TOPGEN], 1u);
            else XB_SPIN(xb_ld(&bar[XB_TOPGEN]) == tg, bar);
            __builtin_amdgcn_fence(__ATOMIC_ACQUIRE, "agent");
            xb_add(&bar[XB_XGEN(b.x)], 1u);
            asm volatile("s_waitcnt vmcnt(0)" ::: "memory");
        } else {
            XB_SPIN(xb_ld(&bar[XB_XGEN(b.x)]) == gen, bar);
            __builtin_amdgcn_fence(__ATOMIC_ACQUIRE, "agent");
            asm volatile("s_waitcnt vmcnt(0)" ::: "memory");
        }
    }
    __syncthreads();
}

typedef float cplx __attribute__((ext_vector_type(2)));
DI cplx mk2(float a, float b) { cplx r; r.x = a; r.y = b; return r; }
DI constexpr float cos32(int m) { constexpr float t[16] = {1.f, 0.98078528040323043f, 0.92387953251128674f, 0.83146961230254524f, 0.70710678118654752f, 0.55557023301960218f, 0.38268343236508977f, 0.19509032201612825f,
    0.f, -0.19509032201612825f, -0.38268343236508977f, -0.55557023301960218f, -0.70710678118654752f, -0.83146961230254524f, -0.92387953251128674f, -0.98078528040323043f}; return t[m]; }
DI constexpr float sin32(int m) { constexpr float t[16] = {0.f, 0.19509032201612825f, 0.38268343236508977f, 0.55557023301960218f, 0.70710678118654752f, 0.83146961230254524f, 0.92387953251128674f, 0.98078528040323043f,
    1.f, 0.98078528040323043f, 0.92387953251128674f, 0.83146961230254524f, 0.70710678118654752f, 0.55557023301960218f, 0.38268343236508977f, 0.19509032201612825f}; return t[m]; }
DI constexpr int brev(int k, int bits) { int r = 0; for (int i = 0; i < bits; ++i) r |= ((k >> i) & 1) << (bits - 1 - i); return r; }
DI cplx cmul(cplx a, cplx b) { return mk2(a.x * b.x - a.y * b.y, a.x * b.y + a.y * b.x); }
DI cplx cmulc(cplx a, cplx b) { return mk2(a.x * b.x + a.y * b.y, a.y * b.x - a.x * b.y); }

template <int R, bool INV> DI void dft_reg(cplx (&v)[R]) {
#pragma unroll
  for (int len = R; len >= 2; len >>= 1) {
    const int half = len >> 1;
#pragma unroll
    for (int s = 0; s < R; s += len) {
#pragma unroll
      for (int j = 0; j < half; ++j) {
        const cplx a = v[s + j], b = v[s + j + half];
        v[s + j] = mk2(a.x + b.x, a.y + b.y);
        const cplx d = mk2(a.x - b.x, a.y - b.y);
        const int m = j * (32 / len);
        if (m == 0) v[s + j + half] = d;
        else if (m == 8) v[s + j + half] = INV ? mk2(-d.y, d.x) : mk2(d.y, -d.x);
        else { const float c = cos32(m), sn = sin32(m);
          v[s + j + half] = INV ? mk2(d.x * c - d.y * sn, d.x * sn + d.y * c) : mk2(d.x * c + d.y * sn, d.y * c - d.x * sn); }
      }
    }
  }
}
constexpr int FFT_REGION_F2 = 8704;

template <int NV> DI void fft_fwd3(cplx (&v)[NV][16], LAS cplx* L, int tid) {

#pragma unroll
  for (int i = 0; i < NV; ++i) dft_reg<16, false>(v[i]);

  { float rev = (float)tid * (1.f / 8192.f); asm volatile("" : "+v"(rev)); const cplx w1 = mk2(__builtin_amdgcn_cosf(rev), -__builtin_amdgcn_sinf(rev)); cplx w = mk2(1.f, 0.f);
    const int pb = tid + 2 * (tid >> 5);
#pragma unroll
    for (int k = 0; k < 16; ++k) {
#pragma unroll
      for (int i = 0; i < NV; ++i) L[i * FFT_REGION_F2 + pb + 544 * k] = cmul(v[i][brev(k, 4)], w);
      w = cmul(w, w1); } }
  __syncthreads();
  { const int sb = tid >> 5, ii = tid & 31, pb = 544 * sb + ii;
    cplx u[NV][16];
#pragma unroll
    for (int i = 0; i < NV; ++i)
#pragma unroll
      for (int j = 0; j < 16; ++j) u[i][j] = L[i * FFT_REGION_F2 + pb + 34 * j];

#pragma unroll
    for (int i = 0; i < NV; ++i) dft_reg<16, false>(u[i]);

    float rev = (float)ii * (1.f / 512.f); asm volatile("" : "+v"(rev)); const cplx w1 = mk2(__builtin_amdgcn_cosf(rev), -__builtin_amdgcn_sinf(rev)); cplx w = mk2(1.f, 0.f);
#pragma unroll
    for (int k = 0; k < 16; ++k) {
#pragma unroll
      for (int i = 0; i < NV; ++i) L[i * FFT_REGION_F2 + pb + 34 * k] = cmul(u[i][brev(k, 4)], w);
      w = cmul(w, w1); } }
  __syncthreads();
  { const int sb = tid >> 1, ii = tid & 1, pb = 34 * sb + ii;
    cplx u[NV][16];
#pragma unroll
    for (int i = 0; i < NV; ++i)
#pragma unroll
      for (int j = 0; j < 16; ++j) u[i][j] = L[i * FFT_REGION_F2 + pb + 2 * j];

#pragma unroll
    for (int i = 0; i < NV; ++i) dft_reg<16, false>(u[i]);

#pragma unroll
    for (int k = 0; k < 16; ++k)
#pragma unroll
      for (int i = 0; i < NV; ++i) { const cplx y = u[i][brev(k, 4)]; const cplx yw = cmul(y, mk2(cos32(k), -sin32(k))); L[i * FFT_REGION_F2 + pb + 2 * k] = ii ? yw : y; } }
  __syncthreads();
}
template <int NV> DI void fft_inv3(cplx (&v)[NV][16], LAS cplx* L, int tid) {
  { const int sb = tid >> 1, ii = tid & 1, pb = 34 * sb + ii;
    cplx u[NV][16];
#pragma unroll
    for (int i = 0; i < NV; ++i)
#pragma unroll
      for (int k = 0; k < 16; ++k) { const cplx y = L[i * FFT_REGION_F2 + pb + 2 * k]; const cplx yw = cmulc(y, mk2(cos32(k), -sin32(k))); u[i][k] = ii ? yw : y; }

#pragma unroll
    for (int i = 0; i < NV; ++i) dft_reg<16, true>(u[i]);

#pragma unroll
    for (int i = 0; i < NV; ++i)
#pragma unroll
      for (int j = 0; j < 16; ++j) L[i * FFT_REGION_F2 + pb + 2 * j] = u[i][brev(j, 4)]; }
  __syncthreads();
  { const int sb = tid >> 5, ii = tid & 31, pb = 544 * sb + ii;
    cplx u[NV][16];
    float rev = (float)ii * (1.f / 512.f); asm volatile("" : "+v"(rev)); const cplx w1 = mk2(__builtin_amdgcn_cosf(rev), -__builtin_amdgcn_sinf(rev)); cplx w = mk2(1.f, 0.f);
#pragma unroll
    for (int k = 0; k < 16; ++k) {
#pragma unroll
      for (int i = 0; i < NV; ++i) u[i][k] = cmulc(L[i * FFT_REGION_F2 + pb + 34 * k], w);
      w = cmul(w, w1); }

#pragma unroll
    for (int i = 0; i < NV; ++i) dft_reg<16, true>(u[i]);

#pragma unroll
    for (int i = 0; i < NV; ++i)
#pragma unroll
      for (int j = 0; j < 16; ++j) L[i * FFT_REGION_F2 + pb + 34 * j] = u[i][brev(j, 4)]; }
  __syncthreads();
  { float rev = (float)tid * (1.f / 8192.f); asm volatile("" : "+v"(rev)); const cplx w1 = mk2(__builtin_amdgcn_cosf(rev), -__builtin_amdgcn_sinf(rev)); cplx w = mk2(1.f, 0.f);
    const int pb = tid + 2 * (tid >> 5);
#pragma unroll
    for (int k = 0; k < 16; ++k) {
#pragma unroll
      for (int i = 0; i < NV; ++i) v[i][k] = cmulc(L[i * FFT_REGION_F2 + pb + 544 * k], w);
      w = cmul(w, w1); }

#pragma unroll
    for (int i = 0; i < NV; ++i) dft_reg<16, true>(v[i]);
     }
}

DI float shl1(float x, int lane) { const float t = __shfl_up(x, 1); return lane == 0 ? 0.f : t; }
DI float shr1(float x, int lane) { const float t = __shfl_down(x, 1); return lane == 63 ? 0.f : t; }
DI void hy_conv8(const bf16_t* XT, int c, int bt, int tl, int lane, const float (&cw)[3][3], const float (&cb)[3], float (&x0c)[8], float (&zz)[8]) {
  float uc[3][8];
#pragma unroll
  for (int g = 0; g < 3; ++g) {
    const u32x4 raw = *(const u32x4*)(XT + (size_t)(g * 1024 + c) * NTOK + (size_t)bt * 4096 + 8 * tl);
    float pv[10];
#pragma unroll
    for (int q = 0; q < 4; ++q) { pv[1 + 2 * q] = bflo(raw[q]); pv[2 + 2 * q] = bfhi(raw[q]); }
    { const float t0 = __shfl_up(pv[8], 1), t1 = __shfl_down(pv[1], 1); pv[0] = (lane & 7) == 0 ? 0.f : t0; pv[9] = (lane & 7) == 7 ? 0.f : t1; }
#pragma unroll
    for (int e2 = 0; e2 < 8; ++e2) uc[g][e2] = cw[g][0] * pv[e2] + cw[g][1] * pv[e2 + 1] + cw[g][2] * pv[e2 + 2] + cb[g];
  }
#pragma unroll
  for (int e2 = 0; e2 < 8; ++e2) { x0c[e2] = uc[0][e2]; zz[e2] = uc[1][e2] * uc[2][e2]; }
}
template <int NV> DI void hyena_chan(const Params& p, int l, int c, LAS cplx* L, int tid) {
  bf16_t* XT = (bf16_t*)(p.ws + OFF_XT);
  const int lane = tid & 63;
  const int pb4 = 16 * tid + 2 * (tid >> 1);
  h16x2 Hr[5]; LAS h16x2* Hl = (LAS h16x2*)(L + 2 * FFT_REGION_F2) + tid;
  {
    const float* hT = (const float*)(p.ws + ((l & 1) ? OFF_HP2 : OFF_HP));
    const float* hf = hT + (size_t)c * 4096, * hbk = hT + (size_t)(1024 + c) * 4096;
    cplx f[1][16];
#pragma unroll
    for (int j = 0; j < 8; ++j) f[0][j] = mk2(__builtin_nontemporal_load(hf + tid + 512 * j), 0.f);
#pragma unroll
    for (int j = 8; j < 16; ++j) { const int n = tid + 512 * j; f[0][j] = mk2(n == 4096 ? 0.f : __builtin_nontemporal_load(hbk + (n == 4096 ? 0 : 8192 - n)), 0.f); }
    fft_fwd3<1>(f, L, tid);
#pragma unroll
    for (int m = 0; m < 8; ++m) { const cplx a = L[pb4 + 2 * m], b = L[pb4 + 2 * m + 1];
      h16x2 h0, h1; h0.x = (_Float16)((a.x + b.x) * HSCALE); h0.y = (_Float16)((a.y + b.y) * HSCALE); h1.x = (_Float16)((a.x - b.x) * HSCALE); h1.y = (_Float16)((a.y - b.y) * HSCALE);
      if (2 * m < 11) Hl[(2 * m) * 512] = h0; else Hr[2 * m - 11 < 0 ? 0 : 2 * m - 11] = h0;
      if (2 * m + 1 < 11) Hl[(2 * m + 1) * 512] = h1; else Hr[2 * m + 1 - 11 < 0 ? 0 : 2 * m + 1 - 11] = h1; }
    __syncthreads();
  }
  float cw[3][3], cb[3];
#pragma unroll
  for (int g = 0; g < 3; ++g) { cb[g] = p.conv_b[l * 3072 + g * 1024 + c];
#pragma unroll
    for (int t = 0; t < 3; ++t) cw[g][t] = p.conv_w[((size_t)l * 3 + t) * 3072 + g * 1024 + c]; }
  const float sk = p.skip[l * 1024 + c], sc = 1.f / (8192.f * HSCALE);
#pragma unroll 1
  for (int bp0 = 0; bp0 < 2; bp0 += NV) {
    int tl = tid; asm volatile("" : "+v"(tl));
#pragma unroll
    for (int i = 0; i < NV; ++i) {
      float xa[8], za[8], xb[8], zb[8];
      hy_conv8(XT, c, 2 * (bp0 + i), tl, lane, cw, cb, xa, za);
      hy_conv8(XT, c, 2 * (bp0 + i) + 1, tl, lane, cw, cb, xb, zb);
      LAS cplx* X = L + i * FFT_REGION_F2 + 8 * tl + 2 * (tl >> 2);
#pragma unroll
      for (int e2 = 0; e2 < 8; ++e2) X[e2] = mk2(za[e2], zb[e2]);

    }
    __syncthreads();
    cplx v[NV][16];
    { const int pb = tl + 2 * (tl >> 5);
#pragma unroll
      for (int i = 0; i < NV; ++i) {
#pragma unroll
        for (int j = 0; j < 8; ++j) v[i][j] = L[i * FFT_REGION_F2 + pb + 544 * j];
#pragma unroll
        for (int j = 8; j < 16; ++j) v[i][j] = mk2(0.f, 0.f); } }
    __syncthreads();

    fft_fwd3<NV>(v, L, tid);

#pragma unroll
    for (int i = 0; i < NV; ++i) {
      LAS cplx* Li = L + i * FFT_REGION_F2;
#pragma unroll
      for (int m = 0; m < 8; ++m) { const cplx a = Li[pb4 + 2 * m], b = Li[pb4 + 2 * m + 1];
        const h16x2 h0 = (2 * m < 11) ? Hl[(2 * m) * 512] : Hr[2 * m - 11 < 0 ? 0 : 2 * m - 11], h1 = (2 * m + 1 < 11) ? Hl[(2 * m + 1) * 512] : Hr[2 * m + 1 - 11 < 0 ? 0 : 2 * m + 1 - 11];
        const cplx y0 = cmul(mk2(a.x + b.x, a.y + b.y), mk2((float)h0.x, (float)h0.y)), y1 = cmul(mk2(a.x - b.x, a.y - b.y), mk2((float)h1.x, (float)h1.y));
        Li[pb4 + 2 * m] = mk2(y0.x + y1.x, y0.y + y1.y); Li[pb4 + 2 * m + 1] = mk2(y0.x - y1.x, y0.y - y1.y); }
       }
    __syncthreads();
    fft_inv3<NV>(v, L, tid);

    { const int pb = tl + 2 * (tl >> 5);
#pragma unroll
      for (int i = 0; i < NV; ++i)
#pragma unroll
        for (int j = 0; j < 8; ++j) L[i * FFT_REGION_F2 + pb + 544 * j] = v[i][brev(j, 4)]; }
    __syncthreads();
#pragma unroll
    for (int i = 0; i < NV; ++i) {
      float xa[8], za[8], xb[8], zb[8];
      hy_conv8(XT, c, 2 * (bp0 + i), tl, lane, cw, cb, xa, za);
      hy_conv8(XT, c, 2 * (bp0 + i) + 1, tl, lane, cw, cb, xb, zb);
      const LAS cplx* X = L + i * FFT_REGION_F2 + 8 * tl + 2 * (tl >> 2);
      float ya[8], yb[8];
#pragma unroll
      for (int e2 = 0; e2 < 8; ++e2) { const cplx cv = X[e2]; ya[e2] = xa[e2] * (cv.x * sc + sk * za[e2]); yb[e2] = xb[e2] * (cv.y * sc + sk * zb[e2]); }
      *(u32x4*)(XT + (size_t)c * NTOK + (size_t)(2 * (bp0 + i)) * 4096 + 8 * tl) = (u32x4){pk2(ya[0], ya[1]), pk2(ya[2], ya[3]), pk2(ya[4], ya[5]), pk2(ya[6], ya[7])};
      *(u32x4*)(XT + (size_t)c * NTOK + (size_t)(2 * (bp0 + i) + 1) * 4096 + 8 * tl) = (u32x4){pk2(yb[0], yb[1]), pk2(yb[2], yb[3]), pk2(yb[4], yb[5]), pk2(yb[6], yb[7])};

    }
    __syncthreads();
  }
}

DI void hyena_ctx_item(const Params& p, int l, int c, LAS unsigned char* lds) {
  LAS float* zs = (LAS float*)lds;
  LAS float* hc = zs + 1024;
  LAS float* part = hc + 512;
  bf16_t* XT = (bf16_t*)(p.ws + OFF_XT);
  const float* hTc = (const float*)(p.ws + ((l & 1) ? OFF_HTC2 : OFF_HTC));
  const int tid = otid();
  { const int i = tid - 256; hc[tid] = i >= 0 ? hTc[(size_t)c * 256 + i] : (tid == 0 ? 0.f : hTc[(size_t)(1024 + c) * 256 + (-i)]); }
  float u0[2];
  { const int b = tid >> 7, tq = tid & 127;
#pragma unroll
    for (int e = 0; e < 2; ++e) {
      const int t = tq + 128 * e;
      float uu[3];
#pragma unroll
      for (int g = 0; g < 3; ++g) {
        const bf16_t* row = XT + (size_t)(g * 1024 + c) * NTOK + NLAT + b * 256;
        const float pm = t > 0 ? bf2f(row[t - 1]) : 0.f, p0 = bf2f(row[t]), pp = t < 255 ? bf2f(row[t + 1]) : 0.f;
        const size_t wb = (size_t)l * 3 * 3072 + g * 1024 + c;
        uu[g] = p.conv_w[wb] * pm + p.conv_w[wb + 3072] * p0 + p.conv_w[wb + 6144] * pp + p.conv_b[l * 3072 + g * 1024 + c];
      }
      u0[e] = uu[0]; zs[b * 256 + t] = uu[1] * uu[2];
    } }
  __syncthreads();
  const int t0 = 4 * (tid & 63), cbatch = (tid >> 6) & 3, sh = tid >> 8;
  float y[4] = {0.f, 0.f, 0.f, 0.f};
#pragma unroll 4
  for (int s0 = 128 * sh; s0 < 128 * sh + 128; s0 += 4) {
    const int base = 256 + t0 - s0 - 4;
    const f32x4 H0 = *(const LAS f32x4*)(hc + base), H1 = *(const LAS f32x4*)(hc + base + 4), z4 = *(const LAS f32x4*)(zs + cbatch * 256 + s0);
    const float hw[8] = {H0.x, H0.y, H0.z, H0.w, H1.x, H1.y, H1.z, H1.w}, zv[4] = {z4.x, z4.y, z4.z, z4.w};
#pragma unroll
    for (int j = 0; j < 4; ++j)
#pragma unroll
      for (int u = 0; u < 4; ++u) y[j] += hw[4 + j - u] * zv[u];
  }
  if (sh) *(LAS f32x4*)(part + cbatch * 256 + t0) = (f32x4){y[0], y[1], y[2], y[3]};
  __syncthreads();
  if (!sh) { const f32x4 o = *(const LAS f32x4*)(part + cbatch * 256 + t0); part[cbatch * 256 + t0] = y[0] + o.x; part[cbatch * 256 + t0 + 1] = y[1] + o.y; part[cbatch * 256 + t0 + 2] = y[2] + o.z; part[cbatch * 256 + t0 + 3] = y[3] + o.w; }
  __syncthreads();
  { const int b = tid >> 7, tq = tid & 127; const float sk = p.skip[l * 1024 + c];
#pragma unroll
    for (int e = 0; e < 2; ++e) { const int t = tq + 128 * e;
      XT[(size_t)c * NTOK + NLAT + b * 256 + t] = f2bf(u0[e] * (part[b * 256 + t] + sk * zs[b * 256 + t])); } }
  __syncthreads();
}

#ifndef HY_NV
#define HY_NV 2
#endif
#define MFMA32(a, b, c) __builtin_amdgcn_mfma_f32_32x32x16_bf16((a), (b), (c), 0, 0, 0)
DI float logsig(float x) { return fminf(x, 0.f) - __logf(1.f + __expf(-fabsf(x))); }
DI void phase_gla_prep(const Params& p, int l, LAS unsigned char* lds) {
  LAS float* lrs = (LAS float*)lds;
  LAS float* tots = lrs + 64 * 32;
  LAS bf16_t* qs = (LAS bf16_t*)(tots + 2 * 4 * 128);
  LAS bf16_t* kes = qs + 4 * 64 * 136;
  LAS bf16_t* ats = kes + 2 * 128 * 72;
  const int tid = otid(), d = tid & 127, tq = tid >> 7, wid = tid >> 6, lane = tid & 63;
  const bf16_t* PB = (const bf16_t*)(p.ws + OFF_PB);
  const float* LR = (const float*)(p.ws + OFF_LR);
  bf16_t* QF = (bf16_t*)(p.ws + OFF_QF); bf16_t* QB = (bf16_t*)(p.ws + OFF_QB);
  bf16_t* KEF = (bf16_t*)(p.ws + OFF_KEF); bf16_t* KEB = (bf16_t*)(p.ws + OFF_KEB);
  bf16_t* ATT = (bf16_t*)(p.ws + OFF_ATT); float* DEC = (float*)(p.ws + OFF_DEC);
  const float qscale = 0.08838834764831845f;
  f32x4 lrv; bf16_t qv[16], kv[16];
#define PREP_LOAD(it_) do { const int ch_ = (it_) >> 2, hh_ = (it_) & 3; const size_t t0_ = (size_t)ch_ * 64; lrv = *(const f32x4*)(LR + t0_ * 32 + 4 * tid); \
    _Pragma("unroll") for (int i = 0; i < 16; ++i) { const size_t tk_ = t0_ + tq * 16 + i; qv[i] = PB[tk_ * 4096 + hh_ * 128 + d]; kv[i] = PB[tk_ * 4096 + 512 + hh_ * 128 + d]; } } while (0)
  float gwf[16], gwb[16], gbf = 0.f, gbb = 0.f;
#define PREP_LOADG(it_) do { const int hh_ = (it_) & 3; \
    _Pragma("unroll") for (int r = 0; r < 16; ++r) { gwf[r] = p.gate_w[(((size_t)l * 2 + 0) * 16 + r) * 512 + hh_ * 128 + d]; gwb[r] = p.gate_w[(((size_t)l * 2 + 1) * 16 + r) * 512 + hh_ * 128 + d]; } \
    gbf = p.gate_b[((size_t)l * 2 + 0) * 512 + hh_ * 128 + d]; gbb = p.gate_b[((size_t)l * 2 + 1) * 512 + hh_ * 128 + d]; } while (0)
  if ((int)blockIdx.x < 272 * 4) PREP_LOAD((int)blockIdx.x);
  for (int it = blockIdx.x; it < 272 * 4; it += gridDim.x) {
    const int chunk = it >> 2, h = it & 3, tok0 = chunk * 64;
    *(LAS f32x4*)(lrs + 4 * tid) = lrv;
    PREP_LOADG(it);
    __syncthreads();
    float cf[16], cb[16];
#pragma unroll
    for (int i = 0; i < 16; ++i) {
      const int t = tq * 16 + i; float pf = gbf, pb = gbb;
#pragma unroll
      for (int r4 = 0; r4 < 4; ++r4) { const f32x4 lf = *(const LAS f32x4*)(lrs + t * 32 + 4 * r4), lb = *(const LAS f32x4*)(lrs + t * 32 + 16 + 4 * r4);
        pf += lf.x * gwf[4 * r4] + lf.y * gwf[4 * r4 + 1] + lf.z * gwf[4 * r4 + 2] + lf.w * gwf[4 * r4 + 3]; pb += lb.x * gwb[4 * r4] + lb.y * gwb[4 * r4 + 1] + lb.z * gwb[4 * r4 + 2] + lb.w * gwb[4 * r4 + 3]; }
      cf[i] = logsig(pf) * (1.f / 16.f); cb[i] = logsig(pb) * (1.f / 16.f);
    }
    { float run = 0.f;
#pragma unroll
      for (int i = 0; i < 16; ++i) { run += cf[i]; cf[i] = run; }
      tots[(0 * 4 + tq) * 128 + d] = run; run = 0.f;
#pragma unroll
      for (int i = 15; i >= 0; --i) { run += cb[i]; cb[i] = run; }
      tots[(1 * 4 + tq) * 128 + d] = run; }
    __syncthreads();
    float offf = 0.f, offb = 0.f, cendf = 0.f, cendb = 0.f;
#pragma unroll
    for (int q = 0; q < 4; ++q) { const float a = tots[(0 * 4 + q) * 128 + d], b = tots[(1 * 4 + q) * 128 + d]; cendf += a; cendb += b; if (q < tq) offf += a; if (q > tq) offb += b; }
    const int o16 = d & 15, grp = o16 >> 2, ngrp = (grp == 1) ? 2 : (grp == 2) ? 1 : grp, permd = (d & ~15) | (ngrp << 2) | (o16 & 3);
    unsigned kef[8], keb[8];
    const float ecf = __expf(cendf), ecb = __expf(cendb);
#pragma unroll
    for (int i = 0; i < 16; ++i) {
      const int t = tq * 16 + i; const size_t tok = (size_t)tok0 + t;
      const float q = bf2f(qv[i]) * qscale, k = bf2f(kv[i]);
      const float ea = __expf(cf[i] + offf), eb2 = __expf(cb[i] + offb);
      const float kia = k * __builtin_amdgcn_rcpf(ea), kib = k * __builtin_amdgcn_rcpf(eb2);
      const bf16_t qf = f2bf(q * ea), kf = f2bf(kia), qb = f2bf(q * eb2), kb = f2bf(kib);
      const bf16_t ef = f2bf(kia * ecf), eb = f2bf(kib * ecb);
      qs[(0 * 64 + t) * 136 + d] = qf; qs[(1 * 64 + t) * 136 + d] = kf; qs[(2 * 64 + t) * 136 + d] = qb; qs[(3 * 64 + t) * 136 + d] = kb;
      QF[tok * 512 + h * 128 + permd] = qf; QB[tok * 512 + h * 128 + permd] = qb;
      if (i & 1) { kef[i >> 1] |= (unsigned)ef << 16; keb[i >> 1] |= (unsigned)eb << 16; } else { kef[i >> 1] = ef; keb[i >> 1] = eb; }
    }
    if (it + (int)gridDim.x < 272 * 4) PREP_LOAD(it + (int)gridDim.x);
    { LAS u32x4* d1 = (LAS u32x4*)(kes + (0 * 128 + d) * 72 + tq * 16); d1[0] = (u32x4){kef[0], kef[1], kef[2], kef[3]}; d1[1] = (u32x4){kef[4], kef[5], kef[6], kef[7]};
      LAS u32x4* d2 = (LAS u32x4*)(kes + (1 * 128 + d) * 72 + tq * 16); d2[0] = (u32x4){keb[0], keb[1], keb[2], keb[3]}; d2[1] = (u32x4){keb[4], keb[5], keb[6], keb[7]}; }
    if (tq == 0) { DEC[(((size_t)chunk * 4 + h) * 2 + 0) * 128 + d] = ecf; DEC[(((size_t)chunk * 4 + h) * 2 + 1) * 128 + d] = ecb; }
    __syncthreads();
    {
      const int dir = wid >> 2, ti = (wid >> 1) & 1, si = wid & 1, r = lane & 31, hh = lane >> 5;
      const LAS bf16_t* ka = qs + ((dir * 2 + 1) * 64 + 32 * si + r) * 136 + 8 * hh;
      const LAS bf16_t* qa = qs + ((dir * 2 + 0) * 64 + 32 * ti + r) * 136 + 8 * hh;
      f32x16 acc;
#pragma unroll
      for (int i = 0; i < 16; ++i) acc[i] = 0.f;
#pragma unroll
      for (int ks = 0; ks < 8; ++ks) acc = MFMA32(*(const LAS bf16x8*)(ka + 16 * ks), *(const LAS bf16x8*)(qa + 16 * ks), acc);
      const int t = 32 * ti + r;
      LAS bf16_t* dst = ats + (dir * 64 + t) * 72 + 32 * si + 4 * hh;
#pragma unroll
      for (int g = 0; g < 4; ++g) {
        float vv[4];
#pragma unroll
        for (int e = 0; e < 4; ++e) { const int s = 32 * si + 8 * g + 4 * hh + e; const bool keep = dir ? (s >= t) : (s <= t); vv[e] = keep ? acc[4 * g + e] : 0.f; }
        *(LAS u32x2*)(dst + 8 * g) = (u32x2){pk2(vv[0], vv[1]), pk2(vv[2], vv[3])};
      }
    }
    __syncthreads();
    {
      const size_t chh = (size_t)chunk * 4 + h;
#pragma unroll
      for (int q = 0; q < 2; ++q) { const int pc = tid + 512 * q, row = pc >> 3, cc = pc & 7;
        *(u32x4*)(KEF + (chh * 128 + row) * 64 + 8 * cc) = *(const LAS u32x4*)(kes + (0 * 128 + row) * 72 + 8 * cc);
        *(u32x4*)(KEB + (chh * 128 + row) * 64 + 8 * cc) = *(const LAS u32x4*)(kes + (1 * 128 + row) * 72 + 8 * cc);
        const int rr = row & 63, dd = row >> 6;
        *(u32x4*)(ATT + ((chh * 2 + dd) * 64 + rr) * 64 + 8 * cc) = *(const LAS u32x4*)(ats + (dd * 64 + rr) * 72 + 8 * cc); }
    }
    __syncthreads();
  }
}

#undef PREP_LOAD
#undef PREP_LOADG
DI bf16x8 pack8(const f32x16& x, int s) {
  u32x4 r; r[0] = pk2(x[8 * s + 0], x[8 * s + 1]); r[1] = pk2(x[8 * s + 2], x[8 * s + 3]); r[2] = pk2(x[8 * s + 4], x[8 * s + 5]); r[3] = pk2(x[8 * s + 6], x[8 * s + 7]);
  return __builtin_bit_cast(bf16x8, r);
}
DI void phase_gla_scan(const Params& p, LAS unsigned char* lds) {
  constexpr int BUFB = 64 * 136 * 2 + 128 * 72 * 2 + 64 * 72 * 2 + 512;
  const int tid = otid(), wid = tid >> 6, lane = tid & 63, r = lane & 31, hh = lane >> 5;
  const int bid = blockIdx.x, b = bid >> 3, h = (bid >> 1) & 3, dir = bid & 1;
  const bf16_t* Qg = (const bf16_t*)(p.ws + (dir ? OFF_QB : OFF_QF));
  const bf16_t* Kg = (const bf16_t*)(p.ws + (dir ? OFF_KEB : OFF_KEF));
  const bf16_t* ATT = (const bf16_t*)(p.ws + OFF_ATT); const float* DEC = (const float*)(p.ws + OFF_DEC);
  const bf16_t* VT = (const bf16_t*)(p.ws + OFF_XT) + (size_t)(3072 + h * 256 + 32 * wid + r) * NTOK + 8 * hh;
  bf16_t* Og = dir ? (bf16_t*)(p.ws + OFF_X) : (bf16_t*)(p.ws + OFF_PB);
  const int ldo = dir ? 1024 : 4096;
  const int qrow0 = tid >> 4, qcc = tid & 15, krow0 = tid >> 3, kcc = tid & 7;
  constexpr int OBUF = 64 * 264 * 2;
  LAS unsigned char* obase = lds + 2 * BUFB;
  f32x16 S[4];
#pragma unroll
  for (int m = 0; m < 4; ++m)
#pragma unroll
    for (int i = 0; i < 16; ++i) S[m][i] = 0.f;
  u32x4 pq0, pq1, pk0, pk1, pa; float pdc = 0.f; bf16x8 vf[4], vn[4];
#define SCAN_CIDX(st) ((st) < 4 ? (256 + 4 * b + (dir ? 3 - (st) : (st))) : (64 * b + (dir ? 67 - (st) : (st) - 4)))
#define SCAN_LOAD(st) do { const int ci_ = SCAN_CIDX(st); const size_t tk_ = (size_t)ci_ * 64, ch_ = (size_t)ci_ * 4 + h; \
    pq0 = *(const u32x4*)(Qg + (tk_ + qrow0) * 512 + h * 128 + 8 * qcc); pq1 = *(const u32x4*)(Qg + (tk_ + qrow0 + 32) * 512 + h * 128 + 8 * qcc); \
    pk0 = *(const u32x4*)(Kg + (ch_ * 128 + krow0) * 64 + 8 * kcc); pk1 = *(const u32x4*)(Kg + (ch_ * 128 + krow0 + 64) * 64 + 8 * kcc); \
    pa = *(const u32x4*)(ATT + ((ch_ * 2 + dir) * 64 + krow0) * 64 + 8 * kcc); if (tid < 128) pdc = DEC[(ch_ * 2 + dir) * 128 + tid]; \
    _Pragma("unroll") for (int ks = 0; ks < 4; ++ks) vn[ks] = *(const bf16x8*)(VT + tk_ + 16 * ks); } while (0)
#define SCAN_STORE(bufi) do { LAS unsigned char* bb_ = lds + (bufi) * BUFB; LAS bf16_t* QT_ = (LAS bf16_t*)bb_; LAS bf16_t* KE_ = QT_ + 64 * 136; LAS bf16_t* AT_ = KE_ + 128 * 72; LAS float* DC_ = (LAS float*)(AT_ + 64 * 72); \
    *(LAS u32x4*)(QT_ + qrow0 * 136 + 8 * qcc) = pq0; *(LAS u32x4*)(QT_ + (qrow0 + 32) * 136 + 8 * qcc) = pq1; \
    *(LAS u32x4*)(KE_ + krow0 * 72 + 8 * kcc) = pk0; *(LAS u32x4*)(KE_ + (krow0 + 64) * 72 + 8 * kcc) = pk1; \
    *(LAS u32x4*)(AT_ + krow0 * 72 + 8 * kcc) = pa; if (tid < 128) DC_[tid] = pdc; } while (0)
#define SCAN_WRITEOUT(st) do { const size_t tk_ = (size_t)SCAN_CIDX(st) * 64; const LAS bf16_t* ob_ = (const LAS bf16_t*)(obase + ((st) & 1) * OBUF); \
    _Pragma("unroll 2") for (int q = 0; q < 4; ++q) { const int pc_ = tid + 512 * q, row_ = pc_ >> 5, cc_ = pc_ & 31; \
      *(u32x4*)(Og + (tk_ + row_) * ldo + h * 256 + 8 * cc_) = *(const LAS u32x4*)(ob_ + row_ * 264 + 8 * cc_); } } while (0)
  SCAN_LOAD(0); SCAN_STORE(0);
#pragma unroll
  for (int ks = 0; ks < 4; ++ks) vf[ks] = vn[ks];
  __syncthreads();
#pragma unroll 1
  for (int step = 0; step < 68; ++step) {
    const size_t tok0 = (size_t)SCAN_CIDX(step) * 64;
    if (step > 0) SCAN_WRITEOUT(step - 1);
    __builtin_amdgcn_sched_barrier(0);
    if (step + 1 < 68) SCAN_LOAD(step + 1);
    LAS unsigned char* bb = lds + (step & 1) * BUFB;
    const LAS bf16_t* QT = (const LAS bf16_t*)bb; const LAS bf16_t* KE = QT + 64 * 136; const LAS bf16_t* AT = KE + 128 * 72; const LAS float* DC = (const LAS float*)(AT + 64 * 72);
    bf16x8 sp[8];
#pragma unroll
    for (int m = 0; m < 4; ++m) { sp[2 * m] = pack8(S[m], 0); sp[2 * m + 1] = pack8(S[m], 1); }
    f32x16 o0, o1;
#pragma unroll
    for (int i = 0; i < 16; ++i) { o0[i] = 0.f; o1[i] = 0.f; }
#pragma unroll
    for (int ks = 0; ks < 4; ++ks) {
      o0 = MFMA32(vf[ks], *(const LAS bf16x8*)(AT + r * 72 + 16 * ks + 8 * hh), o0);
      o1 = MFMA32(vf[ks], *(const LAS bf16x8*)(AT + (32 + r) * 72 + 16 * ks + 8 * hh), o1);
    }
#pragma unroll
    for (int k8 = 0; k8 < 8; ++k8) {
      o0 = MFMA32(sp[k8], *(const LAS bf16x8*)(QT + r * 136 + 16 * k8 + 8 * hh), o0);
      o1 = MFMA32(sp[k8], *(const LAS bf16x8*)(QT + (32 + r) * 136 + 16 * k8 + 8 * hh), o1);
    }
#pragma unroll
    for (int m = 0; m < 4; ++m) {
#pragma unroll
      for (int g = 0; g < 4; ++g) { const f32x4 dv = *(const LAS f32x4*)(DC + 32 * m + 8 * g + 4 * hh);
        S[m][4 * g] *= dv.x; S[m][4 * g + 1] *= dv.y; S[m][4 * g + 2] *= dv.z; S[m][4 * g + 3] *= dv.w; }
#pragma unroll
      for (int ks = 0; ks < 4; ++ks) S[m] = MFMA32(*(const LAS bf16x8*)(KE + (32 * m + r) * 72 + 16 * ks + 8 * hh), vf[ks], S[m]);
    }
    { LAS bf16_t* ob = (LAS bf16_t*)(obase + (step & 1) * OBUF) + r * 264 + 32 * wid + 4 * hh;
#pragma unroll
      for (int g = 0; g < 4; ++g) {
        *(LAS u32x2*)(ob + 8 * g) = (u32x2){pk2(o0[4 * g], o0[4 * g + 1]), pk2(o0[4 * g + 2], o0[4 * g + 3])};
        *(LAS u32x2*)(ob + 32 * 264 + 8 * g) = (u32x2){pk2(o1[4 * g], o1[4 * g + 1]), pk2(o1[4 * g + 2], o1[4 * g + 3])};
      } }
    if (step + 1 < 68) { SCAN_STORE((step + 1) & 1);
#pragma unroll
      for (int ks = 0; ks < 4; ++ks) vf[ks] = vn[ks]; }
    __syncthreads();
  }
  SCAN_WRITEOUT(67);
  __syncthreads();
#undef SCAN_WRITEOUT
#undef SCAN_CIDX
#undef SCAN_LOAD
#undef SCAN_STORE
}

DI void phase_post(const Params& p, int l, int ntok, LAS unsigned char* lds) {
  const int tid = otid(), lane = tid & 63;
  { const int gw = blockIdx.x * 8 + (tid >> 6), nw = gridDim.x * 8, l32 = lane & 31, hsel = lane >> 5;
    const bf16_t* PB = (const bf16_t*)(p.ws + OFF_PB); bf16_t* HB = (bf16_t*)(p.ws + OFF_X);
    const f32x4 ng0 = *(const f32x4*)(p.gla_ng + l * 256 + 8 * l32), ng1 = *(const f32x4*)(p.gla_ng + l * 256 + 8 * l32 + 4);
    u32x4 na, nb, nr;
    if (gw < ntok * 2) { const size_t tk = gw >> 1; const int cl = ((gw & 1) * 2 + hsel) * 256 + 8 * l32; na = __builtin_nontemporal_load((const u32x4*)(PB + tk * 4096 + cl)); nb = __builtin_nontemporal_load((const u32x4*)(HB + tk * 1024 + cl)); nr = __builtin_nontemporal_load((const u32x4*)(PB + tk * 4096 + 1024 + cl)); }
    for (int it = gw; it < ntok * 2; it += nw) {
      const size_t tok = it >> 1; const int col = ((it & 1) * 2 + hsel) * 256 + 8 * l32;
      const u32x4 a = na, b = nb, rr = nr;
      if (it + nw < ntok * 2) { const int i2 = it + nw; const size_t tk = i2 >> 1; const int cl = ((i2 & 1) * 2 + hsel) * 256 + 8 * l32; na = __builtin_nontemporal_load((const u32x4*)(PB + tk * 4096 + cl)); nb = __builtin_nontemporal_load((const u32x4*)(HB + tk * 1024 + cl)); nr = __builtin_nontemporal_load((const u32x4*)(PB + tk * 4096 + 1024 + cl)); }
      float o[8], rv[8];
#pragma unroll
      for (int i = 0; i < 4; ++i) { o[2 * i] = bflo(a[i]) + bflo(b[i]); o[2 * i + 1] = bfhi(a[i]) + bfhi(b[i]); rv[2 * i] = bflo(rr[i]); rv[2 * i + 1] = bfhi(rr[i]); }
      float ss = 0.f;
#pragma unroll
      for (int i = 0; i < 8; ++i) ss += o[i] * o[i];
#pragma unroll
      for (int q = 16; q >= 1; q >>= 1) ss += __shfl_xor(ss, q);
      const float rstd = rsqrtf(ss * (1.f / 256.f) + EPSF);
      const float ngv[8] = {ng0.x, ng0.y, ng0.z, ng0.w, ng1.x, ng1.y, ng1.z, ng1.w};
      float y[8];
#pragma unroll
      for (int i = 0; i < 8; ++i) y[i] = o[i] * rstd * ngv[i] * (rv[i] * sigm(rv[i]));
      *(u32x4*)(HB + tok * 1024 + col) = (u32x4){pk2(y[0], y[1]), pk2(y[2], y[3]), pk2(y[4], y[5]), pk2(y[6], y[7])};
    } }
  { LAS bf16_t* t = (LAS bf16_t*)lds;
    const bf16_t* XT = (const bf16_t*)(p.ws + OFF_XT); bf16_t* YH = (bf16_t*)(p.ws + OFF_QF);
    const int ntt = ntok / 128;
    u32x4 pre[2];
#define POST_TLOAD(it_) do { const int c0_ = ((it_) / ntt) * 64, tk0_ = ((it_) % ntt) * 128; \
      _Pragma("unroll") for (int q = 0; q < 2; ++q) { const int pc = tid + 512 * q, cc = pc >> 4, tq = pc & 15; pre[q] = *(const u32x4*)(XT + (size_t)(c0_ + cc) * NTOK + tk0_ + 8 * tq); } } while (0)
    if ((int)blockIdx.x < 16 * ntt) POST_TLOAD((int)blockIdx.x);
    for (int it = blockIdx.x; it < 16 * ntt; it += gridDim.x) {
      const int c0 = (it / ntt) * 64, tok0 = (it % ntt) * 128;
#pragma unroll
      for (int q = 0; q < 2; ++q) { const int pc = tid + 512 * q, cc = pc >> 4, tq = pc & 15; *(LAS u32x4*)(t + cc * 136 + 8 * tq) = pre[q]; }
      if (it + (int)gridDim.x < 16 * ntt) POST_TLOAD(it + (int)gridDim.x);
      __syncthreads();
#pragma unroll
      for (int q = 0; q < 2; ++q) { const int pc = tid + 512 * q, tk = pc >> 3, cq = pc & 7; unsigned w[4];
#pragma unroll
        for (int i = 0; i < 4; ++i) w[i] = (unsigned)t[(8 * cq + 2 * i) * 136 + tk] | ((unsigned)t[(8 * cq + 2 * i + 1) * 136 + tk] << 16);
        *(u32x4*)(YH + (size_t)(tok0 + tk) * 1024 + c0 + 8 * cq) = (u32x4){w[0], w[1], w[2], w[3]}; }
      __syncthreads();
    } }
}

#undef POST_TLOAD
struct SchedG1 : pg8::StaticOrder {
  __device__ bool next(int i, pg8::Unit& u) const {
    pg8::Unit v; if (!pg8::StaticOrder::next(i, v)) return false;
    if (v.pn < 16) { u.pm = 68 + v.pn; u.pn = v.pm; } else { u.pm = v.pm; u.pn = 68 + v.pn; }
    return true;
  }
};
typedef const f32x4 (&AccRef)[2][2][4][2];
DI u32x4 pack_acc8(f32x4 v0, f32x4 v1) { return (u32x4){pk2(v0[0], v0[1]), pk2(v0[2], v0[3]), pk2(v1[0], v1[1]), pk2(v1[2], v1[3])}; }
struct EpiG1 {
  static constexpr bool PERM = true, AFTER_DRAIN = false;
  bf16_t* XT; bf16_t* PB; float* LR;
  DI void operator()(AccRef acc, const pg8::Unit& u, int wr, int wc, int fr, int fq) const {
    if (u.pm >= 68) {
      const int ch0 = (u.pm - 68) * 256 + wr * 64 + fr, tk0 = u.pn * 256 + wc * 32 + 8 * fq;
#pragma unroll
      for (int ai = 0; ai < 2; ++ai)
#pragma unroll
        for (int m = 0; m < 4; ++m) { bf16_t* rp = XT + (size_t)(ch0 + ai * 128 + m * 16) * NTOK + tk0;
#pragma unroll
          for (int bj = 0; bj < 2; ++bj) *(u32x4*)(rp + bj * 128) = pack_acc8(acc[ai][bj][m][0], acc[ai][bj][m][1]); }
    } else {
      const int wp = u.pn - 84, row0 = u.pm * 256 + wr * 64 + fr, col0 = wp * 256 + wc * 32 + 8 * fq;
      if (wp < 16) {
#pragma unroll
        for (int ai = 0; ai < 2; ++ai)
#pragma unroll
          for (int m = 0; m < 4; ++m) { bf16_t* rp = PB + (size_t)(row0 + ai * 128 + m * 16) * 4096 + col0;
#pragma unroll
            for (int bj = 0; bj < 2; ++bj) *(u32x4*)(rp + bj * 128) = pack_acc8(acc[ai][bj][m][0], acc[ai][bj][m][1]); }
      } else if (wc == 0) {
#pragma unroll
        for (int ai = 0; ai < 2; ++ai)
#pragma unroll
          for (int m = 0; m < 4; ++m) { float* rp = LR + (size_t)(row0 + ai * 128 + m * 16) * 32 + 8 * fq; *(f32x4*)rp = acc[ai][0][m][0]; *(f32x4*)(rp + 4) = acc[ai][0][m][1]; }
      }
    }
  }
};
template <int MODE> struct EpiGate {
  static constexpr bool PERM = true, AFTER_DRAIN = false;
  const bf16_t* PB; bf16_t* T1; bf16_t* MG;
  DI void operator()(AccRef acc, const pg8::Unit& u, int wr, int wc, int fr, int fq) const {
    const int row0 = u.pm * 256 + wr * 64 + fr, col0 = u.pn * 256 + wc * 32 + 8 * fq;
#pragma unroll
    for (int ai = 0; ai < 2; ++ai)
#pragma unroll
      for (int m = 0; m < 4; ++m) { const size_t row = (size_t)(row0 + ai * 128 + m * 16);
#pragma unroll
        for (int bj = 0; bj < 2; ++bj) { const int col = col0 + bj * 128;
          const u32x4 g = *(const u32x4*)(PB + row * 4096 + (MODE ? 3072 : 2048) + col);
          const f32x4 v0 = acc[ai][bj][m][0], v1 = acc[ai][bj][m][1];
          float o[8] = {v0[0] * sigm(bflo(g[0])), v0[1] * sigm(bfhi(g[0])), v0[2] * sigm(bflo(g[1])), v0[3] * sigm(bfhi(g[1])),
                        v1[0] * sigm(bflo(g[2])), v1[1] * sigm(bfhi(g[2])), v1[2] * sigm(bflo(g[3])), v1[3] * sigm(bfhi(g[3]))};
          if (MODE) { const u32x4 t = *(const u32x4*)(T1 + row * 1024 + col);
            o[0] += bflo(t[0]); o[1] += bfhi(t[0]); o[2] += bflo(t[1]); o[3] += bfhi(t[1]); o[4] += bflo(t[2]); o[5] += bfhi(t[2]); o[6] += bflo(t[3]); o[7] += bfhi(t[3]); }
          *(u32x4*)((MODE ? MG : T1) + row * 1024 + col) = (u32x4){pk2(o[0], o[1]), pk2(o[2], o[3]), pk2(o[4], o[5]), pk2(o[6], o[7])}; } }
  }
};
struct EpiRes {
  static constexpr bool PERM = false, AFTER_DRAIN = false;
  float* out; float* ctxs; const float* modl; int goff; const float* src_lat; const float* src_ctx;
  DI void operator()(AccRef acc, const pg8::Unit& u, int wr, int wc, int fr, int fq) const {
    const int row0 = u.pm * 256 + wr * 64 + fr, col0 = u.pn * 256 + wc * 32 + 4 * fq;
    const float* gv = modl + (size_t)(u.pm < 64 ? (u.pm >> 4) : 4) * 6144 + goff + col0;
    f32x4 gg[2][2];
#pragma unroll
    for (int bj = 0; bj < 2; ++bj)
#pragma unroll
      for (int n = 0; n < 2; ++n) gg[bj][n] = *(const f32x4*)(gv + bj * 128 + n * 16);
#pragma unroll
    for (int ai = 0; ai < 2; ++ai)
#pragma unroll
      for (int m = 0; m < 4; ++m) { const int row = row0 + ai * 128 + m * 16;
        float* rp = (row < NLAT ? out + (size_t)row * 1024 : ctxs + (size_t)(row - NLAT) * 1024) + col0;
        const float* sp = (row < NLAT ? src_lat + (size_t)row * 1024 : src_ctx + (size_t)(row - NLAT) * 1024) + col0;
#pragma unroll
        for (int bj = 0; bj < 2; ++bj)
#pragma unroll
          for (int n = 0; n < 2; ++n) { f32x4* q = (f32x4*)(rp + bj * 128 + n * 16); *q = *(const f32x4*)(sp + bj * 128 + n * 16) + gg[bj][n] * acc[ai][bj][m][n]; } }
  }
};
struct EpiRelu2 {
  static constexpr bool PERM = true, AFTER_DRAIN = false;
  bf16_t* O;
  DI void operator()(AccRef acc, const pg8::Unit& u, int wr, int wc, int fr, int fq) const {
    const int row0 = u.pm * 256 + wr * 64 + fr, col0 = u.pn * 256 + wc * 32 + 8 * fq;
#pragma unroll
    for (int ai = 0; ai < 2; ++ai)
#pragma unroll
      for (int m = 0; m < 4; ++m) { bf16_t* rp = O + (size_t)(row0 + ai * 128 + m * 16) * 4096 + col0;
#pragma unroll
        for (int bj = 0; bj < 2; ++bj) { f32x4 v0 = acc[ai][bj][m][0], v1 = acc[ai][bj][m][1];
#pragma unroll
          for (int e = 0; e < 4; ++e) { const float a = fmaxf(v0[e], 0.f), b = fmaxf(v1[e], 0.f); v0[e] = a * a; v1[e] = b * b; }
          *(u32x4*)(rp + bj * 128) = pack_acc8(v0, v1); } }
  }
};

#define MFMA16(a, b, c) __builtin_amdgcn_mfma_f32_16x16x32_bf16((a), (b), (c), 0, 0, 0)
template <class F> DI void ctx_gemm(const bf16_t* A, const bf16_t* Bt, int K, int N, LAS unsigned char* lds, const F& epi) {
  constexpr int LDT = 136, TILEB = 64 * LDT * 2;
  const int tid = otid(), wid = tid >> 6, lane = tid & 63, fr = lane & 15, fq = lane >> 4, wm = wid >> 1, wn = wid & 1;
  const int ntn = N / 64, ntiles = 16 * ntn, nk = K / 128;
  const int lrow = tid >> 4, lcc = tid & 15;
  for (int t0 = blockIdx.x; t0 < ntiles; t0 += gridDim.x) {
    int tile = t0;
    if (ntiles == 256 && gridDim.x == 256) { const int x = t0 & 7, idx = t0 >> 3; tile = (4 * (x >> 1) + (idx >> 3)) * 16 + 8 * (x & 1) + (idx & 7); }
    const int tm = tile / ntn, tn = tile % ntn;
    const bf16_t* Ab = A + (size_t)(tm * 64 + lrow) * K + 8 * lcc; const bf16_t* Bb = Bt + (size_t)(tn * 64 + lrow) * K + 8 * lcc;
    const size_t r32 = (size_t)32 * K;
    u32x4 ra0, ra1, rb0, rb1, sa0, sa1, sb0, sb1;
#define CG_LOAD(x0, x1, y0, y1, kt_) do { const int ko_ = (kt_) * 128; x0 = *(const u32x4*)(Ab + ko_); x1 = *(const u32x4*)(Ab + r32 + ko_); y0 = *(const u32x4*)(Bb + ko_); y1 = *(const u32x4*)(Bb + r32 + ko_); } while (0)
#define CG_STORE(x0, x1, y0, y1, bufi) do { LAS bf16_t* dA_ = (LAS bf16_t*)(lds + (bufi) * 2 * TILEB); LAS bf16_t* dB_ = (LAS bf16_t*)(lds + (bufi) * 2 * TILEB + TILEB); \
    *(LAS u32x4*)(dA_ + lrow * LDT + 8 * lcc) = x0; *(LAS u32x4*)(dA_ + (lrow + 32) * LDT + 8 * lcc) = x1; *(LAS u32x4*)(dB_ + lrow * LDT + 8 * lcc) = y0; *(LAS u32x4*)(dB_ + (lrow + 32) * LDT + 8 * lcc) = y1; } while (0)
#define CG_COMPUTE(bufi) do { const LAS bf16_t* sA_ = (const LAS bf16_t*)(lds + (bufi) * 2 * TILEB); const LAS bf16_t* sB_ = (const LAS bf16_t*)(lds + (bufi) * 2 * TILEB + TILEB); \
    _Pragma("unroll") for (int ks = 0; ks < 4; ++ks) { const bf16x8 af = *(const LAS bf16x8*)(sA_ + (16 * wm + fr) * LDT + 32 * ks + 8 * fq); \
      const bf16x8 b0 = *(const LAS bf16x8*)(sB_ + (32 * wn + fr) * LDT + 32 * ks + 8 * fq), b1 = *(const LAS bf16x8*)(sB_ + (32 * wn + 16 + fr) * LDT + 32 * ks + 8 * fq); \
      acc0 = MFMA16(b0, af, acc0); acc1 = MFMA16(b1, af, acc1); } } while (0)
    CG_LOAD(ra0, ra1, rb0, rb1, 0); CG_LOAD(sa0, sa1, sb0, sb1, 1);
    CG_STORE(ra0, ra1, rb0, rb1, 0);
    __syncthreads();
    f32x4 acc0 = {0.f, 0.f, 0.f, 0.f}, acc1 = {0.f, 0.f, 0.f, 0.f};
#pragma unroll 1
    for (int kt = 0; kt < nk; kt += 2) {
      if (kt + 2 < nk) CG_LOAD(ra0, ra1, rb0, rb1, kt + 2);
      CG_COMPUTE(0);
      CG_STORE(sa0, sa1, sb0, sb1, 1);
      __syncthreads();
      if (kt + 3 < nk) CG_LOAD(sa0, sa1, sb0, sb1, kt + 3);
      CG_COMPUTE(1);
      if (kt + 2 < nk) CG_STORE(ra0, ra1, rb0, rb1, 0);
      __syncthreads();
    }
#undef CG_LOAD
#undef CG_STORE
#undef CG_COMPUTE
    const int row = tm * 64 + 16 * wm + fr, col = tn * 64 + 32 * wn + 4 * fq;
    epi(row, col, acc0); epi(row, col + 16, acc1);
  }
}

__global__ void __launch_bounds__(512, 2) fwd_megakernel(Params p) {
  extern __shared__ __attribute__((aligned(16))) unsigned char shm[];
  LAS unsigned char* lds = (LAS unsigned char*)shm;
  cg::grid_group grid = cg::this_grid();
  unsigned char* ws = p.ws;
  const int G = gridDim.x, cblk = blockIdx.x;
  unsigned* cnt = (unsigned*)(ws + OFF_CNT);
  __shared__ unsigned xbw[4];
#define s_item (*(volatile int*)&xbw[2])
  if (threadIdx.x == 0) { xbw[0] = 0u; xbw[1] = 0u; xbw[2] = 0u; xbw[3] = 0u; }
  __syncthreads();
#ifndef TPROBE
#define TPROBE 0
#endif
  unsigned long long tacc = 0ull, tt0 = 0ull;
#define TB(g) do { if (TPROBE == (g) && blockIdx.x == 0) tt0 = __builtin_amdgcn_s_memrealtime(); } while (0)
#define TE(g) do { if (TPROBE == (g) && blockIdx.x == 0) tacc += __builtin_amdgcn_s_memrealtime() - tt0; } while (0)

  TB(5); phase_copy(p); phase_mod(p, lds); phase_a2(p, lds);
  phase_wconv(p, 0, lds, 0, cblk, G); phase_wconv(p, 0, lds, 1, cblk, G);
  grid.sync(); TE(5);
  const XcdBarrier xb = xcd_barrier_post((unsigned*)(ws + OFF_BAR), (volatile LAS unsigned*)xbw);
  for (int l = 0; l < 4; ++l) {
    const bool last = (l == 3);
    const int MR = last ? NLAT : NTOK;
    TB(3); TB(14); if (l > 0) phase_wconv(p, l, lds, 1, cblk, G);
    phase_norm(p, l, p.norm1_g + l * 1024, 0, 1024, NTOK, l == 0);
    if (l == 0) phase_filt_gemm(p, l, lds, cblk, G);
    xcd_barrier(xb); TE(14); TE(3);
    TB(1); TB(6);
    { pg8::Gemm g{(const bf16_t*)(ws + OFF_X), (const bf16_t*)(ws + OFF_X), NTOK, 8448, 1024};
      SchedG1 S; S.init(NTOK, 8448, G, cblk);
      EpiG1 E{(bf16_t*)(ws + OFF_XT), (bf16_t*)(ws + OFF_PB), (float*)(ws + OFF_LR)};
      pg8::gemm_phase<EpiG1, SchedG1, false>(lds, g, S, E, nullptr); }
    xcd_barrier(xb); TE(1); TE(6);
    TB(4); TB(11); phase_gla_prep(p, l, lds);
    if (!last && cblk >= 64) phase_filt_gemm(p, l + 1, lds, cblk - 64, G - 64);
    xcd_barrier(xb); TE(4); TE(11);
    TB(2); TB(7); if (cblk < 32) phase_gla_scan(p, lds); TE(7);
    { LAS cplx* L = (LAS cplx*)lds;
      if (otid() == 0) s_item = (int)atomicAdd(cnt + 2 * l, 1u);
      for (;;) {
        __syncthreads();
        const int it = s_item;
        __syncthreads();
        if (it >= 1024) break;
        if (otid() == 0) s_item = (int)atomicAdd(cnt + 2 * l, 1u);
        hyena_chan<HY_NV>(p, l, __builtin_amdgcn_readfirstlane(it), L, otid());
      }
      if (!last) for (;;) {
        if (otid() == 0) s_item = (int)atomicAdd(cnt + 2 * l + 1, 1u);
        __syncthreads();
        const int it = s_item;
        __syncthreads();
        if (it >= 1024) break;
        hyena_ctx_item(p, l, it, lds);
      } }
    xcd_barrier(xb);
    TE(2);
    TB(4); TB(12); phase_post(p, l, MR, lds);
    xcd_barrier(xb); TE(4); TE(12);
    TB(1); TB(8);
    { pg8::StaticOrder S; S.init(NLAT, 1024, G, cblk);
      const bf16_t* PBc = (const bf16_t*)(ws + OFF_PB); bf16_t* T1 = (bf16_t*)(ws + OFF_KEF); bf16_t* MGp = (bf16_t*)(ws + OFF_XT + (size_t)3072 * NTOK * 2);
      EpiGate<0> E0{PBc, T1, nullptr};
      pg8::Gemm g0{(const bf16_t*)(ws + OFF_QF), (const bf16_t*)(ws + OFF_WBHY), NLAT, 1024, 1024};
      pg8::gemm_phase<EpiGate<0>, pg8::StaticOrder, false>(lds, g0, S, E0, nullptr);
      EpiGate<1> E1{PBc, T1, MGp};
      pg8::Gemm g1{(const bf16_t*)(ws + OFF_X), (const bf16_t*)(ws + OFF_WBGLA), NLAT, 1024, 1024};
      pg8::gemm_phase<EpiGate<1>, pg8::StaticOrder, false>(lds, g1, S, E1, nullptr);
      if (!last) {
        ctx_gemm((const bf16_t*)(ws + OFF_QF) + (size_t)NLAT * 1024, (const bf16_t*)(ws + OFF_WBHY), 1024, 1024, lds, [&](int r, int c, f32x4 v) {
          const size_t row = (size_t)NLAT + r; const u32x2 gt = *(const u32x2*)(PBc + row * 4096 + 2048 + c);
          *(u32x2*)(T1 + row * 1024 + c) = (u32x2){pk2(v[0] * sigm(bflo(gt[0])), v[1] * sigm(bfhi(gt[0]))), pk2(v[2] * sigm(bflo(gt[1])), v[3] * sigm(bfhi(gt[1])))}; });
        ctx_gemm((const bf16_t*)(ws + OFF_X) + (size_t)NLAT * 1024, (const bf16_t*)(ws + OFF_WBGLA), 1024, 1024, lds, [&](int r, int c, f32x4 v) {
          const size_t row = (size_t)NLAT + r; const u32x2 gt = *(const u32x2*)(PBc + row * 4096 + 3072 + c); const u32x2 t1 = *(const u32x2*)(T1 + row * 1024 + c);
          *(u32x2*)(MGp + row * 1024 + c) = (u32x2){pk2(bflo(t1[0]) + v[0] * sigm(bflo(gt[0])), bfhi(t1[0]) + v[1] * sigm(bfhi(gt[0]))), pk2(bflo(t1[1]) + v[2] * sigm(bflo(gt[1])), bfhi(t1[1]) + v[3] * sigm(bfhi(gt[1])))}; });
      } }
    xcd_barrier(xb); TE(8);
    { pg8::StaticOrder S; S.init(NLAT, 1024, G, cblk);
      EpiRes E{p.out, (float*)(ws + OFF_CTXS), modp(p, l, 0), 2048, l == 0 ? p.x : p.out, l == 0 ? p.ctx : (const float*)(ws + OFF_CTXS)};
      pg8::Gemm g{(const bf16_t*)(ws + OFF_XT + (size_t)3072 * NTOK * 2), (const bf16_t*)(ws + OFF_WOUT), NLAT, 1024, 1024};
      pg8::gemm_phase<EpiRes, pg8::StaticOrder, false>(lds, g, S, E, nullptr);
      if (!last) { float* cs = (float*)(ws + OFF_CTXS); const float* gv = modp(p, l, 4) + 2048; const float* csrc = l == 0 ? p.ctx : (const float*)cs;
        ctx_gemm((const bf16_t*)(ws + OFF_XT + (size_t)3072 * NTOK * 2) + (size_t)NLAT * 1024, (const bf16_t*)(ws + OFF_WOUT), 1024, 1024, lds, [&](int r, int c, f32x4 v) {
          *(f32x4*)(cs + (size_t)r * 1024 + c) = *(const f32x4*)(csrc + (size_t)r * 1024 + c) + *(const f32x4*)(gv + c) * v; }); } }
    xcd_barrier(xb); TE(1);
    TB(4); TB(13); phase_norm(p, l, p.norm2_g + l * 1024, 3072, 4096, MR, false);
    xcd_barrier(xb); TE(4); TE(13);
    if (TPROBE == 20) { for (int q = 0; q < 8; ++q) xcd_barrier(xb); }
    TB(1); TB(9);
    { pg8::StaticOrder S; S.init(MR, 4096, G, cblk);
      EpiRelu2 E{(bf16_t*)(ws + OFF_PB)};
      pg8::Gemm g{(const bf16_t*)(ws + OFF_X), (const bf16_t*)(ws + OFF_W1), MR, 4096, 1024};
      pg8::gemm_phase<EpiRelu2, pg8::StaticOrder, false>(lds, g, S, E, nullptr);
      if (!last && cblk >= 64) phase_wconv(p, l + 1, lds, 0, cblk - 64, G - 64); }
    xcd_barrier(xb); TE(9); TB(10);
    { pg8::StaticOrder S; S.init(NLAT, 1024, G, cblk);
      EpiRes E{p.out, (float*)(ws + OFF_CTXS), modp(p, l, 0), 5120, p.out, (const float*)(ws + OFF_CTXS)};
      pg8::Gemm g{(const bf16_t*)(ws + OFF_PB), (const bf16_t*)(ws + OFF_W2), NLAT, 1024, 4096};
      pg8::gemm_phase<EpiRes, pg8::StaticOrder, false>(lds, g, S, E, nullptr);
      if (!last) { float* cs = (float*)(ws + OFF_CTXS); const float* gv = modp(p, l, 4) + 5120;
        ctx_gemm((const bf16_t*)(ws + OFF_PB) + (size_t)NLAT * 4096, (const bf16_t*)(ws + OFF_W2), 4096, 1024, lds, [&](int r, int c, f32x4 v) {
          f32x4* q = (f32x4*)(cs + (size_t)r * 1024 + c); *q = *q + *(const f32x4*)(gv + c) * v; }); } }
    xcd_barrier(xb); TE(1); TE(10);
  }
  phase_final_norm(p);
  if (TPROBE && TPROBE != 20 && blockIdx.x == 0) { const unsigned long long s0 = __builtin_amdgcn_s_memrealtime(); while (__builtin_amdgcn_s_memrealtime() - s0 < tacc) __builtin_amdgcn_s_sleep(8); }
}

#ifndef HY_NV
#define HY_NV 2
#endif
constexpr size_t DYN_LDS = 2 * FFT_REGION_F2 * 8 + 11 * 512 * 4;

extern "C" void kernel_launch(void* const* d_in, const int* in_sizes, int n_in, void* d_out, int out_size, void* d_ws, size_t ws_size, hipStream_t stream) {
  if (ws_size < WS_TOTAL || n_in < 28) return;
  static int grid_blocks = 0;
  if (!grid_blocks) {
    int dev = 0, cus = 0, per_cu = 0;
    hipGetDevice(&dev);
    hipDeviceGetAttribute(&cus, hipDeviceAttributeMultiprocessorCount, dev);
    hipFuncSetAttribute((const void*)fwd_megakernel, hipFuncAttributeMaxDynamicSharedMemorySize, (int)DYN_LDS);
    hipOccupancyMaxActiveBlocksPerMultiprocessor(&per_cu, fwd_megakernel, 512, DYN_LDS);
    if (per_cu < 1) per_cu = 1;
    grid_blocks = cus * 1;
  }
  Params p{};
  const float** pp = (const float**)&p;
  for (int i = 0; i < 28; ++i) pp[i] = (const float*)d_in[i];
  p.out = (float*)d_out; p.ws = (unsigned char*)d_ws;
  void* args[] = {&p};
  hipLaunchCooperativeKernel((const void*)fwd_megakernel, dim3(grid_blocks), dim3(512), args, DYN_LDS, stream);
}
```

```cpp
#include <hip/hip_runtime.h>
#include <hip/hip_cooperative_groups.h>
namespace cg = cooperative_groups;
#define DI __device__ __forceinline__

__device__ __forceinline__ int otid() { int t = threadIdx.x; asm volatile("" : "+v"(t)); return t; }
namespace pg8 {
#define PG8_LAS __attribute__((address_space(3)))
typedef unsigned short bf16_t;
typedef short bf16x8 __attribute__((ext_vector_type(8)));
typedef float f32x4 __attribute__((ext_vector_type(4)));
typedef unsigned u32x4 __attribute__((ext_vector_type(4)));
constexpr int BM = 256, BK = 64, HALF = 128, HTB = HALF * BK * 2  , STAGE_BYTES = 8 * HTB, NXCD = 8, WGM = 8;

__host__ __device__ __forceinline__ int lds_byte(int r, int c) { const int st = (r >> 4) * 2 + (c >> 5), rr = r & 15, cc = c & 31, ob = rr * 64 + cc * 2; return st * 1024 + (ob ^ (((ob >> 9) & 1) << 5)); }
__host__ __device__ __forceinline__ void stage_rc(int b, int& R, int& C) { const int st = b / 1024, sb = b % 1024, swz = sb ^ (((sb >> 9) & 1) << 5); R = (st >> 1) * 16 + swz / 64; C = (st & 1) * 32 + (swz % 64) / 2; }
__host__ __device__ __forceinline__ int perm32(int rho) { const int n = rho >> 4, i = rho & 15; return 8 * (i >> 2) + 4 * n + (i & 3); }

struct Unit { int pm, pn; };
struct Gemm { const bf16_t* A; const bf16_t* Bt; int M, N, K; };
struct StaticOrder {
    int nM, nN, nwg, G, c;
    __host__ __device__ void init(int M, int N, int G_, int c_) { nM = M / BM; nN = N / BM; nwg = nM * nN; G = G_; c = c_; }
    __host__ __device__ bool next(int i, Unit& u) const {
        const long L = (long)i * G + c; if (L >= nwg) return false;
        int wgid = (int)L; { const int q = nwg / NXCD, r = nwg % NXCD, xcd = wgid % NXCD, off = wgid / NXCD; wgid = (xcd < r ? xcd * (q + 1) : r * (q + 1) + (xcd - r) * q) + off; }
        const int nig = WGM * nN, gid = wgid / nig, fm = gid * WGM, gsz = (nM - fm) < WGM ? (nM - fm) : WGM;
        u.pm = fm + ((wgid % nig) % gsz); u.pn = (wgid % nig) / gsz; return true;
    }
    __device__ __forceinline__ void a_ready(const Unit&) const {}
    __device__ __forceinline__ void done(const Unit&) const {}
};
__device__ __forceinline__ unsigned cvt_pk_bf16(float lo, float hi) { unsigned r; asm volatile("v_cvt_pk_bf16_f32 %0, %1, %2" : "=v"(r) : "v"(lo), "v"(hi)); return r; }
template <class Epi, class Sched, bool STAMP = false>
__device__ __forceinline__ void gemm_phase(PG8_LAS unsigned char* lds, const Gemm g, const Sched& S, const Epi& E, unsigned long long* stamps) {
    const int tid = otid(), wid = __builtin_amdgcn_readfirstlane(tid >> 6), lane = tid & 63, wr = wid >> 2, wc = wid & 3, fr = lane & 15, fq = lane >> 4;
    const int K = g.K, nt = K / BK;
    int ts_lo = 0, ts_hi = 0, nts = 0; const unsigned long long rt_entry = STAMP ? (unsigned long long)wall_clock64() : 0ull;
#define PG8_STAMP() do { if (STAMP && wid == 0 && nts < 64) { const unsigned long long _c = (unsigned long long)clock64(); \
        ts_lo = (lane == nts) ? (int)(unsigned)_c : ts_lo; ts_hi = (lane == nts) ? (int)(unsigned)(_c >> 32) : ts_hi; ++nts; } } while (0)
    PG8_STAMP();
    unsigned voffA[2], voffB[2];
#pragma unroll
    for (int i = 0; i < 2; ++i) { int R, C; stage_rc(tid * 16 + i * 8192, R, C); const int Rb = Epi::PERM ? ((R & ~31) + perm32(R & 31)) : R;
        voffA[i] = (unsigned)(R * K + C) * 2u; voffB[i] = (unsigned)(Rb * K + C) * 2u; }
    const size_t kstep = (size_t)(BK * 2);
    const size_t hstep = (size_t)HALF * K * 2;
    const size_t tstep = 2 * hstep;
    const unsigned ldsw = (unsigned)wid * 1024u;
    const int aoff = lds_byte(wr * 64 + fr, fq * 8), boff = lds_byte(wc * 32 + fr, fq * 8);
#define PG8_SA(b, h) (((b) * 2 + (h)) * HTB)
#define PG8_SB(b, h) ((4 + (b) * 2 + (h)) * HTB)
#define PG8_STAGE(bufoff, gbase, voff) do { _Pragma("unroll") for (int _i = 0; _i < 2; ++_i) \
        __builtin_amdgcn_global_load_lds((const unsigned*)((const char*)(gbase) + (voff)[_i]), (PG8_LAS unsigned*)(lds + (bufoff) + ldsw + _i * 8192), 16, 0, 0); } while (0)
#define PG8_LDA(dst, b, h) do { _Pragma("unroll") for (int m = 0; m < 4; ++m) _Pragma("unroll") for (int k = 0; k < 2; ++k) dst[m][k] = *(const PG8_LAS bf16x8*)(lds + PG8_SA(b, h) + aoff + m * 2048 + k * 1024); } while (0)
#define PG8_LDB(dst, b, h) do { _Pragma("unroll") for (int n = 0; n < 2; ++n) _Pragma("unroll") for (int k = 0; k < 2; ++k) dst[n][k] = *(const PG8_LAS bf16x8*)(lds + PG8_SB(b, h) + boff + n * 2048 + k * 1024); } while (0)
#define PG8_MMA(ai, bj, At, Bt) do { __builtin_amdgcn_s_setprio(1); _Pragma("unroll") for (int m = 0; m < 4; ++m) _Pragma("unroll") for (int n = 0; n < 2; ++n) _Pragma("unroll") for (int k = 0; k < 2; ++k) \
        acc[ai][bj][m][n] = __builtin_amdgcn_mfma_f32_16x16x32_bf16(Bt[n][k], At[m][k], acc[ai][bj][m][n], 0, 0, 0); __builtin_amdgcn_s_setprio(0); } while (0)
#define PG8_WAIT_V(n) asm volatile("s_waitcnt vmcnt(" #n ")" ::: "memory")
#define PG8_WAIT_L(n) asm volatile("s_waitcnt lgkmcnt(" #n ")" ::: "memory")
#define PG8_BAR __builtin_amdgcn_s_barrier()
#define PG8_SCHED __builtin_amdgcn_sched_barrier(0)
    Unit cur, nxt; int ui = 0;
    if (!S.next(0, cur)) return;
    f32x4 acc[2][2][4][2];
#pragma unroll
    for (int a = 0; a < 2; ++a)
#pragma unroll
        for (int b = 0; b < 2; ++b)
#pragma unroll
            for (int m = 0; m < 4; ++m)
#pragma unroll
                for (int n = 0; n < 2; ++n) acc[a][b][m][n] = (f32x4){0.f, 0.f, 0.f, 0.f};
    bf16x8 At[4][2], B0[2][2], B1[2][2];
    const char* cA = (const char*)g.A + (size_t)cur.pm * tstep; const char* cB = (const char*)g.Bt + (size_t)cur.pn * tstep;
    S.a_ready(cur);
    PG8_STAGE(PG8_SB(0, 0), cB, voffB); PG8_STAGE(PG8_SA(0, 0), cA, voffA); PG8_STAGE(PG8_SB(0, 1), cB + hstep, voffB); PG8_STAGE(PG8_SA(0, 1), cA + hstep, voffA);
    if (wr == 1) PG8_BAR;
    PG8_WAIT_V(4); PG8_BAR;
    PG8_STAGE(PG8_SB(1, 0), cB + kstep, voffB); PG8_STAGE(PG8_SA(1, 0), cA + kstep, voffA); PG8_STAGE(PG8_SB(1, 1), cB + hstep + kstep, voffB);
    PG8_WAIT_V(6); PG8_BAR;
    PG8_STAMP();
    for (;;) {
        const bool has_next = S.next(ui + 1, nxt);
        const char* nA = has_next ? (const char*)g.A + (size_t)nxt.pm * tstep : cA; const char* nB = has_next ? (const char*)g.Bt + (size_t)nxt.pn * tstep : cB;
        for (int t = 0; t < nt; t += 2) {
            const bool last = (t == nt - 2);
            const char* a1 = cA + (size_t)(t + 1) * kstep;
            const char* a2 = last ? nA : cA + (size_t)(t + 2) * kstep; const char* b2 = last ? nB : cB + (size_t)(t + 2) * kstep;
            const char* a3 = a2 + kstep; const char* b3 = b2 + kstep;
            if (last && has_next) S.a_ready(nxt);
            PG8_LDB(B0, 0, 0); PG8_SCHED; PG8_LDA(At, 0, 0); PG8_STAGE(PG8_SA(1, 1), a1 + hstep, voffA);
            PG8_WAIT_L(8); PG8_BAR; PG8_WAIT_L(0); PG8_MMA(0, 0, At, B0); PG8_BAR; PG8_SCHED;
            PG8_LDB(B1, 0, 1); PG8_STAGE(PG8_SB(0, 0), b2, voffB);
            PG8_BAR; PG8_WAIT_L(0); PG8_MMA(0, 1, At, B1); PG8_BAR;
            PG8_LDA(At, 0, 1); PG8_STAGE(PG8_SA(0, 0), a2, voffA);
            PG8_BAR; PG8_WAIT_L(0); PG8_MMA(1, 0, At, B0); PG8_BAR; PG8_SCHED;
            PG8_STAGE(PG8_SB(0, 1), b2 + hstep, voffB);
            PG8_WAIT_V(6); PG8_BAR; PG8_MMA(1, 1, At, B1); PG8_BAR;
            PG8_LDB(B0, 1, 0); PG8_SCHED; PG8_LDA(At, 1, 0); PG8_STAGE(PG8_SA(0, 1), a2 + hstep, voffA);
            PG8_WAIT_L(8); PG8_BAR; PG8_WAIT_L(0); PG8_MMA(0, 0, At, B0); PG8_BAR; PG8_SCHED;
            PG8_LDB(B1, 1, 1); PG8_STAGE(PG8_SB(1, 0), b3, voffB);
            PG8_BAR; PG8_WAIT_L(0); PG8_MMA(0, 1, At, B1); PG8_BAR;
            PG8_LDA(At, 1, 1); PG8_STAGE(PG8_SA(1, 0), a3, voffA);
            PG8_BAR; PG8_WAIT_L(0); PG8_MMA(1, 0, At, B0); PG8_BAR; PG8_SCHED;
            PG8_STAGE(PG8_SB(1, 1), b3 + hstep, voffB);
            PG8_WAIT_V(6); PG8_BAR; PG8_MMA(1, 1, At, B1); PG8_BAR;
        }
        PG8_STAMP();
        if constexpr (!Epi::AFTER_DRAIN) { E(acc, cur, wr, wc, fr, fq); S.done(cur); }
        PG8_STAMP();
        if (!has_next) break;
#pragma unroll
        for (int a = 0; a < 2; ++a)
#pragma unroll
            for (int b = 0; b < 2; ++b)
#pragma unroll
                for (int m = 0; m < 4; ++m)
#pragma unroll
                    for (int n = 0; n < 2; ++n) acc[a][b][m][n] = (f32x4){0.f, 0.f, 0.f, 0.f};
        cur = nxt; cA = nA; cB = nB; ++ui;
    }
    PG8_WAIT_V(0);
    if (wr == 0) PG8_BAR;
    PG8_BAR;
    if constexpr (Epi::AFTER_DRAIN) { E.fused(acc, cur, wr, wc, fr, fq, lds, wid, lane); S.done(cur); }
    PG8_STAMP();
    if (STAMP && wid == 0) { stamps[lane] = lane < nts ? (((unsigned long long)(unsigned)ts_hi << 32) | (unsigned)ts_lo) : 0ull;
        if (lane == 62) stamps[62] = rt_entry; if (lane == 63) stamps[63] = (unsigned long long)wall_clock64(); }
#undef PG8_STAMP
#undef PG8_SA
#undef PG8_SB
#undef PG8_STAGE
#undef PG8_LDA
#undef PG8_LDB
#undef PG8_MMA
#undef PG8_WAIT_V
#undef PG8_WAIT_L
#undef PG8_BAR
#undef PG8_SCHED
}
}

using pg8::bf16_t; using pg8::bf16x8; using pg8::f32x4; using pg8::u32x4;
typedef float f32x16 __attribute__((ext_vector_type(16)));
typedef _Float16 h16x2 __attribute__((ext_vector_type(2)));
typedef unsigned u32x2 __attribute__((ext_vector_type(2)));
#define LAS __attribute__((address_space(3)))

constexpr int NTOK = 17408, NLAT = 16384, DM = 1024, NTH = 512;
constexpr float EPSF = 1e-6f;
constexpr float HSCALE = 64.f;

constexpr size_t SZ_H = (size_t)NTOK * 1024 * 2;
constexpr size_t OFF_X = 0;
constexpr size_t OFF_WIN = OFF_X + SZ_H;
constexpr size_t OFF_WBHY = OFF_WIN + (size_t)8448 * 1024 * 2;
constexpr size_t OFF_WBGLA = OFF_WBHY + 2097152;
constexpr size_t OFF_WOUT = OFF_WBGLA + 2097152;
constexpr size_t OFF_W1 = OFF_WOUT + 2097152;
constexpr size_t OFF_W2 = OFF_W1 + 8388608;
constexpr size_t OFF_XT = OFF_W2 + 8388608;
constexpr size_t SZ_XT = (size_t)4096 * NTOK * 2;
constexpr size_t OFF_PB = OFF_XT + SZ_XT;
constexpr size_t OFF_LR = OFF_PB + SZ_XT;
constexpr size_t OFF_QF = OFF_LR + (size_t)NTOK * 32 * 4;
constexpr size_t SZ_Q = (size_t)NTOK * 512 * 2;
constexpr size_t OFF_QB = OFF_QF + SZ_Q;
constexpr size_t OFF_KEF = OFF_QB + SZ_Q;
constexpr size_t OFF_KEB = OFF_KEF + SZ_Q;
constexpr size_t OFF_ATT = OFF_KEB + SZ_Q;
constexpr size_t OFF_DEC = OFF_ATT + SZ_Q;
constexpr size_t OFF_HP = OFF_DEC + (size_t)272 * 4 * 2 * 128 * 4;
constexpr size_t OFF_CTXS = OFF_HP + (size_t)1024 * 8192 * 4;
constexpr size_t OFF_MOD = OFF_CTXS + 4194304;
constexpr size_t OFF_A2L = OFF_MOD + 491520;
constexpr size_t OFF_A2C = OFF_A2L + 4194304;
constexpr size_t OFF_HTC = OFF_A2C + 262144;
constexpr size_t OFF_HP2 = OFF_HTC + 2097152;
constexpr size_t OFF_HTC2 = OFF_HP2 + (size_t)1024 * 8192 * 4;
constexpr size_t OFF_CNT = OFF_HTC2 + 2097152;
constexpr size_t OFF_BAR = OFF_CNT + 1024;
constexpr size_t WS_TOTAL = OFF_BAR + 16384;

struct Params {
  const float *x, *c, *ctx, *c_ctx, *ada_w, *ada_b, *norm1_g, *norm2_g, *w_in, *conv_w, *conv_b, *fw1, *fb1, *fw2, *fb2, *fw3, *ffreq,
      *decay, *skip, *gate_w, *gate_b, *gla_ng, *w_bhy, *w_bgla, *w_out, *mlp_w1, *mlp_w2, *final_g;
  float* out; unsigned char* ws;
};

typedef float f32x2_t __attribute__((ext_vector_type(2)));
typedef __bf16 bf16x2_t __attribute__((ext_vector_type(2)));
DI bf16_t f2bf(float f) { const __bf16 b = (__bf16)f; return __builtin_bit_cast(bf16_t, b); }
DI float bf2f(bf16_t b) { return __uint_as_float(((unsigned)b) << 16); }
DI unsigned pk2(float lo, float hi) { f32x2_t v; v.x = lo; v.y = hi; const bf16x2_t b = __builtin_convertvector(v, bf16x2_t); return __builtin_bit_cast(unsigned, b); }
DI float bflo(unsigned w) { return __uint_as_float(w << 16); }
DI float bfhi(unsigned w) { return __uint_as_float(w & 0xffff0000u); }
DI float sigm(float x) { return __builtin_amdgcn_rcpf(1.f + __expf(-x)); }
DI float my_sin(float x) { float r = x * 0.15915494309189535f; r -= rintf(r); return __builtin_amdgcn_sinf(r); }
DI float wave_sum(float v) {
#pragma unroll
  for (int o = 32; o >= 1; o >>= 1) v += __shfl_xor(v, o);
  return v;
}
DI float* xrow(const Params& p, int row) { return row < NLAT ? p.out + (size_t)row * DM : (float*)(p.ws + OFF_CTXS) + (size_t)(row - NLAT) * DM; }
DI const float* xrow_in(const Params& p, int row) { return row < NLAT ? p.x + (size_t)row * DM : p.ctx + (size_t)(row - NLAT) * DM; }
DI const float* modp(const Params& p, int l, int s) { return (const float*)(p.ws + OFF_MOD) + ((size_t)l * 5 + s) * 6144; }

DI void phase_copy(const Params& p) {
  if (blockIdx.x == 0) { unsigned* z = (unsigned*)(p.ws + OFF_CNT); for (int i = otid(); i < (1024 + 16384) / 4; i += NTH) z[i] = 0u; }
}

DI void phase_mod(const Params& p, LAS unsigned char* lds) {
  LAS float* sv = (LAS float*)lds;
  LAS float* red = sv + 5 * 1024;
  const int tid = otid();
  bool loaded = false;
  for (int it = blockIdx.x; it < 4 * 48; it += gridDim.x) {
    if (!loaded) {
      for (int i = tid; i < 5 * 1024; i += NTH) { const int s = i >> 10, k = i & 1023; const float v = s < 4 ? p.c[s * 1024 + k] : p.c_ctx[k]; sv[i] = v * sigm(v); }
      loaded = true;
    }
    __syncthreads();
    const int l = it / 48, cb = it % 48, cg4 = tid & 31, kq = tid >> 5;
    const float* W = p.ada_w + (size_t)l * 1024 * 6144 + cb * 128 + 4 * cg4;
    f32x4 a0 = {0.f, 0.f, 0.f, 0.f}, a1 = a0, a2 = a0, a3 = a0, a4 = a0;
#pragma unroll 8
    for (int k = kq * 64; k < kq * 64 + 64; ++k) { const f32x4 w = __builtin_nontemporal_load((const f32x4*)(W + (size_t)k * 6144)); a0 += w * sv[k]; a1 += w * sv[1024 + k]; a2 += w * sv[2048 + k]; a3 += w * sv[3072 + k]; a4 += w * sv[4096 + k]; }
    LAS float* r = red + kq * 5 * 128 + 4 * cg4;
    *(LAS f32x4*)(r) = a0; *(LAS f32x4*)(r + 128) = a1; *(LAS f32x4*)(r + 256) = a2; *(LAS f32x4*)(r + 384) = a3; *(LAS f32x4*)(r + 512) = a4;
    __syncthreads();
    if (tid < 128) {
      const int col = cb * 128 + tid;
      const float bias = p.ada_b[l * 6144 + col];
      float* mo = (float*)(p.ws + OFF_MOD) + (size_t)l * 5 * 6144 + col;
#pragma unroll
      for (int s = 0; s < 5; ++s) { float t = bias;
#pragma unroll
        for (int q = 0; q < 16; ++q) t += red[q * 5 * 128 + s * 128 + tid]; mo[(size_t)s * 6144] = t; }
    }
    __syncthreads();
  }
}

DI void phase_a2(const Params& p, LAS unsigned char* lds) {
  LAS float* zf = (LAS float*)lds;
  LAS float* a1s = zf + 64 * 36;
  const int tid = otid(), tl = tid >> 6, m = tid & 63;
  const int per = (4096 + 256) / 64;
  for (int it = blockIdx.x; it < 4 * per; it += gridDim.x) {
    const int l = it / per, r = it % per;
    const bool isc = r >= 64; const int Lq = isc ? 256 : 4096; const int i0 = (isc ? (r - 64) : r) * 64;
    for (int e = tid; e < 64 * 33; e += NTH) {
      const int tt = e / 33, f = e % 33, i = i0 + tt; float v;
      if (f == 0) v = (float)i / (float)(Lq - 1);
      else { const int j = (f - 1) & 15; const float band = 1e-4f + (float)j * ((15.f - 1e-4f) / 15.f); float rev = (float)i * band / (float)Lq; rev -= floorf(rev);
             v = (f <= 16) ? __builtin_amdgcn_cosf(rev) : -__builtin_amdgcn_sinf(rev); }
      zf[tt * 36 + f] = v;
    }
    const float fr = p.ffreq[l * 64 + m], b1v = p.fb1[l * 64 + m], b2v = p.fb2[l * 64 + m];
    float w1r[33];
#pragma unroll
    for (int f = 0; f < 33; ++f) w1r[f] = p.fw1[((size_t)l * 33 + f) * 64 + m];
    __syncthreads();
#pragma unroll 1
    for (int q = 0; q < 8; ++q) { const int tt = tl * 8 + q; float acc = b1v;
#pragma unroll
      for (int f = 0; f < 33; ++f) acc += zf[tt * 36 + f] * w1r[f];
      a1s[tt * 64 + m] = my_sin(fr * acc); }
    float w2r[64];
#pragma unroll
    for (int j = 0; j < 64; ++j) w2r[j] = p.fw2[((size_t)l * 64 + j) * 64 + m];
    __syncthreads();
    float* dst = isc ? (float*)(p.ws + OFF_A2C) + ((size_t)l * 256 + i0) * 64 : (float*)(p.ws + OFF_A2L) + ((size_t)l * 4096 + i0) * 64;
#pragma unroll 1
    for (int q = 0; q < 8; ++q) { const int tt = tl * 8 + q; float acc = b2v;
#pragma unroll
      for (int j4 = 0; j4 < 16; ++j4) { const f32x4 a = *(const LAS f32x4*)(a1s + tt * 64 + 4 * j4); acc += a.x * w2r[4 * j4] + a.y * w2r[4 * j4 + 1] + a.z * w2r[4 * j4 + 2] + a.w * w2r[4 * j4 + 3]; }
      dst[(size_t)tt * 64 + m] = my_sin(fr * acc); }
    __syncthreads();
  }
}

DI void wt_load(const float* src, int ld_src, int k0, int n0, f32x4 (&v)[2]) {
  const int tid = otid();
#pragma unroll
  for (int q = 0; q < 2; ++q) { const int kk = (tid >> 3) + 64 * q, nq = tid & 7; v[q] = __builtin_nontemporal_load((const f32x4*)(src + (size_t)(k0 + kk) * ld_src + n0 + 4 * nq)); }
}
DI void wt_store(const f32x4 (&v)[2], int k0, bf16_t* dst, int ld_dst, int drow0, LAS unsigned char* lds) {
  LAS bf16_t* t = (LAS bf16_t*)lds;
  const int tid = otid();
#pragma unroll
  for (int q = 0; q < 2; ++q) {
    const int kk = (tid >> 3) + 64 * q, nq = tid & 7;
    t[(4 * nq + 0) * 136 + kk] = f2bf(v[q].x); t[(4 * nq + 1) * 136 + kk] = f2bf(v[q].y); t[(4 * nq + 2) * 136 + kk] = f2bf(v[q].z); t[(4 * nq + 3) * 136 + kk] = f2bf(v[q].w);
  }
  __syncthreads();
  { const int n = tid >> 4, kq = tid & 15;
    const u32x4 o = *(const LAS u32x4*)(t + n * 136 + 8 * kq);
    *(u32x4*)(dst + (size_t)(drow0 + n) * ld_dst + k0 + 8 * kq) = o; }
  __syncthreads();
}
DI int win_dst_row(int n) {
  if (n < 3072) return n;
  if (n < 4096) return 4096 + (n - 3072);
  if (n < 5120) return 3072 + (n - 4096);
  if (n < 6144) return 4096 + 1024 + (n - 5120);
  if (n < 6176) return 8192 + (n - 6144);
  if (n < 7200) return 4096 + 2048 + (n - 6176);
  return 4096 + 3072 + (n - 7200);
}
struct WtItem { const float* src; int ld_src, k0, n0; bf16_t* dst; int ld_dst, drow0; };
DI WtItem wt_decode(const Params& p, int l, int part, int it) {
  unsigned char* ws = p.ws; WtItem w;
  const int n_win = 8 * 257, n_sq = 8 * 32, n_w1 = 8 * 128;
  if (part == 0) {
    if (it < n_win) { const int kt = it & 7, nt = it >> 3; w.src = p.w_in + (size_t)l * 1024 * 8224; w.ld_src = 8224; w.k0 = kt * 128; w.n0 = nt * 32; w.dst = (bf16_t*)(ws + OFF_WIN); w.ld_dst = 1024; w.drow0 = win_dst_row(nt * 32); }
    else { const int r = it - n_win, which = r / n_sq, q = r % n_sq, kt = q & 7, nt = q >> 3;
      w.src = (which == 0 ? p.w_bhy : which == 1 ? p.w_bgla : p.w_out) + (size_t)l * 1024 * 1024; w.ld_src = 1024; w.k0 = kt * 128; w.n0 = nt * 32;
      w.dst = (bf16_t*)(ws + (which == 0 ? OFF_WBHY : which == 1 ? OFF_WBGLA : OFF_WOUT)); w.ld_dst = 1024; w.drow0 = nt * 32; }
  } else {
    if (it < n_w1) { const int kt = it & 7, nt = it >> 3; w.src = p.mlp_w1 + (size_t)l * 1024 * 4096; w.ld_src = 4096; w.k0 = kt * 128; w.n0 = nt * 32; w.dst = (bf16_t*)(ws + OFF_W1); w.ld_dst = 1024; w.drow0 = nt * 32; }
    else { const int r = it - n_w1, kt = r & 31, nt = r >> 5; w.src = p.mlp_w2 + (size_t)l * 4096 * 1024; w.ld_src = 1024; w.k0 = kt * 128; w.n0 = nt * 32; w.dst = (bf16_t*)(ws + OFF_W2); w.ld_dst = 4096; w.drow0 = nt * 32; }
  }
  return w;
}
DI void phase_wconv(const Params& p, int l, LAS unsigned char* lds, int part, int blk, int nblk) {
  unsigned char* ws = p.ws;
  const int total = part == 0 ? (8 * 257 + 3 * 8 * 32) : (8 * 128 + 32 * 32);
  f32x4 v[2];
  if (blk < total) { const WtItem w = wt_decode(p, l, part, blk); wt_load(w.src, w.ld_src, w.k0, w.n0, v); }
  for (int it = blk; it < total; it += nblk) {
    const WtItem w = wt_decode(p, l, part, it);
    f32x4 cur[2] = {v[0], v[1]};
    if (it + nblk < total) { const WtItem w2 = wt_decode(p, l, part, it + nblk); wt_load(w2.src, w2.ld_src, w2.k0, w2.n0, v); }
    wt_store(cur, w.k0, w.dst, w.ld_dst, w.drow0, lds);
  }
  if (part == 0) { u32x4* z = (u32x4*)(ws + OFF_WIN + (size_t)8224 * 1024 * 2); const int n = 224 * 1024 * 2 / 16;
    for (int i = blk * NTH + otid(); i < n; i += nblk * NTH) z[i] = (u32x4){0u, 0u, 0u, 0u}; }
}

DI void phase_norm(const Params& p, int l, const float* g, int sh_off, int sc_off, int nrows, bool from_input) {
  const int lane = otid() & 63, gw = blockIdx.x * 8 + (otid() >> 6), nw = gridDim.x * 8;
  bf16_t* hb = (bf16_t*)(p.ws + OFF_X);
  const int rp = (nrows + nw - 1) / nw, r0 = gw * rp, r1 = min(nrows, r0 + rp);
  f32x4 A[4], B[4]; int scur = -1;
  f32x4 pa[4], pb2[4];
#define NORM_LOAD(rw) do { const int ra_ = (rw), rb_ = ((rw) + 1 < r1) ? (rw) + 1 : (rw); const float* xa_ = from_input ? xrow_in(p, ra_) : xrow(p, ra_); const float* xb_ = from_input ? xrow_in(p, rb_) : xrow(p, rb_); \
    _Pragma("unroll") for (int i = 0; i < 4; ++i) { pa[i] = *(const f32x4*)(xa_ + 4 * lane + 256 * i); pb2[i] = *(const f32x4*)(xb_ + 4 * lane + 256 * i); } } while (0)
  if (r0 < r1) NORM_LOAD(r0);
  for (int row = r0; row < r1; row += 2) {
    const bool two = row + 1 < r1;
    const int s = row < NLAT ? (row >> 12) : 4;
    if (s != scur) { scur = s; const float* mo = modp(p, l, s);
#pragma unroll
      for (int i = 0; i < 4; ++i) { const int c = 4 * lane + 256 * i; const f32x4 gg = *(const f32x4*)(g + c), sc = *(const f32x4*)(mo + sc_off + c); A[i] = gg * (sc + 1.f); B[i] = *(const f32x4*)(mo + sh_off + c); } }
    f32x4 va[4], vb[4]; float sa = 0.f, sb = 0.f;
#pragma unroll
    for (int i = 0; i < 4; ++i) { va[i] = pa[i]; vb[i] = pb2[i]; }
    if (row + 2 < r1) NORM_LOAD(row + 2);
#pragma unroll
    for (int i = 0; i < 4; ++i) { sa += va[i].x * va[i].x + va[i].y * va[i].y + va[i].z * va[i].z + va[i].w * va[i].w; sb += vb[i].x * vb[i].x + vb[i].y * vb[i].y + vb[i].z * vb[i].z + vb[i].w * vb[i].w; }
#pragma unroll
    for (int o = 32; o >= 1; o >>= 1) { sa += __shfl_xor(sa, o); sb += __shfl_xor(sb, o); }
    const float ra = rsqrtf(sa * (1.f / 1024.f) + EPSF), rb = rsqrtf(sb * (1.f / 1024.f) + EPSF);
    const int s2 = (row + 1) < NLAT ? ((row + 1) >> 12) : 4;
#pragma unroll
    for (int i = 0; i < 4; ++i) { const int c = 4 * lane + 256 * i; const f32x4 ya = va[i] * ra * A[i] + B[i];
      *(u32x2*)(hb + (size_t)row * 1024 + c) = (u32x2){pk2(ya.x, ya.y), pk2(ya.z, ya.w)}; }
    if (two) {
      if (s2 != scur) { scur = s2; const float* mo = modp(p, l, s2);
#pragma unroll
        for (int i = 0; i < 4; ++i) { const int c = 4 * lane + 256 * i; const f32x4 gg = *(const f32x4*)(g + c), sc = *(const f32x4*)(mo + sc_off + c); A[i] = gg * (sc + 1.f); B[i] = *(const f32x4*)(mo + sh_off + c); } }
#pragma unroll
      for (int i = 0; i < 4; ++i) { const int c = 4 * lane + 256 * i; const f32x4 yb = vb[i] * rb * A[i] + B[i];
        *(u32x2*)(hb + (size_t)(row + 1) * 1024 + c) = (u32x2){pk2(yb.x, yb.y), pk2(yb.z, yb.w)}; }
    }
  }
}
#undef NORM_LOAD
DI void phase_final_norm(const Params& p) {
  const int lane = otid() & 63, gw = blockIdx.x * 8 + (otid() >> 6), nw = gridDim.x * 8;
  for (int row = gw; row < NLAT; row += nw) {
    float* xr = p.out + (size_t)row * DM;
    float4 v[4]; float ss = 0.f;
#pragma unroll
    for (int i = 0; i < 4; ++i) { v[i] = *(const float4*)(xr + 4 * lane + 256 * i); ss += v[i].x * v[i].x + v[i].y * v[i].y + v[i].z * v[i].z + v[i].w * v[i].w; }
    ss = wave_sum(ss);
    const float rstd = rsqrtf(ss * (1.f / 1024.f) + EPSF);
#pragma unroll
    for (int i = 0; i < 4; ++i) { const int c = 4 * lane + 256 * i; const float4 gg = *(const float4*)(p.final_g + c);
      *(float4*)(xr + c) = make_float4(v[i].x * rstd * gg.x, v[i].y * rstd * gg.y, v[i].z * rstd * gg.z, v[i].w * rstd * gg.w); }
  }
}

DI void phase_filt_gemm(const Params& p, int l, LAS unsigned char* lds, int blk, int nblk) {
  LAS float* w3s = (LAS float*)lds;
  LAS float* a2s = w3s + 64 * 64;
  const int tid = otid();
  const int nL = 32 * 32, nC = 32 * 2;
  for (int it = blk; it < nL + nC; it += nblk) {
    const bool isc = it >= nL; const int r = isc ? it - nL : it; const int Lq = isc ? 256 : 4096;
    const int ntt = Lq / 128, dt = r / ntt, tt0 = (r % ntt) * 128, d0 = dt * 64;
    const float* A2 = isc ? (const float*)(p.ws + OFF_A2C) + (size_t)l * 256 * 64 : (const float*)(p.ws + OFF_A2L) + (size_t)l * 4096 * 64;
    float* hT = isc ? (float*)(p.ws + ((l & 1) ? OFF_HTC2 : OFF_HTC)) : (float*)(p.ws + ((l & 1) ? OFF_HP2 : OFF_HP));
    { const int m = tid >> 3, q = tid & 7; const float* s = p.fw3 + ((size_t)l * 64 + m) * 2048 + d0;
      *(LAS f32x4*)(w3s + m * 64 + 4 * q) = *(const f32x4*)(s + 4 * q); *(LAS f32x4*)(w3s + m * 64 + 32 + 4 * q) = *(const f32x4*)(s + 32 + 4 * q); }
    { const int tt = tid >> 2, mq = tid & 3; const float* s = A2 + (size_t)(tt0 + tt) * 64 + 16 * mq;
#pragma unroll
      for (int q = 0; q < 4; ++q) { const float4 v = *(const float4*)(s + 4 * q);
        a2s[(16 * mq + 4 * q + 0) * 132 + tt] = v.x; a2s[(16 * mq + 4 * q + 1) * 132 + tt] = v.y; a2s[(16 * mq + 4 * q + 2) * 132 + tt] = v.z; a2s[(16 * mq + 4 * q + 3) * 132 + tt] = v.w; } }
    __syncthreads();
    const int cx = tid & 15, ty = tid >> 4;
    float acc[4][4];
#pragma unroll
    for (int a = 0; a < 4; ++a)
#pragma unroll
      for (int b = 0; b < 4; ++b) acc[a][b] = 0.f;
#pragma unroll 8
    for (int m = 0; m < 64; ++m) {
      const f32x4 wv = *(const LAS f32x4*)(w3s + m * 64 + 4 * cx), av = *(const LAS f32x4*)(a2s + m * 132 + 4 * ty);
      const float w[4] = {wv.x, wv.y, wv.z, wv.w}, a[4] = {av.x, av.y, av.z, av.w};
#pragma unroll
      for (int ci = 0; ci < 4; ++ci)
#pragma unroll
        for (int ti = 0; ti < 4; ++ti) acc[ci][ti] += w[ci] * a[ti];
    }
    const float inv = 1.f / (float)(Lq - 1);
#pragma unroll
    for (int ci = 0; ci < 4; ++ci) {
      const int dirch = d0 + 4 * cx + ci; const float dc = fabsf(p.decay[l * 1024 + (dirch & 1023)]);
      float o[4];
#pragma unroll
      for (int ti = 0; ti < 4; ++ti) { const float tl = (float)(tt0 + 4 * ty + ti) * inv; o[ti] = acc[ci][ti] * __expf(-tl * dc); }
      *(float4*)(hT + (size_t)dirch * Lq + tt0 + 4 * ty) = make_float4(o[0], o[1], o[2], o[3]);
    }
    __syncthreads();
  }
}
#define XB_TMO      128
#define XB_XCNT(j)  (256  + 64 * (j))
#define XB_XSUB(j)  (1280 + 64 * (j))
#define XB_XGEN(j)  (2304 + 64 * (j))
#define XB_TOP      3328
#define XB_TOPGEN   3392
#define XCD_BAR_WORDS 3456
#define XB_SPIN_CAP (1u << 18)

__device__ __forceinline__ unsigned xb_ld(unsigned* p)              { return __hip_atomic_load(p, __ATOMIC_RELAXED, __HIP_MEMORY_SCOPE_AGENT); }
__device__ __forceinline__ unsigned xb_add(unsigned* p, unsigned v) { return __hip_atomic_fetch_add(p, v, __ATOMIC_RELAXED, __HIP_MEMORY_SCOPE_AGENT); }
__device__ __forceinline__ unsigned xb_xcc_id() { return (unsigned)__builtin_amdgcn_s_getreg((3 << 11) | 20) & 0xFu; }
#define XB_SPIN(cond, bar) do { unsigned _sp = 0; while (cond) { __builtin_amdgcn_s_sleep(1); \
    if ((++_sp & 255u) == 0u) { if (xb_ld(&(bar)[XB_TMO])) break; if (_sp > XB_SPIN_CAP) { atomicAdd(&(bar)[XB_TMO], 1u); break; } } } } while (0)
struct XcdBarrier {
    unsigned* bar; unsigned x;
    volatile LAS unsigned* st;
};

__device__ __forceinline__ XcdBarrier xcd_barrier_post(unsigned* bar, volatile LAS unsigned* st) {
    XcdBarrier b; b.bar = bar; b.x = xb_xcc_id(); b.st = st;
    if (threadIdx.x == 0) (void)xb_add(&bar[XB_XCNT(b.x)], 1u);
    return b;
}
__device__ __forceinline__ void xcd_barrier_complete(unsigned* bar, unsigned x, unsigned& nloc, unsigned& nx) {
    const unsigned G = gridDim.x * gridDim.y * gridDim.z;
    unsigned sum, cnt, mine, sp = 0u;
    for (;;) {
        sum = 0u; cnt = 0u; mine = 0u;
#pragma unroll
        for (unsigned j = 0; j < 16; ++j) { const unsigned c = xb_ld(&bar[XB_XCNT(j)]); sum += c; cnt += (c > 0u) ? 1u : 0u; mine = (j == x) ? c : mine; }
        if (sum == G) break;
        __builtin_amdgcn_s_sleep(1);
        if ((++sp & 255u) == 0u) { if (xb_ld(&bar[XB_TMO])) break; if (sp > XB_SPIN_CAP) { atomicAdd(&bar[XB_TMO], 1u); break; } }
    }
    nloc = mine > 0u ? mine : 1u; nx = cnt > 0u ? cnt : 1u;
}

__device__ __forceinline__ void xcd_barrier(const XcdBarrier& b) {
    asm volatile("s_waitcnt vmcnt(0)" ::: "memory");
    __syncthreads();
    if (threadIdx.x == 0) {
        unsigned* bar = b.bar;
        __builtin_amdgcn_s_waitcnt(0);
        unsigned nloc = b.st[0], nx = b.st[1];
        if (nloc == 0u) { xcd_barrier_complete(bar, b.x, nloc, nx); b.st[0] = nloc; b.st[1] = nx; }
        const unsigned old = xb_add(&bar[XB_XSUB(b.x)], 1u);
        const unsigned gen = old / nloc;
        if (old + 1u == (gen + 1u) * nloc) {
            __builtin_amdgcn_fence(__ATOMIC_RELEASE, "agent");
            asm volatile("s_waitcnt vmcnt(0)" ::: "memory");
            const unsigned og = xb_add(&bar[XB_TOP], 1u);
            const unsigned tg = og / nx;
            if (og + 1u == (tg + 1u) * nx) xb_add(&bar[XB_TOPGEN], 1u);
            else XB_SPIN(xb_ld(&bar[XB_TOPGEN]) == tg, bar);
            __builtin_amdgcn_fence(__ATOMIC_ACQUIRE, "agent");
            xb_add(&bar[XB_XGEN(b.x)], 1u);
            asm volatile("s_waitcnt vmcnt(0)" ::: "memory");
        } else {
            XB_SPIN(xb_ld(&bar[XB_XGEN(b.x)]) == gen, bar);
            __builtin_amdgcn_fence(__ATOMIC_ACQUIRE, "agent");
            asm volatile("s_waitcnt vmcnt(0)" ::: "memory");
        }
    }
    __syncthreads();
}

typedef float cplx __attribute__((ext_vector_type(2)));
DI cplx mk2(float a, float b) { cplx r; r.x = a; r.y = b; return r; }
DI constexpr float cos32(int m) { constexpr float t[16] = {1.f, 0.98078528040323043f, 0.92387953251128674f, 0.83146961230254524f, 0.70710678118654752f, 0.55557023301960218f, 0.38268343236508977f, 0.19509032201612825f,
    0.f, -0.19509032201612825f, -0.38268343236508977f, -0.55557023301960218f, -0.70710678118654752f, -0.83146961230254524f, -0.92387953251128674f, -0.98078528040323043f}; return t[m]; }
DI constexpr float sin32(int m) { constexpr float t[16] = {0.f, 0.19509032201612825f, 0.38268343236508977f, 0.55557023301960218f, 0.70710678118654752f, 0.83146961230254524f, 0.92387953251128674f, 0.98078528040323043f,
    1.f, 0.98078528040323043f, 0.92387953251128674f, 0.83146961230254524f, 0.70710678118654752f, 0.55557023301960218f, 0.38268343236508977f, 0.19509032201612825f}; return t[m]; }
DI constexpr int brev(int k, int bits) { int r = 0; for (int i = 0; i < bits; ++i) r |= ((k >> i) & 1) << (bits - 1 - i); return r; }
DI cplx cmul_c(cplx a, cplx b) { return mk2(a.x * b.x - a.y * b.y, a.x * b.y + a.y * b.x); }
DI cplx cmulc_c(cplx a, cplx b) { return mk2(a.x * b.x + a.y * b.y, a.y * b.x - a.x * b.y); }
DI cplx cmul(cplx a, cplx b) { cplx r; asm("v_pk_mul_f32 %0, %1, %2 op_sel_hi:[1,0]\n\tv_pk_fma_f32 %0, %1, %2, %0 op_sel:[1,1,0] op_sel_hi:[0,1,1] neg_lo:[1,0,0]" : "=&v"(r) : "v"(a), "v"(b)); return r; }
DI cplx cmulc(cplx a, cplx b) { cplx r; asm("v_pk_mul_f32 %0, %1, %2 op_sel_hi:[1,0]\n\tv_pk_fma_f32 %0, %1, %2, %0 op_sel:[1,1,0] op_sel_hi:[0,1,1] neg_hi:[1,0,0]" : "=&v"(r) : "v"(a), "v"(b)); return r; }

template <int R, bool INV> DI void dft_reg(cplx (&v)[R]) {
#pragma unroll
  for (int len = R; len >= 2; len >>= 1) {
    const int half = len >> 1;
#pragma unroll
    for (int s = 0; s < R; s += len) {
#pragma unroll
      for (int j = 0; j < half; ++j) {
        const cplx a = v[s + j], b = v[s + j + half];
        v[s + j] = mk2(a.x + b.x, a.y + b.y);
        const cplx d = mk2(a.x - b.x, a.y - b.y);
        const int m = j * (32 / len);
        if (m == 0) v[s + j + half] = d;
        else if (m == 8) v[s + j + half] = INV ? mk2(-d.y, d.x) : mk2(d.y, -d.x);
        else { const float c = cos32(m), sn = sin32(m);
          v[s + j + half] = INV ? mk2(d.x * c - d.y * sn, d.x * sn + d.y * c) : mk2(d.x * c + d.y * sn, d.y * c - d.x * sn); }
      }
    }
  }
}
constexpr int FFT_REGION_F2 = 8704;

template <int NV> DI void fft_fwd3(cplx (&v)[NV][16], LAS cplx* L, int tid) {

#pragma unroll
  for (int i = 0; i < NV; ++i) dft_reg<16, false>(v[i]);

  { float rev = (float)tid * (1.f / 8192.f); asm volatile("" : "+v"(rev)); const cplx w1 = mk2(__builtin_amdgcn_cosf(rev), -__builtin_amdgcn_sinf(rev)); cplx w = mk2(1.f, 0.f);
    const int pb = tid + 2 * (tid >> 5);
#pragma unroll
    for (int k = 0; k < 16; ++k) {
#pragma unroll
      for (int i = 0; i < NV; ++i) L[i * FFT_REGION_F2 + pb + 544 * k] = cmul(v[i][brev(k, 4)], w);
      w = cmul(w, w1); } }
  __syncthreads();
  { const int sb = tid >> 5, ii = tid & 31, pb = 544 * sb + ii;
    cplx u[NV][16];
#pragma unroll
    for (int i = 0; i < NV; ++i)
#pragma unroll
      for (int j = 0; j < 16; ++j) u[i][j] = L[i * FFT_REGION_F2 + pb + 34 * j];

#pragma unroll
    for (int i = 0; i < NV; ++i) dft_reg<16, false>(u[i]);

    float rev = (float)ii * (1.f / 512.f); asm volatile("" : "+v"(rev)); const cplx w1 = mk2(__builtin_amdgcn_cosf(rev), -__builtin_amdgcn_sinf(rev)); cplx w = mk2(1.f, 0.f);
#pragma unroll
    for (int k = 0; k < 16; ++k) {
#pragma unroll
      for (int i = 0; i < NV; ++i) L[i * FFT_REGION_F2 + pb + 34 * k] = cmul(u[i][brev(k, 4)], w);
      w = cmul(w, w1); } }
  __syncthreads();
  { const int sb = tid >> 1, ii = tid & 1, pb = 34 * sb + ii;
    cplx u[NV][16];
#pragma unroll
    for (int i = 0; i < NV; ++i)
#pragma unroll
      for (int j = 0; j < 16; ++j) u[i][j] = L[i * FFT_REGION_F2 + pb + 2 * j];

#pragma unroll
    for (int i = 0; i < NV; ++i) dft_reg<16, false>(u[i]);

#pragma unroll
    for (int k = 0; k < 16; ++k)
#pragma unroll
      for (int i = 0; i < NV; ++i) { const cplx y = u[i][brev(k, 4)]; const cplx yw = cmul_c(y, mk2(cos32(k), -sin32(k))); L[i * FFT_REGION_F2 + pb + 2 * k] = ii ? yw : y; } }
  __syncthreads();
}
template <int NV> DI void fft_inv3(cplx (&v)[NV][16], LAS cplx* L, int tid) {
  { const int sb = tid >> 1, ii = tid & 1, pb = 34 * sb + ii;
    cplx u[NV][16];
#pragma unroll
    for (int i = 0; i < NV; ++i)
#pragma unroll
      for (int k = 0; k < 16; ++k) { const cplx y = L[i * FFT_REGION_F2 + pb + 2 * k]; const cplx yw = cmulc_c(y, mk2(cos32(k), -sin32(k))); u[i][k] = ii ? yw : y; }

#pragma unroll
    for (int i = 0; i < NV; ++i) dft_reg<16, true>(u[i]);

#pragma unroll
    for (int i = 0; i < NV; ++i)
#pragma unroll
      for (int j = 0; j < 16; ++j) L[i * FFT_REGION_F2 + pb + 2 * j] = u[i][brev(j, 4)]; }
  __syncthreads();
  { const int sb = tid >> 5, ii = tid & 31, pb = 544 * sb + ii;
    cplx u[NV][16];
    float rev = (float)ii * (1.f / 512.f); asm volatile("" : "+v"(rev)); const cplx w1 = mk2(__builtin_amdgcn_cosf(rev), -__builtin_amdgcn_sinf(rev)); cplx w = mk2(1.f, 0.f);
#pragma unroll
    for (int k = 0; k < 16; ++k) {
#pragma unroll
      for (int i = 0; i < NV; ++i) u[i][k] = cmulc(L[i * FFT_REGION_F2 + pb + 34 * k], w);
      w = cmul(w, w1); }

#pragma unroll
    for (int i = 0; i < NV; ++i) dft_reg<16, true>(u[i]);

#pragma unroll
    for (int i = 0; i < NV; ++i)
#pragma unroll
      for (int j = 0; j < 16; ++j) L[i * FFT_REGION_F2 + pb + 34 * j] = u[i][brev(j, 4)]; }
  __syncthreads();
  { float rev = (float)tid * (1.f / 8192.f); asm volatile("" : "+v"(rev)); const cplx w1 = mk2(__builtin_amdgcn_cosf(rev), -__builtin_amdgcn_sinf(rev)); cplx w = mk2(1.f, 0.f);
    const int pb = tid + 2 * (tid >> 5);
#pragma unroll
    for (int k = 0; k < 16; ++k) {
#pragma unroll
      for (int i = 0; i < NV; ++i) v[i][k] = cmulc(L[i * FFT_REGION_F2 + pb + 544 * k], w);
      w = cmul(w, w1); }

#pragma unroll
    for (int i = 0; i < NV; ++i) dft_reg<16, true>(v[i]);
     }
}

DI float shl1(float x, int lane) { const float t = __shfl_up(x, 1); return lane == 0 ? 0.f : t; }
DI float shr1(float x, int lane) { const float t = __shfl_down(x, 1); return lane == 63 ? 0.f : t; }
DI void hy_conv8(const bf16_t* XT, int c, int bt, int tl, int lane, const float (&cw)[3][3], const float (&cb)[3], float (&x0c)[8], float (&zz)[8]) {
  float uc[3][8];
#pragma unroll
  for (int g = 0; g < 3; ++g) {
    const u32x4 raw = *(const u32x4*)(XT + (size_t)(g * 1024 + c) * NTOK + (size_t)bt * 4096 + 8 * tl);
    float pv[10];
#pragma unroll
    for (int q = 0; q < 4; ++q) { pv[1 + 2 * q] = bflo(raw[q]); pv[2 + 2 * q] = bfhi(raw[q]); }
    { const float t0 = __shfl_up(pv[8], 1), t1 = __shfl_down(pv[1], 1); pv[0] = (lane & 7) == 0 ? 0.f : t0; pv[9] = (lane & 7) == 7 ? 0.f : t1; }
#pragma unroll
    for (int e2 = 0; e2 < 8; ++e2) uc[g][e2] = cw[g][0] * pv[e2] + cw[g][1] * pv[e2 + 1] + cw[g][2] * pv[e2 + 2] + cb[g];
  }
#pragma unroll
  for (int e2 = 0; e2 < 8; ++e2) { x0c[e2] = uc[0][e2]; zz[e2] = uc[1][e2] * uc[2][e2]; }
}
template <int NV> DI void hyena_chan(const Params& p, int l, int c, LAS cplx* L, int tid) {
  bf16_t* XT = (bf16_t*)(p.ws + OFF_XT);
  const int lane = tid & 63;
  const int pb4 = 16 * tid + 2 * (tid >> 1);
  h16x2 Hr[5]; LAS h16x2* Hl = (LAS h16x2*)(L + 2 * FFT_REGION_F2) + tid;
  {
    const float* hT = (const float*)(p.ws + ((l & 1) ? OFF_HP2 : OFF_HP));
    const float* hf = hT + (size_t)c * 4096, * hbk = hT + (size_t)(1024 + c) * 4096;
    cplx f[1][16];
#pragma unroll
    for (int j = 0; j < 8; ++j) f[0][j] = mk2(__builtin_nontemporal_load(hf + tid + 512 * j), 0.f);
#pragma unroll
    for (int j = 8; j < 16; ++j) { const int n = tid + 512 * j; f[0][j] = mk2(n == 4096 ? 0.f : __builtin_nontemporal_load(hbk + (n == 4096 ? 0 : 8192 - n)), 0.f); }
    fft_fwd3<1>(f, L, tid);
#pragma unroll
    for (int m = 0; m < 8; ++m) { const cplx a = L[pb4 + 2 * m], b = L[pb4 + 2 * m + 1];
      h16x2 h0, h1; h0.x = (_Float16)((a.x + b.x) * HSCALE); h0.y = (_Float16)((a.y + b.y) * HSCALE); h1.x = (_Float16)((a.x - b.x) * HSCALE); h1.y = (_Float16)((a.y - b.y) * HSCALE);
      if (2 * m < 11) Hl[(2 * m) * 512] = h0; else Hr[2 * m - 11 < 0 ? 0 : 2 * m - 11] = h0;
      if (2 * m + 1 < 11) Hl[(2 * m + 1) * 512] = h1; else Hr[2 * m + 1 - 11 < 0 ? 0 : 2 * m + 1 - 11] = h1; }
    __syncthreads();
  }
  float cw[3][3], cb[3];
#pragma unroll
  for (int g = 0; g < 3; ++g) { cb[g] = p.conv_b[l * 3072 + g * 1024 + c];
#pragma unroll
    for (int t = 0; t < 3; ++t) cw[g][t] = p.conv_w[((size_t)l * 3 + t) * 3072 + g * 1024 + c]; }
  const float sk = p.skip[l * 1024 + c], sc = 1.f / (8192.f * HSCALE);
#pragma unroll 1
  for (int bp0 = 0; bp0 < 2; bp0 += NV) {
    int tl = tid; asm volatile("" : "+v"(tl));
#pragma unroll
    for (int i = 0; i < NV; ++i) {
      float xa[8], za[8], xb[8], zb[8];
      hy_conv8(XT, c, 2 * (bp0 + i), tl, lane, cw, cb, xa, za);
      hy_conv8(XT, c, 2 * (bp0 + i) + 1, tl, lane, cw, cb, xb, zb);
      LAS cplx* X = L + i * FFT_REGION_F2 + 8 * tl + 2 * (tl >> 2);
#pragma unroll
      for (int e2 = 0; e2 < 8; ++e2) X[e2] = mk2(za[e2], zb[e2]);

    }
    __syncthreads();
    cplx v[NV][16];
    { const int pb = tl + 2 * (tl >> 5);
#pragma unroll
      for (int i = 0; i < NV; ++i) {
#pragma unroll
        for (int j = 0; j < 8; ++j) v[i][j] = L[i * FFT_REGION_F2 + pb + 544 * j];
#pragma unroll
        for (int j = 8; j < 16; ++j) v[i][j] = mk2(0.f, 0.f); } }
    __syncthreads();

    fft_fwd3<NV>(v, L, tid);

#pragma unroll
    for (int i = 0; i < NV; ++i) {
      LAS cplx* Li = L + i * FFT_REGION_F2;
#pragma unroll
      for (int m = 0; m < 8; ++m) { const cplx a = Li[pb4 + 2 * m], b = Li[pb4 + 2 * m + 1];
        const h16x2 h0 = (2 * m < 11) ? Hl[(2 * m) * 512] : Hr[2 * m - 11 < 0 ? 0 : 2 * m - 11], h1 = (2 * m + 1 < 11) ? Hl[(2 * m + 1) * 512] : Hr[2 * m + 1 - 11 < 0 ? 0 : 2 * m + 1 - 11];
        const cplx y0 = cmul(mk2(a.x + b.x, a.y + b.y), mk2((float)h0.x, (float)h0.y)), y1 = cmul(mk2(a.x - b.x, a.y - b.y), mk2((float)h1.x, (float)h1.y));
        Li[pb4 + 2 * m] = mk2(y0.x + y1.x, y0.y + y1.y); Li[pb4 + 2 * m + 1] = mk2(y0.x - y1.x, y0.y - y1.y); }
       }
    __syncthreads();
    fft_inv3<NV>(v, L, tid);

    { const int pb = tl + 2 * (tl >> 5);
#pragma unroll
      for (int i = 0; i < NV; ++i)
#pragma unroll
        for (int j = 0; j < 8; ++j) L[i * FFT_REGION_F2 + pb + 544 * j] = v[i][brev(j, 4)]; }
    __syncthreads();
#pragma unroll
    for (int i = 0; i < NV; ++i) {
      float xa[8], za[8], xb[8], zb[8];
      hy_conv8(XT, c, 2 * (bp0 + i), tl, lane, cw, cb, xa, za);
      hy_conv8(XT, c, 2 * (bp0 + i) + 1, tl, lane, cw, cb, xb, zb);
      const LAS cplx* X = L + i * FFT_REGION_F2 + 8 * tl + 2 * (tl >> 2);
      float ya[8], yb[8];
#pragma unroll
      for (int e2 = 0; e2 < 8; ++e2) { const cplx cv = X[e2]; ya[e2] = xa[e2] * (cv.x * sc + sk * za[e2]); yb[e2] = xb[e2] * (cv.y * sc + sk * zb[e2]); }
      *(u32x4*)(XT + (size_t)c * NTOK + (size_t)(2 * (bp0 + i)) * 4096 + 8 * tl) = (u32x4){pk2(ya[0], ya[1]), pk2(ya[2], ya[3]), pk2(ya[4], ya[5]), pk2(ya[6], ya[7])};
      *(u32x4*)(XT + (size_t)c * NTOK + (size_t)(2 * (bp0 + i) + 1) * 4096 + 8 * tl) = (u32x4){pk2(yb[0], yb[1]), pk2(yb[2], yb[3]), pk2(yb[4], yb[5]), pk2(yb[6], yb[7])};

    }
    __syncthreads();
  }
}

DI void hyena_ctx_item(const Params& p, int l, int c, LAS unsigned char* lds) {
  LAS float* zs = (LAS float*)lds;
  LAS float* hc = zs + 1024;
  LAS float* part = hc + 512;
  bf16_t* XT = (bf16_t*)(p.ws + OFF_XT);
  const float* hTc = (const float*)(p.ws + ((l & 1) ? OFF_HTC2 : OFF_HTC));
  const int tid = otid();
  { const int i = tid - 256; hc[tid] = i >= 0 ? hTc[(size_t)c * 256 + i] : (tid == 0 ? 0.f : hTc[(size_t)(1024 + c) * 256 + (-i)]); }
  float u0[2];
  { const int b = tid >> 7, tq = tid & 127;
#pragma unroll
    for (int e = 0; e < 2; ++e) {
      const int t = tq + 128 * e;
      float uu[3];
#pragma unroll
      for (int g = 0; g < 3; ++g) {
        const bf16_t* row = XT + (size_t)(g * 1024 + c) * NTOK + NLAT + b * 256;
        const float pm = t > 0 ? bf2f(row[t - 1]) : 0.f, p0 = bf2f(row[t]), pp = t < 255 ? bf2f(row[t + 1]) : 0.f;
        const size_t wb = (size_t)l * 3 * 3072 + g * 1024 + c;
        uu[g] = p.conv_w[wb] * pm + p.conv_w[wb + 3072] * p0 + p.conv_w[wb + 6144] * pp + p.conv_b[l * 3072 + g * 1024 + c];
      }
      u0[e] = uu[0]; zs[b * 256 + t] = uu[1] * uu[2];
    } }
  __syncthreads();
  const int t0 = 4 * (tid & 63), cbatch = (tid >> 6) & 3, sh = tid >> 8;
  float y[4] = {0.f, 0.f, 0.f, 0.f};
#pragma unroll 4
  for (int s0 = 128 * sh; s0 < 128 * sh + 128; s0 += 4) {
    const int base = 256 + t0 - s0 - 4;
    const f32x4 H0 = *(const LAS f32x4*)(hc + base), H1 = *(const LAS f32x4*)(hc + base + 4), z4 = *(const LAS f32x4*)(zs + cbatch * 256 + s0);
    const float hw[8] = {H0.x, H0.y, H0.z, H0.w, H1.x, H1.y, H1.z, H1.w}, zv[4] = {z4.x, z4.y, z4.z, z4.w};
#pragma unroll
    for (int j = 0; j < 4; ++j)
#pragma unroll
      for (int u = 0; u < 4; ++u) y[j] += hw[4 + j - u] * zv[u];
  }
  if (sh) *(LAS f32x4*)(part + cbatch * 256 + t0) = (f32x4){y[0], y[1], y[2], y[3]};
  __syncthreads();
  if (!sh) { const f32x4 o = *(const LAS f32x4*)(part + cbatch * 256 + t0); part[cbatch * 256 + t0] = y[0] + o.x; part[cbatch * 256 + t0 + 1] = y[1] + o.y; part[cbatch * 256 + t0 + 2] = y[2] + o.z; part[cbatch * 256 + t0 + 3] = y[3] + o.w; }
  __syncthreads();
  { const int b = tid >> 7, tq = tid & 127; const float sk = p.skip[l * 1024 + c];
#pragma unroll
    for (int e = 0; e < 2; ++e) { const int t = tq + 128 * e;
      XT[(size_t)c * NTOK + NLAT + b * 256 + t] = f2bf(u0[e] * (part[b * 256 + t] + sk * zs[b * 256 + t])); } }
  __syncthreads();
}

#ifndef HY_NV
#define HY_NV 2
#endif
#define MFMA32(a, b, c) __builtin_amdgcn_mfma_f32_32x32x16_bf16((a), (b), (c), 0, 0, 0)
DI float logsig(float x) { return fminf(x, 0.f) - __logf(1.f + __expf(-fabsf(x))); }
DI void phase_gla_prep(const Params& p, int l, LAS unsigned char* lds) {
  LAS float* lrs = (LAS float*)lds;
  LAS float* tots = lrs + 64 * 32;
  LAS bf16_t* qs = (LAS bf16_t*)(tots + 2 * 4 * 128);
  LAS bf16_t* kes = qs + 4 * 64 * 136;
  LAS bf16_t* ats = kes + 2 * 128 * 72;
  const int tid = otid(), d = tid & 127, tq = tid >> 7, wid = tid >> 6, lane = tid & 63;
  const bf16_t* PB = (const bf16_t*)(p.ws + OFF_PB);
  const float* LR = (const float*)(p.ws + OFF_LR);
  bf16_t* QF = (bf16_t*)(p.ws + OFF_QF); bf16_t* QB = (bf16_t*)(p.ws + OFF_QB);
  bf16_t* KEF = (bf16_t*)(p.ws + OFF_KEF); bf16_t* KEB = (bf16_t*)(p.ws + OFF_KEB);
  bf16_t* ATT = (bf16_t*)(p.ws + OFF_ATT); float* DEC = (float*)(p.ws + OFF_DEC);
  const float qscale = 0.08838834764831845f;
  f32x4 lrv; bf16_t qv[16], kv[16];
#define PREP_LOAD(it_) do { const int ch_ = (it_) >> 2, hh_ = (it_) & 3; const size_t t0_ = (size_t)ch_ * 64; lrv = *(const f32x4*)(LR + t0_ * 32 + 4 * tid); \
    _Pragma("unroll") for (int i = 0; i < 16; ++i) { const size_t tk_ = t0_ + tq * 16 + i; qv[i] = PB[tk_ * 4096 + hh_ * 128 + d]; kv[i] = PB[tk_ * 4096 + 512 + hh_ * 128 + d]; } } while (0)
  float gwf[16], gwb[16], gbf = 0.f, gbb = 0.f;
#define PREP_LOADG(it_) do { const int hh_ = (it_) & 3; \
    _Pragma("unroll") for (int r = 0; r < 16; ++r) { gwf[r] = p.gate_w[(((size_t)l * 2 + 0) * 16 + r) * 512 + hh_ * 128 + d]; gwb[r] = p.gate_w[(((size_t)l * 2 + 1) * 16 + r) * 512 + hh_ * 128 + d]; } \
    gbf = p.gate_b[((size_t)l * 2 + 0) * 512 + hh_ * 128 + d]; gbb = p.gate_b[((size_t)l * 2 + 1) * 512 + hh_ * 128 + d]; } while (0)
  if ((int)blockIdx.x < 272 * 4) PREP_LOAD((int)blockIdx.x);
  for (int it = blockIdx.x; it < 272 * 4; it += gridDim.x) {
    const int chunk = it >> 2, h = it & 3, tok0 = chunk * 64;
    *(LAS f32x4*)(lrs + 4 * tid) = lrv;
    PREP_LOADG(it);
    __syncthreads();
    float cf[16], cb[16];
#pragma unroll
    for (int i = 0; i < 16; ++i) {
      const int t = tq * 16 + i; float pf = gbf, pb = gbb;
#pragma unroll
      for (int r4 = 0; r4 < 4; ++r4) { const f32x4 lf = *(const LAS f32x4*)(lrs + t * 32 + 4 * r4), lb = *(const LAS f32x4*)(lrs + t * 32 + 16 + 4 * r4);
        pf += lf.x * gwf[4 * r4] + lf.y * gwf[4 * r4 + 1] + lf.z * gwf[4 * r4 + 2] + lf.w * gwf[4 * r4 + 3]; pb += lb.x * gwb[4 * r4] + lb.y * gwb[4 * r4 + 1] + lb.z * gwb[4 * r4 + 2] + lb.w * gwb[4 * r4 + 3]; }
      cf[i] = logsig(pf) * (1.f / 16.f); cb[i] = logsig(pb) * (1.f / 16.f);
    }
    { float run = 0.f;
#pragma unroll
      for (int i = 0; i < 16; ++i) { run += cf[i]; cf[i] = run; }
      tots[(0 * 4 + tq) * 128 + d] = run; run = 0.f;
#pragma unroll
      for (int i = 15; i >= 0; --i) { run += cb[i]; cb[i] = run; }
      tots[(1 * 4 + tq) * 128 + d] = run; }
    __syncthreads();
    float offf = 0.f, offb = 0.f, cendf = 0.f, cendb = 0.f;
#pragma unroll
    for (int q = 0; q < 4; ++q) { const float a = tots[(0 * 4 + q) * 128 + d], b = tots[(1 * 4 + q) * 128 + d]; cendf += a; cendb += b; if (q < tq) offf += a; if (q > tq) offb += b; }
    const int o16 = d & 15, grp = o16 >> 2, ngrp = (grp == 1) ? 2 : (grp == 2) ? 1 : grp, permd = (d & ~15) | (ngrp << 2) | (o16 & 3);
    unsigned kef[8], keb[8];
    const float ecf = __expf(cendf), ecb = __expf(cendb);
#pragma unroll
    for (int i = 0; i < 16; ++i) {
      const int t = tq * 16 + i; const size_t tok = (size_t)tok0 + t;
      const float q = bf2f(qv[i]) * qscale, k = bf2f(kv[i]);
      const float ea = __expf(cf[i] + offf), eb2 = __expf(cb[i] + offb);
      const float kia = k * __builtin_amdgcn_rcpf(ea), kib = k * __builtin_amdgcn_rcpf(eb2);
      const bf16_t qf = f2bf(q * ea), kf = f2bf(kia), qb = f2bf(q * eb2), kb = f2bf(kib);
      const bf16_t ef = f2bf(kia * ecf), eb = f2bf(kib * ecb);
      qs[(0 * 64 + t) * 136 + d] = qf; qs[(1 * 64 + t) * 136 + d] = kf; qs[(2 * 64 + t) * 136 + d] = qb; qs[(3 * 64 + t) * 136 + d] = kb;
      QF[tok * 512 + h * 128 + permd] = qf; QB[tok * 512 + h * 128 + permd] = qb;
      if (i & 1) { kef[i >> 1] |= (unsigned)ef << 16; keb[i >> 1] |= (unsigned)eb << 16; } else { kef[i >> 1] = ef; keb[i >> 1] = eb; }
    }
    if (it + (int)gridDim.x < 272 * 4) PREP_LOAD(it + (int)gridDim.x);
    { LAS u32x4* d1 = (LAS u32x4*)(kes + (0 * 128 + d) * 72 + tq * 16); d1[0] = (u32x4){kef[0], kef[1], kef[2], kef[3]}; d1[1] = (u32x4){kef[4], kef[5], kef[6], kef[7]};
      LAS u32x4* d2 = (LAS u32x4*)(kes + (1 * 128 + d) * 72 + tq * 16); d2[0] = (u32x4){keb[0], keb[1], keb[2], keb[3]}; d2[1] = (u32x4){keb[4], keb[5], keb[6], keb[7]}; }
    if (tq == 0) { DEC[(((size_t)chunk * 4 + h) * 2 + 0) * 128 + d] = ecf; DEC[(((size_t)chunk * 4 + h) * 2 + 1) * 128 + d] = ecb; }
    __syncthreads();
    {
      const int dir = wid >> 2, ti = (wid >> 1) & 1, si = wid & 1, r = lane & 31, hh = lane >> 5;
      const LAS bf16_t* ka = qs + ((dir * 2 + 1) * 64 + 32 * si + r) * 136 + 8 * hh;
      const LAS bf16_t* qa = qs + ((dir * 2 + 0) * 64 + 32 * ti + r) * 136 + 8 * hh;
      f32x16 acc;
#pragma unroll
      for (int i = 0; i < 16; ++i) acc[i] = 0.f;
#pragma unroll
      for (int ks = 0; ks < 8; ++ks) acc = MFMA32(*(const LAS bf16x8*)(ka + 16 * ks), *(const LAS bf16x8*)(qa + 16 * ks), acc);
      const int t = 32 * ti + r;
      LAS bf16_t* dst = ats + (dir * 64 + t) * 72 + 32 * si + 4 * hh;
#pragma unroll
      for (int g = 0; g < 4; ++g) {
        float vv[4];
#pragma unroll
        for (int e = 0; e < 4; ++e) { const int s = 32 * si + 8 * g + 4 * hh + e; const bool keep = dir ? (s >= t) : (s <= t); vv[e] = keep ? acc[4 * g + e] : 0.f; }
        *(LAS u32x2*)(dst + 8 * g) = (u32x2){pk2(vv[0], vv[1]), pk2(vv[2], vv[3])};
      }
    }
    __syncthreads();
    {
      const size_t chh = (size_t)chunk * 4 + h;
#pragma unroll
      for (int q = 0; q < 2; ++q) { const int pc = tid + 512 * q, row = pc >> 3, cc = pc & 7;
        *(u32x4*)(KEF + (chh * 128 + row) * 64 + 8 * cc) = *(const LAS u32x4*)(kes + (0 * 128 + row) * 72 + 8 * cc);
        *(u32x4*)(KEB + (chh * 128 + row) * 64 + 8 * cc) = *(const LAS u32x4*)(kes + (1 * 128 + row) * 72 + 8 * cc);
        const int rr = row & 63, dd = row >> 6;
        *(u32x4*)(ATT + ((chh * 2 + dd) * 64 + rr) * 64 + 8 * cc) = *(const LAS u32x4*)(ats + (dd * 64 + rr) * 72 + 8 * cc); }
    }
    __syncthreads();
  }
}

#undef PREP_LOAD
#undef PREP_LOADG
DI bf16x8 pack8(const f32x16& x, int s) {
  u32x4 r; r[0] = pk2(x[8 * s + 0], x[8 * s + 1]); r[1] = pk2(x[8 * s + 2], x[8 * s + 3]); r[2] = pk2(x[8 * s + 4], x[8 * s + 5]); r[3] = pk2(x[8 * s + 6], x[8 * s + 7]);
  return __builtin_bit_cast(bf16x8, r);
}
DI void phase_gla_scan(const Params& p, LAS unsigned char* lds) {
  constexpr int BUFB = 64 * 136 * 2 + 128 * 72 * 2 + 64 * 72 * 2 + 512;
  const int tid = otid(), wid = tid >> 6, lane = tid & 63, r = lane & 31, hh = lane >> 5;
  const int bid = blockIdx.x, b = bid >> 3, h = (bid >> 1) & 3, dir = bid & 1;
  const bf16_t* Qg = (const bf16_t*)(p.ws + (dir ? OFF_QB : OFF_QF));
  const bf16_t* Kg = (const bf16_t*)(p.ws + (dir ? OFF_KEB : OFF_KEF));
  const bf16_t* ATT = (const bf16_t*)(p.ws + OFF_ATT); const float* DEC = (const float*)(p.ws + OFF_DEC);
  const bf16_t* VT = (const bf16_t*)(p.ws + OFF_XT) + (size_t)(3072 + h * 256 + 32 * wid + r) * NTOK + 8 * hh;
  bf16_t* Og = dir ? (bf16_t*)(p.ws + OFF_X) : (bf16_t*)(p.ws + OFF_PB);
  const int ldo = dir ? 1024 : 4096;
  const int qrow0 = tid >> 4, qcc = tid & 15, krow0 = tid >> 3, kcc = tid & 7;
  constexpr int OBUF = 64 * 264 * 2;
  LAS unsigned char* obase = lds + 2 * BUFB;
  f32x16 S[4];
#pragma unroll
  for (int m = 0; m < 4; ++m)
#pragma unroll
    for (int i = 0; i < 16; ++i) S[m][i] = 0.f;
  u32x4 pq0, pq1, pk0, pk1, pa; float pdc = 0.f; bf16x8 vf[4], vn[4];
#define SCAN_CIDX(st) ((st) < 4 ? (256 + 4 * b + (dir ? 3 - (st) : (st))) : (64 * b + (dir ? 67 - (st) : (st) - 4)))
#define SCAN_LOAD(st) do { const int ci_ = SCAN_CIDX(st); const size_t tk_ = (size_t)ci_ * 64, ch_ = (size_t)ci_ * 4 + h; \
    pq0 = *(const u32x4*)(Qg + (tk_ + qrow0) * 512 + h * 128 + 8 * qcc); pq1 = *(const u32x4*)(Qg + (tk_ + qrow0 + 32) * 512 + h * 128 + 8 * qcc); \
    pk0 = *(const u32x4*)(Kg + (ch_ * 128 + krow0) * 64 + 8 * kcc); pk1 = *(const u32x4*)(Kg + (ch_ * 128 + krow0 + 64) * 64 + 8 * kcc); \
    pa = *(const u32x4*)(ATT + ((ch_ * 2 + dir) * 64 + krow0) * 64 + 8 * kcc); if (tid < 128) pdc = DEC[(ch_ * 2 + dir) * 128 + tid]; \
    _Pragma("unroll") for (int ks = 0; ks < 4; ++ks) vn[ks] = *(const bf16x8*)(VT + tk_ + 16 * ks); } while (0)
#define SCAN_STORE(bufi) do { LAS unsigned char* bb_ = lds + (bufi) * BUFB; LAS bf16_t* QT_ = (LAS bf16_t*)bb_; LAS bf16_t* KE_ = QT_ + 64 * 136; LAS bf16_t* AT_ = KE_ + 128 * 72; LAS float* DC_ = (LAS float*)(AT_ + 64 * 72); \
    *(LAS u32x4*)(QT_ + qrow0 * 136 + 8 * qcc) = pq0; *(LAS u32x4*)(QT_ + (qrow0 + 32) * 136 + 8 * qcc) = pq1; \
    *(LAS u32x4*)(KE_ + krow0 * 72 + 8 * kcc) = pk0; *(LAS u32x4*)(KE_ + (krow0 + 64) * 72 + 8 * kcc) = pk1; \
    *(LAS u32x4*)(AT_ + krow0 * 72 + 8 * kcc) = pa; if (tid < 128) DC_[tid] = pdc; } while (0)
#define SCAN_WRITEOUT(st) do { const size_t tk_ = (size_t)SCAN_CIDX(st) * 64; const LAS bf16_t* ob_ = (const LAS bf16_t*)(obase + ((st) & 1) * OBUF); \
    _Pragma("unroll 2") for (int q = 0; q < 4; ++q) { const int pc_ = tid + 512 * q, row_ = pc_ >> 5, cc_ = pc_ & 31; \
      *(u32x4*)(Og + (tk_ + row_) * ldo + h * 256 + 8 * cc_) = *(const LAS u32x4*)(ob_ + row_ * 264 + 8 * cc_); } } while (0)
  SCAN_LOAD(0); SCAN_STORE(0);
#pragma unroll
  for (int ks = 0; ks < 4; ++ks) vf[ks] = vn[ks];
  __syncthreads();
#pragma unroll 1
  for (int step = 0; step < 68; ++step) {
    const size_t tok0 = (size_t)SCAN_CIDX(step) * 64;
    if (step > 0) SCAN_WRITEOUT(step - 1);
    __builtin_amdgcn_sched_barrier(0);
    if (step + 1 < 68) SCAN_LOAD(step + 1);
    LAS unsigned char* bb = lds + (step & 1) * BUFB;
    const LAS bf16_t* QT = (const LAS bf16_t*)bb; const LAS bf16_t* KE = QT + 64 * 136; const LAS bf16_t* AT = KE + 128 * 72; const LAS float* DC = (const LAS float*)(AT + 64 * 72);
    bf16x8 sp[8];
#pragma unroll
    for (int m = 0; m < 4; ++m) { sp[2 * m] = pack8(S[m], 0); sp[2 * m + 1] = pack8(S[m], 1); }
    f32x16 o0, o1;
#pragma unroll
    for (int i = 0; i < 16; ++i) { o0[i] = 0.f; o1[i] = 0.f; }
#pragma unroll
    for (int ks = 0; ks < 4; ++ks) {
      o0 = MFMA32(vf[ks], *(const LAS bf16x8*)(AT + r * 72 + 16 * ks + 8 * hh), o0);
      o1 = MFMA32(vf[ks], *(const LAS bf16x8*)(AT + (32 + r) * 72 + 16 * ks + 8 * hh), o1);
    }
#pragma unroll
    for (int k8 = 0; k8 < 8; ++k8) {
      o0 = MFMA32(sp[k8], *(const LAS bf16x8*)(QT + r * 136 + 16 * k8 + 8 * hh), o0);
      o1 = MFMA32(sp[k8], *(const LAS bf16x8*)(QT + (32 + r) * 136 + 16 * k8 + 8 * hh), o1);
    }
#pragma unroll
    for (int m = 0; m < 4; ++m) {
#pragma unroll
      for (int g = 0; g < 4; ++g) { const f32x4 dv = *(const LAS f32x4*)(DC + 32 * m + 8 * g + 4 * hh);
        S[m][4 * g] *= dv.x; S[m][4 * g + 1] *= dv.y; S[m][4 * g + 2] *= dv.z; S[m][4 * g + 3] *= dv.w; }
#pragma unroll
      for (int ks = 0; ks < 4; ++ks) S[m] = MFMA32(*(const LAS bf16x8*)(KE + (32 * m + r) * 72 + 16 * ks + 8 * hh), vf[ks], S[m]);
    }
    { LAS bf16_t* ob = (LAS bf16_t*)(obase + (step & 1) * OBUF) + r * 264 + 32 * wid + 4 * hh;
#pragma unroll
      for (int g = 0; g < 4; ++g) {
        *(LAS u32x2*)(ob + 8 * g) = (u32x2){pk2(o0[4 * g], o0[4 * g + 1]), pk2(o0[4 * g + 2], o0[4 * g + 3])};
        *(LAS u32x2*)(ob + 32 * 264 + 8 * g) = (u32x2){pk2(o1[4 * g], o1[4 * g + 1]), pk2(o1[4 * g + 2], o1[4 * g + 3])};
      } }
    if (step + 1 < 68) { SCAN_STORE((step + 1) & 1);
#pragma unroll
      for (int ks = 0; ks < 4; ++ks) vf[ks] = vn[ks]; }
    __syncthreads();
  }
  SCAN_WRITEOUT(67);
  __syncthreads();
#undef SCAN_WRITEOUT
#undef SCAN_CIDX
#undef SCAN_LOAD
#undef SCAN_STORE
}

DI void phase_post(const Params& p, int l, int ntok, LAS unsigned char* lds) {
  const int tid = otid(), lane = tid & 63;
  { const int gw = blockIdx.x * 8 + (tid >> 6), nw = gridDim.x * 8, l32 = lane & 31, hsel = lane >> 5;
    const bf16_t* PB = (const bf16_t*)(p.ws + OFF_PB); bf16_t* HB = (bf16_t*)(p.ws + OFF_X);
    const f32x4 ng0 = *(const f32x4*)(p.gla_ng + l * 256 + 8 * l32), ng1 = *(const f32x4*)(p.gla_ng + l * 256 + 8 * l32 + 4);
    u32x4 na, nb, nr;
    if (gw < ntok * 2) { const size_t tk = gw >> 1; const int cl = ((gw & 1) * 2 + hsel) * 256 + 8 * l32; na = __builtin_nontemporal_load((const u32x4*)(PB + tk * 4096 + cl)); nb = __builtin_nontemporal_load((const u32x4*)(HB + tk * 1024 + cl)); nr = __builtin_nontemporal_load((const u32x4*)(PB + tk * 4096 + 1024 + cl)); }
    for (int it = gw; it < ntok * 2; it += nw) {
      const size_t tok = it >> 1; const int col = ((it & 1) * 2 + hsel) * 256 + 8 * l32;
      const u32x4 a = na, b = nb, rr = nr;
      if (it + nw < ntok * 2) { const int i2 = it + nw; const size_t tk = i2 >> 1; const int cl = ((i2 & 1) * 2 + hsel) * 256 + 8 * l32; na = __builtin_nontemporal_load((const u32x4*)(PB + tk * 4096 + cl)); nb = __builtin_nontemporal_load((const u32x4*)(HB + tk * 1024 + cl)); nr = __builtin_nontemporal_load((const u32x4*)(PB + tk * 4096 + 1024 + cl)); }
      float o[8], rv[8];
#pragma unroll
      for (int i = 0; i < 4; ++i) { o[2 * i] = bflo(a[i]) + bflo(b[i]); o[2 * i + 1] = bfhi(a[i]) + bfhi(b[i]); rv[2 * i] = bflo(rr[i]); rv[2 * i + 1] = bfhi(rr[i]); }
      float ss = 0.f;
#pragma unroll
      for (int i = 0; i < 8; ++i) ss += o[i] * o[i];
#pragma unroll
      for (int q = 16; q >= 1; q >>= 1) ss += __shfl_xor(ss, q);
      const float rstd = rsqrtf(ss * (1.f / 256.f) + EPSF);
      const float ngv[8] = {ng0.x, ng0.y, ng0.z, ng0.w, ng1.x, ng1.y, ng1.z, ng1.w};
      float y[8];
#pragma unroll
      for (int i = 0; i < 8; ++i) y[i] = o[i] * rstd * ngv[i] * (rv[i] * sigm(rv[i]));
      *(u32x4*)(HB + tok * 1024 + col) = (u32x4){pk2(y[0], y[1]), pk2(y[2], y[3]), pk2(y[4], y[5]), pk2(y[6], y[7])};
    } }
  { LAS bf16_t* t = (LAS bf16_t*)lds;
    const bf16_t* XT = (const bf16_t*)(p.ws + OFF_XT); bf16_t* YH = (bf16_t*)(p.ws + OFF_QF);
    const int ntt = ntok / 128;
    u32x4 pre[2];
#define POST_TLOAD(it_) do { const int c0_ = ((it_) / ntt) * 64, tk0_ = ((it_) % ntt) * 128; \
      _Pragma("unroll") for (int q = 0; q < 2; ++q) { const int pc = tid + 512 * q, cc = pc >> 4, tq = pc & 15; pre[q] = *(const u32x4*)(XT + (size_t)(c0_ + cc) * NTOK + tk0_ + 8 * tq); } } while (0)
    if ((int)blockIdx.x < 16 * ntt) POST_TLOAD((int)blockIdx.x);
    for (int it = blockIdx.x; it < 16 * ntt; it += gridDim.x) {
      const int c0 = (it / ntt) * 64, tok0 = (it % ntt) * 128;
#pragma unroll
      for (int q = 0; q < 2; ++q) { const int pc = tid + 512 * q, cc = pc >> 4, tq = pc & 15; *(LAS u32x4*)(t + cc * 136 + 8 * tq) = pre[q]; }
      if (it + (int)gridDim.x < 16 * ntt) POST_TLOAD(it + (int)gridDim.x);
      __syncthreads();
#pragma unroll
      for (int q = 0; q < 2; ++q) { const int pc = tid + 512 * q, tk = pc >> 3, cq = pc & 7; unsigned w[4];
#pragma unroll
        for (int i = 0; i < 4; ++i) w[i] = (unsigned)t[(8 * cq + 2 * i) * 136 + tk] | ((unsigned)t[(8 * cq + 2 * i + 1) * 136 + tk] << 16);
        *(u32x4*)(YH + (size_t)(tok0 + tk) * 1024 + c0 + 8 * cq) = (u32x4){w[0], w[1], w[2], w[3]}; }
      __syncthreads();
    } }
}

#undef POST_TLOAD
struct SchedG1 : pg8::StaticOrder {
  __device__ bool next(int i, pg8::Unit& u) const {
    pg8::Unit v; if (!pg8::StaticOrder::next(i, v)) return false;
    if (v.pn < 16) { u.pm = 68 + v.pn; u.pn = v.pm; } else { u.pm = v.pm; u.pn = 68 + v.pn; }
    return true;
  }
};
typedef const f32x4 (&AccRef)[2][2][4][2];
DI u32x4 pack_acc8(f32x4 v0, f32x4 v1) { return (u32x4){pk2(v0[0], v0[1]), pk2(v0[2], v0[3]), pk2(v1[0], v1[1]), pk2(v1[2], v1[3])}; }
struct EpiG1 {
  static constexpr bool PERM = true, AFTER_DRAIN = false;
  bf16_t* XT; bf16_t* PB; float* LR;
  DI void operator()(AccRef acc, const pg8::Unit& u, int wr, int wc, int fr, int fq) const {
    if (u.pm >= 68) {
      const int ch0 = (u.pm - 68) * 256 + wr * 64 + fr, tk0 = u.pn * 256 + wc * 32 + 8 * fq;
#pragma unroll
      for (int ai = 0; ai < 2; ++ai)
#pragma unroll
        for (int m = 0; m < 4; ++m) { bf16_t* rp = XT + (size_t)(ch0 + ai * 128 + m * 16) * NTOK + tk0;
#pragma unroll
          for (int bj = 0; bj < 2; ++bj) *(u32x4*)(rp + bj * 128) = pack_acc8(acc[ai][bj][m][0], acc[ai][bj][m][1]); }
    } else {
      const int wp = u.pn - 84, row0 = u.pm * 256 + wr * 64 + fr, col0 = wp * 256 + wc * 32 + 8 * fq;
      if (wp < 16) {
#pragma unroll
        for (int ai = 0; ai < 2; ++ai)
#pragma unroll
          for (int m = 0; m < 4; ++m) { bf16_t* rp = PB + (size_t)(row0 + ai * 128 + m * 16) * 4096 + col0;
#pragma unroll
            for (int bj = 0; bj < 2; ++bj) *(u32x4*)(rp + bj * 128) = pack_acc8(acc[ai][bj][m][0], acc[ai][bj][m][1]); }
      } else if (wc == 0) {
#pragma unroll
        for (int ai = 0; ai < 2; ++ai)
#pragma unroll
          for (int m = 0; m < 4; ++m) { float* rp = LR + (size_t)(row0 + ai * 128 + m * 16) * 32 + 8 * fq; *(f32x4*)rp = acc[ai][0][m][0]; *(f32x4*)(rp + 4) = acc[ai][0][m][1]; }
      }
    }
  }
};
template <int MODE> struct EpiGate {
  static constexpr bool PERM = true, AFTER_DRAIN = false;
  const bf16_t* PB; bf16_t* T1; bf16_t* MG;
  DI void operator()(AccRef acc, const pg8::Unit& u, int wr, int wc, int fr, int fq) const {
    const int row0 = u.pm * 256 + wr * 64 + fr, col0 = u.pn * 256 + wc * 32 + 8 * fq;
#pragma unroll
    for (int ai = 0; ai < 2; ++ai)
#pragma unroll
      for (int m = 0; m < 4; ++m) { const size_t row = (size_t)(row0 + ai * 128 + m * 16);
#pragma unroll
        for (int bj = 0; bj < 2; ++bj) { const int col = col0 + bj * 128;
          const u32x4 g = *(const u32x4*)(PB + row * 4096 + (MODE ? 3072 : 2048) + col);
          const f32x4 v0 = acc[ai][bj][m][0], v1 = acc[ai][bj][m][1];
          float o[8] = {v0[0] * sigm(bflo(g[0])), v0[1] * sigm(bfhi(g[0])), v0[2] * sigm(bflo(g[1])), v0[3] * sigm(bfhi(g[1])),
                        v1[0] * sigm(bflo(g[2])), v1[1] * sigm(bfhi(g[2])), v1[2] * sigm(bflo(g[3])), v1[3] * sigm(bfhi(g[3]))};
          if (MODE) { const u32x4 t = *(const u32x4*)(T1 + row * 1024 + col);
            o[0] += bflo(t[0]); o[1] += bfhi(t[0]); o[2] += bflo(t[1]); o[3] += bfhi(t[1]); o[4] += bflo(t[2]); o[5] += bfhi(t[2]); o[6] += bflo(t[3]); o[7] += bfhi(t[3]); }
          *(u32x4*)((MODE ? MG : T1) + row * 1024 + col) = (u32x4){pk2(o[0], o[1]), pk2(o[2], o[3]), pk2(o[4], o[5]), pk2(o[6], o[7])}; } }
  }
};
struct EpiRes {
  static constexpr bool PERM = false, AFTER_DRAIN = false;
  float* out; float* ctxs; const float* modl; int goff; const float* src_lat; const float* src_ctx;
  DI void operator()(AccRef acc, const pg8::Unit& u, int wr, int wc, int fr, int fq) const {
    const int row0 = u.pm * 256 + wr * 64 + fr, col0 = u.pn * 256 + wc * 32 + 4 * fq;
    const float* gv = modl + (size_t)(u.pm < 64 ? (u.pm >> 4) : 4) * 6144 + goff + col0;
    f32x4 gg[2][2];
#pragma unroll
    for (int bj = 0; bj < 2; ++bj)
#pragma unroll
      for (int n = 0; n < 2; ++n) gg[bj][n] = *(const f32x4*)(gv + bj * 128 + n * 16);
#pragma unroll
    for (int ai = 0; ai < 2; ++ai)
#pragma unroll
      for (int m = 0; m < 4; ++m) { const int row = row0 + ai * 128 + m * 16;
        float* rp = (row < NLAT ? out + (size_t)row * 1024 : ctxs + (size_t)(row - NLAT) * 1024) + col0;
        const float* sp = (row < NLAT ? src_lat + (size_t)row * 1024 : src_ctx + (size_t)(row - NLAT) * 1024) + col0;
#pragma unroll
        for (int bj = 0; bj < 2; ++bj)
#pragma unroll
          for (int n = 0; n < 2; ++n) { f32x4* q = (f32x4*)(rp + bj * 128 + n * 16); *q = *(const f32x4*)(sp + bj * 128 + n * 16) + gg[bj][n] * acc[ai][bj][m][n]; } }
  }
};
struct EpiRelu2 {
  static constexpr bool PERM = true, AFTER_DRAIN = false;
  bf16_t* O;
  DI void operator()(AccRef acc, const pg8::Unit& u, int wr, int wc, int fr, int fq) const {
    const int row0 = u.pm * 256 + wr * 64 + fr, col0 = u.pn * 256 + wc * 32 + 8 * fq;
#pragma unroll
    for (int ai = 0; ai < 2; ++ai)
#pragma unroll
      for (int m = 0; m < 4; ++m) { bf16_t* rp = O + (size_t)(row0 + ai * 128 + m * 16) * 4096 + col0;
#pragma unroll
        for (int bj = 0; bj < 2; ++bj) { f32x4 v0 = acc[ai][bj][m][0], v1 = acc[ai][bj][m][1];
#pragma unroll
          for (int e = 0; e < 4; ++e) { const float a = fmaxf(v0[e], 0.f), b = fmaxf(v1[e], 0.f); v0[e] = a * a; v1[e] = b * b; }
          *(u32x4*)(rp + bj * 128) = pack_acc8(v0, v1); } }
  }
};

#define MFMA16(a, b, c) __builtin_amdgcn_mfma_f32_16x16x32_bf16((a), (b), (c), 0, 0, 0)
template <class F> DI void ctx_gemm(const bf16_t* A, const bf16_t* Bt, int K, int N, LAS unsigned char* lds, const F& epi) {
  constexpr int LDT = 136, TILEB = 64 * LDT * 2;
  const int tid = otid(), wid = tid >> 6, lane = tid & 63, fr = lane & 15, fq = lane >> 4, wm = wid >> 1, wn = wid & 1;
  const int ntn = N / 64, ntiles = 16 * ntn, nk = K / 128;
  const int lrow = tid >> 4, lcc = tid & 15;
  for (int t0 = blockIdx.x; t0 < ntiles; t0 += gridDim.x) {
    int tile = t0;
    if (ntiles == 256 && gridDim.x == 256) { const int x = t0 & 7, idx = t0 >> 3; tile = (4 * (x >> 1) + (idx >> 3)) * 16 + 8 * (x & 1) + (idx & 7); }
    const int tm = tile / ntn, tn = tile % ntn;
    const bf16_t* Ab = A + (size_t)(tm * 64 + lrow) * K + 8 * lcc; const bf16_t* Bb = Bt + (size_t)(tn * 64 + lrow) * K + 8 * lcc;
    const size_t r32 = (size_t)32 * K;
    u32x4 ra0, ra1, rb0, rb1, sa0, sa1, sb0, sb1;
#define CG_LOAD(x0, x1, y0, y1, kt_) do { const int ko_ = (kt_) * 128; x0 = *(const u32x4*)(Ab + ko_); x1 = *(const u32x4*)(Ab + r32 + ko_); y0 = *(const u32x4*)(Bb + ko_); y1 = *(const u32x4*)(Bb + r32 + ko_); } while (0)
#define CG_STORE(x0, x1, y0, y1, bufi) do { LAS bf16_t* dA_ = (LAS bf16_t*)(lds + (bufi) * 2 * TILEB); LAS bf16_t* dB_ = (LAS bf16_t*)(lds + (bufi) * 2 * TILEB + TILEB); \
    *(LAS u32x4*)(dA_ + lrow * LDT + 8 * lcc) = x0; *(LAS u32x4*)(dA_ + (lrow + 32) * LDT + 8 * lcc) = x1; *(LAS u32x4*)(dB_ + lrow * LDT + 8 * lcc) = y0; *(LAS u32x4*)(dB_ + (lrow + 32) * LDT + 8 * lcc) = y1; } while (0)
#define CG_COMPUTE(bufi) do { const LAS bf16_t* sA_ = (const LAS bf16_t*)(lds + (bufi) * 2 * TILEB); const LAS bf16_t* sB_ = (const LAS bf16_t*)(lds + (bufi) * 2 * TILEB + TILEB); \
    _Pragma("unroll") for (int ks = 0; ks < 4; ++ks) { const bf16x8 af = *(const LAS bf16x8*)(sA_ + (16 * wm + fr) * LDT + 32 * ks + 8 * fq); \
      const bf16x8 b0 = *(const LAS bf16x8*)(sB_ + (32 * wn + fr) * LDT + 32 * ks + 8 * fq), b1 = *(const LAS bf16x8*)(sB_ + (32 * wn + 16 + fr) * LDT + 32 * ks + 8 * fq); \
      acc0 = MFMA16(b0, af, acc0); acc1 = MFMA16(b1, af, acc1); } } while (0)
    CG_LOAD(ra0, ra1, rb0, rb1, 0); CG_LOAD(sa0, sa1, sb0, sb1, 1);
    CG_STORE(ra0, ra1, rb0, rb1, 0);
    __syncthreads();
    f32x4 acc0 = {0.f, 0.f, 0.f, 0.f}, acc1 = {0.f, 0.f, 0.f, 0.f};
#pragma unroll 1
    for (int kt = 0; kt < nk; kt += 2) {
      if (kt + 2 < nk) CG_LOAD(ra0, ra1, rb0, rb1, kt + 2);
      CG_COMPUTE(0);
      CG_STORE(sa0, sa1, sb0, sb1, 1);
      __syncthreads();
      if (kt + 3 < nk) CG_LOAD(sa0, sa1, sb0, sb1, kt + 3);
      CG_COMPUTE(1);
      if (kt + 2 < nk) CG_STORE(ra0, ra1, rb0, rb1, 0);
      __syncthreads();
    }
#undef CG_LOAD
#undef CG_STORE
#undef CG_COMPUTE
    const int row = tm * 64 + 16 * wm + fr, col = tn * 64 + 32 * wn + 4 * fq;
    epi(row, col, acc0); epi(row, col + 16, acc1);
  }
}

__global__ void __launch_bounds__(512, 2) fwd_megakernel(Params p) {
  extern __shared__ __attribute__((aligned(16))) unsigned char shm[];
  LAS unsigned char* lds = (LAS unsigned char*)shm;
  cg::grid_group grid = cg::this_grid();
  unsigned char* ws = p.ws;
  const int G = gridDim.x, cblk = blockIdx.x;
  unsigned* cnt = (unsigned*)(ws + OFF_CNT);
  __shared__ unsigned xbw[4];
#define s_item (*(volatile int*)&xbw[2])
  if (threadIdx.x == 0) { xbw[0] = 0u; xbw[1] = 0u; xbw[2] = 0u; xbw[3] = 0u; }
  __syncthreads();
#ifndef TPROBE
#define TPROBE 0
#endif
  unsigned long long tacc = 0ull, tt0 = 0ull;
#define TB(g) do { if (TPROBE == (g) && blockIdx.x == 0) tt0 = __builtin_amdgcn_s_memrealtime(); } while (0)
#define TE(g) do { if (TPROBE == (g) && blockIdx.x == 0) tacc += __builtin_amdgcn_s_memrealtime() - tt0; } while (0)

  TB(5); phase_copy(p); phase_mod(p, lds); phase_a2(p, lds);
  phase_wconv(p, 0, lds, 0, cblk, G); phase_wconv(p, 0, lds, 1, cblk, G);
  grid.sync(); TE(5);
  const XcdBarrier xb = xcd_barrier_post((unsigned*)(ws + OFF_BAR), (volatile LAS unsigned*)xbw);
  for (int l = 0; l < 4; ++l) {
    const bool last = (l == 3);
    const int MR = last ? NLAT : NTOK;
    TB(3); TB(14); if (l > 0) phase_wconv(p, l, lds, 1, cblk, G);
    phase_norm(p, l, p.norm1_g + l * 1024, 0, 1024, NTOK, l == 0);
    if (l == 0) phase_filt_gemm(p, l, lds, cblk, G);
    xcd_barrier(xb); TE(14); TE(3);
    TB(1); TB(6);
    { pg8::Gemm g{(const bf16_t*)(ws + OFF_X), (const bf16_t*)(ws + OFF_X), NTOK, 8448, 1024};
      SchedG1 S; S.init(NTOK, 8448, G, cblk);
      EpiG1 E{(bf16_t*)(ws + OFF_XT), (bf16_t*)(ws + OFF_PB), (float*)(ws + OFF_LR)};
      pg8::gemm_phase<EpiG1, SchedG1, false>(lds, g, S, E, nullptr); }
    xcd_barrier(xb); TE(1); TE(6);
    TB(4); TB(11); phase_gla_prep(p, l, lds);
    if (!last && cblk >= 64) phase_filt_gemm(p, l + 1, lds, cblk - 64, G - 64);
    xcd_barrier(xb); TE(4); TE(11);
    TB(2); TB(7); if (cblk < 32) phase_gla_scan(p, lds); TE(7);
    { LAS cplx* L = (LAS cplx*)lds;
      if (otid() == 0) s_item = (int)atomicAdd(cnt + 2 * l, 1u);
      for (;;) {
        __syncthreads();
        const int it = s_item;
        __syncthreads();
        if (it >= 1024) break;
        if (otid() == 0) s_item = (int)atomicAdd(cnt + 2 * l, 1u);
        hyena_chan<HY_NV>(p, l, __builtin_amdgcn_readfirstlane(it), L, otid());
      }
      if (!last) for (;;) {
        if (otid() == 0) s_item = (int)atomicAdd(cnt + 2 * l + 1, 1u);
        __syncthreads();
        const int it = s_item;
        __syncthreads();
        if (it >= 1024) break;
        hyena_ctx_item(p, l, it, lds);
      } }
    xcd_barrier(xb);
    TE(2);
    TB(4); TB(12); phase_post(p, l, MR, lds);
    xcd_barrier(xb); TE(4); TE(12);
    TB(1); TB(8);
    { pg8::StaticOrder S; S.init(NLAT, 1024, G, cblk);
      const bf16_t* PBc = (const bf16_t*)(ws + OFF_PB); bf16_t* T1 = (bf16_t*)(ws + OFF_KEF); bf16_t* MGp = (bf16_t*)(ws + OFF_XT + (size_t)3072 * NTOK * 2);
      EpiGate<0> E0{PBc, T1, nullptr};
      pg8::Gemm g0{(const bf16_t*)(ws + OFF_QF), (const bf16_t*)(ws + OFF_WBHY), NLAT, 1024, 1024};
      pg8::gemm_phase<EpiGate<0>, pg8::StaticOrder, false>(lds, g0, S, E0, nullptr);
      EpiGate<1> E1{PBc, T1, MGp};
      pg8::Gemm g1{(const bf16_t*)(ws + OFF_X), (const bf16_t*)(ws + OFF_WBGLA), NLAT, 1024, 1024};
      pg8::gemm_phase<EpiGate<1>, pg8::StaticOrder, false>(lds, g1, S, E1, nullptr);
      if (!last) {
        ctx_gemm((const bf16_t*)(ws + OFF_QF) + (size_t)NLAT * 1024, (const bf16_t*)(ws + OFF_WBHY), 1024, 1024, lds, [&](int r, int c, f32x4 v) {
          const size_t row = (size_t)NLAT + r; const u32x2 gt = *(const u32x2*)(PBc + row * 4096 + 2048 + c);
          *(u32x2*)(T1 + row * 1024 + c) = (u32x2){pk2(v[0] * sigm(bflo(gt[0])), v[1] * sigm(bfhi(gt[0]))), pk2(v[2] * sigm(bflo(gt[1])), v[3] * sigm(bfhi(gt[1])))}; });
        ctx_gemm((const bf16_t*)(ws + OFF_X) + (size_t)NLAT * 1024, (const bf16_t*)(ws + OFF_WBGLA), 1024, 1024, lds, [&](int r, int c, f32x4 v) {
          const size_t row = (size_t)NLAT + r; const u32x2 gt = *(const u32x2*)(PBc + row * 4096 + 3072 + c); const u32x2 t1 = *(const u32x2*)(T1 + row * 1024 + c);
          *(u32x2*)(MGp + row * 1024 + c) = (u32x2){pk2(bflo(t1[0]) + v[0] * sigm(bflo(gt[0])), bfhi(t1[0]) + v[1] * sigm(bfhi(gt[0]))), pk2(bflo(t1[1]) + v[2] * sigm(bflo(gt[1])), bfhi(t1[1]) + v[3] * sigm(bfhi(gt[1])))}; });
      } }
    xcd_barrier(xb); TE(8);
    { pg8::StaticOrder S; S.init(NLAT, 1024, G, cblk);
      EpiRes E{p.out, (float*)(ws + OFF_CTXS), modp(p, l, 0), 2048, l == 0 ? p.x : p.out, l == 0 ? p.ctx : (const float*)(ws + OFF_CTXS)};
      pg8::Gemm g{(const bf16_t*)(ws + OFF_XT + (size_t)3072 * NTOK * 2), (const bf16_t*)(ws + OFF_WOUT), NLAT, 1024, 1024};
      pg8::gemm_phase<EpiRes, pg8::StaticOrder, false>(lds, g, S, E, nullptr);
      if (!last) { float* cs = (float*)(ws + OFF_CTXS); const float* gv = modp(p, l, 4) + 2048; const float* csrc = l == 0 ? p.ctx : (const float*)cs;
        ctx_gemm((const bf16_t*)(ws + OFF_XT + (size_t)3072 * NTOK * 2) + (size_t)NLAT * 1024, (const bf16_t*)(ws + OFF_WOUT), 1024, 1024, lds, [&](int r, int c, f32x4 v) {
          *(f32x4*)(cs + (size_t)r * 1024 + c) = *(const f32x4*)(csrc + (size_t)r * 1024 + c) + *(const f32x4*)(gv + c) * v; }); } }
    xcd_barrier(xb); TE(1);
    TB(4); TB(13); phase_norm(p, l, p.norm2_g + l * 1024, 3072, 4096, MR, false);
    xcd_barrier(xb); TE(4); TE(13);
    if (TPROBE == 20) { for (int q = 0; q < 8; ++q) xcd_barrier(xb); }
    TB(1); TB(9);
    { pg8::StaticOrder S; S.init(MR, 4096, G, cblk);
      EpiRelu2 E{(bf16_t*)(ws + OFF_PB)};
      pg8::Gemm g{(const bf16_t*)(ws + OFF_X), (const bf16_t*)(ws + OFF_W1), MR, 4096, 1024};
      pg8::gemm_phase<EpiRelu2, pg8::StaticOrder, false>(lds, g, S, E, nullptr);
      if (!last && cblk >= 64) phase_wconv(p, l + 1, lds, 0, cblk - 64, G - 64); }
    xcd_barrier(xb); TE(9); TB(10);
    { pg8::StaticOrder S; S.init(NLAT, 1024, G, cblk);
      EpiRes E{p.out, (float*)(ws + OFF_CTXS), modp(p, l, 0), 5120, p.out, (const float*)(ws + OFF_CTXS)};
      pg8::Gemm g{(const bf16_t*)(ws + OFF_PB), (const bf16_t*)(ws + OFF_W2), NLAT, 1024, 4096};
      pg8::gemm_phase<EpiRes, pg8::StaticOrder, false>(lds, g, S, E, nullptr);
      if (!last) { float* cs = (float*)(ws + OFF_CTXS); const float* gv = modp(p, l, 4) + 5120;
        ctx_gemm((const bf16_t*)(ws + OFF_PB) + (size_t)NLAT * 4096, (const bf16_t*)(ws + OFF_W2), 4096, 1024, lds, [&](int r, int c, f32x4 v) {
          f32x4* q = (f32x4*)(cs + (size_t)r * 1024 + c); *q = *q + *(const f32x4*)(gv + c) * v; }); } }
    xcd_barrier(xb); TE(1); TE(10);
  }
  phase_final_norm(p);
  if (TPROBE && TPROBE != 20 && blockIdx.x == 0) { const unsigned long long s0 = __builtin_amdgcn_s_memrealtime(); while (__builtin_amdgcn_s_memrealtime() - s0 < tacc) __builtin_amdgcn_s_sleep(8); }
}

#ifndef HY_NV
#define HY_NV 2
#endif
constexpr size_t DYN_LDS = 2 * FFT_REGION_F2 * 8 + 11 * 512 * 4;

extern "C" void kernel_launch(void* const* d_in, const int* in_sizes, int n_in, void* d_out, int out_size, void* d_ws, size_t ws_size, hipStream_t stream) {
  if (ws_size < WS_TOTAL || n_in < 28) return;
  static int grid_blocks = 0;
  if (!grid_blocks) {
    int dev = 0, cus = 0, per_cu = 0;
    hipGetDevice(&dev);
    hipDeviceGetAttribute(&cus, hipDeviceAttributeMultiprocessorCount, dev);
    hipFuncSetAttribute((const void*)fwd_megakernel, hipFuncAttributeMaxDynamicSharedMemorySize, (int)DYN_LDS);
    hipOccupancyMaxActiveBlocksPerMultiprocessor(&per_cu, fwd_megakernel, 512, DYN_LDS);
    if (per_cu < 1) per_cu = 1;
    grid_blocks = cus * 1;
  }
  Params p{};
  const float** pp = (const float**)&p;
  for (int i = 0; i < 28; ++i) pp[i] = (const float*)d_in[i];
  p.out = (float*)d_out; p.ws = (unsigned char*)d_ws;
  void* args[] = {&p};
  hipLaunchCooperativeKernel((const void*)fwd_megakernel, dim3(grid_blocks), dim3(512), args, DYN_LDS, stream);
}
```

```cpp
#include <hip/hip_runtime.h>
#include <hip/hip_cooperative_groups.h>
namespace cg = cooperative_groups;
#define DI __device__ __forceinline__

__device__ __forceinline__ int otid() { int t = threadIdx.x; asm volatile("" : "+v"(t)); return t; }
namespace pg8 {
#define PG8_LAS __attribute__((address_space(3)))
typedef unsigned short bf16_t;
typedef short bf16x8 __attribute__((ext_vector_type(8)));
typedef float f32x4 __attribute__((ext_vector_type(4)));
typedef unsigned u32x4 __attribute__((ext_vector_type(4)));
constexpr int BM = 256, BK = 64, HALF = 128, HTB = HALF * BK * 2  , STAGE_BYTES = 8 * HTB, NXCD = 8, WGM = 8;

__host__ __device__ __forceinline__ int lds_byte(int r, int c) { const int st = (r >> 4) * 2 + (c >> 5), rr = r & 15, cc = c & 31, ob = rr * 64 + cc * 2; return st * 1024 + (ob ^ (((ob >> 9) & 1) << 5)); }
__host__ __device__ __forceinline__ void stage_rc(int b, int& R, int& C) { const int st = b / 1024, sb = b % 1024, swz = sb ^ (((sb >> 9) & 1) << 5); R = (st >> 1) * 16 + swz / 64; C = (st & 1) * 32 + (swz % 64) / 2; }
__host__ __device__ __forceinline__ int perm32(int rho) { const int n = rho >> 4, i = rho & 15; return 8 * (i >> 2) + 4 * n + (i & 3); }

struct Unit { int pm, pn; };
struct Gemm { const bf16_t* A; const bf16_t* Bt; int M, N, K; };
struct StaticOrder {
    int nM, nN, nwg, G, c;
    __host__ __device__ void init(int M, int N, int G_, int c_) { nM = M / BM; nN = N / BM; nwg = nM * nN; G = G_; c = c_; }
    __host__ __device__ bool next(int i, Unit& u) const {
        const long L = (long)i * G + c; if (L >= nwg) return false;
        int wgid = (int)L; { const int q = nwg / NXCD, r = nwg % NXCD, xcd = wgid % NXCD, off = wgid / NXCD; wgid = (xcd < r ? xcd * (q + 1) : r * (q + 1) + (xcd - r) * q) + off; }
        const int nig = WGM * nN, gid = wgid / nig, fm = gid * WGM, gsz = (nM - fm) < WGM ? (nM - fm) : WGM;
        u.pm = fm + ((wgid % nig) % gsz); u.pn = (wgid % nig) / gsz; return true;
    }
    __device__ __forceinline__ void a_ready(const Unit&) const {}
    __device__ __forceinline__ void done(const Unit&) const {}
};
__device__ __forceinline__ unsigned cvt_pk_bf16(float lo, float hi) { unsigned r; asm volatile("v_cvt_pk_bf16_f32 %0, %1, %2" : "=v"(r) : "v"(lo), "v"(hi)); return r; }
template <class Epi, class Sched, bool STAMP = false>
__device__ __forceinline__ void gemm_phase(PG8_LAS unsigned char* lds, const Gemm g, const Sched& S, const Epi& E, unsigned long long* stamps) {
    const int tid = otid(), wid = __builtin_amdgcn_readfirstlane(tid >> 6), lane = tid & 63, wr = wid >> 2, wc = wid & 3, fr = lane & 15, fq = lane >> 4;
    const int K = g.K, nt = K / BK;
    int ts_lo = 0, ts_hi = 0, nts = 0; const unsigned long long rt_entry = STAMP ? (unsigned long long)wall_clock64() : 0ull;
#define PG8_STAMP() do { if (STAMP && wid == 0 && nts < 64) { const unsigned long long _c = (unsigned long long)clock64(); \
        ts_lo = (lane == nts) ? (int)(unsigned)_c : ts_lo; ts_hi = (lane == nts) ? (int)(unsigned)(_c >> 32) : ts_hi; ++nts; } } while (0)
    PG8_STAMP();
    unsigned voffA[2], voffB[2];
#pragma unroll
    for (int i = 0; i < 2; ++i) { int R, C; stage_rc(tid * 16 + i * 8192, R, C); const int Rb = Epi::PERM ? ((R & ~31) + perm32(R & 31)) : R;
        voffA[i] = (unsigned)(R * K + C) * 2u; voffB[i] = (unsigned)(Rb * K + C) * 2u; }
    const size_t kstep = (size_t)(BK * 2);
    const size_t hstep = (size_t)HALF * K * 2;
    const size_t tstep = 2 * hstep;
    const unsigned ldsw = (unsigned)wid * 1024u;
    const int aoff = lds_byte(wr * 64 + fr, fq * 8), boff = lds_byte(wc * 32 + fr, fq * 8);
#define PG8_SA(b, h) (((b) * 2 + (h)) * HTB)
#define PG8_SB(b, h) ((4 + (b) * 2 + (h)) * HTB)
#define PG8_STAGE(bufoff, gbase, voff) do { _Pragma("unroll") for (int _i = 0; _i < 2; ++_i) \
        __builtin_amdgcn_global_load_lds((const unsigned*)((const char*)(gbase) + (voff)[_i]), (PG8_LAS unsigned*)(lds + (bufoff) + ldsw + _i * 8192), 16, 0, 0); } while (0)
#define PG8_LDA(dst, b, h) do { _Pragma("unroll") for (int m = 0; m < 4; ++m) _Pragma("unroll") for (int k = 0; k < 2; ++k) dst[m][k] = *(const PG8_LAS bf16x8*)(lds + PG8_SA(b, h) + aoff + m * 2048 + k * 1024); } while (0)
#define PG8_LDB(dst, b, h) do { _Pragma("unroll") for (int n = 0; n < 2; ++n) _Pragma("unroll") for (int k = 0; k < 2; ++k) dst[n][k] = *(const PG8_LAS bf16x8*)(lds + PG8_SB(b, h) + boff + n * 2048 + k * 1024); } while (0)
#define PG8_MMA(ai, bj, At, Bt) do { __builtin_amdgcn_s_setprio(1); _Pragma("unroll") for (int m = 0; m < 4; ++m) _Pragma("unroll") for (int n = 0; n < 2; ++n) _Pragma("unroll") for (int k = 0; k < 2; ++k) \
        acc[ai][bj][m][n] = __builtin_amdgcn_mfma_f32_16x16x32_bf16(Bt[n][k], At[m][k], acc[ai][bj][m][n], 0, 0, 0); __builtin_amdgcn_s_setprio(0); } while (0)
#define PG8_WAIT_V(n) asm volatile("s_waitcnt vmcnt(" #n ")" ::: "memory")
#define PG8_WAIT_L(n) asm volatile("s_waitcnt lgkmcnt(" #n ")" ::: "memory")
#define PG8_BAR __builtin_amdgcn_s_barrier()
#define PG8_SCHED __builtin_amdgcn_sched_barrier(0)
    Unit cur, nxt; int ui = 0;
    if (!S.next(0, cur)) return;
    f32x4 acc[2][2][4][2];
#pragma unroll
    for (int a = 0; a < 2; ++a)
#pragma unroll
        for (int b = 0; b < 2; ++b)
#pragma unroll
            for (int m = 0; m < 4; ++m)
#pragma unroll
                for (int n = 0; n < 2; ++n) acc[a][b][m][n] = (f32x4){0.f, 0.f, 0.f, 0.f};
    bf16x8 At[4][2], B0[2][2], B1[2][2];
    const char* cA = (const char*)g.A + (size_t)cur.pm * tstep; const char* cB = (const char*)g.Bt + (size_t)cur.pn * tstep;
    S.a_ready(cur);
    PG8_STAGE(PG8_SB(0, 0), cB, voffB); PG8_STAGE(PG8_SA(0, 0), cA, voffA); PG8_STAGE(PG8_SB(0, 1), cB + hstep, voffB); PG8_STAGE(PG8_SA(0, 1), cA + hstep, voffA);
    if (wr == 1) PG8_BAR;
    PG8_WAIT_V(4); PG8_BAR;
    PG8_STAGE(PG8_SB(1, 0), cB + kstep, voffB); PG8_STAGE(PG8_SA(1, 0), cA + kstep, voffA); PG8_STAGE(PG8_SB(1, 1), cB + hstep + kstep, voffB);
    PG8_WAIT_V(6); PG8_BAR;
    PG8_STAMP();
    for (;;) {
        const bool has_next = S.next(ui + 1, nxt);
        const char* nA = has_next ? (const char*)g.A + (size_t)nxt.pm * tstep : cA; const char* nB = has_next ? (const char*)g.Bt + (size_t)nxt.pn * tstep : cB;
        for (int t = 0; t < nt; t += 2) {
            const bool last = (t == nt - 2);
            const char* a1 = cA + (size_t)(t + 1) * kstep;
            const char* a2 = last ? nA : cA + (size_t)(t + 2) * kstep; const char* b2 = last ? nB : cB + (size_t)(t + 2) * kstep;
            const char* a3 = a2 + kstep; const char* b3 = b2 + kstep;
            if (last && has_next) S.a_ready(nxt);
            PG8_LDB(B0, 0, 0); PG8_SCHED; PG8_LDA(At, 0, 0); PG8_STAGE(PG8_SA(1, 1), a1 + hstep, voffA);
            PG8_WAIT_L(8); PG8_BAR; PG8_WAIT_L(0); PG8_MMA(0, 0, At, B0); PG8_BAR; PG8_SCHED;
            PG8_LDB(B1, 0, 1); PG8_STAGE(PG8_SB(0, 0), b2, voffB);
            PG8_BAR; PG8_WAIT_L(0); PG8_MMA(0, 1, At, B1); PG8_BAR;
            PG8_LDA(At, 0, 1); PG8_STAGE(PG8_SA(0, 0), a2, voffA);
            PG8_BAR; PG8_WAIT_L(0); PG8_MMA(1, 0, At, B0); PG8_BAR; PG8_SCHED;
            PG8_STAGE(PG8_SB(0, 1), b2 + hstep, voffB);
            PG8_WAIT_V(6); PG8_BAR; PG8_MMA(1, 1, At, B1); PG8_BAR;
            PG8_LDB(B0, 1, 0); PG8_SCHED; PG8_LDA(At, 1, 0); PG8_STAGE(PG8_SA(0, 1), a2 + hstep, voffA);
            PG8_WAIT_L(8); PG8_BAR; PG8_WAIT_L(0); PG8_MMA(0, 0, At, B0); PG8_BAR; PG8_SCHED;
            PG8_LDB(B1, 1, 1); PG8_STAGE(PG8_SB(1, 0), b3, voffB);
            PG8_BAR; PG8_WAIT_L(0); PG8_MMA(0, 1, At, B1); PG8_BAR;
            PG8_LDA(At, 1, 1); PG8_STAGE(PG8_SA(1, 0), a3, voffA);
            PG8_BAR; PG8_WAIT_L(0); PG8_MMA(1, 0, At, B0); PG8_BAR; PG8_SCHED;
            PG8_STAGE(PG8_SB(1, 1), b3 + hstep, voffB);
            PG8_WAIT_V(6); PG8_BAR; PG8_MMA(1, 1, At, B1); PG8_BAR;
        }
        PG8_STAMP();
        if constexpr (!Epi::AFTER_DRAIN) { E(acc, cur, wr, wc, fr, fq); S.done(cur); }
        PG8_STAMP();
        if (!has_next) break;
#pragma unroll
        for (int a = 0; a < 2; ++a)
#pragma unroll
            for (int b = 0; b < 2; ++b)
#pragma unroll
                for (int m = 0; m < 4; ++m)
#pragma unroll
                    for (int n = 0; n < 2; ++n) acc[a][b][m][n] = (f32x4){0.f, 0.f, 0.f, 0.f};
        cur = nxt; cA = nA; cB = nB; ++ui;
    }
    PG8_WAIT_V(0);
    if (wr == 0) PG8_BAR;
    PG8_BAR;
    if constexpr (Epi::AFTER_DRAIN) { E.fused(acc, cur, wr, wc, fr, fq, lds, wid, lane); S.done(cur); }
    PG8_STAMP();
    if (STAMP && wid == 0) { stamps[lane] = lane < nts ? (((unsigned long long)(unsigned)ts_hi << 32) | (unsigned)ts_lo) : 0ull;
        if (lane == 62) stamps[62] = rt_entry; if (lane == 63) stamps[63] = (unsigned long long)wall_clock64(); }
#undef PG8_STAMP
#undef PG8_SA
#undef PG8_SB
#undef PG8_STAGE
#undef PG8_LDA
#undef PG8_LDB
#undef PG8_MMA
#undef PG8_WAIT_V
#undef PG8_WAIT_L
#undef PG8_BAR
#undef PG8_SCHED
}
}

using pg8::bf16_t; using pg8::bf16x8; using pg8::f32x4; using pg8::u32x4;
typedef float f32x16 __attribute__((ext_vector_type(16)));
typedef _Float16 h16x2 __attribute__((ext_vector_type(2)));
typedef unsigned u32x2 __attribute__((ext_vector_type(2)));
#define LAS __attribute__((address_space(3)))

constexpr int NTOK = 17408, NLAT = 16384, DM = 1024, NTH = 512;
constexpr float EPSF = 1e-6f;
constexpr float HSCALE = 64.f;

constexpr size_t SZ_H = (size_t)NTOK * 1024 * 2;
constexpr size_t OFF_X = 0;
constexpr size_t OFF_WIN = OFF_X + SZ_H;
constexpr size_t OFF_WBHY = OFF_WIN + (size_t)8448 * 1024 * 2;
constexpr size_t OFF_WBGLA = OFF_WBHY + 2097152;
constexpr size_t OFF_WOUT = OFF_WBGLA + 2097152;
constexpr size_t OFF_W1 = OFF_WOUT + 2097152;
constexpr size_t OFF_W2 = OFF_W1 + 8388608;
constexpr size_t OFF_XT = OFF_W2 + 8388608;
constexpr size_t SZ_XT = (size_t)4096 * NTOK * 2;
constexpr size_t OFF_PB = OFF_XT + SZ_XT;
constexpr size_t OFF_LR = OFF_PB + SZ_XT;
constexpr size_t OFF_QF = OFF_LR + (size_t)NTOK * 32 * 4;
constexpr size_t SZ_Q = (size_t)NTOK * 512 * 2;
constexpr size_t OFF_QB = OFF_QF + SZ_Q;
constexpr size_t OFF_KEF = OFF_QB + SZ_Q;
constexpr size_t OFF_KEB = OFF_KEF + SZ_Q;
constexpr size_t OFF_ATT = OFF_KEB + SZ_Q;
constexpr size_t OFF_DEC = OFF_ATT + SZ_Q;
constexpr size_t OFF_HP = OFF_DEC + (size_t)272 * 4 * 2 * 128 * 4;
constexpr size_t OFF_CTXS = OFF_HP + (size_t)1024 * 8192 * 4;
constexpr size_t OFF_MOD = OFF_CTXS + 4194304;
constexpr size_t OFF_A2L = OFF_MOD + 491520;
constexpr size_t OFF_A2C = OFF_A2L + 4194304;
constexpr size_t OFF_HTC = OFF_A2C + 262144;
constexpr size_t OFF_HP2 = OFF_HTC + 2097152;
constexpr size_t OFF_HTC2 = OFF_HP2 + (size_t)1024 * 8192 * 4;
constexpr size_t OFF_CNT = OFF_HTC2 + 2097152;
constexpr size_t OFF_BAR = OFF_CNT + 1024;
constexpr size_t WS_TOTAL = OFF_BAR + 16384;

struct Params {
  const float *x, *c, *ctx, *c_ctx, *ada_w, *ada_b, *norm1_g, *norm2_g, *w_in, *conv_w, *conv_b, *fw1, *fb1, *fw2, *fb2, *fw3, *ffreq,
      *decay, *skip, *gate_w, *gate_b, *gla_ng, *w_bhy, *w_bgla, *w_out, *mlp_w1, *mlp_w2, *final_g;
  float* out; unsigned char* ws;
};

typedef float f32x2_t __attribute__((ext_vector_type(2)));
typedef __bf16 bf16x2_t __attribute__((ext_vector_type(2)));
DI bf16_t f2bf(float f) { const __bf16 b = (__bf16)f; return __builtin_bit_cast(bf16_t, b); }
DI float bf2f(bf16_t b) { return __uint_as_float(((unsigned)b) << 16); }
DI unsigned pk2(float lo, float hi) { f32x2_t v; v.x = lo; v.y = hi; const bf16x2_t b = __builtin_convertvector(v, bf16x2_t); return __builtin_bit_cast(unsigned, b); }
DI float bflo(unsigned w) { return __uint_as_float(w << 16); }
DI float bfhi(unsigned w) { return __uint_as_float(w & 0xffff0000u); }
DI float sigm(float x) { return __builtin_amdgcn_rcpf(1.f + __expf(-x)); }
DI float my_sin(float x) { float r = x * 0.15915494309189535f; r -= rintf(r); return __builtin_amdgcn_sinf(r); }
DI float wave_sum(float v) {
#pragma unroll
  for (int o = 32; o >= 1; o >>= 1) v += __shfl_xor(v, o);
  return v;
}
DI float* xrow(const Params& p, int row) { return row < NLAT ? p.out + (size_t)row * DM : (float*)(p.ws + OFF_CTXS) + (size_t)(row - NLAT) * DM; }
DI const float* xrow_in(const Params& p, int row) { return row < NLAT ? p.x + (size_t)row * DM : p.ctx + (size_t)(row - NLAT) * DM; }
DI const float* modp(const Params& p, int l, int s) { return (const float*)(p.ws + OFF_MOD) + ((size_t)l * 5 + s) * 6144; }

DI void phase_copy(const Params& p) {
  if (blockIdx.x == 0) { unsigned* z = (unsigned*)(p.ws + OFF_CNT); for (int i = otid(); i < (1024 + 16384) / 4; i += NTH) z[i] = 0u; }
}

DI void phase_mod(const Params& p, LAS unsigned char* lds) {
  LAS float* sv = (LAS float*)lds;
  LAS float* red = sv + 5 * 1024;
  const int tid = otid();
  bool loaded = false;
  for (int it = blockIdx.x; it < 4 * 48; it += gridDim.x) {
    if (!loaded) {
      for (int i = tid; i < 5 * 1024; i += NTH) { const int s = i >> 10, k = i & 1023; const float v = s < 4 ? p.c[s * 1024 + k] : p.c_ctx[k]; sv[i] = v * sigm(v); }
      loaded = true;
    }
    __syncthreads();
    const int l = it / 48, cb = it % 48, cg4 = tid & 31, kq = tid >> 5;
    const float* W = p.ada_w + (size_t)l * 1024 * 6144 + cb * 128 + 4 * cg4;
    f32x4 a0 = {0.f, 0.f, 0.f, 0.f}, a1 = a0, a2 = a0, a3 = a0, a4 = a0;
#pragma unroll 8
    for (int k = kq * 64; k < kq * 64 + 64; ++k) { const f32x4 w = __builtin_nontemporal_load((const f32x4*)(W + (size_t)k * 6144)); a0 += w * sv[k]; a1 += w * sv[1024 + k]; a2 += w * sv[2048 + k]; a3 += w * sv[3072 + k]; a4 += w * sv[4096 + k]; }
    LAS float* r = red + kq * 5 * 128 + 4 * cg4;
    *(LAS f32x4*)(r) = a0; *(LAS f32x4*)(r + 128) = a1; *(LAS f32x4*)(r + 256) = a2; *(LAS f32x4*)(r + 384) = a3; *(LAS f32x4*)(r + 512) = a4;
    __syncthreads();
    if (tid < 128) {
      const int col = cb * 128 + tid;
      const float bias = p.ada_b[l * 6144 + col];
      float* mo = (float*)(p.ws + OFF_MOD) + (size_t)l * 5 * 6144 + col;
#pragma unroll
      for (int s = 0; s < 5; ++s) { float t = bias;
#pragma unroll
        for (int q = 0; q < 16; ++q) t += red[q * 5 * 128 + s * 128 + tid]; mo[(size_t)s * 6144] = t; }
    }
    __syncthreads();
  }
}

DI void phase_a2(const Params& p, LAS unsigned char* lds) {
  LAS float* zf = (LAS float*)lds;
  LAS float* a1s = zf + 64 * 36;
  const int tid = otid(), tl = tid >> 6, m = tid & 63;
  const int per = (4096 + 256) / 64;
  for (int it = blockIdx.x; it < 4 * per; it += gridDim.x) {
    const int l = it / per, r = it % per;
    const bool isc = r >= 64; const int Lq = isc ? 256 : 4096; const int i0 = (isc ? (r - 64) : r) * 64;
    for (int e = tid; e < 64 * 33; e += NTH) {
      const int tt = e / 33, f = e % 33, i = i0 + tt; float v;
      if (f == 0) v = (float)i / (float)(Lq - 1);
      else { const int j = (f - 1) & 15; const float band = 1e-4f + (float)j * ((15.f - 1e-4f) / 15.f); float rev = (float)i * band / (float)Lq; rev -= floorf(rev);
             v = (f <= 16) ? __builtin_amdgcn_cosf(rev) : -__builtin_amdgcn_sinf(rev); }
      zf[tt * 36 + f] = v;
    }
    const float fr = p.ffreq[l * 64 + m], b1v = p.fb1[l * 64 + m], b2v = p.fb2[l * 64 + m];
    float w1r[33];
#pragma unroll
    for (int f = 0; f < 33; ++f) w1r[f] = p.fw1[((size_t)l * 33 + f) * 64 + m];
    __syncthreads();
#pragma unroll 1
    for (int q = 0; q < 8; ++q) { const int tt = tl * 8 + q; float acc = b1v;
#pragma unroll
      for (int f = 0; f < 33; ++f) acc += zf[tt * 36 + f] * w1r[f];
      a1s[tt * 64 + m] = my_sin(fr * acc); }
    float w2r[64];
#pragma unroll
    for (int j = 0; j < 64; ++j) w2r[j] = p.fw2[((size_t)l * 64 + j) * 64 + m];
    __syncthreads();
    float* dst = isc ? (float*)(p.ws + OFF_A2C) + ((size_t)l * 256 + i0) * 64 : (float*)(p.ws + OFF_A2L) + ((size_t)l * 4096 + i0) * 64;
#pragma unroll 1
    for (int q = 0; q < 8; ++q) { const int tt = tl * 8 + q; float acc = b2v;
#pragma unroll
      for (int j4 = 0; j4 < 16; ++j4) { const f32x4 a = *(const LAS f32x4*)(a1s + tt * 64 + 4 * j4); acc += a.x * w2r[4 * j4] + a.y * w2r[4 * j4 + 1] + a.z * w2r[4 * j4 + 2] + a.w * w2r[4 * j4 + 3]; }
      dst[(size_t)tt * 64 + m] = my_sin(fr * acc); }
    __syncthreads();
  }
}

DI void wt_load(const float* src, int ld_src, int k0, int n0, f32x4 (&v)[2]) {
  const int tid = otid();
#pragma unroll
  for (int q = 0; q < 2; ++q) { const int kk = (tid >> 3) + 64 * q, nq = tid & 7; v[q] = __builtin_nontemporal_load((const f32x4*)(src + (size_t)(k0 + kk) * ld_src + n0 + 4 * nq)); }
}
DI void wt_store(const f32x4 (&v)[2], int k0, bf16_t* dst, int ld_dst, int drow0, LAS unsigned char* lds) {
  LAS bf16_t* t = (LAS bf16_t*)lds;
  const int tid = otid();
#pragma unroll
  for (int q = 0; q < 2; ++q) {
    const int kk = (tid >> 3) + 64 * q, nq = tid & 7;
    t[(4 * nq + 0) * 136 + kk] = f2bf(v[q].x); t[(4 * nq + 1) * 136 + kk] = f2bf(v[q].y); t[(4 * nq + 2) * 136 + kk] = f2bf(v[q].z); t[(4 * nq + 3) * 136 + kk] = f2bf(v[q].w);
  }
  __syncthreads();
  { const int n = tid >> 4, kq = tid & 15;
    const u32x4 o = *(const LAS u32x4*)(t + n * 136 + 8 * kq);
    *(u32x4*)(dst + (size_t)(drow0 + n) * ld_dst + k0 + 8 * kq) = o; }
  __syncthreads();
}
DI int win_dst_row(int n) {
  if (n < 3072) return n;
  if (n < 4096) return 4096 + (n - 3072);
  if (n < 5120) return 3072 + (n - 4096);
  if (n < 6144) return 4096 + 1024 + (n - 5120);
  if (n < 6176) return 8192 + (n - 6144);
  if (n < 7200) return 4096 + 2048 + (n - 6176);
  return 4096 + 3072 + (n - 7200);
}
struct WtItem { const float* src; int ld_src, k0, n0; bf16_t* dst; int ld_dst, drow0; };
DI WtItem wt_decode(const Params& p, int l, int part, int it) {
  unsigned char* ws = p.ws; WtItem w;
  const int n_win = 8 * 257, n_sq = 8 * 32, n_w1 = 8 * 128;
  if (part == 0) {
    if (it < n_win) { const int kt = it & 7, nt = it >> 3; w.src = p.w_in + (size_t)l * 1024 * 8224; w.ld_src = 8224; w.k0 = kt * 128; w.n0 = nt * 32; w.dst = (bf16_t*)(ws + OFF_WIN); w.ld_dst = 1024; w.drow0 = win_dst_row(nt * 32); }
    else { const int r = it - n_win, which = r / n_sq, q = r % n_sq, kt = q & 7, nt = q >> 3;
      w.src = (which == 0 ? p.w_bhy : which == 1 ? p.w_bgla : p.w_out) + (size_t)l * 1024 * 1024; w.ld_src = 1024; w.k0 = kt * 128; w.n0 = nt * 32;
      w.dst = (bf16_t*)(ws + (which == 0 ? OFF_WBHY : which == 1 ? OFF_WBGLA : OFF_WOUT)); w.ld_dst = 1024; w.drow0 = nt * 32; }
  } else {
    if (it < n_w1) { const int kt = it & 7, nt = it >> 3; w.src = p.mlp_w1 + (size_t)l * 1024 * 4096; w.ld_src = 4096; w.k0 = kt * 128; w.n0 = nt * 32; w.dst = (bf16_t*)(ws + OFF_W1); w.ld_dst = 1024; w.drow0 = nt * 32; }
    else { const int r = it - n_w1, kt = r & 31, nt = r >> 5; w.src = p.mlp_w2 + (size_t)l * 4096 * 1024; w.ld_src = 1024; w.k0 = kt * 128; w.n0 = nt * 32; w.dst = (bf16_t*)(ws + OFF_W2); w.ld_dst = 4096; w.drow0 = nt * 32; }
  }
  return w;
}
DI void phase_wconv(const Params& p, int l, LAS unsigned char* lds, int part, int blk, int nblk) {
  unsigned char* ws = p.ws;
  const int total = part == 0 ? (8 * 257 + 3 * 8 * 32) : (8 * 128 + 32 * 32);
  f32x4 v[2];
  if (blk < total) { const WtItem w = wt_decode(p, l, part, blk); wt_load(w.src, w.ld_src, w.k0, w.n0, v); }
  for (int it = blk; it < total; it += nblk) {
    const WtItem w = wt_decode(p, l, part, it);
    f32x4 cur[2] = {v[0], v[1]};
    if (it + nblk < total) { const WtItem w2 = wt_decode(p, l, part, it + nblk); wt_load(w2.src, w2.ld_src, w2.k0, w2.n0, v); }
    wt_store(cur, w.k0, w.dst, w.ld_dst, w.drow0, lds);
  }
  if (part == 0) { u32x4* z = (u32x4*)(ws + OFF_WIN + (size_t)8224 * 1024 * 2); const int n = 224 * 1024 * 2 / 16;
    for (int i = blk * NTH + otid(); i < n; i += nblk * NTH) z[i] = (u32x4){0u, 0u, 0u, 0u}; }
}

DI void phase_norm(const Params& p, int l, const float* g, int sh_off, int sc_off, int nrows, bool from_input) {
  const int lane = otid() & 63, gw = blockIdx.x * 8 + (otid() >> 6), nw = gridDim.x * 8;
  bf16_t* hb = (bf16_t*)(p.ws + OFF_X);
  const int rp = (nrows + nw - 1) / nw, r0 = gw * rp, r1 = min(nrows, r0 + rp);
  f32x4 A[4], B[4]; int scur = -1;
  f32x4 pa[4], pb2[4];
#define NORM_LOAD(rw) do { const int ra_ = (rw), rb_ = ((rw) + 1 < r1) ? (rw) + 1 : (rw); const float* xa_ = from_input ? xrow_in(p, ra_) : xrow(p, ra_); const float* xb_ = from_input ? xrow_in(p, rb_) : xrow(p, rb_); \
    _Pragma("unroll") for (int i = 0; i < 4; ++i) { pa[i] = *(const f32x4*)(xa_ + 4 * lane + 256 * i); pb2[i] = *(const f32x4*)(xb_ + 4 * lane + 256 * i); } } while (0)
  if (r0 < r1) NORM_LOAD(r0);
  for (int row = r0; row < r1; row += 2) {
    const bool two = row + 1 < r1;
    const int s = row < NLAT ? (row >> 12) : 4;
    if (s != scur) { scur = s; const float* mo = modp(p, l, s);
#pragma unroll
      for (int i = 0; i < 4; ++i) { const int c = 4 * lane + 256 * i; const f32x4 gg = *(const f32x4*)(g + c), sc = *(const f32x4*)(mo + sc_off + c); A[i] = gg * (sc + 1.f); B[i] = *(const f32x4*)(mo + sh_off + c); } }
    f32x4 va[4], vb[4]; float sa = 0.f, sb = 0.f;
#pragma unroll
    for (int i = 0; i < 4; ++i) { va[i] = pa[i]; vb[i] = pb2[i]; }
    if (row + 2 < r1) NORM_LOAD(row + 2);
#pragma unroll
    for (int i = 0; i < 4; ++i) { sa += va[i].x * va[i].x + va[i].y * va[i].y + va[i].z * va[i].z + va[i].w * va[i].w; sb += vb[i].x * vb[i].x + vb[i].y * vb[i].y + vb[i].z * vb[i].z + vb[i].w * vb[i].w; }
#pragma unroll
    for (int o = 32; o >= 1; o >>= 1) { sa += __shfl_xor(sa, o); sb += __shfl_xor(sb, o); }
    const float ra = rsqrtf(sa * (1.f / 1024.f) + EPSF), rb = rsqrtf(sb * (1.f / 1024.f) + EPSF);
    const int s2 = (row + 1) < NLAT ? ((row + 1) >> 12) : 4;
#pragma unroll
    for (int i = 0; i < 4; ++i) { const int c = 4 * lane + 256 * i; const f32x4 ya = va[i] * ra * A[i] + B[i];
      *(u32x2*)(hb + (size_t)row * 1024 + c) = (u32x2){pk2(ya.x, ya.y), pk2(ya.z, ya.w)}; }
    if (two) {
      if (s2 != scur) { scur = s2; const float* mo = modp(p, l, s2);
#pragma unroll
        for (int i = 0; i < 4; ++i) { const int c = 4 * lane + 256 * i; const f32x4 gg = *(const f32x4*)(g + c), sc = *(const f32x4*)(mo + sc_off + c); A[i] = gg * (sc + 1.f); B[i] = *(const f32x4*)(mo + sh_off + c); } }
#pragma unroll
      for (int i = 0; i < 4; ++i) { const int c = 4 * lane + 256 * i; const f32x4 yb = vb[i] * rb * A[i] + B[i];
        *(u32x2*)(hb + (size_t)(row + 1) * 1024 + c) = (u32x2){pk2(yb.x, yb.y), pk2(yb.z, yb.w)}; }
    }
  }
}
#undef NORM_LOAD
DI void phase_final_norm(const Params& p) {
  const int lane = otid() & 63, gw = blockIdx.x * 8 + (otid() >> 6), nw = gridDim.x * 8;
  for (int row = gw; row < NLAT; row += nw) {
    float* xr = p.out + (size_t)row * DM;
    float4 v[4]; float ss = 0.f;
#pragma unroll
    for (int i = 0; i < 4; ++i) { v[i] = *(const float4*)(xr + 4 * lane + 256 * i); ss += v[i].x * v[i].x + v[i].y * v[i].y + v[i].z * v[i].z + v[i].w * v[i].w; }
    ss = wave_sum(ss);
    const float rstd = rsqrtf(ss * (1.f / 1024.f) + EPSF);
#pragma unroll
    for (int i = 0; i < 4; ++i) { const int c = 4 * lane + 256 * i; const float4 gg = *(const float4*)(p.final_g + c);
      *(float4*)(xr + c) = make_float4(v[i].x * rstd * gg.x, v[i].y * rstd * gg.y, v[i].z * rstd * gg.z, v[i].w * rstd * gg.w); }
  }
}

DI void phase_filt_gemm(const Params& p, int l, LAS unsigned char* lds, int blk, int nblk) {
  LAS float* w3s = (LAS float*)lds;
  LAS float* a2s = w3s + 64 * 64;
  const int tid = otid();
  const int nL = 32 * 32, nC = 32 * 2;
  for (int it = blk; it < nL + nC; it += nblk) {
    const bool isc = it >= nL; const int r = isc ? it - nL : it; const int Lq = isc ? 256 : 4096;
    const int ntt = Lq / 128, dt = r / ntt, tt0 = (r % ntt) * 128, d0 = dt * 64;
    const float* A2 = isc ? (const float*)(p.ws + OFF_A2C) + (size_t)l * 256 * 64 : (const float*)(p.ws + OFF_A2L) + (size_t)l * 4096 * 64;
    float* hT = isc ? (float*)(p.ws + ((l & 1) ? OFF_HTC2 : OFF_HTC)) : (float*)(p.ws + ((l & 1) ? OFF_HP2 : OFF_HP));
    { const int m = tid >> 3, q = tid & 7; const float* s = p.fw3 + ((size_t)l * 64 + m) * 2048 + d0;
      *(LAS f32x4*)(w3s + m * 64 + 4 * q) = *(const f32x4*)(s + 4 * q); *(LAS f32x4*)(w3s + m * 64 + 32 + 4 * q) = *(const f32x4*)(s + 32 + 4 * q); }
    { const int tt = tid >> 2, mq = tid & 3; const float* s = A2 + (size_t)(tt0 + tt) * 64 + 16 * mq;
#pragma unroll
      for (int q = 0; q < 4; ++q) { const float4 v = *(const float4*)(s + 4 * q);
        a2s[(16 * mq + 4 * q + 0) * 132 + tt] = v.x; a2s[(16 * mq + 4 * q + 1) * 132 + tt] = v.y; a2s[(16 * mq + 4 * q + 2) * 132 + tt] = v.z; a2s[(16 * mq + 4 * q + 3) * 132 + tt] = v.w; } }
    __syncthreads();
    const int cx = tid & 15, ty = tid >> 4;
    float acc[4][4];
#pragma unroll
    for (int a = 0; a < 4; ++a)
#pragma unroll
      for (int b = 0; b < 4; ++b) acc[a][b] = 0.f;
#pragma unroll 8
    for (int m = 0; m < 64; ++m) {
      const f32x4 wv = *(const LAS f32x4*)(w3s + m * 64 + 4 * cx), av = *(const LAS f32x4*)(a2s + m * 132 + 4 * ty);
      const float w[4] = {wv.x, wv.y, wv.z, wv.w}, a[4] = {av.x, av.y, av.z, av.w};
#pragma unroll
      for (int ci = 0; ci < 4; ++ci)
#pragma unroll
        for (int ti = 0; ti < 4; ++ti) acc[ci][ti] += w[ci] * a[ti];
    }
    const float inv = 1.f / (float)(Lq - 1);
#pragma unroll
    for (int ci = 0; ci < 4; ++ci) {
      const int dirch = d0 + 4 * cx + ci; const float dc = fabsf(p.decay[l * 1024 + (dirch & 1023)]);
      float o[4];
#pragma unroll
      for (int ti = 0; ti < 4; ++ti) { const float tl = (float)(tt0 + 4 * ty + ti) * inv; o[ti] = acc[ci][ti] * __expf(-tl * dc); }
      *(float4*)(hT + (size_t)dirch * Lq + tt0 + 4 * ty) = make_float4(o[0], o[1], o[2], o[3]);
    }
    __syncthreads();
  }
}
#define XB_TMO      128
#define XB_XCNT(j)  (256  + 64 * (j))
#define XB_XSUB(j)  (1280 + 64 * (j))
#define XB_XGEN(j)  (2304 + 64 * (j))
#define XB_TOP      3328
#define XB_TOPGEN   3392
#define XCD_BAR_WORDS 3456
#define XB_SPIN_CAP (1u << 18)

__device__ __forceinline__ unsigned xb_ld(unsigned* p)              { return __hip_atomic_load(p, __ATOMIC_RELAXED, __HIP_MEMORY_SCOPE_AGENT); }
__device__ __forceinline__ unsigned xb_add(unsigned* p, unsigned v) { return __hip_atomic_fetch_add(p, v, __ATOMIC_RELAXED, __HIP_MEMORY_SCOPE_AGENT); }
__device__ __forceinline__ unsigned xb_xcc_id() { return (unsigned)__builtin_amdgcn_s_getreg((3 << 11) | 20) & 0xFu; }
#define XB_SPIN(cond, bar) do { unsigned _sp = 0; while (cond) { __builtin_amdgcn_s_sleep(1); \
    if ((++_sp & 255u) == 0u) { if (xb_ld(&(bar)[XB_TMO])) break; if (_sp > XB_SPIN_CAP) { atomicAdd(&(bar)[XB_TMO], 1u); break; } } } } while (0)
struct XcdBarrier {
    unsigned* bar; unsigned x;
    volatile LAS unsigned* st;
};

__device__ __forceinline__ XcdBarrier xcd_barrier_post(unsigned* bar, volatile LAS unsigned* st) {
    XcdBarrier b; b.bar = bar; b.x = xb_xcc_id(); b.st = st;
    if (threadIdx.x == 0) (void)xb_add(&bar[XB_XCNT(b.x)], 1u);
    return b;
}
__device__ __forceinline__ void xcd_barrier_complete(unsigned* bar, unsigned x, unsigned& nloc, unsigned& nx) {
    const unsigned G = gridDim.x * gridDim.y * gridDim.z;
    unsigned sum, cnt, mine, sp = 0u;
    for (;;) {
        sum = 0u; cnt = 0u; mine = 0u;
#pragma unroll
        for (unsigned j = 0; j < 16; ++j) { const unsigned c = xb_ld(&bar[XB_XCNT(j)]); sum += c; cnt += (c > 0u) ? 1u : 0u; mine = (j == x) ? c : mine; }
        if (sum == G) break;
        __builtin_amdgcn_s_sleep(1);
        if ((++sp & 255u) == 0u) { if (xb_ld(&bar[XB_TMO])) break; if (sp > XB_SPIN_CAP) { atomicAdd(&bar[XB_TMO], 1u); break; } }
    }
    nloc = mine > 0u ? mine : 1u; nx = cnt > 0u ? cnt : 1u;
}

__device__ __forceinline__ void xcd_barrier(const XcdBarrier& b) {
    asm volatile("s_waitcnt vmcnt(0)" ::: "memory");
    __syncthreads();
    if (threadIdx.x == 0) {
        unsigned* bar = b.bar;
        __builtin_amdgcn_s_waitcnt(0);
        unsigned nloc = b.st[0], nx = b.st[1];
        if (nloc == 0u) { xcd_barrier_complete(bar, b.x, nloc, nx); b.st[0] = nloc; b.st[1] = nx; }
        const unsigned old = xb_add(&bar[XB_XSUB(b.x)], 1u);
        const unsigned gen = old / nloc;
        if (old + 1u == (gen + 1u) * nloc) {
            __builtin_amdgcn_fence(__ATOMIC_RELEASE, "agent");
            asm volatile("s_waitcnt vmcnt(0)" ::: "memory");
            const unsigned og = xb_add(&bar[XB_TOP], 1u);
            const unsigned tg = og / nx;
            if (og + 1u == (tg + 1u) * nx) xb_add(&bar[XB_TOPGEN], 1u);
            else XB_SPIN(xb_ld(&bar[XB_TOPGEN]) == tg, bar);
            __builtin_amdgcn_fence(__ATOMIC_ACQUIRE, "agent");
            xb_add(&bar[XB_XGEN(b.x)], 1u);
            asm volatile("s_waitcnt vmcnt(0)" ::: "memory");
        } else {
            XB_SPIN(xb_ld(&bar[XB_XGEN(b.x)]) == gen, bar);
            __builtin_amdgcn_fence(__ATOMIC_ACQUIRE, "agent");
            asm volatile("s_waitcnt vmcnt(0)" ::: "memory");
        }
    }
    __syncthreads();
}

typedef float cplx __attribute__((ext_vector_type(2)));
DI cplx mk2(float a, float b) { cplx r; r.x = a; r.y = b; return r; }
DI constexpr float cos32(int m) { constexpr float t[16] = {1.f, 0.98078528040323043f, 0.92387953251128674f, 0.83146961230254524f, 0.70710678118654752f, 0.55557023301960218f, 0.38268343236508977f, 0.19509032201612825f,
    0.f, -0.19509032201612825f, -0.38268343236508977f, -0.55557023301960218f, -0.70710678118654752f, -0.83146961230254524f, -0.92387953251128674f, -0.98078528040323043f}; return t[m]; }
DI constexpr float sin32(int m) { constexpr float t[16] = {0.f, 0.19509032201612825f, 0.38268343236508977f, 0.55557023301960218f, 0.70710678118654752f, 0.83146961230254524f, 0.92387953251128674f, 0.98078528040323043f,
    1.f, 0.98078528040323043f, 0.92387953251128674f, 0.83146961230254524f, 0.70710678118654752f, 0.55557023301960218f, 0.38268343236508977f, 0.19509032201612825f}; return t[m]; }
DI constexpr int brev(int k, int bits) { int r = 0; for (int i = 0; i < bits; ++i) r |= ((k >> i) & 1) << (bits - 1 - i); return r; }
DI cplx cmul_c(cplx a, cplx b) { return mk2(a.x * b.x - a.y * b.y, a.x * b.y + a.y * b.x); }
DI cplx cmulc_c(cplx a, cplx b) { return mk2(a.x * b.x + a.y * b.y, a.y * b.x - a.x * b.y); }
DI cplx cmul(cplx a, cplx b) { cplx r; asm("v_pk_mul_f32 %0, %1, %2 op_sel_hi:[1,0]\n\tv_pk_fma_f32 %0, %1, %2, %0 op_sel:[1,1,0] op_sel_hi:[0,1,1] neg_lo:[1,0,0]" : "=&v"(r) : "v"(a), "v"(b)); return r; }
DI cplx cmulc(cplx a, cplx b) { cplx r; asm("v_pk_mul_f32 %0, %1, %2 op_sel_hi:[1,0]\n\tv_pk_fma_f32 %0, %1, %2, %0 op_sel:[1,1,0] op_sel_hi:[0,1,1] neg_hi:[1,0,0]" : "=&v"(r) : "v"(a), "v"(b)); return r; }
DI cplx cmul_s(cplx a, cplx b) { cplx r; asm("v_pk_mul_f32 %0, %1, %2 op_sel_hi:[1,0]\n\tv_pk_fma_f32 %0, %1, %2, %0 op_sel:[1,1,0] op_sel_hi:[0,1,1] neg_lo:[1,0,0]" : "=&v"(r) : "v"(a), "s"(b)); return r; }
DI cplx cmulc_s(cplx a, cplx b) { cplx r; asm("v_pk_mul_f32 %0, %1, %2 op_sel_hi:[1,0]\n\tv_pk_fma_f32 %0, %1, %2, %0 op_sel:[1,1,0] op_sel_hi:[0,1,1] neg_hi:[1,0,0]" : "=&v"(r) : "v"(a), "s"(b)); return r; }
DI cplx mul_mi(cplx a) { cplx r; asm("v_pk_mul_f32 %0, %1, 1.0 op_sel:[1,0] op_sel_hi:[0,0] neg_hi:[1,0]" : "=v"(r) : "v"(a)); return r; }
DI cplx mul_pi(cplx a) { cplx r; asm("v_pk_mul_f32 %0, %1, 1.0 op_sel:[1,0] op_sel_hi:[0,0] neg_lo:[1,0]" : "=v"(r) : "v"(a)); return r; }

template <int R, bool INV> DI void dft_reg(cplx (&v)[R]) {
#pragma unroll
  for (int len = R; len >= 2; len >>= 1) {
    const int half = len >> 1;
#pragma unroll
    for (int s = 0; s < R; s += len) {
#pragma unroll
      for (int j = 0; j < half; ++j) {
        const cplx a = v[s + j], b = v[s + j + half];
        v[s + j] = mk2(a.x + b.x, a.y + b.y);
        const cplx d = mk2(a.x - b.x, a.y - b.y);
        const int m = j * (32 / len);
        if (m == 0) v[s + j + half] = d;
        else if (m == 8) v[s + j + half] = INV ? mul_pi(d) : mul_mi(d);
        else { const cplx K = mk2(cos32(m), sin32(m));
          v[s + j + half] = INV ? cmul_s(d, K) : cmulc_s(d, K); }
      }
    }
  }
}
constexpr int FFT_REGION_F2 = 8704;

template <int NV> DI void fft_fwd3(cplx (&v)[NV][16], LAS cplx* L, int tid) {

#pragma unroll
  for (int i = 0; i < NV; ++i) dft_reg<16, false>(v[i]);

  { float rev = (float)tid * (1.f / 8192.f); asm volatile("" : "+v"(rev)); const cplx w1 = mk2(__builtin_amdgcn_cosf(rev), -__builtin_amdgcn_sinf(rev)); cplx w = mk2(1.f, 0.f);
    const int pb = tid + 2 * (tid >> 5);
#pragma unroll
    for (int k = 0; k < 16; ++k) {
#pragma unroll
      for (int i = 0; i < NV; ++i) L[i * FFT_REGION_F2 + pb + 544 * k] = cmul(v[i][brev(k, 4)], w);
      w = cmul(w, w1); } }
  __syncthreads();
  { const int sb = tid >> 5, ii = tid & 31, pb = 544 * sb + ii;
    cplx u[NV][16];
#pragma unroll
    for (int i = 0; i < NV; ++i)
#pragma unroll
      for (int j = 0; j < 16; ++j) u[i][j] = L[i * FFT_REGION_F2 + pb + 34 * j];

#pragma unroll
    for (int i = 0; i < NV; ++i) dft_reg<16, false>(u[i]);

    float rev = (float)ii * (1.f / 512.f); asm volatile("" : "+v"(rev)); const cplx w1 = mk2(__builtin_amdgcn_cosf(rev), -__builtin_amdgcn_sinf(rev)); cplx w = mk2(1.f, 0.f);
#pragma unroll
    for (int k = 0; k < 16; ++k) {
#pragma unroll
      for (int i = 0; i < NV; ++i) L[i * FFT_REGION_F2 + pb + 34 * k] = cmul(u[i][brev(k, 4)], w);
      w = cmul(w, w1); } }
  __syncthreads();
  { const int sb = tid >> 1, ii = tid & 1, pb = 34 * sb + ii;
    cplx u[NV][16];
#pragma unroll
    for (int i = 0; i < NV; ++i)
#pragma unroll
      for (int j = 0; j < 16; ++j) u[i][j] = L[i * FFT_REGION_F2 + pb + 2 * j];

#pragma unroll
    for (int i = 0; i < NV; ++i) dft_reg<16, false>(u[i]);

#pragma unroll
    for (int k = 0; k < 16; ++k)
#pragma unroll
      for (int i = 0; i < NV; ++i) { const cplx y = u[i][brev(k, 4)]; const cplx yw = cmul_c(y, mk2(cos32(k), -sin32(k))); L[i * FFT_REGION_F2 + pb + 2 * k] = ii ? yw : y; } }
  __syncthreads();
}
template <int NV> DI void fft_inv3(cplx (&v)[NV][16], LAS cplx* L, int tid) {
  { const int sb = tid >> 1, ii = tid & 1, pb = 34 * sb + ii;
    cplx u[NV][16];
#pragma unroll
    for (int i = 0; i < NV; ++i)
#pragma unroll
      for (int k = 0; k < 16; ++k) { const cplx y = L[i * FFT_REGION_F2 + pb + 2 * k]; const cplx yw = cmulc_c(y, mk2(cos32(k), -sin32(k))); u[i][k] = ii ? yw : y; }

#pragma unroll
    for (int i = 0; i < NV; ++i) dft_reg<16, true>(u[i]);

#pragma unroll
    for (int i = 0; i < NV; ++i)
#pragma unroll
      for (int j = 0; j < 16; ++j) L[i * FFT_REGION_F2 + pb + 2 * j] = u[i][brev(j, 4)]; }
  __syncthreads();
  { const int sb = tid >> 5, ii = tid & 31, pb = 544 * sb + ii;
    cplx u[NV][16];
    float rev = (float)ii * (1.f / 512.f); asm volatile("" : "+v"(rev)); const cplx w1 = mk2(__builtin_amdgcn_cosf(rev), -__builtin_amdgcn_sinf(rev)); cplx w = mk2(1.f, 0.f);
#pragma unroll
    for (int k = 0; k < 16; ++k) {
#pragma unroll
      for (int i = 0; i < NV; ++i) u[i][k] = cmulc(L[i * FFT_REGION_F2 + pb + 34 * k], w);
      w = cmul(w, w1); }

#pragma unroll
    for (int i = 0; i < NV; ++i) dft_reg<16, true>(u[i]);

#pragma unroll
    for (int i = 0; i < NV; ++i)
#pragma unroll
      for (int j = 0; j < 16; ++j) L[i * FFT_REGION_F2 + pb + 34 * j] = u[i][brev(j, 4)]; }
  __syncthreads();
  { float rev = (float)tid * (1.f / 8192.f); asm volatile("" : "+v"(rev)); const cplx w1 = mk2(__builtin_amdgcn_cosf(rev), -__builtin_amdgcn_sinf(rev)); cplx w = mk2(1.f, 0.f);
    const int pb = tid + 2 * (tid >> 5);
#pragma unroll
    for (int k = 0; k < 16; ++k) {
#pragma unroll
      for (int i = 0; i < NV; ++i) v[i][k] = cmulc(L[i * FFT_REGION_F2 + pb + 544 * k], w);
      w = cmul(w, w1); }

#pragma unroll
    for (int i = 0; i < NV; ++i) dft_reg<16, true>(v[i]);
     }
}

DI float shl1(float x, int lane) { const float t = __shfl_up(x, 1); return lane == 0 ? 0.f : t; }
DI float shr1(float x, int lane) { const float t = __shfl_down(x, 1); return lane == 63 ? 0.f : t; }
DI void hy_conv8(const bf16_t* XT, int c, int bt, int tl, int lane, const float (&cw)[3][3], const float (&cb)[3], float (&x0c)[8], float (&zz)[8]) {
  float uc[3][8];
#pragma unroll
  for (int g = 0; g < 3; ++g) {
    const u32x4 raw = *(const u32x4*)(XT + (size_t)(g * 1024 + c) * NTOK + (size_t)bt * 4096 + 8 * tl);
    float pv[10];
#pragma unroll
    for (int q = 0; q < 4; ++q) { pv[1 + 2 * q] = bflo(raw[q]); pv[2 + 2 * q] = bfhi(raw[q]); }
    { const float t0 = __shfl_up(pv[8], 1), t1 = __shfl_down(pv[1], 1); pv[0] = (lane & 7) == 0 ? 0.f : t0; pv[9] = (lane & 7) == 7 ? 0.f : t1; }
#pragma unroll
    for (int e2 = 0; e2 < 8; ++e2) uc[g][e2] = cw[g][0] * pv[e2] + cw[g][1] * pv[e2 + 1] + cw[g][2] * pv[e2 + 2] + cb[g];
  }
#pragma unroll
  for (int e2 = 0; e2 < 8; ++e2) { x0c[e2] = uc[0][e2]; zz[e2] = uc[1][e2] * uc[2][e2]; }
}
template <int NV> DI void hyena_chan(const Params& p, int l, int c, LAS cplx* L, int tid) {
  bf16_t* XT = (bf16_t*)(p.ws + OFF_XT);
  const int lane = tid & 63;
  const int pb4 = 16 * tid + 2 * (tid >> 1);
  h16x2 Hr[5]; LAS h16x2* Hl = (LAS h16x2*)(L + 2 * FFT_REGION_F2) + tid;
  {
    const float* hT = (const float*)(p.ws + ((l & 1) ? OFF_HP2 : OFF_HP));
    const float* hf = hT + (size_t)c * 4096, * hbk = hT + (size_t)(1024 + c) * 4096;
    cplx f[1][16];
#pragma unroll
    for (int j = 0; j < 8; ++j) f[0][j] = mk2(__builtin_nontemporal_load(hf + tid + 512 * j), 0.f);
#pragma unroll
    for (int j = 8; j < 16; ++j) { const int n = tid + 512 * j; f[0][j] = mk2(n == 4096 ? 0.f : __builtin_nontemporal_load(hbk + (n == 4096 ? 0 : 8192 - n)), 0.f); }
    fft_fwd3<1>(f, L, tid);
#pragma unroll
    for (int m = 0; m < 8; ++m) { const cplx a = L[pb4 + 2 * m], b = L[pb4 + 2 * m + 1];
      h16x2 h0, h1; h0.x = (_Float16)((a.x + b.x) * HSCALE); h0.y = (_Float16)((a.y + b.y) * HSCALE); h1.x = (_Float16)((a.x - b.x) * HSCALE); h1.y = (_Float16)((a.y - b.y) * HSCALE);
      if (2 * m < 11) Hl[(2 * m) * 512] = h0; else Hr[2 * m - 11 < 0 ? 0 : 2 * m - 11] = h0;
      if (2 * m + 1 < 11) Hl[(2 * m + 1) * 512] = h1; else Hr[2 * m + 1 - 11 < 0 ? 0 : 2 * m + 1 - 11] = h1; }
    __syncthreads();
  }
  float cw[3][3], cb[3];
#pragma unroll
  for (int g = 0; g < 3; ++g) { cb[g] = p.conv_b[l * 3072 + g * 1024 + c];
#pragma unroll
    for (int t = 0; t < 3; ++t) cw[g][t] = p.conv_w[((size_t)l * 3 + t) * 3072 + g * 1024 + c]; }
  const float sk = p.skip[l * 1024 + c], sc = 1.f / (8192.f * HSCALE);
#pragma unroll 1
  for (int bp0 = 0; bp0 < 2; bp0 += NV) {
    int tl = tid; asm volatile("" : "+v"(tl));
#pragma unroll
    for (int i = 0; i < NV; ++i) {
      float xa[8], za[8], xb[8], zb[8];
      hy_conv8(XT, c, 2 * (bp0 + i), tl, lane, cw, cb, xa, za);
      hy_conv8(XT, c, 2 * (bp0 + i) + 1, tl, lane, cw, cb, xb, zb);
      LAS cplx* X = L + i * FFT_REGION_F2 + 8 * tl + 2 * (tl >> 2);
#pragma unroll
      for (int e2 = 0; e2 < 8; ++e2) X[e2] = mk2(za[e2], zb[e2]);

    }
    __syncthreads();
    cplx v[NV][16];
    { const int pb = tl + 2 * (tl >> 5);
#pragma unroll
      for (int i = 0; i < NV; ++i) {
#pragma unroll
        for (int j = 0; j < 8; ++j) v[i][j] = L[i * FFT_REGION_F2 + pb + 544 * j];
#pragma unroll
        for (int j = 8; j < 16; ++j) v[i][j] = mk2(0.f, 0.f); } }
    __syncthreads();

    fft_fwd3<NV>(v, L, tid);

#pragma unroll
    for (int i = 0; i < NV; ++i) {
      LAS cplx* Li = L + i * FFT_REGION_F2;
#pragma unroll
      for (int m = 0; m < 8; ++m) { const cplx a = Li[pb4 + 2 * m], b = Li[pb4 + 2 * m + 1];
        const h16x2 h0 = (2 * m < 11) ? Hl[(2 * m) * 512] : Hr[2 * m - 11 < 0 ? 0 : 2 * m - 11], h1 = (2 * m + 1 < 11) ? Hl[(2 * m + 1) * 512] : Hr[2 * m + 1 - 11 < 0 ? 0 : 2 * m + 1 - 11];
        const cplx y0 = cmul(mk2(a.x + b.x, a.y + b.y), mk2((float)h0.x, (float)h0.y)), y1 = cmul(mk2(a.x - b.x, a.y - b.y), mk2((float)h1.x, (float)h1.y));
        Li[pb4 + 2 * m] = mk2(y0.x + y1.x, y0.y + y1.y); Li[pb4 + 2 * m + 1] = mk2(y0.x - y1.x, y0.y - y1.y); }
       }
    __syncthreads();
    fft_inv3<NV>(v, L, tid);

    { const int pb = tl + 2 * (tl >> 5);
#pragma unroll
      for (int i = 0; i < NV; ++i)
#pragma unroll
        for (int j = 0; j < 8; ++j) L[i * FFT_REGION_F2 + pb + 544 * j] = v[i][brev(j, 4)]; }
    __syncthreads();
#pragma unroll
    for (int i = 0; i < NV; ++i) {
      float xa[8], za[8], xb[8], zb[8];
      hy_conv8(XT, c, 2 * (bp0 + i), tl, lane, cw, cb, xa, za);
      hy_conv8(XT, c, 2 * (bp0 + i) + 1, tl, lane, cw, cb, xb, zb);
      const LAS cplx* X = L + i * FFT_REGION_F2 + 8 * tl + 2 * (tl >> 2);
      float ya[8], yb[8];
#pragma unroll
      for (int e2 = 0; e2 < 8; ++e2) { const cplx cv = X[e2]; ya[e2] = xa[e2] * (cv.x * sc + sk * za[e2]); yb[e2] = xb[e2] * (cv.y * sc + sk * zb[e2]); }
      *(u32x4*)(XT + (size_t)c * NTOK + (size_t)(2 * (bp0 + i)) * 4096 + 8 * tl) = (u32x4){pk2(ya[0], ya[1]), pk2(ya[2], ya[3]), pk2(ya[4], ya[5]), pk2(ya[6], ya[7])};
      *(u32x4*)(XT + (size_t)c * NTOK + (size_t)(2 * (bp0 + i) + 1) * 4096 + 8 * tl) = (u32x4){pk2(yb[0], yb[1]), pk2(yb[2], yb[3]), pk2(yb[4], yb[5]), pk2(yb[6], yb[7])};

    }
    __syncthreads();
  }
}

DI void hyena_ctx_item(const Params& p, int l, int c, LAS unsigned char* lds) {
  LAS float* zs = (LAS float*)lds;
  LAS float* hc = zs + 1024;
  LAS float* part = hc + 512;
  bf16_t* XT = (bf16_t*)(p.ws + OFF_XT);
  const float* hTc = (const float*)(p.ws + ((l & 1) ? OFF_HTC2 : OFF_HTC));
  const int tid = otid();
  { const int i = tid - 256; hc[tid] = i >= 0 ? hTc[(size_t)c * 256 + i] : (tid == 0 ? 0.f : hTc[(size_t)(1024 + c) * 256 + (-i)]); }
  float u0[2];
  { const int b = tid >> 7, tq = tid & 127;
#pragma unroll
    for (int e = 0; e < 2; ++e) {
      const int t = tq + 128 * e;
      float uu[3];
#pragma unroll
      for (int g = 0; g < 3; ++g) {
        const bf16_t* row = XT + (size_t)(g * 1024 + c) * NTOK + NLAT + b * 256;
        const float pm = t > 0 ? bf2f(row[t - 1]) : 0.f, p0 = bf2f(row[t]), pp = t < 255 ? bf2f(row[t + 1]) : 0.f;
        const size_t wb = (size_t)l * 3 * 3072 + g * 1024 + c;
        uu[g] = p.conv_w[wb] * pm + p.conv_w[wb + 3072] * p0 + p.conv_w[wb + 6144] * pp + p.conv_b[l * 3072 + g * 1024 + c];
      }
      u0[e] = uu[0]; zs[b * 256 + t] = uu[1] * uu[2];
    } }
  __syncthreads();
  const int t0 = 4 * (tid & 63), cbatch = (tid >> 6) & 3, sh = tid >> 8;
  float y[4] = {0.f, 0.f, 0.f, 0.f};
#pragma unroll 4
  for (int s0 = 128 * sh; s0 < 128 * sh + 128; s0 += 4) {
    const int base = 256 + t0 - s0 - 4;
    const f32x4 H0 = *(const LAS f32x4*)(hc + base), H1 = *(const LAS f32x4*)(hc + base + 4), z4 = *(const LAS f32x4*)(zs + cbatch * 256 + s0);
    const float hw[8] = {H0.x, H0.y, H0.z, H0.w, H1.x, H1.y, H1.z, H1.w}, zv[4] = {z4.x, z4.y, z4.z, z4.w};
#pragma unroll
    for (int j = 0; j < 4; ++j)
#pragma unroll
      for (int u = 0; u < 4; ++u) y[j] += hw[4 + j - u] * zv[u];
  }
  if (sh) *(LAS f32x4*)(part + cbatch * 256 + t0) = (f32x4){y[0], y[1], y[2], y[3]};
  __syncthreads();
  if (!sh) { const f32x4 o = *(const LAS f32x4*)(part + cbatch * 256 + t0); part[cbatch * 256 + t0] = y[0] + o.x; part[cbatch * 256 + t0 + 1] = y[1] + o.y; part[cbatch * 256 + t0 + 2] = y[2] + o.z; part[cbatch * 256 + t0 + 3] = y[3] + o.w; }
  __syncthreads();
  { const int b = tid >> 7, tq = tid & 127; const float sk = p.skip[l * 1024 + c];
#pragma unroll
    for (int e = 0; e < 2; ++e) { const int t = tq + 128 * e;
      XT[(size_t)c * NTOK + NLAT + b * 256 + t] = f2bf(u0[e] * (part[b * 256 + t] + sk * zs[b * 256 + t])); } }
  __syncthreads();
}

#ifndef HY_NV
#define HY_NV 2
#endif
#define MFMA32(a, b, c) __builtin_amdgcn_mfma_f32_32x32x16_bf16((a), (b), (c), 0, 0, 0)
DI float logsig(float x) { return fminf(x, 0.f) - __logf(1.f + __expf(-fabsf(x))); }
DI void phase_gla_prep(const Params& p, int l, LAS unsigned char* lds) {
  LAS float* lrs = (LAS float*)lds;
  LAS float* tots = lrs + 64 * 32;
  LAS bf16_t* qs = (LAS bf16_t*)(tots + 2 * 4 * 128);
  LAS bf16_t* kes = qs + 4 * 64 * 136;
  LAS bf16_t* ats = kes + 2 * 128 * 72;
  const int tid = otid(), d = tid & 127, tq = tid >> 7, wid = tid >> 6, lane = tid & 63;
  const bf16_t* PB = (const bf16_t*)(p.ws + OFF_PB);
  const float* LR = (const float*)(p.ws + OFF_LR);
  bf16_t* QF = (bf16_t*)(p.ws + OFF_QF); bf16_t* QB = (bf16_t*)(p.ws + OFF_QB);
  bf16_t* KEF = (bf16_t*)(p.ws + OFF_KEF); bf16_t* KEB = (bf16_t*)(p.ws + OFF_KEB);
  bf16_t* ATT = (bf16_t*)(p.ws + OFF_ATT); float* DEC = (float*)(p.ws + OFF_DEC);
  const float qscale = 0.08838834764831845f;
  f32x4 lrv; bf16_t qv[16], kv[16];
#define PREP_LOAD(it_) do { const int ch_ = (it_) >> 2, hh_ = (it_) & 3; const size_t t0_ = (size_t)ch_ * 64; lrv = *(const f32x4*)(LR + t0_ * 32 + 4 * tid); \
    _Pragma("unroll") for (int i = 0; i < 16; ++i) { const size_t tk_ = t0_ + tq * 16 + i; qv[i] = PB[tk_ * 4096 + hh_ * 128 + d]; kv[i] = PB[tk_ * 4096 + 512 + hh_ * 128 + d]; } } while (0)
  float gwf[16], gwb[16], gbf = 0.f, gbb = 0.f;
#define PREP_LOADG(it_) do { const int hh_ = (it_) & 3; \
    _Pragma("unroll") for (int r = 0; r < 16; ++r) { gwf[r] = p.gate_w[(((size_t)l * 2 + 0) * 16 + r) * 512 + hh_ * 128 + d]; gwb[r] = p.gate_w[(((size_t)l * 2 + 1) * 16 + r) * 512 + hh_ * 128 + d]; } \
    gbf = p.gate_b[((size_t)l * 2 + 0) * 512 + hh_ * 128 + d]; gbb = p.gate_b[((size_t)l * 2 + 1) * 512 + hh_ * 128 + d]; } while (0)
  if ((int)blockIdx.x < 272 * 4) PREP_LOAD((int)blockIdx.x);
  for (int it = blockIdx.x; it < 272 * 4; it += gridDim.x) {
    const int chunk = it >> 2, h = it & 3, tok0 = chunk * 64;
    *(LAS f32x4*)(lrs + 4 * tid) = lrv;
    PREP_LOADG(it);
    __syncthreads();
    float cf[16], cb[16];
#pragma unroll
    for (int i = 0; i < 16; ++i) {
      const int t = tq * 16 + i; float pf = gbf, pb = gbb;
#pragma unroll
      for (int r4 = 0; r4 < 4; ++r4) { const f32x4 lf = *(const LAS f32x4*)(lrs + t * 32 + 4 * r4), lb = *(const LAS f32x4*)(lrs + t * 32 + 16 + 4 * r4);
        pf += lf.x * gwf[4 * r4] + lf.y * gwf[4 * r4 + 1] + lf.z * gwf[4 * r4 + 2] + lf.w * gwf[4 * r4 + 3]; pb += lb.x * gwb[4 * r4] + lb.y * gwb[4 * r4 + 1] + lb.z * gwb[4 * r4 + 2] + lb.w * gwb[4 * r4 + 3]; }
      cf[i] = logsig(pf) * (1.f / 16.f); cb[i] = logsig(pb) * (1.f / 16.f);
    }
    { float run = 0.f;
#pragma unroll
      for (int i = 0; i < 16; ++i) { run += cf[i]; cf[i] = run; }
      tots[(0 * 4 + tq) * 128 + d] = run; run = 0.f;
#pragma unroll
      for (int i = 15; i >= 0; --i) { run += cb[i]; cb[i] = run; }
      tots[(1 * 4 + tq) * 128 + d] = run; }
    __syncthreads();
    float offf = 0.f, offb = 0.f, cendf = 0.f, cendb = 0.f;
#pragma unroll
    for (int q = 0; q < 4; ++q) { const float a = tots[(0 * 4 + q) * 128 + d], b = tots[(1 * 4 + q) * 128 + d]; cendf += a; cendb += b; if (q < tq) offf += a; if (q > tq) offb += b; }
    const int o16 = d & 15, grp = o16 >> 2, ngrp = (grp == 1) ? 2 : (grp == 2) ? 1 : grp, permd = (d & ~15) | (ngrp << 2) | (o16 & 3);
    unsigned kef[8], keb[8];
    const float ecf = __expf(cendf), ecb = __expf(cendb);
#pragma unroll
    for (int i = 0; i < 16; ++i) {
      const int t = tq * 16 + i; const size_t tok = (size_t)tok0 + t;
      const float q = bf2f(qv[i]) * qscale, k = bf2f(kv[i]);
      const float ea = __expf(cf[i] + offf), eb2 = __expf(cb[i] + offb);
      const float kia = k * __builtin_amdgcn_rcpf(ea), kib = k * __builtin_amdgcn_rcpf(eb2);
      const bf16_t qf = f2bf(q * ea), kf = f2bf(kia), qb = f2bf(q * eb2), kb = f2bf(kib);
      const bf16_t ef = f2bf(kia * ecf), eb = f2bf(kib * ecb);
      qs[(0 * 64 + t) * 136 + d] = qf; qs[(1 * 64 + t) * 136 + d] = kf; qs[(2 * 64 + t) * 136 + d] = qb; qs[(3 * 64 + t) * 136 + d] = kb;
      QF[tok * 512 + h * 128 + permd] = qf; QB[tok * 512 + h * 128 + permd] = qb;
      if (i & 1) { kef[i >> 1] |= (unsigned)ef << 16; keb[i >> 1] |= (unsigned)eb << 16; } else { kef[i >> 1] = ef; keb[i >> 1] = eb; }
    }
    if (it + (int)gridDim.x < 272 * 4) PREP_LOAD(it + (int)gridDim.x);
    { LAS u32x4* d1 = (LAS u32x4*)(kes + (0 * 128 + d) * 72 + tq * 16); d1[0] = (u32x4){kef[0], kef[1], kef[2], kef[3]}; d1[1] = (u32x4){kef[4], kef[5], kef[6], kef[7]};
      LAS u32x4* d2 = (LAS u32x4*)(kes + (1 * 128 + d) * 72 + tq * 16); d2[0] = (u32x4){keb[0], keb[1], keb[2], keb[3]}; d2[1] = (u32x4){keb[4], keb[5], keb[6], keb[7]}; }
    if (tq == 0) { DEC[(((size_t)chunk * 4 + h) * 2 + 0) * 128 + d] = ecf; DEC[(((size_t)chunk * 4 + h) * 2 + 1) * 128 + d] = ecb; }
    __syncthreads();
    {
      const int dir = wid >> 2, ti = (wid >> 1) & 1, si = wid & 1, r = lane & 31, hh = lane >> 5;
      const LAS bf16_t* ka = qs + ((dir * 2 + 1) * 64 + 32 * si + r) * 136 + 8 * hh;
      const LAS bf16_t* qa = qs + ((dir * 2 + 0) * 64 + 32 * ti + r) * 136 + 8 * hh;
      f32x16 acc;
#pragma unroll
      for (int i = 0; i < 16; ++i) acc[i] = 0.f;
#pragma unroll
      for (int ks = 0; ks < 8; ++ks) acc = MFMA32(*(const LAS bf16x8*)(ka + 16 * ks), *(const LAS bf16x8*)(qa + 16 * ks), acc);
      const int t = 32 * ti + r;
      LAS bf16_t* dst = ats + (dir * 64 + t) * 72 + 32 * si + 4 * hh;
#pragma unroll
      for (int g = 0; g < 4; ++g) {
        float vv[4];
#pragma unroll
        for (int e = 0; e < 4; ++e) { const int s = 32 * si + 8 * g + 4 * hh + e; const bool keep = dir ? (s >= t) : (s <= t); vv[e] = keep ? acc[4 * g + e] : 0.f; }
        *(LAS u32x2*)(dst + 8 * g) = (u32x2){pk2(vv[0], vv[1]), pk2(vv[2], vv[3])};
      }
    }
    __syncthreads();
    {
      const size_t chh = (size_t)chunk * 4 + h;
#pragma unroll
      for (int q = 0; q < 2; ++q) { const int pc = tid + 512 * q, row = pc >> 3, cc = pc & 7;
        *(u32x4*)(KEF + (chh * 128 + row) * 64 + 8 * cc) = *(const LAS u32x4*)(kes + (0 * 128 + row) * 72 + 8 * cc);
        *(u32x4*)(KEB + (chh * 128 + row) * 64 + 8 * cc) = *(const LAS u32x4*)(kes + (1 * 128 + row) * 72 + 8 * cc);
        const int rr = row & 63, dd = row >> 6;
        *(u32x4*)(ATT + ((chh * 2 + dd) * 64 + rr) * 64 + 8 * cc) = *(const LAS u32x4*)(ats + (dd * 64 + rr) * 72 + 8 * cc); }
    }
    __syncthreads();
  }
}

#undef PREP_LOAD
#undef PREP_LOADG
DI bf16x8 pack8(const f32x16& x, int s) {
  u32x4 r; r[0] = pk2(x[8 * s + 0], x[8 * s + 1]); r[1] = pk2(x[8 * s + 2], x[8 * s + 3]); r[2] = pk2(x[8 * s + 4], x[8 * s + 5]); r[3] = pk2(x[8 * s + 6], x[8 * s + 7]);
  return __builtin_bit_cast(bf16x8, r);
}
DI void phase_gla_scan(const Params& p, LAS unsigned char* lds) {
  constexpr int BUFB = 64 * 136 * 2 + 128 * 72 * 2 + 64 * 72 * 2 + 512;
  const int tid = otid(), wid = tid >> 6, lane = tid & 63, r = lane & 31, hh = lane >> 5;
  const int bid = blockIdx.x, b = bid >> 3, h = (bid >> 1) & 3, dir = bid & 1;
  const bf16_t* Qg = (const bf16_t*)(p.ws + (dir ? OFF_QB : OFF_QF));
  const bf16_t* Kg = (const bf16_t*)(p.ws + (dir ? OFF_KEB : OFF_KEF));
  const bf16_t* ATT = (const bf16_t*)(p.ws + OFF_ATT); const float* DEC = (const float*)(p.ws + OFF_DEC);
  const bf16_t* VT = (const bf16_t*)(p.ws + OFF_XT) + (size_t)(3072 + h * 256 + 32 * wid + r) * NTOK + 8 * hh;
  bf16_t* Og = dir ? (bf16_t*)(p.ws + OFF_X) : (bf16_t*)(p.ws + OFF_PB);
  const int ldo = dir ? 1024 : 4096;
  const int qrow0 = tid >> 4, qcc = tid & 15, krow0 = tid >> 3, kcc = tid & 7;
  constexpr int OBUF = 64 * 264 * 2;
  LAS unsigned char* obase = lds + 2 * BUFB;
  f32x16 S[4];
#pragma unroll
  for (int m = 0; m < 4; ++m)
#pragma unroll
    for (int i = 0; i < 16; ++i) S[m][i] = 0.f;
  u32x4 pq0, pq1, pk0, pk1, pa; float pdc = 0.f; bf16x8 vf[4], vn[4];
#define SCAN_CIDX(st) ((st) < 4 ? (256 + 4 * b + (dir ? 3 - (st) : (st))) : (64 * b + (dir ? 67 - (st) : (st) - 4)))
#define SCAN_LOAD(st) do { const int ci_ = SCAN_CIDX(st); const size_t tk_ = (size_t)ci_ * 64, ch_ = (size_t)ci_ * 4 + h; \
    pq0 = *(const u32x4*)(Qg + (tk_ + qrow0) * 512 + h * 128 + 8 * qcc); pq1 = *(const u32x4*)(Qg + (tk_ + qrow0 + 32) * 512 + h * 128 + 8 * qcc); \
    pk0 = *(const u32x4*)(Kg + (ch_ * 128 + krow0) * 64 + 8 * kcc); pk1 = *(const u32x4*)(Kg + (ch_ * 128 + krow0 + 64) * 64 + 8 * kcc); \
    pa = *(const u32x4*)(ATT + ((ch_ * 2 + dir) * 64 + krow0) * 64 + 8 * kcc); if (tid < 128) pdc = DEC[(ch_ * 2 + dir) * 128 + tid]; \
    _Pragma("unroll") for (int ks = 0; ks < 4; ++ks) vn[ks] = *(const bf16x8*)(VT + tk_ + 16 * ks); } while (0)
#define SCAN_STORE(bufi) do { LAS unsigned char* bb_ = lds + (bufi) * BUFB; LAS bf16_t* QT_ = (LAS bf16_t*)bb_; LAS bf16_t* KE_ = QT_ + 64 * 136; LAS bf16_t* AT_ = KE_ + 128 * 72; LAS float* DC_ = (LAS float*)(AT_ + 64 * 72); \
    *(LAS u32x4*)(QT_ + qrow0 * 136 + 8 * qcc) = pq0; *(LAS u32x4*)(QT_ + (qrow0 + 32) * 136 + 8 * qcc) = pq1; \
    *(LAS u32x4*)(KE_ + krow0 * 72 + 8 * kcc) = pk0; *(LAS u32x4*)(KE_ + (krow0 + 64) * 72 + 8 * kcc) = pk1; \
    *(LAS u32x4*)(AT_ + krow0 * 72 + 8 * kcc) = pa; if (tid < 128) DC_[tid] = pdc; } while (0)
#define SCAN_WRITEOUT(st) do { const size_t tk_ = (size_t)SCAN_CIDX(st) * 64; const LAS bf16_t* ob_ = (const LAS bf16_t*)(obase + ((st) & 1) * OBUF); \
    _Pragma("unroll 2") for (int q = 0; q < 4; ++q) { const int pc_ = tid + 512 * q, row_ = pc_ >> 5, cc_ = pc_ & 31; \
      *(u32x4*)(Og + (tk_ + row_) * ldo + h * 256 + 8 * cc_) = *(const LAS u32x4*)(ob_ + row_ * 264 + 8 * cc_); } } while (0)
  SCAN_LOAD(0); SCAN_STORE(0);
#pragma unroll
  for (int ks = 0; ks < 4; ++ks) vf[ks] = vn[ks];
  __syncthreads();
#pragma unroll 1
  for (int step = 0; step < 68; ++step) {
    const size_t tok0 = (size_t)SCAN_CIDX(step) * 64;
    if (step > 0) SCAN_WRITEOUT(step - 1);
    __builtin_amdgcn_sched_barrier(0);
    if (step + 1 < 68) SCAN_LOAD(step + 1);
    LAS unsigned char* bb = lds + (step & 1) * BUFB;
    const LAS bf16_t* QT = (const LAS bf16_t*)bb; const LAS bf16_t* KE = QT + 64 * 136; const LAS bf16_t* AT = KE + 128 * 72; const LAS float* DC = (const LAS float*)(AT + 64 * 72);
    bf16x8 sp[8];
#pragma unroll
    for (int m = 0; m < 4; ++m) { sp[2 * m] = pack8(S[m], 0); sp[2 * m + 1] = pack8(S[m], 1); }
    f32x16 o0, o1;
#pragma unroll
    for (int i = 0; i < 16; ++i) { o0[i] = 0.f; o1[i] = 0.f; }
#pragma unroll
    for (int ks = 0; ks < 4; ++ks) {
      o0 = MFMA32(vf[ks], *(const LAS bf16x8*)(AT + r * 72 + 16 * ks + 8 * hh), o0);
      o1 = MFMA32(vf[ks], *(const LAS bf16x8*)(AT + (32 + r) * 72 + 16 * ks + 8 * hh), o1);
    }
#pragma unroll
    for (int k8 = 0; k8 < 8; ++k8) {
      o0 = MFMA32(sp[k8], *(const LAS bf16x8*)(QT + r * 136 + 16 * k8 + 8 * hh), o0);
      o1 = MFMA32(sp[k8], *(const LAS bf16x8*)(QT + (32 + r) * 136 + 16 * k8 + 8 * hh), o1);
    }
#pragma unroll
    for (int m = 0; m < 4; ++m) {
#pragma unroll
      for (int g = 0; g < 4; ++g) { const f32x4 dv = *(const LAS f32x4*)(DC + 32 * m + 8 * g + 4 * hh);
        S[m][4 * g] *= dv.x; S[m][4 * g + 1] *= dv.y; S[m][4 * g + 2] *= dv.z; S[m][4 * g + 3] *= dv.w; }
#pragma unroll
      for (int ks = 0; ks < 4; ++ks) S[m] = MFMA32(*(const LAS bf16x8*)(KE + (32 * m + r) * 72 + 16 * ks + 8 * hh), vf[ks], S[m]);
    }
    { LAS bf16_t* ob = (LAS bf16_t*)(obase + (step & 1) * OBUF) + r * 264 + 32 * wid + 4 * hh;
#pragma unroll
      for (int g = 0; g < 4; ++g) {
        *(LAS u32x2*)(ob + 8 * g) = (u32x2){pk2(o0[4 * g], o0[4 * g + 1]), pk2(o0[4 * g + 2], o0[4 * g + 3])};
        *(LAS u32x2*)(ob + 32 * 264 + 8 * g) = (u32x2){pk2(o1[4 * g], o1[4 * g + 1]), pk2(o1[4 * g + 2], o1[4 * g + 3])};
      } }
    if (step + 1 < 68) { SCAN_STORE((step + 1) & 1);
#pragma unroll
      for (int ks = 0; ks < 4; ++ks) vf[ks] = vn[ks]; }
    __syncthreads();
  }
  SCAN_WRITEOUT(67);
  __syncthreads();
#undef SCAN_WRITEOUT
#undef SCAN_CIDX
#undef SCAN_LOAD
#undef SCAN_STORE
}

DI void phase_post(const Params& p, int l, int ntok, LAS unsigned char* lds) {
  const int tid = otid(), lane = tid & 63;
  { const int gw = blockIdx.x * 8 + (tid >> 6), nw = gridDim.x * 8, l32 = lane & 31, hsel = lane >> 5;
    const bf16_t* PB = (const bf16_t*)(p.ws + OFF_PB); bf16_t* HB = (bf16_t*)(p.ws + OFF_X);
    const f32x4 ng0 = *(const f32x4*)(p.gla_ng + l * 256 + 8 * l32), ng1 = *(const f32x4*)(p.gla_ng + l * 256 + 8 * l32 + 4);
    u32x4 na, nb, nr;
    if (gw < ntok * 2) { const size_t tk = gw >> 1; const int cl = ((gw & 1) * 2 + hsel) * 256 + 8 * l32; na = __builtin_nontemporal_load((const u32x4*)(PB + tk * 4096 + cl)); nb = __builtin_nontemporal_load((const u32x4*)(HB + tk * 1024 + cl)); nr = __builtin_nontemporal_load((const u32x4*)(PB + tk * 4096 + 1024 + cl)); }
    for (int it = gw; it < ntok * 2; it += nw) {
      const size_t tok = it >> 1; const int col = ((it & 1) * 2 + hsel) * 256 + 8 * l32;
      const u32x4 a = na, b = nb, rr = nr;
      if (it + nw < ntok * 2) { const int i2 = it + nw; const size_t tk = i2 >> 1; const int cl = ((i2 & 1) * 2 + hsel) * 256 + 8 * l32; na = __builtin_nontemporal_load((const u32x4*)(PB + tk * 4096 + cl)); nb = __builtin_nontemporal_load((const u32x4*)(HB + tk * 1024 + cl)); nr = __builtin_nontemporal_load((const u32x4*)(PB + tk * 4096 + 1024 + cl)); }
      float o[8], rv[8];
#pragma unroll
      for (int i = 0; i < 4; ++i) { o[2 * i] = bflo(a[i]) + bflo(b[i]); o[2 * i + 1] = bfhi(a[i]) + bfhi(b[i]); rv[2 * i] = bflo(rr[i]); rv[2 * i + 1] = bfhi(rr[i]); }
      float ss = 0.f;
#pragma unroll
      for (int i = 0; i < 8; ++i) ss += o[i] * o[i];
#pragma unroll
      for (int q = 16; q >= 1; q >>= 1) ss += __shfl_xor(ss, q);
      const float rstd = rsqrtf(ss * (1.f / 256.f) + EPSF);
      const float ngv[8] = {ng0.x, ng0.y, ng0.z, ng0.w, ng1.x, ng1.y, ng1.z, ng1.w};
      float y[8];
#pragma unroll
      for (int i = 0; i < 8; ++i) y[i] = o[i] * rstd * ngv[i] * (rv[i] * sigm(rv[i]));
      *(u32x4*)(HB + tok * 1024 + col) = (u32x4){pk2(y[0], y[1]), pk2(y[2], y[3]), pk2(y[4], y[5]), pk2(y[6], y[7])};
    } }
  { LAS bf16_t* t = (LAS bf16_t*)lds;
    const bf16_t* XT = (const bf16_t*)(p.ws + OFF_XT); bf16_t* YH = (bf16_t*)(p.ws + OFF_QF);
    const int ntt = ntok / 128;
    u32x4 pre[2];
#define POST_TLOAD(it_) do { const int c0_ = ((it_) / ntt) * 64, tk0_ = ((it_) % ntt) * 128; \
      _Pragma("unroll") for (int q = 0; q < 2; ++q) { const int pc = tid + 512 * q, cc = pc >> 4, tq = pc & 15; pre[q] = *(const u32x4*)(XT + (size_t)(c0_ + cc) * NTOK + tk0_ + 8 * tq); } } while (0)
    if ((int)blockIdx.x < 16 * ntt) POST_TLOAD((int)blockIdx.x);
    for (int it = blockIdx.x; it < 16 * ntt; it += gridDim.x) {
      const int c0 = (it / ntt) * 64, tok0 = (it % ntt) * 128;
#pragma unroll
      for (int q = 0; q < 2; ++q) { const int pc = tid + 512 * q, cc = pc >> 4, tq = pc & 15; *(LAS u32x4*)(t + cc * 136 + 8 * tq) = pre[q]; }
      if (it + (int)gridDim.x < 16 * ntt) POST_TLOAD(it + (int)gridDim.x);
      __syncthreads();
#pragma unroll
      for (int q = 0; q < 2; ++q) { const int pc = tid + 512 * q, tk = pc >> 3, cq = pc & 7; unsigned w[4];
#pragma unroll
        for (int i = 0; i < 4; ++i) w[i] = (unsigned)t[(8 * cq + 2 * i) * 136 + tk] | ((unsigned)t[(8 * cq + 2 * i + 1) * 136 + tk] << 16);
        *(u32x4*)(YH + (size_t)(tok0 + tk) * 1024 + c0 + 8 * cq) = (u32x4){w[0], w[1], w[2], w[3]}; }
      __syncthreads();
    } }
}

#undef POST_TLOAD
struct SchedG1 : pg8::StaticOrder {
  __device__ bool next(int i, pg8::Unit& u) const {
    pg8::Unit v; if (!pg8::StaticOrder::next(i, v)) return false;
    if (v.pn < 16) { u.pm = 68 + v.pn; u.pn = v.pm; } else { u.pm = v.pm; u.pn = 68 + v.pn; }
    return true;
  }
};
typedef const f32x4 (&AccRef)[2][2][4][2];
DI u32x4 pack_acc8(f32x4 v0, f32x4 v1) { return (u32x4){pk2(v0[0], v0[1]), pk2(v0[2], v0[3]), pk2(v1[0], v1[1]), pk2(v1[2], v1[3])}; }
struct EpiG1 {
  static constexpr bool PERM = true, AFTER_DRAIN = false;
  bf16_t* XT; bf16_t* PB; float* LR;
  DI void operator()(AccRef acc, const pg8::Unit& u, int wr, int wc, int fr, int fq) const {
    if (u.pm >= 68) {
      const int ch0 = (u.pm - 68) * 256 + wr * 64 + fr, tk0 = u.pn * 256 + wc * 32 + 8 * fq;
#pragma unroll
      for (int ai = 0; ai < 2; ++ai)
#pragma unroll
        for (int m = 0; m < 4; ++m) { bf16_t* rp = XT + (size_t)(ch0 + ai * 128 + m * 16) * NTOK + tk0;
#pragma unroll
          for (int bj = 0; bj < 2; ++bj) *(u32x4*)(rp + bj * 128) = pack_acc8(acc[ai][bj][m][0], acc[ai][bj][m][1]); }
    } else {
      const int wp = u.pn - 84, row0 = u.pm * 256 + wr * 64 + fr, col0 = wp * 256 + wc * 32 + 8 * fq;
      if (wp < 16) {
#pragma unroll
        for (int ai = 0; ai < 2; ++ai)
#pragma unroll
          for (int m = 0; m < 4; ++m) { bf16_t* rp = PB + (size_t)(row0 + ai * 128 + m * 16) * 4096 + col0;
#pragma unroll
            for (int bj = 0; bj < 2; ++bj) *(u32x4*)(rp + bj * 128) = pack_acc8(acc[ai][bj][m][0], acc[ai][bj][m][1]); }
      } else if (wc == 0) {
#pragma unroll
        for (int ai = 0; ai < 2; ++ai)
#pragma unroll
          for (int m = 0; m < 4; ++m) { float* rp = LR + (size_t)(row0 + ai * 128 + m * 16) * 32 + 8 * fq; *(f32x4*)rp = acc[ai][0][m][0]; *(f32x4*)(rp + 4) = acc[ai][0][m][1]; }
      }
    }
  }
};
template <int MODE> struct EpiGate {
  static constexpr bool PERM = true, AFTER_DRAIN = false;
  const bf16_t* PB; bf16_t* T1; bf16_t* MG;
  DI void operator()(AccRef acc, const pg8::Unit& u, int wr, int wc, int fr, int fq) const {
    const int row0 = u.pm * 256 + wr * 64 + fr, col0 = u.pn * 256 + wc * 32 + 8 * fq;
#pragma unroll
    for (int ai = 0; ai < 2; ++ai)
#pragma unroll
      for (int m = 0; m < 4; ++m) { const size_t row = (size_t)(row0 + ai * 128 + m * 16);
#pragma unroll
        for (int bj = 0; bj < 2; ++bj) { const int col = col0 + bj * 128;
          const u32x4 g = *(const u32x4*)(PB + row * 4096 + (MODE ? 3072 : 2048) + col);
          const f32x4 v0 = acc[ai][bj][m][0], v1 = acc[ai][bj][m][1];
          float o[8] = {v0[0] * sigm(bflo(g[0])), v0[1] * sigm(bfhi(g[0])), v0[2] * sigm(bflo(g[1])), v0[3] * sigm(bfhi(g[1])),
                        v1[0] * sigm(bflo(g[2])), v1[1] * sigm(bfhi(g[2])), v1[2] * sigm(bflo(g[3])), v1[3] * sigm(bfhi(g[3]))};
          if (MODE) { const u32x4 t = *(const u32x4*)(T1 + row * 1024 + col);
            o[0] += bflo(t[0]); o[1] += bfhi(t[0]); o[2] += bflo(t[1]); o[3] += bfhi(t[1]); o[4] += bflo(t[2]); o[5] += bfhi(t[2]); o[6] += bflo(t[3]); o[7] += bfhi(t[3]); }
          *(u32x4*)((MODE ? MG : T1) + row * 1024 + col) = (u32x4){pk2(o[0], o[1]), pk2(o[2], o[3]), pk2(o[4], o[5]), pk2(o[6], o[7])}; } }
  }
};
struct EpiRes {
  static constexpr bool PERM = false, AFTER_DRAIN = false;
  float* out; float* ctxs; const float* modl; int goff; const float* src_lat; const float* src_ctx;
  DI void operator()(AccRef acc, const pg8::Unit& u, int wr, int wc, int fr, int fq) const {
    const int row0 = u.pm * 256 + wr * 64 + fr, col0 = u.pn * 256 + wc * 32 + 4 * fq;
    const float* gv = modl + (size_t)(u.pm < 64 ? (u.pm >> 4) : 4) * 6144 + goff + col0;
    f32x4 gg[2][2];
#pragma unroll
    for (int bj = 0; bj < 2; ++bj)
#pragma unroll
      for (int n = 0; n < 2; ++n) gg[bj][n] = *(const f32x4*)(gv + bj * 128 + n * 16);
#pragma unroll
    for (int ai = 0; ai < 2; ++ai)
#pragma unroll
      for (int m = 0; m < 4; ++m) { const int row = row0 + ai * 128 + m * 16;
        float* rp = (row < NLAT ? out + (size_t)row * 1024 : ctxs + (size_t)(row - NLAT) * 1024) + col0;
        const float* sp = (row < NLAT ? src_lat + (size_t)row * 1024 : src_ctx + (size_t)(row - NLAT) * 1024) + col0;
#pragma unroll
        for (int bj = 0; bj < 2; ++bj)
#pragma unroll
          for (int n = 0; n < 2; ++n) { f32x4* q = (f32x4*)(rp + bj * 128 + n * 16); *q = *(const f32x4*)(sp + bj * 128 + n * 16) + gg[bj][n] * acc[ai][bj][m][n]; } }
  }
};
struct EpiRelu2 {
  static constexpr bool PERM = true, AFTER_DRAIN = false;
  bf16_t* O;
  DI void operator()(AccRef acc, const pg8::Unit& u, int wr, int wc, int fr, int fq) const {
    const int row0 = u.pm * 256 + wr * 64 + fr, col0 = u.pn * 256 + wc * 32 + 8 * fq;
#pragma unroll
    for (int ai = 0; ai < 2; ++ai)
#pragma unroll
      for (int m = 0; m < 4; ++m) { bf16_t* rp = O + (size_t)(row0 + ai * 128 + m * 16) * 4096 + col0;
#pragma unroll
        for (int bj = 0; bj < 2; ++bj) { f32x4 v0 = acc[ai][bj][m][0], v1 = acc[ai][bj][m][1];
#pragma unroll
          for (int e = 0; e < 4; ++e) { const float a = fmaxf(v0[e], 0.f), b = fmaxf(v1[e], 0.f); v0[e] = a * a; v1[e] = b * b; }
          *(u32x4*)(rp + bj * 128) = pack_acc8(v0, v1); } }
  }
};

#define MFMA16(a, b, c) __builtin_amdgcn_mfma_f32_16x16x32_bf16((a), (b), (c), 0, 0, 0)
template <class F> DI void ctx_gemm(const bf16_t* A, const bf16_t* Bt, int K, int N, LAS unsigned char* lds, const F& epi) {
  constexpr int LDT = 136, TILEB = 64 * LDT * 2;
  const int tid = otid(), wid = tid >> 6, lane = tid & 63, fr = lane & 15, fq = lane >> 4, wm = wid >> 1, wn = wid & 1;
  const int ntn = N / 64, ntiles = 16 * ntn, nk = K / 128;
  const int lrow = tid >> 4, lcc = tid & 15;
  for (int t0 = blockIdx.x; t0 < ntiles; t0 += gridDim.x) {
    int tile = t0;
    if (ntiles == 256 && gridDim.x == 256) { const int x = t0 & 7, idx = t0 >> 3; tile = (4 * (x >> 1) + (idx >> 3)) * 16 + 8 * (x & 1) + (idx & 7); }
    const int tm = tile / ntn, tn = tile % ntn;
    const bf16_t* Ab = A + (size_t)(tm * 64 + lrow) * K + 8 * lcc; const bf16_t* Bb = Bt + (size_t)(tn * 64 + lrow) * K + 8 * lcc;
    const size_t r32 = (size_t)32 * K;
    u32x4 ra0, ra1, rb0, rb1, sa0, sa1, sb0, sb1;
#define CG_LOAD(x0, x1, y0, y1, kt_) do { const int ko_ = (kt_) * 128; x0 = *(const u32x4*)(Ab + ko_); x1 = *(const u32x4*)(Ab + r32 + ko_); y0 = *(const u32x4*)(Bb + ko_); y1 = *(const u32x4*)(Bb + r32 + ko_); } while (0)
#define CG_STORE(x0, x1, y0, y1, bufi) do { LAS bf16_t* dA_ = (LAS bf16_t*)(lds + (bufi) * 2 * TILEB); LAS bf16_t* dB_ = (LAS bf16_t*)(lds + (bufi) * 2 * TILEB + TILEB); \
    *(LAS u32x4*)(dA_ + lrow * LDT + 8 * lcc) = x0; *(LAS u32x4*)(dA_ + (lrow + 32) * LDT + 8 * lcc) = x1; *(LAS u32x4*)(dB_ + lrow * LDT + 8 * lcc) = y0; *(LAS u32x4*)(dB_ + (lrow + 32) * LDT + 8 * lcc) = y1; } while (0)
#define CG_COMPUTE(bufi) do { const LAS bf16_t* sA_ = (const LAS bf16_t*)(lds + (bufi) * 2 * TILEB); const LAS bf16_t* sB_ = (const LAS bf16_t*)(lds + (bufi) * 2 * TILEB + TILEB); \
    _Pragma("unroll") for (int ks = 0; ks < 4; ++ks) { const bf16x8 af = *(const LAS bf16x8*)(sA_ + (16 * wm + fr) * LDT + 32 * ks + 8 * fq); \
      const bf16x8 b0 = *(const LAS bf16x8*)(sB_ + (32 * wn + fr) * LDT + 32 * ks + 8 * fq), b1 = *(const LAS bf16x8*)(sB_ + (32 * wn + 16 + fr) * LDT + 32 * ks + 8 * fq); \
      acc0 = MFMA16(b0, af, acc0); acc1 = MFMA16(b1, af, acc1); } } while (0)
    CG_LOAD(ra0, ra1, rb0, rb1, 0); CG_LOAD(sa0, sa1, sb0, sb1, 1);
    CG_STORE(ra0, ra1, rb0, rb1, 0);
    __syncthreads();
    f32x4 acc0 = {0.f, 0.f, 0.f, 0.f}, acc1 = {0.f, 0.f, 0.f, 0.f};
#pragma unroll 1
    for (int kt = 0; kt < nk; kt += 2) {
      if (kt + 2 < nk) CG_LOAD(ra0, ra1, rb0, rb1, kt + 2);
      CG_COMPUTE(0);
      CG_STORE(sa0, sa1, sb0, sb1, 1);
      __syncthreads();
      if (kt + 3 < nk) CG_LOAD(sa0, sa1, sb0, sb1, kt + 3);
      CG_COMPUTE(1);
      if (kt + 2 < nk) CG_STORE(ra0, ra1, rb0, rb1, 0);
      __syncthreads();
    }
#undef CG_LOAD
#undef CG_STORE
#undef CG_COMPUTE
    const int row = tm * 64 + 16 * wm + fr, col = tn * 64 + 32 * wn + 4 * fq;
    epi(row, col, acc0); epi(row, col + 16, acc1);
  }
}

__global__ void __launch_bounds__(512, 2) fwd_megakernel(Params p) {
  extern __shared__ __attribute__((aligned(16))) unsigned char shm[];
  LAS unsigned char* lds = (LAS unsigned char*)shm;
  cg::grid_group grid = cg::this_grid();
  unsigned char* ws = p.ws;
  const int G = gridDim.x, cblk = blockIdx.x;
  unsigned* cnt = (unsigned*)(ws + OFF_CNT);
  __shared__ unsigned xbw[4];
#define s_item (*(volatile int*)&xbw[2])
  if (threadIdx.x == 0) { xbw[0] = 0u; xbw[1] = 0u; xbw[2] = 0u; xbw[3] = 0u; }
  __syncthreads();
#ifndef TPROBE
#define TPROBE 0
#endif
  unsigned long long tacc = 0ull, tt0 = 0ull;
#define TB(g) do { if (TPROBE == (g) && blockIdx.x == 0) tt0 = __builtin_amdgcn_s_memrealtime(); } while (0)
#define TE(g) do { if (TPROBE == (g) && blockIdx.x == 0) tacc += __builtin_amdgcn_s_memrealtime() - tt0; } while (0)

  TB(5); phase_copy(p); phase_mod(p, lds); phase_a2(p, lds);
  phase_wconv(p, 0, lds, 0, cblk, G); phase_wconv(p, 0, lds, 1, cblk, G);
  grid.sync(); TE(5);
  const XcdBarrier xb = xcd_barrier_post((unsigned*)(ws + OFF_BAR), (volatile LAS unsigned*)xbw);
  for (int l = 0; l < 4; ++l) {
    const bool last = (l == 3);
    const int MR = last ? NLAT : NTOK;
    TB(3); TB(14); if (l > 0) phase_wconv(p, l, lds, 1, cblk, G);
    phase_norm(p, l, p.norm1_g + l * 1024, 0, 1024, NTOK, l == 0);
    if (l == 0) phase_filt_gemm(p, l, lds, cblk, G);
    xcd_barrier(xb); TE(14); TE(3);
    TB(1); TB(6);
    { pg8::Gemm g{(const bf16_t*)(ws + OFF_X), (const bf16_t*)(ws + OFF_X), NTOK, 8448, 1024};
      SchedG1 S; S.init(NTOK, 8448, G, cblk);
      EpiG1 E{(bf16_t*)(ws + OFF_XT), (bf16_t*)(ws + OFF_PB), (float*)(ws + OFF_LR)};
      pg8::gemm_phase<EpiG1, SchedG1, false>(lds, g, S, E, nullptr); }
    xcd_barrier(xb); TE(1); TE(6);
    TB(4); TB(11); phase_gla_prep(p, l, lds);
    if (!last && cblk >= 64) phase_filt_gemm(p, l + 1, lds, cblk - 64, G - 64);
    xcd_barrier(xb); TE(4); TE(11);
    TB(2); TB(7); if (cblk < 32) phase_gla_scan(p, lds); TE(7);
    { LAS cplx* L = (LAS cplx*)lds;
      if (otid() == 0) s_item = (int)atomicAdd(cnt + 2 * l, 1u);
      for (;;) {
        __syncthreads();
        const int it = s_item;
        __syncthreads();
        if (it >= 1024) break;
        if (otid() == 0) s_item = (int)atomicAdd(cnt + 2 * l, 1u);
        hyena_chan<HY_NV>(p, l, __builtin_amdgcn_readfirstlane(it), L, otid());
      }
      if (!last) for (;;) {
        if (otid() == 0) s_item = (int)atomicAdd(cnt + 2 * l + 1, 1u);
        __syncthreads();
        const int it = s_item;
        __syncthreads();
        if (it >= 1024) break;
        hyena_ctx_item(p, l, it, lds);
      } }
    xcd_barrier(xb);
    TE(2);
    TB(4); TB(12); phase_post(p, l, MR, lds);
    xcd_barrier(xb); TE(4); TE(12);
    TB(1); TB(8);
    { pg8::StaticOrder S; S.init(NLAT, 1024, G, cblk);
      const bf16_t* PBc = (const bf16_t*)(ws + OFF_PB); bf16_t* T1 = (bf16_t*)(ws + OFF_KEF); bf16_t* MGp = (bf16_t*)(ws + OFF_XT + (size_t)3072 * NTOK * 2);
      EpiGate<0> E0{PBc, T1, nullptr};
      pg8::Gemm g0{(const bf16_t*)(ws + OFF_QF), (const bf16_t*)(ws + OFF_WBHY), NLAT, 1024, 1024};
      pg8::gemm_phase<EpiGate<0>, pg8::StaticOrder, false>(lds, g0, S, E0, nullptr);
      EpiGate<1> E1{PBc, T1, MGp};
      pg8::Gemm g1{(const bf16_t*)(ws + OFF_X), (const bf16_t*)(ws + OFF_WBGLA), NLAT, 1024, 1024};
      pg8::gemm_phase<EpiGate<1>, pg8::StaticOrder, false>(lds, g1, S, E1, nullptr);
      if (!last) {
        ctx_gemm((const bf16_t*)(ws + OFF_QF) + (size_t)NLAT * 1024, (const bf16_t*)(ws + OFF_WBHY), 1024, 1024, lds, [&](int r, int c, f32x4 v) {
          const size_t row = (size_t)NLAT + r; const u32x2 gt = *(const u32x2*)(PBc + row * 4096 + 2048 + c);
          *(u32x2*)(T1 + row * 1024 + c) = (u32x2){pk2(v[0] * sigm(bflo(gt[0])), v[1] * sigm(bfhi(gt[0]))), pk2(v[2] * sigm(bflo(gt[1])), v[3] * sigm(bfhi(gt[1])))}; });
        ctx_gemm((const bf16_t*)(ws + OFF_X) + (size_t)NLAT * 1024, (const bf16_t*)(ws + OFF_WBGLA), 1024, 1024, lds, [&](int r, int c, f32x4 v) {
          const size_t row = (size_t)NLAT + r; const u32x2 gt = *(const u32x2*)(PBc + row * 4096 + 3072 + c); const u32x2 t1 = *(const u32x2*)(T1 + row * 1024 + c);
          *(u32x2*)(MGp + row * 1024 + c) = (u32x2){pk2(bflo(t1[0]) + v[0] * sigm(bflo(gt[0])), bfhi(t1[0]) + v[1] * sigm(bfhi(gt[0]))), pk2(bflo(t1[1]) + v[2] * sigm(bflo(gt[1])), bfhi(t1[1]) + v[3] * sigm(bfhi(gt[1])))}; });
      } }
    xcd_barrier(xb); TE(8);
    { pg8::StaticOrder S; S.init(NLAT, 1024, G, cblk);
      EpiRes E{p.out, (float*)(ws + OFF_CTXS), modp(p, l, 0), 2048, l == 0 ? p.x : p.out, l == 0 ? p.ctx : (const float*)(ws + OFF_CTXS)};
      pg8::Gemm g{(const bf16_t*)(ws + OFF_XT + (size_t)3072 * NTOK * 2), (const bf16_t*)(ws + OFF_WOUT), NLAT, 1024, 1024};
      pg8::gemm_phase<EpiRes, pg8::StaticOrder, false>(lds, g, S, E, nullptr);
      if (!last) { float* cs = (float*)(ws + OFF_CTXS); const float* gv = modp(p, l, 4) + 2048; const float* csrc = l == 0 ? p.ctx : (const float*)cs;
        ctx_gemm((const bf16_t*)(ws + OFF_XT + (size_t)3072 * NTOK * 2) + (size_t)NLAT * 1024, (const bf16_t*)(ws + OFF_WOUT), 1024, 1024, lds, [&](int r, int c, f32x4 v) {
          *(f32x4*)(cs + (size_t)r * 1024 + c) = *(const f32x4*)(csrc + (size_t)r * 1024 + c) + *(const f32x4*)(gv + c) * v; }); } }
    xcd_barrier(xb); TE(1);
    TB(4); TB(13); phase_norm(p, l, p.norm2_g + l * 1024, 3072, 4096, MR, false);
    xcd_barrier(xb); TE(4); TE(13);
    if (TPROBE == 20) { for (int q = 0; q < 8; ++q) xcd_barrier(xb); }
    TB(1); TB(9);
    { pg8::StaticOrder S; S.init(MR, 4096, G, cblk);
      EpiRelu2 E{(bf16_t*)(ws + OFF_PB)};
      pg8::Gemm g{(const bf16_t*)(ws + OFF_X), (const bf16_t*)(ws + OFF_W1), MR, 4096, 1024};
      pg8::gemm_phase<EpiRelu2, pg8::StaticOrder, false>(lds, g, S, E, nullptr);
      if (!last && cblk >= 64) phase_wconv(p, l + 1, lds, 0, cblk - 64, G - 64); }
    xcd_barrier(xb); TE(9); TB(10);
    { pg8::StaticOrder S; S.init(NLAT, 1024, G, cblk);
      EpiRes E{p.out, (float*)(ws + OFF_CTXS), modp(p, l, 0), 5120, p.out, (const float*)(ws + OFF_CTXS)};
      pg8::Gemm g{(const bf16_t*)(ws + OFF_PB), (const bf16_t*)(ws + OFF_W2), NLAT, 1024, 4096};
      pg8::gemm_phase<EpiRes, pg8::StaticOrder, false>(lds, g, S, E, nullptr);
      if (!last) { float* cs = (float*)(ws + OFF_CTXS); const float* gv = modp(p, l, 4) + 5120;
        ctx_gemm((const bf16_t*)(ws + OFF_PB) + (size_t)NLAT * 4096, (const bf16_t*)(ws + OFF_W2), 4096, 1024, lds, [&](int r, int c, f32x4 v) {
          f32x4* q = (f32x4*)(cs + (size_t)r * 1024 + c); *q = *q + *(const f32x4*)(gv + c) * v; }); } }
    xcd_barrier(xb); TE(1); TE(10);
  }
  phase_final_norm(p);
  if (TPROBE && TPROBE != 20 && blockIdx.x == 0) { const unsigned long long s0 = __builtin_amdgcn_s_memrealtime(); while (__builtin_amdgcn_s_memrealtime() - s0 < tacc) __builtin_amdgcn_s_sleep(8); }
}

#ifndef HY_NV
#define HY_NV 2
#endif
constexpr size_t DYN_LDS = 2 * FFT_REGION_F2 * 8 + 11 * 512 * 4;

extern "C" void kernel_launch(void* const* d_in, const int* in_sizes, int n_in, void* d_out, int out_size, void* d_ws, size_t ws_size, hipStream_t stream) {
  if (ws_size < WS_TOTAL || n_in < 28) return;
  static int grid_blocks = 0;
  if (!grid_blocks) {
    int dev = 0, cus = 0, per_cu = 0;
    hipGetDevice(&dev);
    hipDeviceGetAttribute(&cus, hipDeviceAttributeMultiprocessorCount, dev);
    hipFuncSetAttribute((const void*)fwd_megakernel, hipFuncAttributeMaxDynamicSharedMemorySize, (int)DYN_LDS);
    hipOccupancyMaxActiveBlocksPerMultiprocessor(&per_cu, fwd_megakernel, 512, DYN_LDS);
    if (per_cu < 1) per_cu = 1;
    grid_blocks = cus * 1;
  }
  Params p{};
  const float** pp = (const float**)&p;
  for (int i = 0; i < 28; ++i) pp[i] = (const float*)d_in[i];
  p.out = (float*)d_out; p.ws = (unsigned char*)d_ws;
  void* args[] = {&p};
  hipLaunchCooperativeKernel((const void*)fwd_megakernel, dim3(grid_blocks), dim3(512), args, DYN_LDS, stream);
}
```

```cpp
#include <hip/hip_runtime.h>
#include <hip/hip_cooperative_groups.h>
namespace cg = cooperative_groups;
#define DI __device__ __forceinline__

__device__ __forceinline__ int otid() { int t = threadIdx.x; asm volatile("" : "+v"(t)); return t; }
namespace pg8 {
#define PG8_LAS __attribute__((address_space(3)))
typedef unsigned short bf16_t;
typedef short bf16x8 __attribute__((ext_vector_type(8)));
typedef float f32x4 __attribute__((ext_vector_type(4)));
typedef unsigned u32x4 __attribute__((ext_vector_type(4)));
constexpr int BM = 256, BK = 64, HALF = 128, HTB = HALF * BK * 2  , STAGE_BYTES = 8 * HTB, NXCD = 8, WGM = 8;

__host__ __device__ __forceinline__ int lds_byte(int r, int c) { const int st = (r >> 4) * 2 + (c >> 5), rr = r & 15, cc = c & 31, ob = rr * 64 + cc * 2; return st * 1024 + (ob ^ (((ob >> 9) & 1) << 5)); }
__host__ __device__ __forceinline__ void stage_rc(int b, int& R, int& C) { const int st = b / 1024, sb = b % 1024, swz = sb ^ (((sb >> 9) & 1) << 5); R = (st >> 1) * 16 + swz / 64; C = (st & 1) * 32 + (swz % 64) / 2; }
__host__ __device__ __forceinline__ int perm32(int rho) { const int n = rho >> 4, i = rho & 15; return 8 * (i >> 2) + 4 * n + (i & 3); }

struct Unit { int pm, pn; };
struct Gemm { const bf16_t* A; const bf16_t* Bt; int M, N, K; };
struct StaticOrder {
    int nM, nN, nwg, G, c;
    __host__ __device__ void init(int M, int N, int G_, int c_) { nM = M / BM; nN = N / BM; nwg = nM * nN; G = G_; c = c_; }
    __host__ __device__ bool next(int i, Unit& u) const {
        const long L = (long)i * G + c; if (L >= nwg) return false;
        int wgid = (int)L; { const int q = nwg / NXCD, r = nwg % NXCD, xcd = wgid % NXCD, off = wgid / NXCD; wgid = (xcd < r ? xcd * (q + 1) : r * (q + 1) + (xcd - r) * q) + off; }
        const int nig = WGM * nN, gid = wgid / nig, fm = gid * WGM, gsz = (nM - fm) < WGM ? (nM - fm) : WGM;
        u.pm = fm + ((wgid % nig) % gsz); u.pn = (wgid % nig) / gsz; return true;
    }
    __device__ __forceinline__ void a_ready(const Unit&) const {}
    __device__ __forceinline__ void done(const Unit&) const {}
};
__device__ __forceinline__ unsigned cvt_pk_bf16(float lo, float hi) { unsigned r; asm volatile("v_cvt_pk_bf16_f32 %0, %1, %2" : "=v"(r) : "v"(lo), "v"(hi)); return r; }
template <class Epi, class Sched, bool STAMP = false>
__device__ __forceinline__ void gemm_phase(PG8_LAS unsigned char* lds, const Gemm g, const Sched& S, const Epi& E, unsigned long long* stamps) {
    const int tid = otid(), wid = __builtin_amdgcn_readfirstlane(tid >> 6), lane = tid & 63, wr = wid >> 2, wc = wid & 3, fr = lane & 15, fq = lane >> 4;
    const int K = g.K, nt = K / BK;
    int ts_lo = 0, ts_hi = 0, nts = 0; const unsigned long long rt_entry = STAMP ? (unsigned long long)wall_clock64() : 0ull;
#define PG8_STAMP() do { if (STAMP && wid == 0 && nts < 64) { const unsigned long long _c = (unsigned long long)clock64(); \
        ts_lo = (lane == nts) ? (int)(unsigned)_c : ts_lo; ts_hi = (lane == nts) ? (int)(unsigned)(_c >> 32) : ts_hi; ++nts; } } while (0)
    PG8_STAMP();
    unsigned voffA[2], voffB[2];
#pragma unroll
    for (int i = 0; i < 2; ++i) { int R, C; stage_rc(tid * 16 + i * 8192, R, C); const int Rb = Epi::PERM ? ((R & ~31) + perm32(R & 31)) : R;
        voffA[i] = (unsigned)(R * K + C) * 2u; voffB[i] = (unsigned)(Rb * K + C) * 2u; }
    const size_t kstep = (size_t)(BK * 2);
    const size_t hstep = (size_t)HALF * K * 2;
    const size_t tstep = 2 * hstep;
    const unsigned ldsw = (unsigned)wid * 1024u;
    const int aoff = lds_byte(wr * 64 + fr, fq * 8), boff = lds_byte(wc * 32 + fr, fq * 8);
#define PG8_SA(b, h) (((b) * 2 + (h)) * HTB)
#define PG8_SB(b, h) ((4 + (b) * 2 + (h)) * HTB)
#define PG8_STAGE(bufoff, gbase, voff) do { _Pragma("unroll") for (int _i = 0; _i < 2; ++_i) \
        __builtin_amdgcn_global_load_lds((const unsigned*)((const char*)(gbase) + (voff)[_i]), (PG8_LAS unsigned*)(lds + (bufoff) + ldsw + _i * 8192), 16, 0, 0); } while (0)
#define PG8_LDA(dst, b, h) do { _Pragma("unroll") for (int m = 0; m < 4; ++m) _Pragma("unroll") for (int k = 0; k < 2; ++k) dst[m][k] = *(const PG8_LAS bf16x8*)(lds + PG8_SA(b, h) + aoff + m * 2048 + k * 1024); } while (0)
#define PG8_LDB(dst, b, h) do { _Pragma("unroll") for (int n = 0; n < 2; ++n) _Pragma("unroll") for (int k = 0; k < 2; ++k) dst[n][k] = *(const PG8_LAS bf16x8*)(lds + PG8_SB(b, h) + boff + n * 2048 + k * 1024); } while (0)
#define PG8_MMA(ai, bj, At, Bt) do { __builtin_amdgcn_s_setprio(1); _Pragma("unroll") for (int m = 0; m < 4; ++m) _Pragma("unroll") for (int n = 0; n < 2; ++n) _Pragma("unroll") for (int k = 0; k < 2; ++k) \
        acc[ai][bj][m][n] = __builtin_amdgcn_mfma_f32_16x16x32_bf16(Bt[n][k], At[m][k], acc[ai][bj][m][n], 0, 0, 0); __builtin_amdgcn_s_setprio(0); } while (0)
#define PG8_WAIT_V(n) asm volatile("s_waitcnt vmcnt(" #n ")" ::: "memory")
#define PG8_WAIT_L(n) asm volatile("s_waitcnt lgkmcnt(" #n ")" ::: "memory")
#define PG8_BAR __builtin_amdgcn_s_barrier()
#define PG8_SCHED __builtin_amdgcn_sched_barrier(0)
    Unit cur, nxt; int ui = 0;
    if (!S.next(0, cur)) return;
    f32x4 acc[2][2][4][2];
#pragma unroll
    for (int a = 0; a < 2; ++a)
#pragma unroll
        for (int b = 0; b < 2; ++b)
#pragma unroll
            for (int m = 0; m < 4; ++m)
#pragma unroll
                for (int n = 0; n < 2; ++n) acc[a][b][m][n] = (f32x4){0.f, 0.f, 0.f, 0.f};
    bf16x8 At[4][2], B0[2][2], B1[2][2];
    const char* cA = (const char*)g.A + (size_t)cur.pm * tstep; const char* cB = (const char*)g.Bt + (size_t)cur.pn * tstep;
    S.a_ready(cur);
    PG8_STAGE(PG8_SB(0, 0), cB, voffB); PG8_STAGE(PG8_SA(0, 0), cA, voffA); PG8_STAGE(PG8_SB(0, 1), cB + hstep, voffB); PG8_STAGE(PG8_SA(0, 1), cA + hstep, voffA);
    if (wr == 1) PG8_BAR;
    PG8_WAIT_V(4); PG8_BAR;
    PG8_STAGE(PG8_SB(1, 0), cB + kstep, voffB); PG8_STAGE(PG8_SA(1, 0), cA + kstep, voffA); PG8_STAGE(PG8_SB(1, 1), cB + hstep + kstep, voffB);
    PG8_WAIT_V(6); PG8_BAR;
    PG8_STAMP();
    for (;;) {
        const bool has_next = S.next(ui + 1, nxt);
        const char* nA = has_next ? (const char*)g.A + (size_t)nxt.pm * tstep : cA; const char* nB = has_next ? (const char*)g.Bt + (size_t)nxt.pn * tstep : cB;
        for (int t = 0; t < nt; t += 2) {
            const bool last = (t == nt - 2);
            const char* a1 = cA + (size_t)(t + 1) * kstep;
            const char* a2 = last ? nA : cA + (size_t)(t + 2) * kstep; const char* b2 = last ? nB : cB + (size_t)(t + 2) * kstep;
            const char* a3 = a2 + kstep; const char* b3 = b2 + kstep;
            if (last && has_next) S.a_ready(nxt);
            PG8_LDB(B0, 0, 0); PG8_SCHED; PG8_LDA(At, 0, 0); PG8_STAGE(PG8_SA(1, 1), a1 + hstep, voffA);
            PG8_WAIT_L(8); PG8_BAR; PG8_WAIT_L(0); PG8_MMA(0, 0, At, B0); PG8_BAR; PG8_SCHED;
            PG8_LDB(B1, 0, 1); PG8_STAGE(PG8_SB(0, 0), b2, voffB);
            PG8_BAR; PG8_WAIT_L(0); PG8_MMA(0, 1, At, B1); PG8_BAR;
            PG8_LDA(At, 0, 1); PG8_STAGE(PG8_SA(0, 0), a2, voffA);
            PG8_BAR; PG8_WAIT_L(0); PG8_MMA(1, 0, At, B0); PG8_BAR; PG8_SCHED;
            PG8_STAGE(PG8_SB(0, 1), b2 + hstep, voffB);
            PG8_WAIT_V(6); PG8_BAR; PG8_MMA(1, 1, At, B1); PG8_BAR;
            PG8_LDB(B0, 1, 0); PG8_SCHED; PG8_LDA(At, 1, 0); PG8_STAGE(PG8_SA(0, 1), a2 + hstep, voffA);
            PG8_WAIT_L(8); PG8_BAR; PG8_WAIT_L(0); PG8_MMA(0, 0, At, B0); PG8_BAR; PG8_SCHED;
            PG8_LDB(B1, 1, 1); PG8_STAGE(PG8_SB(1, 0), b3, voffB);
            PG8_BAR; PG8_WAIT_L(0); PG8_MMA(0, 1, At, B1); PG8_BAR;
            PG8_LDA(At, 1, 1); PG8_STAGE(PG8_SA(1, 0), a3, voffA);
            PG8_BAR; PG8_WAIT_L(0); PG8_MMA(1, 0, At, B0); PG8_BAR; PG8_SCHED;
            PG8_STAGE(PG8_SB(1, 1), b3 + hstep, voffB);
            PG8_WAIT_V(6); PG8_BAR; PG8_MMA(1, 1, At, B1); PG8_BAR;
        }
        PG8_STAMP();
        if constexpr (!Epi::AFTER_DRAIN) { E(acc, cur, wr, wc, fr, fq); S.done(cur); }
        PG8_STAMP();
        if (!has_next) break;
#pragma unroll
        for (int a = 0; a < 2; ++a)
#pragma unroll
            for (int b = 0; b < 2; ++b)
#pragma unroll
                for (int m = 0; m < 4; ++m)
#pragma unroll
                    for (int n = 0; n < 2; ++n) acc[a][b][m][n] = (f32x4){0.f, 0.f, 0.f, 0.f};
        cur = nxt; cA = nA; cB = nB; ++ui;
    }
    PG8_WAIT_V(0);
    if (wr == 0) PG8_BAR;
    PG8_BAR;
    if constexpr (Epi::AFTER_DRAIN) { E.fused(acc, cur, wr, wc, fr, fq, lds, wid, lane); S.done(cur); }
    PG8_STAMP();
    if (STAMP && wid == 0) { stamps[lane] = lane < nts ? (((unsigned long long)(unsigned)ts_hi << 32) | (unsigned)ts_lo) : 0ull;
        if (lane == 62) stamps[62] = rt_entry; if (lane == 63) stamps[63] = (unsigned long long)wall_clock64(); }
#undef PG8_STAMP
#undef PG8_SA
#undef PG8_SB
#undef PG8_STAGE
#undef PG8_LDA
#undef PG8_LDB
#undef PG8_MMA
#undef PG8_WAIT_V
#undef PG8_WAIT_L
#undef PG8_BAR
#undef PG8_SCHED
}
}

using pg8::bf16_t; using pg8::bf16x8; using pg8::f32x4; using pg8::u32x4;
typedef float f32x16 __attribute__((ext_vector_type(16)));
typedef _Float16 h16x2 __attribute__((ext_vector_type(2)));
typedef unsigned u32x2 __attribute__((ext_vector_type(2)));
#define LAS __attribute__((address_space(3)))

constexpr int NTOK = 17408, NLAT = 16384, DM = 1024, NTH = 512;
constexpr float EPSF = 1e-6f;
constexpr float HSCALE = 64.f;

constexpr size_t SZ_H = (size_t)NTOK * 1024 * 2;
constexpr size_t OFF_X = 0;
constexpr size_t OFF_WIN = OFF_X + SZ_H;
constexpr size_t OFF_WBHY = OFF_WIN + (size_t)8448 * 1024 * 2;
constexpr size_t OFF_WBGLA = OFF_WBHY + 2097152;
constexpr size_t OFF_WOUT = OFF_WBGLA + 2097152;
constexpr size_t OFF_W1 = OFF_WOUT + 2097152;
constexpr size_t OFF_W2 = OFF_W1 + 8388608;
constexpr size_t OFF_XT = OFF_W2 + 8388608;
constexpr size_t SZ_XT = (size_t)4096 * NTOK * 2;
constexpr size_t OFF_PB = OFF_XT + SZ_XT;
constexpr size_t OFF_LR = OFF_PB + SZ_XT;
constexpr size_t OFF_QF = OFF_LR + (size_t)NTOK * 32 * 4;
constexpr size_t SZ_Q = (size_t)NTOK * 512 * 2;
constexpr size_t OFF_QB = OFF_QF + SZ_Q;
constexpr size_t OFF_KEF = OFF_QB + SZ_Q;
constexpr size_t OFF_KEB = OFF_KEF + SZ_Q;
constexpr size_t OFF_ATT = OFF_KEB + SZ_Q;
constexpr size_t OFF_DEC = OFF_ATT + SZ_Q;
constexpr size_t OFF_HP = OFF_DEC + (size_t)272 * 4 * 2 * 128 * 4;
constexpr size_t OFF_CTXS = OFF_HP + (size_t)1024 * 8192 * 4;
constexpr size_t OFF_MOD = OFF_CTXS + 4194304;
constexpr size_t OFF_A2L = OFF_MOD + 491520;
constexpr size_t OFF_A2C = OFF_A2L + 4194304;
constexpr size_t OFF_HTC = OFF_A2C + 262144;
constexpr size_t OFF_HP2 = OFF_HTC + 2097152;
constexpr size_t OFF_HTC2 = OFF_HP2 + (size_t)1024 * 8192 * 4;
constexpr size_t OFF_CNT = OFF_HTC2 + 2097152;
constexpr size_t OFF_BAR = OFF_CNT + 1024;
constexpr size_t WS_TOTAL = OFF_BAR + 16384;

struct Params {
  const float *x, *c, *ctx, *c_ctx, *ada_w, *ada_b, *norm1_g, *norm2_g, *w_in, *conv_w, *conv_b, *fw1, *fb1, *fw2, *fb2, *fw3, *ffreq,
      *decay, *skip, *gate_w, *gate_b, *gla_ng, *w_bhy, *w_bgla, *w_out, *mlp_w1, *mlp_w2, *final_g;
  float* out; unsigned char* ws;
};

typedef float f32x2_t __attribute__((ext_vector_type(2)));
typedef __bf16 bf16x2_t __attribute__((ext_vector_type(2)));
DI bf16_t f2bf(float f) { const __bf16 b = (__bf16)f; return __builtin_bit_cast(bf16_t, b); }
DI float bf2f(bf16_t b) { return __uint_as_float(((unsigned)b) << 16); }
DI unsigned pk2(float lo, float hi) { f32x2_t v; v.x = lo; v.y = hi; const bf16x2_t b = __builtin_convertvector(v, bf16x2_t); return __builtin_bit_cast(unsigned, b); }
DI float bflo(unsigned w) { return __uint_as_float(w << 16); }
DI float bfhi(unsigned w) { return __uint_as_float(w & 0xffff0000u); }
DI float sigm(float x) { return __builtin_amdgcn_rcpf(1.f + __expf(-x)); }
DI float my_sin(float x) { float r = x * 0.15915494309189535f; r -= rintf(r); return __builtin_amdgcn_sinf(r); }
DI float wave_sum(float v) {
#pragma unroll
  for (int o = 32; o >= 1; o >>= 1) v += __shfl_xor(v, o);
  return v;
}
DI float* xrow(const Params& p, int row) { return row < NLAT ? p.out + (size_t)row * DM : (float*)(p.ws + OFF_CTXS) + (size_t)(row - NLAT) * DM; }
DI const float* xrow_in(const Params& p, int row) { return row < NLAT ? p.x + (size_t)row * DM : p.ctx + (size_t)(row - NLAT) * DM; }
DI const float* modp(const Params& p, int l, int s) { return (const float*)(p.ws + OFF_MOD) + ((size_t)l * 5 + s) * 6144; }

DI void phase_copy(const Params& p) {
  if (blockIdx.x == 0) { unsigned* z = (unsigned*)(p.ws + OFF_CNT); for (int i = otid(); i < (1024 + 16384) / 4; i += NTH) z[i] = 0u; }
}

DI void phase_mod(const Params& p, LAS unsigned char* lds) {
  LAS float* sv = (LAS float*)lds;
  LAS float* red = sv + 5 * 1024;
  const int tid = otid();
  bool loaded = false;
  for (int it = blockIdx.x; it < 4 * 48; it += gridDim.x) {
    if (!loaded) {
      for (int i = tid; i < 5 * 1024; i += NTH) { const int s = i >> 10, k = i & 1023; const float v = s < 4 ? p.c[s * 1024 + k] : p.c_ctx[k]; sv[i] = v * sigm(v); }
      loaded = true;
    }
    __syncthreads();
    const int l = it / 48, cb = it % 48, cg4 = tid & 31, kq = tid >> 5;
    const float* W = p.ada_w + (size_t)l * 1024 * 6144 + cb * 128 + 4 * cg4;
    f32x4 a0 = {0.f, 0.f, 0.f, 0.f}, a1 = a0, a2 = a0, a3 = a0, a4 = a0;
#pragma unroll 8
    for (int k = kq * 64; k < kq * 64 + 64; ++k) { const f32x4 w = __builtin_nontemporal_load((const f32x4*)(W + (size_t)k * 6144)); a0 += w * sv[k]; a1 += w * sv[1024 + k]; a2 += w * sv[2048 + k]; a3 += w * sv[3072 + k]; a4 += w * sv[4096 + k]; }
    LAS float* r = red + kq * 5 * 128 + 4 * cg4;
    *(LAS f32x4*)(r) = a0; *(LAS f32x4*)(r + 128) = a1; *(LAS f32x4*)(r + 256) = a2; *(LAS f32x4*)(r + 384) = a3; *(LAS f32x4*)(r + 512) = a4;
    __syncthreads();
    if (tid < 128) {
      const int col = cb * 128 + tid;
      const float bias = p.ada_b[l * 6144 + col];
      float* mo = (float*)(p.ws + OFF_MOD) + (size_t)l * 5 * 6144 + col;
#pragma unroll
      for (int s = 0; s < 5; ++s) { float t = bias;
#pragma unroll
        for (int q = 0; q < 16; ++q) t += red[q * 5 * 128 + s * 128 + tid]; mo[(size_t)s * 6144] = t; }
    }
    __syncthreads();
  }
}

DI void phase_a2(const Params& p, LAS unsigned char* lds) {
  LAS float* zf = (LAS float*)lds;
  LAS float* a1s = zf + 64 * 36;
  const int tid = otid(), tl = tid >> 6, m = tid & 63;
  const int per = (4096 + 256) / 64;
  for (int it = blockIdx.x; it < 4 * per; it += gridDim.x) {
    const int l = it / per, r = it % per;
    const bool isc = r >= 64; const int Lq = isc ? 256 : 4096; const int i0 = (isc ? (r - 64) : r) * 64;
    for (int e = tid; e < 64 * 33; e += NTH) {
      const int tt = e / 33, f = e % 33, i = i0 + tt; float v;
      if (f == 0) v = (float)i / (float)(Lq - 1);
      else { const int j = (f - 1) & 15; const float band = 1e-4f + (float)j * ((15.f - 1e-4f) / 15.f); float rev = (float)i * band / (float)Lq; rev -= floorf(rev);
             v = (f <= 16) ? __builtin_amdgcn_cosf(rev) : -__builtin_amdgcn_sinf(rev); }
      zf[tt * 36 + f] = v;
    }
    const float fr = p.ffreq[l * 64 + m], b1v = p.fb1[l * 64 + m], b2v = p.fb2[l * 64 + m];
    float w1r[33];
#pragma unroll
    for (int f = 0; f < 33; ++f) w1r[f] = p.fw1[((size_t)l * 33 + f) * 64 + m];
    __syncthreads();
#pragma unroll 1
    for (int q = 0; q < 8; ++q) { const int tt = tl * 8 + q; float acc = b1v;
#pragma unroll
      for (int f = 0; f < 33; ++f) acc += zf[tt * 36 + f] * w1r[f];
      a1s[tt * 64 + m] = my_sin(fr * acc); }
    float w2r[64];
#pragma unroll
    for (int j = 0; j < 64; ++j) w2r[j] = p.fw2[((size_t)l * 64 + j) * 64 + m];
    __syncthreads();
    float* dst = isc ? (float*)(p.ws + OFF_A2C) + ((size_t)l * 256 + i0) * 64 : (float*)(p.ws + OFF_A2L) + ((size_t)l * 4096 + i0) * 64;
#pragma unroll 1
    for (int q = 0; q < 8; ++q) { const int tt = tl * 8 + q; float acc = b2v;
#pragma unroll
      for (int j4 = 0; j4 < 16; ++j4) { const f32x4 a = *(const LAS f32x4*)(a1s + tt * 64 + 4 * j4); acc += a.x * w2r[4 * j4] + a.y * w2r[4 * j4 + 1] + a.z * w2r[4 * j4 + 2] + a.w * w2r[4 * j4 + 3]; }
      dst[(size_t)tt * 64 + m] = my_sin(fr * acc); }
    __syncthreads();
  }
}

DI void wt_load(const float* src, int ld_src, int k0, int n0, f32x4 (&v)[2]) {
  const int tid = otid();
#pragma unroll
  for (int q = 0; q < 2; ++q) { const int kk = (tid >> 3) + 64 * q, nq = tid & 7; v[q] = __builtin_nontemporal_load((const f32x4*)(src + (size_t)(k0 + kk) * ld_src + n0 + 4 * nq)); }
}
DI void wt_store(const f32x4 (&v)[2], int k0, bf16_t* dst, int ld_dst, int drow0, LAS unsigned char* lds) {
  LAS bf16_t* t = (LAS bf16_t*)lds;
  const int tid = otid();
#pragma unroll
  for (int q = 0; q < 2; ++q) {
    const int kk = (tid >> 3) + 64 * q, nq = tid & 7;
    t[(4 * nq + 0) * 136 + kk] = f2bf(v[q].x); t[(4 * nq + 1) * 136 + kk] = f2bf(v[q].y); t[(4 * nq + 2) * 136 + kk] = f2bf(v[q].z); t[(4 * nq + 3) * 136 + kk] = f2bf(v[q].w);
  }
  __syncthreads();
  { const int n = tid >> 4, kq = tid & 15;
    const u32x4 o = *(const LAS u32x4*)(t + n * 136 + 8 * kq);
    *(u32x4*)(dst + (size_t)(drow0 + n) * ld_dst + k0 + 8 * kq) = o; }
  __syncthreads();
}
DI int win_dst_row(int n) {
  if (n < 3072) return n;
  if (n < 4096) return 4096 + (n - 3072);
  if (n < 5120) return 3072 + (n - 4096);
  if (n < 6144) return 4096 + 1024 + (n - 5120);
  if (n < 6176) return 8192 + (n - 6144);
  if (n < 7200) return 4096 + 2048 + (n - 6176);
  return 4096 + 3072 + (n - 7200);
}
struct WtItem { const float* src; int ld_src, k0, n0; bf16_t* dst; int ld_dst, drow0; };
DI WtItem wt_decode(const Params& p, int l, int part, int it) {
  unsigned char* ws = p.ws; WtItem w;
  const int n_win = 8 * 257, n_sq = 8 * 32, n_w1 = 8 * 128;
  if (part == 0) {
    if (it < n_win) { const int kt = it & 7, nt = it >> 3; w.src = p.w_in + (size_t)l * 1024 * 8224; w.ld_src = 8224; w.k0 = kt * 128; w.n0 = nt * 32; w.dst = (bf16_t*)(ws + OFF_WIN); w.ld_dst = 1024; w.drow0 = win_dst_row(nt * 32); }
    else { const int r = it - n_win, which = r / n_sq, q = r % n_sq, kt = q & 7, nt = q >> 3;
      w.src = (which == 0 ? p.w_bhy : which == 1 ? p.w_bgla : p.w_out) + (size_t)l * 1024 * 1024; w.ld_src = 1024; w.k0 = kt * 128; w.n0 = nt * 32;
      w.dst = (bf16_t*)(ws + (which == 0 ? OFF_WBHY : which == 1 ? OFF_WBGLA : OFF_WOUT)); w.ld_dst = 1024; w.drow0 = nt * 32; }
  } else {
    if (it < n_w1) { const int kt = it & 7, nt = it >> 3; w.src = p.mlp_w1 + (size_t)l * 1024 * 4096; w.ld_src = 4096; w.k0 = kt * 128; w.n0 = nt * 32; w.dst = (bf16_t*)(ws + OFF_W1); w.ld_dst = 1024; w.drow0 = nt * 32; }
    else { const int r = it - n_w1, kt = r & 31, nt = r >> 5; w.src = p.mlp_w2 + (size_t)l * 4096 * 1024; w.ld_src = 1024; w.k0 = kt * 128; w.n0 = nt * 32; w.dst = (bf16_t*)(ws + OFF_W2); w.ld_dst = 4096; w.drow0 = nt * 32; }
  }
  return w;
}
DI void phase_wconv(const Params& p, int l, LAS unsigned char* lds, int part, int blk, int nblk) {
  unsigned char* ws = p.ws;
  const int total = part == 0 ? (8 * 257 + 3 * 8 * 32) : (8 * 128 + 32 * 32);
  f32x4 v[2];
  if (blk < total) { const WtItem w = wt_decode(p, l, part, blk); wt_load(w.src, w.ld_src, w.k0, w.n0, v); }
  for (int it = blk; it < total; it += nblk) {
    const WtItem w = wt_decode(p, l, part, it);
    f32x4 cur[2] = {v[0], v[1]};
    if (it + nblk < total) { const WtItem w2 = wt_decode(p, l, part, it + nblk); wt_load(w2.src, w2.ld_src, w2.k0, w2.n0, v); }
    wt_store(cur, w.k0, w.dst, w.ld_dst, w.drow0, lds);
  }
  if (part == 0) { u32x4* z = (u32x4*)(ws + OFF_WIN + (size_t)8224 * 1024 * 2); const int n = 224 * 1024 * 2 / 16;
    for (int i = blk * NTH + otid(); i < n; i += nblk * NTH) z[i] = (u32x4){0u, 0u, 0u, 0u}; }
}

DI void phase_norm(const Params& p, int l, const float* g, int sh_off, int sc_off, int nrows, bool from_input) {
  const int lane = otid() & 63, gw = blockIdx.x * 8 + (otid() >> 6), nw = gridDim.x * 8;
  bf16_t* hb = (bf16_t*)(p.ws + OFF_X);
  const int rp = (nrows + nw - 1) / nw, r0 = gw * rp, r1 = min(nrows, r0 + rp);
  f32x4 A[4], B[4]; int scur = -1;
  f32x4 pa[4], pb2[4];
#define NORM_LOAD(rw) do { const int ra_ = (rw), rb_ = ((rw) + 1 < r1) ? (rw) + 1 : (rw); const float* xa_ = from_input ? xrow_in(p, ra_) : xrow(p, ra_); const float* xb_ = from_input ? xrow_in(p, rb_) : xrow(p, rb_); \
    _Pragma("unroll") for (int i = 0; i < 4; ++i) { pa[i] = *(const f32x4*)(xa_ + 4 * lane + 256 * i); pb2[i] = *(const f32x4*)(xb_ + 4 * lane + 256 * i); } } while (0)
  if (r0 < r1) NORM_LOAD(r0);
  for (int row = r0; row < r1; row += 2) {
    const bool two = row + 1 < r1;
    const int s = row < NLAT ? (row >> 12) : 4;
    if (s != scur) { scur = s; const float* mo = modp(p, l, s);
#pragma unroll
      for (int i = 0; i < 4; ++i) { const int c = 4 * lane + 256 * i; const f32x4 gg = *(const f32x4*)(g + c), sc = *(const f32x4*)(mo + sc_off + c); A[i] = gg * (sc + 1.f); B[i] = *(const f32x4*)(mo + sh_off + c); } }
    f32x4 va[4], vb[4]; float sa = 0.f, sb = 0.f;
#pragma unroll
    for (int i = 0; i < 4; ++i) { va[i] = pa[i]; vb[i] = pb2[i]; }
    if (row + 2 < r1) NORM_LOAD(row + 2);
#pragma unroll
    for (int i = 0; i < 4; ++i) { sa += va[i].x * va[i].x + va[i].y * va[i].y + va[i].z * va[i].z + va[i].w * va[i].w; sb += vb[i].x * vb[i].x + vb[i].y * vb[i].y + vb[i].z * vb[i].z + vb[i].w * vb[i].w; }
#pragma unroll
    for (int o = 32; o >= 1; o >>= 1) { sa += __shfl_xor(sa, o); sb += __shfl_xor(sb, o); }
    const float ra = rsqrtf(sa * (1.f / 1024.f) + EPSF), rb = rsqrtf(sb * (1.f / 1024.f) + EPSF);
    const int s2 = (row + 1) < NLAT ? ((row + 1) >> 12) : 4;
#pragma unroll
    for (int i = 0; i < 4; ++i) { const int c = 4 * lane + 256 * i; const f32x4 ya = va[i] * ra * A[i] + B[i];
      *(u32x2*)(hb + (size_t)row * 1024 + c) = (u32x2){pk2(ya.x, ya.y), pk2(ya.z, ya.w)}; }
    if (two) {
      if (s2 != scur) { scur = s2; const float* mo = modp(p, l, s2);
#pragma unroll
        for (int i = 0; i < 4; ++i) { const int c = 4 * lane + 256 * i; const f32x4 gg = *(const f32x4*)(g + c), sc = *(const f32x4*)(mo + sc_off + c); A[i] = gg * (sc + 1.f); B[i] = *(const f32x4*)(mo + sh_off + c); } }
#pragma unroll
      for (int i = 0; i < 4; ++i) { const int c = 4 * lane + 256 * i; const f32x4 yb = vb[i] * rb * A[i] + B[i];
        *(u32x2*)(hb + (size_t)(row + 1) * 1024 + c) = (u32x2){pk2(yb.x, yb.y), pk2(yb.z, yb.w)}; }
    }
  }
}
#undef NORM_LOAD
DI void phase_final_norm(const Params& p) {
  const int lane = otid() & 63, gw = blockIdx.x * 8 + (otid() >> 6), nw = gridDim.x * 8;
  for (int row = gw; row < NLAT; row += nw) {
    float* xr = p.out + (size_t)row * DM;
    float4 v[4]; float ss = 0.f;
#pragma unroll
    for (int i = 0; i < 4; ++i) { v[i] = *(const float4*)(xr + 4 * lane + 256 * i); ss += v[i].x * v[i].x + v[i].y * v[i].y + v[i].z * v[i].z + v[i].w * v[i].w; }
    ss = wave_sum(ss);
    const float rstd = rsqrtf(ss * (1.f / 1024.f) + EPSF);
#pragma unroll
    for (int i = 0; i < 4; ++i) { const int c = 4 * lane + 256 * i; const float4 gg = *(const float4*)(p.final_g + c);
      *(float4*)(xr + c) = make_float4(v[i].x * rstd * gg.x, v[i].y * rstd * gg.y, v[i].z * rstd * gg.z, v[i].w * rstd * gg.w); }
  }
}

DI void phase_filt_gemm(const Params& p, int l, LAS unsigned char* lds, int blk, int nblk) {
  LAS float* w3s = (LAS float*)lds;
  LAS float* a2s = w3s + 64 * 64;
  const int tid = otid();
  const int nL = 32 * 32, nC = 32 * 2;
  for (int it = blk; it < nL + nC; it += nblk) {
    const bool isc = it >= nL; const int r = isc ? it - nL : it; const int Lq = isc ? 256 : 4096;
    const int ntt = Lq / 128, dt = r / ntt, tt0 = (r % ntt) * 128, d0 = dt * 64;
    const float* A2 = isc ? (const float*)(p.ws + OFF_A2C) + (size_t)l * 256 * 64 : (const float*)(p.ws + OFF_A2L) + (size_t)l * 4096 * 64;
    float* hT = isc ? (float*)(p.ws + ((l & 1) ? OFF_HTC2 : OFF_HTC)) : (float*)(p.ws + ((l & 1) ? OFF_HP2 : OFF_HP));
    { const int m = tid >> 3, q = tid & 7; const float* s = p.fw3 + ((size_t)l * 64 + m) * 2048 + d0;
      *(LAS f32x4*)(w3s + m * 64 + 4 * q) = *(const f32x4*)(s + 4 * q); *(LAS f32x4*)(w3s + m * 64 + 32 + 4 * q) = *(const f32x4*)(s + 32 + 4 * q); }
    { const int tt = tid >> 2, mq = tid & 3; const float* s = A2 + (size_t)(tt0 + tt) * 64 + 16 * mq;
#pragma unroll
      for (int q = 0; q < 4; ++q) { const float4 v = *(const float4*)(s + 4 * q);
        a2s[(16 * mq + 4 * q + 0) * 132 + tt] = v.x; a2s[(16 * mq + 4 * q + 1) * 132 + tt] = v.y; a2s[(16 * mq + 4 * q + 2) * 132 + tt] = v.z; a2s[(16 * mq + 4 * q + 3) * 132 + tt] = v.w; } }
    __syncthreads();
    const int cx = tid & 15, ty = tid >> 4;
    float acc[4][4];
#pragma unroll
    for (int a = 0; a < 4; ++a)
#pragma unroll
      for (int b = 0; b < 4; ++b) acc[a][b] = 0.f;
#pragma unroll 8
    for (int m = 0; m < 64; ++m) {
      const f32x4 wv = *(const LAS f32x4*)(w3s + m * 64 + 4 * cx), av = *(const LAS f32x4*)(a2s + m * 132 + 4 * ty);
      const float w[4] = {wv.x, wv.y, wv.z, wv.w}, a[4] = {av.x, av.y, av.z, av.w};
#pragma unroll
      for (int ci = 0; ci < 4; ++ci)
#pragma unroll
        for (int ti = 0; ti < 4; ++ti) acc[ci][ti] += w[ci] * a[ti];
    }
    const float inv = 1.f / (float)(Lq - 1);
#pragma unroll
    for (int ci = 0; ci < 4; ++ci) {
      const int dirch = d0 + 4 * cx + ci; const float dc = fabsf(p.decay[l * 1024 + (dirch & 1023)]);
      float o[4];
#pragma unroll
      for (int ti = 0; ti < 4; ++ti) { const float tl = (float)(tt0 + 4 * ty + ti) * inv; o[ti] = acc[ci][ti] * __expf(-tl * dc); }
      *(float4*)(hT + (size_t)dirch * Lq + tt0 + 4 * ty) = make_float4(o[0], o[1], o[2], o[3]);
    }
    __syncthreads();
  }
}
#define XB_TMO      128
#define XB_XCNT(j)  (256  + 64 * (j))
#define XB_XSUB(j)  (1280 + 64 * (j))
#define XB_XGEN(j)  (2304 + 64 * (j))
#define XB_TOP      3328
#define XB_TOPGEN   3392
#define XCD_BAR_WORDS 3456
#define XB_SPIN_CAP (1u << 18)

__device__ __forceinline__ unsigned xb_ld(unsigned* p)              { return __hip_atomic_load(p, __ATOMIC_RELAXED, __HIP_MEMORY_SCOPE_AGENT); }
__device__ __forceinline__ unsigned xb_add(unsigned* p, unsigned v) { return __hip_atomic_fetch_add(p, v, __ATOMIC_RELAXED, __HIP_MEMORY_SCOPE_AGENT); }
__device__ __forceinline__ unsigned xb_xcc_id() { return (unsigned)__builtin_amdgcn_s_getreg((3 << 11) | 20) & 0xFu; }
#define XB_SPIN(cond, bar) do { unsigned _sp = 0; while (cond) { __builtin_amdgcn_s_sleep(1); \
    if ((++_sp & 255u) == 0u) { if (xb_ld(&(bar)[XB_TMO])) break; if (_sp > XB_SPIN_CAP) { atomicAdd(&(bar)[XB_TMO], 1u); break; } } } } while (0)
struct XcdBarrier {
    unsigned* bar; unsigned x;
    volatile LAS unsigned* st;
};

__device__ __forceinline__ XcdBarrier xcd_barrier_post(unsigned* bar, volatile LAS unsigned* st) {
    XcdBarrier b; b.bar = bar; b.x = xb_xcc_id(); b.st = st;
    if (threadIdx.x == 0) (void)xb_add(&bar[XB_XCNT(b.x)], 1u);
    return b;
}
__device__ __forceinline__ void xcd_barrier_complete(unsigned* bar, unsigned x, unsigned& nloc, unsigned& nx) {
    const unsigned G = gridDim.x * gridDim.y * gridDim.z;
    unsigned sum, cnt, mine, sp = 0u;
    for (;;) {
        sum = 0u; cnt = 0u; mine = 0u;
#pragma unroll
        for (unsigned j = 0; j < 16; ++j) { const unsigned c = xb_ld(&bar[XB_XCNT(j)]); sum += c; cnt += (c > 0u) ? 1u : 0u; mine = (j == x) ? c : mine; }
        if (sum == G) break;
        __builtin_amdgcn_s_sleep(1);
        if ((++sp & 255u) == 0u) { if (xb_ld(&bar[XB_TMO])) break; if (sp > XB_SPIN_CAP) { atomicAdd(&bar[XB_TMO], 1u); break; } }
    }
    nloc = mine > 0u ? mine : 1u; nx = cnt > 0u ? cnt : 1u;
}

__device__ __forceinline__ void xcd_barrier(const XcdBarrier& b) {
    asm volatile("s_waitcnt vmcnt(0)" ::: "memory");
    __syncthreads();
    if (threadIdx.x == 0) {
        unsigned* bar = b.bar;
        __builtin_amdgcn_s_waitcnt(0);
        unsigned nloc = b.st[0], nx = b.st[1];
        if (nloc == 0u) { xcd_barrier_complete(bar, b.x, nloc, nx); b.st[0] = nloc; b.st[1] = nx; }
        const unsigned old = xb_add(&bar[XB_XSUB(b.x)], 1u);
        const unsigned gen = old / nloc;
        if (old + 1u == (gen + 1u) * nloc) {
            __builtin_amdgcn_fence(__ATOMIC_RELEASE, "agent");
            asm volatile("s_waitcnt vmcnt(0)" ::: "memory");
            const unsigned og = xb_add(&bar[XB_TOP], 1u);
            const unsigned tg = og / nx;
            if (og + 1u == (tg + 1u) * nx) xb_add(&bar[XB_TOPGEN], 1u);
            else XB_SPIN(xb_ld(&bar[XB_TOPGEN]) == tg, bar);
            __builtin_amdgcn_fence(__ATOMIC_ACQUIRE, "agent");
            xb_add(&bar[XB_XGEN(b.x)], 1u);
            asm volatile("s_waitcnt vmcnt(0)" ::: "memory");
        } else {
            XB_SPIN(xb_ld(&bar[XB_XGEN(b.x)]) == gen, bar);
            __builtin_amdgcn_fence(__ATOMIC_ACQUIRE, "agent");
            asm volatile("s_waitcnt vmcnt(0)" ::: "memory");
        }
    }
    __syncthreads();
}

typedef float cplx __attribute__((ext_vector_type(2)));
DI cplx mk2(float a, float b) { cplx r; r.x = a; r.y = b; return r; }
DI constexpr float cos32(int m) { constexpr float t[16] = {1.f, 0.98078528040323043f, 0.92387953251128674f, 0.83146961230254524f, 0.70710678118654752f, 0.55557023301960218f, 0.38268343236508977f, 0.19509032201612825f,
    0.f, -0.19509032201612825f, -0.38268343236508977f, -0.55557023301960218f, -0.70710678118654752f, -0.83146961230254524f, -0.92387953251128674f, -0.98078528040323043f}; return t[m]; }
DI constexpr float sin32(int m) { constexpr float t[16] = {0.f, 0.19509032201612825f, 0.38268343236508977f, 0.55557023301960218f, 0.70710678118654752f, 0.83146961230254524f, 0.92387953251128674f, 0.98078528040323043f,
    1.f, 0.98078528040323043f, 0.92387953251128674f, 0.83146961230254524f, 0.70710678118654752f, 0.55557023301960218f, 0.38268343236508977f, 0.19509032201612825f}; return t[m]; }
DI constexpr int brev(int k, int bits) { int r = 0; for (int i = 0; i < bits; ++i) r |= ((k >> i) & 1) << (bits - 1 - i); return r; }
DI cplx cmul_c(cplx a, cplx b) { return mk2(a.x * b.x - a.y * b.y, a.x * b.y + a.y * b.x); }
DI cplx cmulc_c(cplx a, cplx b) { return mk2(a.x * b.x + a.y * b.y, a.y * b.x - a.x * b.y); }
DI cplx cmul(cplx a, cplx b) { cplx r; asm("v_pk_mul_f32 %0, %1, %2 op_sel_hi:[1,0]\n\tv_pk_fma_f32 %0, %1, %2, %0 op_sel:[1,1,0] op_sel_hi:[0,1,1] neg_lo:[1,0,0]" : "=&v"(r) : "v"(a), "v"(b)); return r; }
DI cplx cmulc(cplx a, cplx b) { cplx r; asm("v_pk_mul_f32 %0, %1, %2 op_sel_hi:[1,0]\n\tv_pk_fma_f32 %0, %1, %2, %0 op_sel:[1,1,0] op_sel_hi:[0,1,1] neg_hi:[1,0,0]" : "=&v"(r) : "v"(a), "v"(b)); return r; }
DI cplx cmul_s(cplx a, cplx b) { cplx r; asm("v_pk_mul_f32 %0, %1, %2 op_sel_hi:[1,0]\n\tv_pk_fma_f32 %0, %1, %2, %0 op_sel:[1,1,0] op_sel_hi:[0,1,1] neg_lo:[1,0,0]" : "=&v"(r) : "v"(a), "s"(b)); return r; }
DI cplx cmulc_s(cplx a, cplx b) { cplx r; asm("v_pk_mul_f32 %0, %1, %2 op_sel_hi:[1,0]\n\tv_pk_fma_f32 %0, %1, %2, %0 op_sel:[1,1,0] op_sel_hi:[0,1,1] neg_hi:[1,0,0]" : "=&v"(r) : "v"(a), "s"(b)); return r; }
DI cplx mul_mi(cplx a) { cplx r; asm("v_pk_mul_f32 %0, %1, 1.0 op_sel:[1,0] op_sel_hi:[0,0] neg_hi:[1,0]" : "=v"(r) : "v"(a)); return r; }
DI cplx mul_pi(cplx a) { cplx r; asm("v_pk_mul_f32 %0, %1, 1.0 op_sel:[1,0] op_sel_hi:[0,0] neg_lo:[1,0]" : "=v"(r) : "v"(a)); return r; }

template <int R, bool INV> DI void dft_reg(cplx (&v)[R]) {
#pragma unroll
  for (int len = R; len >= 2; len >>= 1) {
    const int half = len >> 1;
#pragma unroll
    for (int s = 0; s < R; s += len) {
#pragma unroll
      for (int j = 0; j < half; ++j) {
        const cplx a = v[s + j], b = v[s + j + half];
        v[s + j] = mk2(a.x + b.x, a.y + b.y);
        const cplx d = mk2(a.x - b.x, a.y - b.y);
        const int m = j * (32 / len);
        if (m == 0) v[s + j + half] = d;
        else if (m == 8) v[s + j + half] = INV ? mul_pi(d) : mul_mi(d);
        else { const cplx K = mk2(cos32(m), sin32(m));
          v[s + j + half] = INV ? cmul_s(d, K) : cmulc_s(d, K); }
      }
    }
  }
}
constexpr int FFT_REGION_F2 = 8704;

template <int NV> DI void fft_fwd3(cplx (&v)[NV][16], LAS cplx* L, int tid) {

#pragma unroll
  for (int i = 0; i < NV; ++i) dft_reg<16, false>(v[i]);

  { float rev = (float)tid * (1.f / 8192.f); asm volatile("" : "+v"(rev)); const cplx w1 = mk2(__builtin_amdgcn_cosf(rev), -__builtin_amdgcn_sinf(rev)); cplx w = mk2(1.f, 0.f);
    const int pb = tid + 2 * (tid >> 5);
#pragma unroll
    for (int k = 0; k < 16; ++k) {
#pragma unroll
      for (int i = 0; i < NV; ++i) L[i * FFT_REGION_F2 + pb + 544 * k] = cmul(v[i][brev(k, 4)], w);
      w = cmul(w, w1); } }
  __syncthreads();
  { const int sb = tid >> 5, ii = tid & 31, pb = 544 * sb + ii;
    cplx u[NV][16];
#pragma unroll
    for (int i = 0; i < NV; ++i)
#pragma unroll
      for (int j = 0; j < 16; ++j) u[i][j] = L[i * FFT_REGION_F2 + pb + 34 * j];

#pragma unroll
    for (int i = 0; i < NV; ++i) dft_reg<16, false>(u[i]);

    float rev = (float)ii * (1.f / 512.f); asm volatile("" : "+v"(rev)); const cplx w1 = mk2(__builtin_amdgcn_cosf(rev), -__builtin_amdgcn_sinf(rev)); cplx w = mk2(1.f, 0.f);
#pragma unroll
    for (int k = 0; k < 16; ++k) {
#pragma unroll
      for (int i = 0; i < NV; ++i) L[i * FFT_REGION_F2 + pb + 34 * k] = cmul(u[i][brev(k, 4)], w);
      w = cmul(w, w1); } }
  __syncthreads();
  { const int sb = tid >> 1, ii = tid & 1, pb = 34 * sb + ii;
    cplx u[NV][16];
#pragma unroll
    for (int i = 0; i < NV; ++i)
#pragma unroll
      for (int j = 0; j < 16; ++j) u[i][j] = L[i * FFT_REGION_F2 + pb + 2 * j];

#pragma unroll
    for (int i = 0; i < NV; ++i) dft_reg<16, false>(u[i]);

#pragma unroll
    for (int k = 0; k < 16; ++k)
#pragma unroll
      for (int i = 0; i < NV; ++i) { const cplx y = u[i][brev(k, 4)]; const cplx yw = cmul_c(y, mk2(cos32(k), -sin32(k))); L[i * FFT_REGION_F2 + pb + 2 * k] = ii ? yw : y; } }
  __syncthreads();
}
template <int NV> DI void fft_inv3(cplx (&v)[NV][16], LAS cplx* L, int tid) {
  { const int sb = tid >> 1, ii = tid & 1, pb = 34 * sb + ii;
    cplx u[NV][16];
#pragma unroll
    for (int i = 0; i < NV; ++i)
#pragma unroll
      for (int k = 0; k < 16; ++k) { const cplx y = L[i * FFT_REGION_F2 + pb + 2 * k]; const cplx yw = cmulc_c(y, mk2(cos32(k), -sin32(k))); u[i][k] = ii ? yw : y; }

#pragma unroll
    for (int i = 0; i < NV; ++i) dft_reg<16, true>(u[i]);

#pragma unroll
    for (int i = 0; i < NV; ++i)
#pragma unroll
      for (int j = 0; j < 16; ++j) L[i * FFT_REGION_F2 + pb + 2 * j] = u[i][brev(j, 4)]; }
  __syncthreads();
  { const int sb = tid >> 5, ii = tid & 31, pb = 544 * sb + ii;
    cplx u[NV][16];
    float rev = (float)ii * (1.f / 512.f); asm volatile("" : "+v"(rev)); const cplx w1 = mk2(__builtin_amdgcn_cosf(rev), -__builtin_amdgcn_sinf(rev)); cplx w = mk2(1.f, 0.f);
#pragma unroll
    for (int k = 0; k < 16; ++k) {
#pragma unroll
      for (int i = 0; i < NV; ++i) u[i][k] = cmulc(L[i * FFT_REGION_F2 + pb + 34 * k], w);
      w = cmul(w, w1); }

#pragma unroll
    for (int i = 0; i < NV; ++i) dft_reg<16, true>(u[i]);

#pragma unroll
    for (int i = 0; i < NV; ++i)
#pragma unroll
      for (int j = 0; j < 16; ++j) L[i * FFT_REGION_F2 + pb + 34 * j] = u[i][brev(j, 4)]; }
  __syncthreads();
  { float rev = (float)tid * (1.f / 8192.f); asm volatile("" : "+v"(rev)); const cplx w1 = mk2(__builtin_amdgcn_cosf(rev), -__builtin_amdgcn_sinf(rev)); cplx w = mk2(1.f, 0.f);
    const int pb = tid + 2 * (tid >> 5);
#pragma unroll
    for (int k = 0; k < 16; ++k) {
#pragma unroll
      for (int i = 0; i < NV; ++i) v[i][k] = cmulc(L[i * FFT_REGION_F2 + pb + 544 * k], w);
      w = cmul(w, w1); }

#pragma unroll
    for (int i = 0; i < NV; ++i) dft_reg<16, true>(v[i]);
     }
}

DI float shl1(float x, int lane) { const float t = __shfl_up(x, 1); return lane == 0 ? 0.f : t; }
DI float shr1(float x, int lane) { const float t = __shfl_down(x, 1); return lane == 63 ? 0.f : t; }
DI void hy_conv8(const bf16_t* XT, int c, int bt, int tl, int lane, const float (&cw)[3][3], const float (&cb)[3], float (&x0c)[8], float (&zz)[8]) {
  float uc[3][8];
#pragma unroll
  for (int g = 0; g < 3; ++g) {
    const u32x4 raw = *(const u32x4*)(XT + (size_t)(g * 1024 + c) * NTOK + (size_t)bt * 4096 + 8 * tl);
    float pv[10];
#pragma unroll
    for (int q = 0; q < 4; ++q) { pv[1 + 2 * q] = bflo(raw[q]); pv[2 + 2 * q] = bfhi(raw[q]); }
    { const float t0 = __shfl_up(pv[8], 1), t1 = __shfl_down(pv[1], 1); pv[0] = (lane & 7) == 0 ? 0.f : t0; pv[9] = (lane & 7) == 7 ? 0.f : t1; }
#pragma unroll
    for (int e2 = 0; e2 < 8; ++e2) uc[g][e2] = cw[g][0] * pv[e2] + cw[g][1] * pv[e2 + 1] + cw[g][2] * pv[e2 + 2] + cb[g];
  }
#pragma unroll
  for (int e2 = 0; e2 < 8; ++e2) { x0c[e2] = uc[0][e2]; zz[e2] = uc[1][e2] * uc[2][e2]; }
}
template <int NV> DI void hyena_chan(const Params& p, int l, int c, LAS cplx* L, int tid) {
  bf16_t* XT = (bf16_t*)(p.ws + OFF_XT);
  const int lane = tid & 63;
  const int pb4 = 16 * tid + 2 * (tid >> 1);
  h16x2 Hr[5]; LAS h16x2* Hl = (LAS h16x2*)(L + 2 * FFT_REGION_F2) + tid;
  {
    const float* hT = (const float*)(p.ws + ((l & 1) ? OFF_HP2 : OFF_HP));
    const float* hf = hT + (size_t)c * 4096, * hbk = hT + (size_t)(1024 + c) * 4096;
    cplx f[1][16];
#pragma unroll
    for (int j = 0; j < 8; ++j) f[0][j] = mk2(__builtin_nontemporal_load(hf + tid + 512 * j), 0.f);
#pragma unroll
    for (int j = 8; j < 16; ++j) { const int n = tid + 512 * j; f[0][j] = mk2(n == 4096 ? 0.f : __builtin_nontemporal_load(hbk + (n == 4096 ? 0 : 8192 - n)), 0.f); }
    fft_fwd3<1>(f, L, tid);
#pragma unroll
    for (int m = 0; m < 8; ++m) { const cplx a = L[pb4 + 2 * m], b = L[pb4 + 2 * m + 1];
      h16x2 h0, h1; h0.x = (_Float16)((a.x + b.x) * HSCALE); h0.y = (_Float16)((a.y + b.y) * HSCALE); h1.x = (_Float16)((a.x - b.x) * HSCALE); h1.y = (_Float16)((a.y - b.y) * HSCALE);
      if (2 * m < 11) Hl[(2 * m) * 512] = h0; else Hr[2 * m - 11 < 0 ? 0 : 2 * m - 11] = h0;
      if (2 * m + 1 < 11) Hl[(2 * m + 1) * 512] = h1; else Hr[2 * m + 1 - 11 < 0 ? 0 : 2 * m + 1 - 11] = h1; }
    __syncthreads();
  }
  float cw[3][3], cb[3];
#pragma unroll
  for (int g = 0; g < 3; ++g) { cb[g] = p.conv_b[l * 3072 + g * 1024 + c];
#pragma unroll
    for (int t = 0; t < 3; ++t) cw[g][t] = p.conv_w[((size_t)l * 3 + t) * 3072 + g * 1024 + c]; }
  const float sk = p.skip[l * 1024 + c], sc = 1.f / (8192.f * HSCALE);
#pragma unroll 1
  for (int bp0 = 0; bp0 < 2; bp0 += NV) {
    int tl = tid; asm volatile("" : "+v"(tl));
#pragma unroll
    for (int i = 0; i < NV; ++i) {
      float xa[8], za[8], xb[8], zb[8];
      hy_conv8(XT, c, 2 * (bp0 + i), tl, lane, cw, cb, xa, za);
      hy_conv8(XT, c, 2 * (bp0 + i) + 1, tl, lane, cw, cb, xb, zb);
      LAS cplx* X = L + i * FFT_REGION_F2 + 8 * tl + 2 * (tl >> 2);
#pragma unroll
      for (int e2 = 0; e2 < 8; ++e2) X[e2] = mk2(za[e2], zb[e2]);

    }
    __syncthreads();
    cplx v[NV][16];
    { const int pb = tl + 2 * (tl >> 5);
#pragma unroll
      for (int i = 0; i < NV; ++i) {
#pragma unroll
        for (int j = 0; j < 8; ++j) v[i][j] = L[i * FFT_REGION_F2 + pb + 544 * j];
#pragma unroll
        for (int j = 8; j < 16; ++j) v[i][j] = mk2(0.f, 0.f); } }
    __syncthreads();

    fft_fwd3<NV>(v, L, tid);

#pragma unroll
    for (int i = 0; i < NV; ++i) {
      LAS cplx* Li = L + i * FFT_REGION_F2;
#pragma unroll
      for (int m = 0; m < 8; ++m) { const cplx a = Li[pb4 + 2 * m], b = Li[pb4 + 2 * m + 1];
        const h16x2 h0 = (2 * m < 11) ? Hl[(2 * m) * 512] : Hr[2 * m - 11 < 0 ? 0 : 2 * m - 11], h1 = (2 * m + 1 < 11) ? Hl[(2 * m + 1) * 512] : Hr[2 * m + 1 - 11 < 0 ? 0 : 2 * m + 1 - 11];
        const cplx y0 = cmul(mk2(a.x + b.x, a.y + b.y), mk2((float)h0.x, (float)h0.y)), y1 = cmul(mk2(a.x - b.x, a.y - b.y), mk2((float)h1.x, (float)h1.y));
        Li[pb4 + 2 * m] = mk2(y0.x + y1.x, y0.y + y1.y); Li[pb4 + 2 * m + 1] = mk2(y0.x - y1.x, y0.y - y1.y); }
       }
    __syncthreads();
    fft_inv3<NV>(v, L, tid);

    { const int pb = tl + 2 * (tl >> 5);
#pragma unroll
      for (int i = 0; i < NV; ++i)
#pragma unroll
        for (int j = 0; j < 8; ++j) L[i * FFT_REGION_F2 + pb + 544 * j] = v[i][brev(j, 4)]; }
    __syncthreads();
#pragma unroll
    for (int i = 0; i < NV; ++i) {
      float xa[8], za[8], xb[8], zb[8];
      hy_conv8(XT, c, 2 * (bp0 + i), tl, lane, cw, cb, xa, za);
      hy_conv8(XT, c, 2 * (bp0 + i) + 1, tl, lane, cw, cb, xb, zb);
      const LAS cplx* X = L + i * FFT_REGION_F2 + 8 * tl + 2 * (tl >> 2);
      float ya[8], yb[8];
#pragma unroll
      for (int e2 = 0; e2 < 8; ++e2) { const cplx cv = X[e2]; ya[e2] = xa[e2] * (cv.x * sc + sk * za[e2]); yb[e2] = xb[e2] * (cv.y * sc + sk * zb[e2]); }
      *(u32x4*)(XT + (size_t)c * NTOK + (size_t)(2 * (bp0 + i)) * 4096 + 8 * tl) = (u32x4){pk2(ya[0], ya[1]), pk2(ya[2], ya[3]), pk2(ya[4], ya[5]), pk2(ya[6], ya[7])};
      *(u32x4*)(XT + (size_t)c * NTOK + (size_t)(2 * (bp0 + i) + 1) * 4096 + 8 * tl) = (u32x4){pk2(yb[0], yb[1]), pk2(yb[2], yb[3]), pk2(yb[4], yb[5]), pk2(yb[6], yb[7])};

    }
    __syncthreads();
  }
}

DI void hyena_ctx_item(const Params& p, int l, int c, LAS unsigned char* lds) {
  LAS float* zs = (LAS float*)lds;
  LAS float* hc = zs + 1024;
  LAS float* part = hc + 512;
  bf16_t* XT = (bf16_t*)(p.ws + OFF_XT);
  const float* hTc = (const float*)(p.ws + ((l & 1) ? OFF_HTC2 : OFF_HTC));
  const int tid = otid();
  { const int i = tid - 256; hc[tid] = i >= 0 ? hTc[(size_t)c * 256 + i] : (tid == 0 ? 0.f : hTc[(size_t)(1024 + c) * 256 + (-i)]); }
  float u0[2];
  { const int b = tid >> 7, tq = tid & 127;
#pragma unroll
    for (int e = 0; e < 2; ++e) {
      const int t = tq + 128 * e;
      float uu[3];
#pragma unroll
      for (int g = 0; g < 3; ++g) {
        const bf16_t* row = XT + (size_t)(g * 1024 + c) * NTOK + NLAT + b * 256;
        const float pm = t > 0 ? bf2f(row[t - 1]) : 0.f, p0 = bf2f(row[t]), pp = t < 255 ? bf2f(row[t + 1]) : 0.f;
        const size_t wb = (size_t)l * 3 * 3072 + g * 1024 + c;
        uu[g] = p.conv_w[wb] * pm + p.conv_w[wb + 3072] * p0 + p.conv_w[wb + 6144] * pp + p.conv_b[l * 3072 + g * 1024 + c];
      }
      u0[e] = uu[0]; zs[b * 256 + t] = uu[1] * uu[2];
    } }
  __syncthreads();
  const int t0 = 4 * (tid & 63), cbatch = (tid >> 6) & 3, sh = tid >> 8;
  float y[4] = {0.f, 0.f, 0.f, 0.f};
#pragma unroll 4
  for (int s0 = 128 * sh; s0 < 128 * sh + 128; s0 += 4) {
    const int base = 256 + t0 - s0 - 4;
    const f32x4 H0 = *(const LAS f32x4*)(hc + base), H1 = *(const LAS f32x4*)(hc + base + 4), z4 = *(const LAS f32x4*)(zs + cbatch * 256 + s0);
    const float hw[8] = {H0.x, H0.y, H0.z, H0.w, H1.x, H1.y, H1.z, H1.w}, zv[4] = {z4.x, z4.y, z4.z, z4.w};
#pragma unroll
    for (int j = 0; j < 4; ++j)
#pragma unroll
      for (int u = 0; u < 4; ++u) y[j] += hw[4 + j - u] * zv[u];
  }
  if (sh) *(LAS f32x4*)(part + cbatch * 256 + t0) = (f32x4){y[0], y[1], y[2], y[3]};
  __syncthreads();
  if (!sh) { const f32x4 o = *(const LAS f32x4*)(part + cbatch * 256 + t0); part[cbatch * 256 + t0] = y[0] + o.x; part[cbatch * 256 + t0 + 1] = y[1] + o.y; part[cbatch * 256 + t0 + 2] = y[2] + o.z; part[cbatch * 256 + t0 + 3] = y[3] + o.w; }
  __syncthreads();
  { const int b = tid >> 7, tq = tid & 127; const float sk = p.skip[l * 1024 + c];
#pragma unroll
    for (int e = 0; e < 2; ++e) { const int t = tq + 128 * e;
      XT[(size_t)c * NTOK + NLAT + b * 256 + t] = f2bf(u0[e] * (part[b * 256 + t] + sk * zs[b * 256 + t])); } }
  __syncthreads();
}

#ifndef HY_NV
#define HY_NV 2
#endif
#define MFMA32(a, b, c) __builtin_amdgcn_mfma_f32_32x32x16_bf16((a), (b), (c), 0, 0, 0)
DI float logsig(float x) { return fminf(x, 0.f) - __logf(1.f + __expf(-fabsf(x))); }
DI void phase_gla_prep(const Params& p, int l, LAS unsigned char* lds) {
  LAS float* lrs = (LAS float*)lds;
  LAS float* tots = lrs + 64 * 32;
  LAS bf16_t* qs = (LAS bf16_t*)(tots + 2 * 4 * 128);
  LAS bf16_t* kes = qs + 4 * 64 * 136;
  LAS bf16_t* ats = kes + 2 * 128 * 72;
  const int tid = otid(), d = tid & 127, tq = tid >> 7, wid = tid >> 6, lane = tid & 63;
  const bf16_t* PB = (const bf16_t*)(p.ws + OFF_PB);
  const float* LR = (const float*)(p.ws + OFF_LR);
  bf16_t* QF = (bf16_t*)(p.ws + OFF_QF); bf16_t* QB = (bf16_t*)(p.ws + OFF_QB);
  bf16_t* KEF = (bf16_t*)(p.ws + OFF_KEF); bf16_t* KEB = (bf16_t*)(p.ws + OFF_KEB);
  bf16_t* ATT = (bf16_t*)(p.ws + OFF_ATT); float* DEC = (float*)(p.ws + OFF_DEC);
  const float qscale = 0.08838834764831845f;
  f32x4 lrv; bf16_t qv[16], kv[16];
#define PREP_LOAD(it_) do { const int ch_ = (it_) >> 2, hh_ = (it_) & 3; const size_t t0_ = (size_t)ch_ * 64; lrv = *(const f32x4*)(LR + t0_ * 32 + 4 * tid); \
    _Pragma("unroll") for (int i = 0; i < 16; ++i) { const size_t tk_ = t0_ + tq * 16 + i; qv[i] = PB[tk_ * 4096 + hh_ * 128 + d]; kv[i] = PB[tk_ * 4096 + 512 + hh_ * 128 + d]; } } while (0)
  float gwf[16], gwb[16], gbf = 0.f, gbb = 0.f;
#define PREP_LOADG(it_) do { const int hh_ = (it_) & 3; \
    _Pragma("unroll") for (int r = 0; r < 16; ++r) { gwf[r] = p.gate_w[(((size_t)l * 2 + 0) * 16 + r) * 512 + hh_ * 128 + d]; gwb[r] = p.gate_w[(((size_t)l * 2 + 1) * 16 + r) * 512 + hh_ * 128 + d]; } \
    gbf = p.gate_b[((size_t)l * 2 + 0) * 512 + hh_ * 128 + d]; gbb = p.gate_b[((size_t)l * 2 + 1) * 512 + hh_ * 128 + d]; } while (0)
  if ((int)blockIdx.x < 272 * 4) PREP_LOAD((int)blockIdx.x);
  for (int it = blockIdx.x; it < 272 * 4; it += gridDim.x) {
    const int chunk = it >> 2, h = it & 3, tok0 = chunk * 64;
    *(LAS f32x4*)(lrs + 4 * tid) = lrv;
    PREP_LOADG(it);
    __syncthreads();
    float cf[16], cb[16];
#pragma unroll
    for (int i = 0; i < 16; ++i) {
      const int t = tq * 16 + i; float pf = gbf, pb = gbb;
#pragma unroll
      for (int r4 = 0; r4 < 4; ++r4) { const f32x4 lf = *(const LAS f32x4*)(lrs + t * 32 + 4 * r4), lb = *(const LAS f32x4*)(lrs + t * 32 + 16 + 4 * r4);
        pf += lf.x * gwf[4 * r4] + lf.y * gwf[4 * r4 + 1] + lf.z * gwf[4 * r4 + 2] + lf.w * gwf[4 * r4 + 3]; pb += lb.x * gwb[4 * r4] + lb.y * gwb[4 * r4 + 1] + lb.z * gwb[4 * r4 + 2] + lb.w * gwb[4 * r4 + 3]; }
      cf[i] = logsig(pf) * (1.f / 16.f); cb[i] = logsig(pb) * (1.f / 16.f);
    }
    { float run = 0.f;
#pragma unroll
      for (int i = 0; i < 16; ++i) { run += cf[i]; cf[i] = run; }
      tots[(0 * 4 + tq) * 128 + d] = run; run = 0.f;
#pragma unroll
      for (int i = 15; i >= 0; --i) { run += cb[i]; cb[i] = run; }
      tots[(1 * 4 + tq) * 128 + d] = run; }
    __syncthreads();
    float offf = 0.f, offb = 0.f, cendf = 0.f, cendb = 0.f;
#pragma unroll
    for (int q = 0; q < 4; ++q) { const float a = tots[(0 * 4 + q) * 128 + d], b = tots[(1 * 4 + q) * 128 + d]; cendf += a; cendb += b; if (q < tq) offf += a; if (q > tq) offb += b; }
    const int o16 = d & 15, grp = o16 >> 2, ngrp = (grp == 1) ? 2 : (grp == 2) ? 1 : grp, permd = (d & ~15) | (ngrp << 2) | (o16 & 3);
    unsigned kef[8], keb[8];
    const float ecf = __expf(cendf), ecb = __expf(cendb);
#pragma unroll
    for (int i = 0; i < 16; ++i) {
      const int t = tq * 16 + i; const size_t tok = (size_t)tok0 + t;
      const float q = bf2f(qv[i]) * qscale, k = bf2f(kv[i]);
      const float ea = __expf(cf[i] + offf), eb2 = __expf(cb[i] + offb);
      const float kia = k * __builtin_amdgcn_rcpf(ea), kib = k * __builtin_amdgcn_rcpf(eb2);
      const bf16_t qf = f2bf(q * ea), kf = f2bf(kia), qb = f2bf(q * eb2), kb = f2bf(kib);
      const bf16_t ef = f2bf(kia * ecf), eb = f2bf(kib * ecb);
      qs[(0 * 64 + t) * 136 + d] = qf; qs[(1 * 64 + t) * 136 + d] = kf; qs[(2 * 64 + t) * 136 + d] = qb; qs[(3 * 64 + t) * 136 + d] = kb;
      QF[tok * 512 + h * 128 + permd] = qf; QB[tok * 512 + h * 128 + permd] = qb;
      if (i & 1) { kef[i >> 1] |= (unsigned)ef << 16; keb[i >> 1] |= (unsigned)eb << 16; } else { kef[i >> 1] = ef; keb[i >> 1] = eb; }
    }
    if (it + (int)gridDim.x < 272 * 4) PREP_LOAD(it + (int)gridDim.x);
    { LAS u32x4* d1 = (LAS u32x4*)(kes + (0 * 128 + d) * 72 + tq * 16); d1[0] = (u32x4){kef[0], kef[1], kef[2], kef[3]}; d1[1] = (u32x4){kef[4], kef[5], kef[6], kef[7]};
      LAS u32x4* d2 = (LAS u32x4*)(kes + (1 * 128 + d) * 72 + tq * 16); d2[0] = (u32x4){keb[0], keb[1], keb[2], keb[3]}; d2[1] = (u32x4){keb[4], keb[5], keb[6], keb[7]}; }
    if (tq == 0) { DEC[(((size_t)chunk * 4 + h) * 2 + 0) * 128 + d] = ecf; DEC[(((size_t)chunk * 4 + h) * 2 + 1) * 128 + d] = ecb; }
    __syncthreads();
    {
      const int dir = wid >> 2, ti = (wid >> 1) & 1, si = wid & 1, r = lane & 31, hh = lane >> 5;
      const LAS bf16_t* ka = qs + ((dir * 2 + 1) * 64 + 32 * si + r) * 136 + 8 * hh;
      const LAS bf16_t* qa = qs + ((dir * 2 + 0) * 64 + 32 * ti + r) * 136 + 8 * hh;
      f32x16 acc;
#pragma unroll
      for (int i = 0; i < 16; ++i) acc[i] = 0.f;
#pragma unroll
      for (int ks = 0; ks < 8; ++ks) acc = MFMA32(*(const LAS bf16x8*)(ka + 16 * ks), *(const LAS bf16x8*)(qa + 16 * ks), acc);
      const int t = 32 * ti + r;
      LAS bf16_t* dst = ats + (dir * 64 + t) * 72 + 32 * si + 4 * hh;
#pragma unroll
      for (int g = 0; g < 4; ++g) {
        float vv[4];
#pragma unroll
        for (int e = 0; e < 4; ++e) { const int s = 32 * si + 8 * g + 4 * hh + e; const bool keep = dir ? (s >= t) : (s <= t); vv[e] = keep ? acc[4 * g + e] : 0.f; }
        *(LAS u32x2*)(dst + 8 * g) = (u32x2){pk2(vv[0], vv[1]), pk2(vv[2], vv[3])};
      }
    }
    __syncthreads();
    {
      const size_t chh = (size_t)chunk * 4 + h;
#pragma unroll
      for (int q = 0; q < 2; ++q) { const int pc = tid + 512 * q, row = pc >> 3, cc = pc & 7;
        *(u32x4*)(KEF + (chh * 128 + row) * 64 + 8 * cc) = *(const LAS u32x4*)(kes + (0 * 128 + row) * 72 + 8 * cc);
        *(u32x4*)(KEB + (chh * 128 + row) * 64 + 8 * cc) = *(const LAS u32x4*)(kes + (1 * 128 + row) * 72 + 8 * cc);
        const int rr = row & 63, dd = row >> 6;
        *(u32x4*)(ATT + ((chh * 2 + dd) * 64 + rr) * 64 + 8 * cc) = *(const LAS u32x4*)(ats + (dd * 64 + rr) * 72 + 8 * cc); }
    }
    __syncthreads();
  }
}

#undef PREP_LOAD
#undef PREP_LOADG
DI bf16x8 pack8(const f32x16& x, int s) {
  u32x4 r; r[0] = pk2(x[8 * s + 0], x[8 * s + 1]); r[1] = pk2(x[8 * s + 2], x[8 * s + 3]); r[2] = pk2(x[8 * s + 4], x[8 * s + 5]); r[3] = pk2(x[8 * s + 6], x[8 * s + 7]);
  return __builtin_bit_cast(bf16x8, r);
}
DI void phase_gla_scan(const Params& p, LAS unsigned char* lds) {
  constexpr int BUFB = 64 * 136 * 2 + 128 * 72 * 2 + 64 * 72 * 2 + 512;
  const int tid = otid(), wid = tid >> 6, lane = tid & 63, r = lane & 31, hh = lane >> 5;
  const int bid = blockIdx.x, b = bid >> 4, h = (bid >> 2) & 3, dir = (bid >> 1) & 1, dvh = bid & 1;
  const bool cwave = wid < 4;
  const bf16_t* Qg = (const bf16_t*)(p.ws + (dir ? OFF_QB : OFF_QF));
  const bf16_t* Kg = (const bf16_t*)(p.ws + (dir ? OFF_KEB : OFF_KEF));
  const bf16_t* ATT = (const bf16_t*)(p.ws + OFF_ATT); const float* DEC = (const float*)(p.ws + OFF_DEC);
  const bf16_t* VT = (const bf16_t*)(p.ws + OFF_XT) + (size_t)(3072 + h * 256 + 128 * dvh + 32 * (wid & 3) + r) * NTOK + 8 * hh;
  bf16_t* Og = (dir ? (bf16_t*)(p.ws + OFF_X) : (bf16_t*)(p.ws + OFF_PB)) + h * 256 + 128 * dvh;
  const int ldo = dir ? 1024 : 4096;
  const int qrow0 = tid >> 4, qcc = tid & 15, krow0 = tid >> 3, kcc = tid & 7;
  constexpr int OBUF = 64 * 264 * 2;
  LAS unsigned char* obase = lds + 2 * BUFB;
  f32x16 S[4];
#pragma unroll
  for (int m = 0; m < 4; ++m)
#pragma unroll
    for (int i = 0; i < 16; ++i) S[m][i] = 0.f;
  u32x4 pq0, pq1, pk0, pk1, pa; float pdc = 0.f; bf16x8 vf[4];
#define SCAN_CIDX(st) ((st) < 4 ? (256 + 4 * b + (dir ? 3 - (st) : (st))) : (64 * b + (dir ? 67 - (st) : (st) - 4)))
#define SCAN_LOAD(st) do { const int ci_ = SCAN_CIDX(st); const size_t tk_ = (size_t)ci_ * 64, ch_ = (size_t)ci_ * 4 + h; \
    pq0 = *(const u32x4*)(Qg + (tk_ + qrow0) * 512 + h * 128 + 8 * qcc); pq1 = *(const u32x4*)(Qg + (tk_ + qrow0 + 32) * 512 + h * 128 + 8 * qcc); \
    pk0 = *(const u32x4*)(Kg + (ch_ * 128 + krow0) * 64 + 8 * kcc); pk1 = *(const u32x4*)(Kg + (ch_ * 128 + krow0 + 64) * 64 + 8 * kcc); \
    pa = *(const u32x4*)(ATT + ((ch_ * 2 + dir) * 64 + krow0) * 64 + 8 * kcc); if (tid < 128) pdc = DEC[(ch_ * 2 + dir) * 128 + tid]; \
 } while (0)
#define SCAN_LOADV(st) do { const size_t tkv_ = (size_t)SCAN_CIDX(st) * 64; _Pragma("unroll") for (int ks = 0; ks < 4; ++ks) vf[ks] = *(const bf16x8*)(VT + tkv_ + 16 * ks); } while (0)
#define SCAN_STORE(bufi) do { LAS unsigned char* bb_ = lds + (bufi) * BUFB; LAS bf16_t* QT_ = (LAS bf16_t*)bb_; LAS bf16_t* KE_ = QT_ + 64 * 136; LAS bf16_t* AT_ = KE_ + 128 * 72; LAS float* DC_ = (LAS float*)(AT_ + 64 * 72); \
    *(LAS u32x4*)(QT_ + qrow0 * 136 + 8 * qcc) = pq0; *(LAS u32x4*)(QT_ + (qrow0 + 32) * 136 + 8 * qcc) = pq1; \
    *(LAS u32x4*)(KE_ + krow0 * 72 + 8 * kcc) = pk0; *(LAS u32x4*)(KE_ + (krow0 + 64) * 72 + 8 * kcc) = pk1; \
    *(LAS u32x4*)(AT_ + krow0 * 72 + 8 * kcc) = pa; if (tid < 128) DC_[tid] = pdc; } while (0)
#define SCAN_WRITEOUT(st) do { const size_t tk_ = (size_t)SCAN_CIDX(st) * 64; const LAS bf16_t* ob_ = (const LAS bf16_t*)(obase + ((st) & 1) * OBUF); \
    _Pragma("unroll 1") for (int q = 0; q < 2; ++q) { const int pc_ = tid + 512 * q, row_ = pc_ >> 4, cc_ = pc_ & 15; \
      *(u32x4*)(Og + (tk_ + row_) * ldo + 8 * cc_) = *(const LAS u32x4*)(ob_ + row_ * 264 + 8 * cc_); } } while (0)
  SCAN_LOAD(0); SCAN_STORE(0); SCAN_LOADV(0);
  __syncthreads();
#pragma unroll 1
  for (int step = 0; step < 68; ++step) {
    const size_t tok0 = (size_t)SCAN_CIDX(step) * 64;
    if (step > 0) SCAN_WRITEOUT(step - 1);
    __builtin_amdgcn_sched_barrier(0);
    if (step + 1 < 68) SCAN_LOAD(step + 1);
    LAS unsigned char* bb = lds + (step & 1) * BUFB;
    const LAS bf16_t* QT = (const LAS bf16_t*)bb; const LAS bf16_t* KE = QT + 64 * 136; const LAS bf16_t* AT = KE + 128 * 72; const LAS float* DC = (const LAS float*)(AT + 64 * 72);
    if (cwave) {
    bf16x8 sp[8];
#pragma unroll
    for (int m = 0; m < 4; ++m) { sp[2 * m] = pack8(S[m], 0); sp[2 * m + 1] = pack8(S[m], 1); }
    f32x16 o0, o1;
#pragma unroll
    for (int i = 0; i < 16; ++i) { o0[i] = 0.f; o1[i] = 0.f; }
#pragma unroll
    for (int ks = 0; ks < 4; ++ks) {
      o0 = MFMA32(vf[ks], *(const LAS bf16x8*)(AT + r * 72 + 16 * ks + 8 * hh), o0);
      o1 = MFMA32(vf[ks], *(const LAS bf16x8*)(AT + (32 + r) * 72 + 16 * ks + 8 * hh), o1);
    }
#pragma unroll
    for (int k8 = 0; k8 < 8; ++k8) {
      o0 = MFMA32(sp[k8], *(const LAS bf16x8*)(QT + r * 136 + 16 * k8 + 8 * hh), o0);
      o1 = MFMA32(sp[k8], *(const LAS bf16x8*)(QT + (32 + r) * 136 + 16 * k8 + 8 * hh), o1);
    }
#pragma unroll
    for (int m = 0; m < 4; ++m) {
#pragma unroll
      for (int g = 0; g < 4; ++g) { const f32x4 dv = *(const LAS f32x4*)(DC + 32 * m + 8 * g + 4 * hh);
        S[m][4 * g] *= dv.x; S[m][4 * g + 1] *= dv.y; S[m][4 * g + 2] *= dv.z; S[m][4 * g + 3] *= dv.w; }
#pragma unroll
      for (int ks = 0; ks < 4; ++ks) S[m] = MFMA32(*(const LAS bf16x8*)(KE + (32 * m + r) * 72 + 16 * ks + 8 * hh), vf[ks], S[m]);
    }
    { LAS bf16_t* ob = (LAS bf16_t*)(obase + (step & 1) * OBUF) + r * 264 + 32 * wid + 4 * hh;
#pragma unroll
      for (int g = 0; g < 4; ++g) {
        *(LAS u32x2*)(ob + 8 * g) = (u32x2){pk2(o0[4 * g], o0[4 * g + 1]), pk2(o0[4 * g + 2], o0[4 * g + 3])};
        *(LAS u32x2*)(ob + 32 * 264 + 8 * g) = (u32x2){pk2(o1[4 * g], o1[4 * g + 1]), pk2(o1[4 * g + 2], o1[4 * g + 3])};
      } }
    }
    if (step + 1 < 68) { if (cwave) SCAN_LOADV(step + 1); SCAN_STORE((step + 1) & 1); }
    __syncthreads();
  }
  SCAN_WRITEOUT(67);
  __syncthreads();
#undef SCAN_WRITEOUT
#undef SCAN_CIDX
#undef SCAN_LOAD
#undef SCAN_LOADV
#undef SCAN_STORE
}

DI void phase_post(const Params& p, int l, int ntok, LAS unsigned char* lds) {
  const int tid = otid(), lane = tid & 63;
  { const int gw = blockIdx.x * 8 + (tid >> 6), nw = gridDim.x * 8, l32 = lane & 31, hsel = lane >> 5;
    const bf16_t* PB = (const bf16_t*)(p.ws + OFF_PB); bf16_t* HB = (bf16_t*)(p.ws + OFF_X);
    const f32x4 ng0 = *(const f32x4*)(p.gla_ng + l * 256 + 8 * l32), ng1 = *(const f32x4*)(p.gla_ng + l * 256 + 8 * l32 + 4);
    u32x4 na, nb, nr;
    if (gw < ntok * 2) { const size_t tk = gw >> 1; const int cl = ((gw & 1) * 2 + hsel) * 256 + 8 * l32; na = __builtin_nontemporal_load((const u32x4*)(PB + tk * 4096 + cl)); nb = __builtin_nontemporal_load((const u32x4*)(HB + tk * 1024 + cl)); nr = __builtin_nontemporal_load((const u32x4*)(PB + tk * 4096 + 1024 + cl)); }
    for (int it = gw; it < ntok * 2; it += nw) {
      const size_t tok = it >> 1; const int col = ((it & 1) * 2 + hsel) * 256 + 8 * l32;
      const u32x4 a = na, b = nb, rr = nr;
      if (it + nw < ntok * 2) { const int i2 = it + nw; const size_t tk = i2 >> 1; const int cl = ((i2 & 1) * 2 + hsel) * 256 + 8 * l32; na = __builtin_nontemporal_load((const u32x4*)(PB + tk * 4096 + cl)); nb = __builtin_nontemporal_load((const u32x4*)(HB + tk * 1024 + cl)); nr = __builtin_nontemporal_load((const u32x4*)(PB + tk * 4096 + 1024 + cl)); }
      float o[8], rv[8];
#pragma unroll
      for (int i = 0; i < 4; ++i) { o[2 * i] = bflo(a[i]) + bflo(b[i]); o[2 * i + 1] = bfhi(a[i]) + bfhi(b[i]); rv[2 * i] = bflo(rr[i]); rv[2 * i + 1] = bfhi(rr[i]); }
      float ss = 0.f;
#pragma unroll
      for (int i = 0; i < 8; ++i) ss += o[i] * o[i];
#pragma unroll
      for (int q = 16; q >= 1; q >>= 1) ss += __shfl_xor(ss, q);
      const float rstd = rsqrtf(ss * (1.f / 256.f) + EPSF);
      const float ngv[8] = {ng0.x, ng0.y, ng0.z, ng0.w, ng1.x, ng1.y, ng1.z, ng1.w};
      float y[8];
#pragma unroll
      for (int i = 0; i < 8; ++i) y[i] = o[i] * rstd * ngv[i] * (rv[i] * sigm(rv[i]));
      *(u32x4*)(HB + tok * 1024 + col) = (u32x4){pk2(y[0], y[1]), pk2(y[2], y[3]), pk2(y[4], y[5]), pk2(y[6], y[7])};
    } }
  { LAS bf16_t* t = (LAS bf16_t*)lds;
    const bf16_t* XT = (const bf16_t*)(p.ws + OFF_XT); bf16_t* YH = (bf16_t*)(p.ws + OFF_QF);
    const int ntt = ntok / 128;
    u32x4 pre[2];
#define POST_TLOAD(it_) do { const int c0_ = ((it_) / ntt) * 64, tk0_ = ((it_) % ntt) * 128; \
      _Pragma("unroll") for (int q = 0; q < 2; ++q) { const int pc = tid + 512 * q, cc = pc >> 4, tq = pc & 15; pre[q] = *(const u32x4*)(XT + (size_t)(c0_ + cc) * NTOK + tk0_ + 8 * tq); } } while (0)
    if ((int)blockIdx.x < 16 * ntt) POST_TLOAD((int)blockIdx.x);
    for (int it = blockIdx.x; it < 16 * ntt; it += gridDim.x) {
      const int c0 = (it / ntt) * 64, tok0 = (it % ntt) * 128;
#pragma unroll
      for (int q = 0; q < 2; ++q) { const int pc = tid + 512 * q, cc = pc >> 4, tq = pc & 15; *(LAS u32x4*)(t + cc * 136 + 8 * tq) = pre[q]; }
      if (it + (int)gridDim.x < 16 * ntt) POST_TLOAD(it + (int)gridDim.x);
      __syncthreads();
#pragma unroll
      for (int q = 0; q < 2; ++q) { const int pc = tid + 512 * q, tk = pc >> 3, cq = pc & 7; unsigned w[4];
#pragma unroll
        for (int i = 0; i < 4; ++i) w[i] = (unsigned)t[(8 * cq + 2 * i) * 136 + tk] | ((unsigned)t[(8 * cq + 2 * i + 1) * 136 + tk] << 16);
        *(u32x4*)(YH + (size_t)(tok0 + tk) * 1024 + c0 + 8 * cq) = (u32x4){w[0], w[1], w[2], w[3]}; }
      __syncthreads();
    } }
}

#undef POST_TLOAD
struct SchedG1 : pg8::StaticOrder {
  __device__ bool next(int i, pg8::Unit& u) const {
    pg8::Unit v; if (!pg8::StaticOrder::next(i, v)) return false;
    if (v.pn < 16) { u.pm = 68 + v.pn; u.pn = v.pm; } else { u.pm = v.pm; u.pn = 68 + v.pn; }
    return true;
  }
};
typedef const f32x4 (&AccRef)[2][2][4][2];
DI u32x4 pack_acc8(f32x4 v0, f32x4 v1) { return (u32x4){pk2(v0[0], v0[1]), pk2(v0[2], v0[3]), pk2(v1[0], v1[1]), pk2(v1[2], v1[3])}; }
struct EpiG1 {
  static constexpr bool PERM = true, AFTER_DRAIN = false;
  bf16_t* XT; bf16_t* PB; float* LR;
  DI void operator()(AccRef acc, const pg8::Unit& u, int wr, int wc, int fr, int fq) const {
    if (u.pm >= 68) {
      const int ch0 = (u.pm - 68) * 256 + wr * 64 + fr, tk0 = u.pn * 256 + wc * 32 + 8 * fq;
#pragma unroll
      for (int ai = 0; ai < 2; ++ai)
#pragma unroll
        for (int m = 0; m < 4; ++m) { bf16_t* rp = XT + (size_t)(ch0 + ai * 128 + m * 16) * NTOK + tk0;
#pragma unroll
          for (int bj = 0; bj < 2; ++bj) *(u32x4*)(rp + bj * 128) = pack_acc8(acc[ai][bj][m][0], acc[ai][bj][m][1]); }
    } else {
      const int wp = u.pn - 84, row0 = u.pm * 256 + wr * 64 + fr, col0 = wp * 256 + wc * 32 + 8 * fq;
      if (wp < 16) {
#pragma unroll
        for (int ai = 0; ai < 2; ++ai)
#pragma unroll
          for (int m = 0; m < 4; ++m) { bf16_t* rp = PB + (size_t)(row0 + ai * 128 + m * 16) * 4096 + col0;
#pragma unroll
            for (int bj = 0; bj < 2; ++bj) *(u32x4*)(rp + bj * 128) = pack_acc8(acc[ai][bj][m][0], acc[ai][bj][m][1]); }
      } else if (wc == 0) {
#pragma unroll
        for (int ai = 0; ai < 2; ++ai)
#pragma unroll
          for (int m = 0; m < 4; ++m) { float* rp = LR + (size_t)(row0 + ai * 128 + m * 16) * 32 + 8 * fq; *(f32x4*)rp = acc[ai][0][m][0]; *(f32x4*)(rp + 4) = acc[ai][0][m][1]; }
      }
    }
  }
};
template <int MODE> struct EpiGate {
  static constexpr bool PERM = true, AFTER_DRAIN = false;
  const bf16_t* PB; bf16_t* T1; bf16_t* MG;
  DI void operator()(AccRef acc, const pg8::Unit& u, int wr, int wc, int fr, int fq) const {
    const int row0 = u.pm * 256 + wr * 64 + fr, col0 = u.pn * 256 + wc * 32 + 8 * fq;
#pragma unroll
    for (int ai = 0; ai < 2; ++ai)
#pragma unroll
      for (int m = 0; m < 4; ++m) { const size_t row = (size_t)(row0 + ai * 128 + m * 16);
#pragma unroll
        for (int bj = 0; bj < 2; ++bj) { const int col = col0 + bj * 128;
          const u32x4 g = *(const u32x4*)(PB + row * 4096 + (MODE ? 3072 : 2048) + col);
          const f32x4 v0 = acc[ai][bj][m][0], v1 = acc[ai][bj][m][1];
          float o[8] = {v0[0] * sigm(bflo(g[0])), v0[1] * sigm(bfhi(g[0])), v0[2] * sigm(bflo(g[1])), v0[3] * sigm(bfhi(g[1])),
                        v1[0] * sigm(bflo(g[2])), v1[1] * sigm(bfhi(g[2])), v1[2] * sigm(bflo(g[3])), v1[3] * sigm(bfhi(g[3]))};
          if (MODE) { const u32x4 t = *(const u32x4*)(T1 + row * 1024 + col);
            o[0] += bflo(t[0]); o[1] += bfhi(t[0]); o[2] += bflo(t[1]); o[3] += bfhi(t[1]); o[4] += bflo(t[2]); o[5] += bfhi(t[2]); o[6] += bflo(t[3]); o[7] += bfhi(t[3]); }
          *(u32x4*)((MODE ? MG : T1) + row * 1024 + col) = (u32x4){pk2(o[0], o[1]), pk2(o[2], o[3]), pk2(o[4], o[5]), pk2(o[6], o[7])}; } }
  }
};
struct EpiRes {
  static constexpr bool PERM = false, AFTER_DRAIN = false;
  float* out; float* ctxs; const float* modl; int goff; const float* src_lat; const float* src_ctx;
  DI void operator()(AccRef acc, const pg8::Unit& u, int wr, int wc, int fr, int fq) const {
    const int row0 = u.pm * 256 + wr * 64 + fr, col0 = u.pn * 256 + wc * 32 + 4 * fq;
    const float* gv = modl + (size_t)(u.pm < 64 ? (u.pm >> 4) : 4) * 6144 + goff + col0;
    f32x4 gg[2][2];
#pragma unroll
    for (int bj = 0; bj < 2; ++bj)
#pragma unroll
      for (int n = 0; n < 2; ++n) gg[bj][n] = *(const f32x4*)(gv + bj * 128 + n * 16);
#pragma unroll
    for (int ai = 0; ai < 2; ++ai)
#pragma unroll
      for (int m = 0; m < 4; ++m) { const int row = row0 + ai * 128 + m * 16;
        float* rp = (row < NLAT ? out + (size_t)row * 1024 : ctxs + (size_t)(row - NLAT) * 1024) + col0;
        const float* sp = (row < NLAT ? src_lat + (size_t)row * 1024 : src_ctx + (size_t)(row - NLAT) * 1024) + col0;
#pragma unroll
        for (int bj = 0; bj < 2; ++bj)
#pragma unroll
          for (int n = 0; n < 2; ++n) { f32x4* q = (f32x4*)(rp + bj * 128 + n * 16); *q = *(const f32x4*)(sp + bj * 128 + n * 16) + gg[bj][n] * acc[ai][bj][m][n]; } }
  }
};
struct EpiRelu2 {
  static constexpr bool PERM = true, AFTER_DRAIN = false;
  bf16_t* O;
  DI void operator()(AccRef acc, const pg8::Unit& u, int wr, int wc, int fr, int fq) const {
    const int row0 = u.pm * 256 + wr * 64 + fr, col0 = u.pn * 256 + wc * 32 + 8 * fq;
#pragma unroll
    for (int ai = 0; ai < 2; ++ai)
#pragma unroll
      for (int m = 0; m < 4; ++m) { bf16_t* rp = O + (size_t)(row0 + ai * 128 + m * 16) * 4096 + col0;
#pragma unroll
        for (int bj = 0; bj < 2; ++bj) { f32x4 v0 = acc[ai][bj][m][0], v1 = acc[ai][bj][m][1];
#pragma unroll
          for (int e = 0; e < 4; ++e) { const float a = fmaxf(v0[e], 0.f), b = fmaxf(v1[e], 0.f); v0[e] = a * a; v1[e] = b * b; }
          *(u32x4*)(rp + bj * 128) = pack_acc8(v0, v1); } }
  }
};

#define MFMA16(a, b, c) __builtin_amdgcn_mfma_f32_16x16x32_bf16((a), (b), (c), 0, 0, 0)
template <class F> DI void ctx_gemm(const bf16_t* A, const bf16_t* Bt, int K, int N, LAS unsigned char* lds, const F& epi) {
  constexpr int LDT = 136, TILEB = 64 * LDT * 2;
  const int tid = otid(), wid = tid >> 6, lane = tid & 63, fr = lane & 15, fq = lane >> 4, wm = wid >> 1, wn = wid & 1;
  const int ntn = N / 64, ntiles = 16 * ntn, nk = K / 128;
  const int lrow = tid >> 4, lcc = tid & 15;
  for (int t0 = blockIdx.x; t0 < ntiles; t0 += gridDim.x) {
    int tile = t0;
    if (ntiles == 256 && gridDim.x == 256) { const int x = t0 & 7, idx = t0 >> 3; tile = (4 * (x >> 1) + (idx >> 3)) * 16 + 8 * (x & 1) + (idx & 7); }
    const int tm = tile / ntn, tn = tile % ntn;
    const bf16_t* Ab = A + (size_t)(tm * 64 + lrow) * K + 8 * lcc; const bf16_t* Bb = Bt + (size_t)(tn * 64 + lrow) * K + 8 * lcc;
    const size_t r32 = (size_t)32 * K;
    u32x4 ra0, ra1, rb0, rb1, sa0, sa1, sb0, sb1;
#define CG_LOAD(x0, x1, y0, y1, kt_) do { const int ko_ = (kt_) * 128; x0 = *(const u32x4*)(Ab + ko_); x1 = *(const u32x4*)(Ab + r32 + ko_); y0 = *(const u32x4*)(Bb + ko_); y1 = *(const u32x4*)(Bb + r32 + ko_); } while (0)
#define CG_STORE(x0, x1, y0, y1, bufi) do { LAS bf16_t* dA_ = (LAS bf16_t*)(lds + (bufi) * 2 * TILEB); LAS bf16_t* dB_ = (LAS bf16_t*)(lds + (bufi) * 2 * TILEB + TILEB); \
    *(LAS u32x4*)(dA_ + lrow * LDT + 8 * lcc) = x0; *(LAS u32x4*)(dA_ + (lrow + 32) * LDT + 8 * lcc) = x1; *(LAS u32x4*)(dB_ + lrow * LDT + 8 * lcc) = y0; *(LAS u32x4*)(dB_ + (lrow + 32) * LDT + 8 * lcc) = y1; } while (0)
#define CG_COMPUTE(bufi) do { const LAS bf16_t* sA_ = (const LAS bf16_t*)(lds + (bufi) * 2 * TILEB); const LAS bf16_t* sB_ = (const LAS bf16_t*)(lds + (bufi) * 2 * TILEB + TILEB); \
    _Pragma("unroll") for (int ks = 0; ks < 4; ++ks) { const bf16x8 af = *(const LAS bf16x8*)(sA_ + (16 * wm + fr) * LDT + 32 * ks + 8 * fq); \
      const bf16x8 b0 = *(const LAS bf16x8*)(sB_ + (32 * wn + fr) * LDT + 32 * ks + 8 * fq), b1 = *(const LAS bf16x8*)(sB_ + (32 * wn + 16 + fr) * LDT + 32 * ks + 8 * fq); \
      acc0 = MFMA16(b0, af, acc0); acc1 = MFMA16(b1, af, acc1); } } while (0)
    CG_LOAD(ra0, ra1, rb0, rb1, 0); CG_LOAD(sa0, sa1, sb0, sb1, 1);
    CG_STORE(ra0, ra1, rb0, rb1, 0);
    __syncthreads();
    f32x4 acc0 = {0.f, 0.f, 0.f, 0.f}, acc1 = {0.f, 0.f, 0.f, 0.f};
#pragma unroll 1
    for (int kt = 0; kt < nk; kt += 2) {
      if (kt + 2 < nk) CG_LOAD(ra0, ra1, rb0, rb1, kt + 2);
      CG_COMPUTE(0);
      CG_STORE(sa0, sa1, sb0, sb1, 1);
      __syncthreads();
      if (kt + 3 < nk) CG_LOAD(sa0, sa1, sb0, sb1, kt + 3);
      CG_COMPUTE(1);
      if (kt + 2 < nk) CG_STORE(ra0, ra1, rb0, rb1, 0);
      __syncthreads();
    }
#undef CG_LOAD
#undef CG_STORE
#undef CG_COMPUTE
    const int row = tm * 64 + 16 * wm + fr, col = tn * 64 + 32 * wn + 4 * fq;
    epi(row, col, acc0); epi(row, col + 16, acc1);
  }
}

__global__ void __launch_bounds__(512, 2) fwd_megakernel(Params p) {
  extern __shared__ __attribute__((aligned(16))) unsigned char shm[];
  LAS unsigned char* lds = (LAS unsigned char*)shm;
  cg::grid_group grid = cg::this_grid();
  unsigned char* ws = p.ws;
  const int G = gridDim.x, cblk = blockIdx.x;
  unsigned* cnt = (unsigned*)(ws + OFF_CNT);
  __shared__ unsigned xbw[4];
#define s_item (*(volatile int*)&xbw[2])
  if (threadIdx.x == 0) { xbw[0] = 0u; xbw[1] = 0u; xbw[2] = 0u; xbw[3] = 0u; }
  __syncthreads();
#ifndef TPROBE
#define TPROBE 0
#endif
  unsigned long long tacc = 0ull, tt0 = 0ull;
#define TB(g) do { if (TPROBE == (g) && blockIdx.x == 0) tt0 = __builtin_amdgcn_s_memrealtime(); } while (0)
#define TE(g) do { if (TPROBE == (g) && blockIdx.x == 0) tacc += __builtin_amdgcn_s_memrealtime() - tt0; } while (0)

  TB(5); phase_copy(p); phase_mod(p, lds); phase_a2(p, lds);
  phase_wconv(p, 0, lds, 0, cblk, G); phase_wconv(p, 0, lds, 1, cblk, G);
  grid.sync(); TE(5);
  const XcdBarrier xb = xcd_barrier_post((unsigned*)(ws + OFF_BAR), (volatile LAS unsigned*)xbw);
  for (int l = 0; l < 4; ++l) {
    const bool last = (l == 3);
    const int MR = last ? NLAT : NTOK;
    TB(3); TB(14); if (l > 0) phase_wconv(p, l, lds, 1, cblk, G);
    phase_norm(p, l, p.norm1_g + l * 1024, 0, 1024, NTOK, l == 0);
    if (l == 0) phase_filt_gemm(p, l, lds, cblk, G);
    xcd_barrier(xb); TE(14); TE(3);
    TB(1); TB(6);
    { pg8::Gemm g{(const bf16_t*)(ws + OFF_X), (const bf16_t*)(ws + OFF_X), NTOK, 8448, 1024};
      SchedG1 S; S.init(NTOK, 8448, G, cblk);
      EpiG1 E{(bf16_t*)(ws + OFF_XT), (bf16_t*)(ws + OFF_PB), (float*)(ws + OFF_LR)};
      pg8::gemm_phase<EpiG1, SchedG1, false>(lds, g, S, E, nullptr); }
    xcd_barrier(xb); TE(1); TE(6);
    TB(4); TB(11); phase_gla_prep(p, l, lds);
    if (!last && cblk >= 64) phase_filt_gemm(p, l + 1, lds, cblk - 64, G - 64);
    xcd_barrier(xb); TE(4); TE(11);
    TB(2); TB(7); if (cblk < 64) phase_gla_scan(p, lds); TE(7);
    { LAS cplx* L = (LAS cplx*)lds;
      if (otid() == 0) s_item = (int)atomicAdd(cnt + 2 * l, 1u);
      for (;;) {
        __syncthreads();
        const int it = s_item;
        __syncthreads();
        if (it >= 1024) break;
        if (otid() == 0) s_item = (int)atomicAdd(cnt + 2 * l, 1u);
        hyena_chan<HY_NV>(p, l, __builtin_amdgcn_readfirstlane(it), L, otid());
      }
      if (!last) for (;;) {
        if (otid() == 0) s_item = (int)atomicAdd(cnt + 2 * l + 1, 1u);
        __syncthreads();
        const int it = s_item;
        __syncthreads();
        if (it >= 1024) break;
        hyena_ctx_item(p, l, it, lds);
      } }
    xcd_barrier(xb);
    TE(2);
    TB(4); TB(12); phase_post(p, l, MR, lds);
    xcd_barrier(xb); TE(4); TE(12);
    TB(1); TB(8);
    { pg8::StaticOrder S; S.init(NLAT, 1024, G, cblk);
      const bf16_t* PBc = (const bf16_t*)(ws + OFF_PB); bf16_t* T1 = (bf16_t*)(ws + OFF_KEF); bf16_t* MGp = (bf16_t*)(ws + OFF_XT + (size_t)3072 * NTOK * 2);
      EpiGate<0> E0{PBc, T1, nullptr};
      pg8::Gemm g0{(const bf16_t*)(ws + OFF_QF), (const bf16_t*)(ws + OFF_WBHY), NLAT, 1024, 1024};
      pg8::gemm_phase<EpiGate<0>, pg8::StaticOrder, false>(lds, g0, S, E0, nullptr);
      EpiGate<1> E1{PBc, T1, MGp};
      pg8::Gemm g1{(const bf16_t*)(ws + OFF_X), (const bf16_t*)(ws + OFF_WBGLA), NLAT, 1024, 1024};
      pg8::gemm_phase<EpiGate<1>, pg8::StaticOrder, false>(lds, g1, S, E1, nullptr);
      if (!last) {
        ctx_gemm((const bf16_t*)(ws + OFF_QF) + (size_t)NLAT * 1024, (const bf16_t*)(ws + OFF_WBHY), 1024, 1024, lds, [&](int r, int c, f32x4 v) {
          const size_t row = (size_t)NLAT + r; const u32x2 gt = *(const u32x2*)(PBc + row * 4096 + 2048 + c);
          *(u32x2*)(T1 + row * 1024 + c) = (u32x2){pk2(v[0] * sigm(bflo(gt[0])), v[1] * sigm(bfhi(gt[0]))), pk2(v[2] * sigm(bflo(gt[1])), v[3] * sigm(bfhi(gt[1])))}; });
        ctx_gemm((const bf16_t*)(ws + OFF_X) + (size_t)NLAT * 1024, (const bf16_t*)(ws + OFF_WBGLA), 1024, 1024, lds, [&](int r, int c, f32x4 v) {
          const size_t row = (size_t)NLAT + r; const u32x2 gt = *(const u32x2*)(PBc + row * 4096 + 3072 + c); const u32x2 t1 = *(const u32x2*)(T1 + row * 1024 + c);
          *(u32x2*)(MGp + row * 1024 + c) = (u32x2){pk2(bflo(t1[0]) + v[0] * sigm(bflo(gt[0])), bfhi(t1[0]) + v[1] * sigm(bfhi(gt[0]))), pk2(bflo(t1[1]) + v[2] * sigm(bflo(gt[1])), bfhi(t1[1]) + v[3] * sigm(bfhi(gt[1])))}; });
      } }
    xcd_barrier(xb); TE(8);
    { pg8::StaticOrder S; S.init(NLAT, 1024, G, cblk);
      EpiRes E{p.out, (float*)(ws + OFF_CTXS), modp(p, l, 0), 2048, l == 0 ? p.x : p.out, l == 0 ? p.ctx : (const float*)(ws + OFF_CTXS)};
      pg8::Gemm g{(const bf16_t*)(ws + OFF_XT + (size_t)3072 * NTOK * 2), (const bf16_t*)(ws + OFF_WOUT), NLAT, 1024, 1024};
      pg8::gemm_phase<EpiRes, pg8::StaticOrder, false>(lds, g, S, E, nullptr);
      if (!last) { float* cs = (float*)(ws + OFF_CTXS); const float* gv = modp(p, l, 4) + 2048; const float* csrc = l == 0 ? p.ctx : (const float*)cs;
        ctx_gemm((const bf16_t*)(ws + OFF_XT + (size_t)3072 * NTOK * 2) + (size_t)NLAT * 1024, (const bf16_t*)(ws + OFF_WOUT), 1024, 1024, lds, [&](int r, int c, f32x4 v) {
          *(f32x4*)(cs + (size_t)r * 1024 + c) = *(const f32x4*)(csrc + (size_t)r * 1024 + c) + *(const f32x4*)(gv + c) * v; }); } }
    xcd_barrier(xb); TE(1);
    TB(4); TB(13); phase_norm(p, l, p.norm2_g + l * 1024, 3072, 4096, MR, false);
    xcd_barrier(xb); TE(4); TE(13);
    if (TPROBE == 20) { for (int q = 0; q < 8; ++q) xcd_barrier(xb); }
    TB(1); TB(9);
    { pg8::StaticOrder S; S.init(MR, 4096, G, cblk);
      EpiRelu2 E{(bf16_t*)(ws + OFF_PB)};
      pg8::Gemm g{(const bf16_t*)(ws + OFF_X), (const bf16_t*)(ws + OFF_W1), MR, 4096, 1024};
      pg8::gemm_phase<EpiRelu2, pg8::StaticOrder, false>(lds, g, S, E, nullptr);
      if (!last && cblk >= 64) phase_wconv(p, l + 1, lds, 0, cblk - 64, G - 64); }
    xcd_barrier(xb); TE(9); TB(10);
    { pg8::StaticOrder S; S.init(NLAT, 1024, G, cblk);
      EpiRes E{p.out, (float*)(ws + OFF_CTXS), modp(p, l, 0), 5120, p.out, (const float*)(ws + OFF_CTXS)};
      pg8::Gemm g{(const bf16_t*)(ws + OFF_PB), (const bf16_t*)(ws + OFF_W2), NLAT, 1024, 4096};
      pg8::gemm_phase<EpiRes, pg8::StaticOrder, false>(lds, g, S, E, nullptr);
      if (!last) { float* cs = (float*)(ws + OFF_CTXS); const float* gv = modp(p, l, 4) + 5120;
        ctx_gemm((const bf16_t*)(ws + OFF_PB) + (size_t)NLAT * 4096, (const bf16_t*)(ws + OFF_W2), 4096, 1024, lds, [&](int r, int c, f32x4 v) {
          f32x4* q = (f32x4*)(cs + (size_t)r * 1024 + c); *q = *q + *(const f32x4*)(gv + c) * v; }); } }
    xcd_barrier(xb); TE(1); TE(10);
  }
  phase_final_norm(p);
  if (TPROBE && TPROBE != 20 && blockIdx.x == 0) { const unsigned long long s0 = __builtin_amdgcn_s_memrealtime(); while (__builtin_amdgcn_s_memrealtime() - s0 < tacc) __builtin_amdgcn_s_sleep(8); }
}

#ifndef HY_NV
#define HY_NV 2
#endif
constexpr size_t DYN_LDS = 2 * FFT_REGION_F2 * 8 + 11 * 512 * 4;

extern "C" void kernel_launch(void* const* d_in, const int* in_sizes, int n_in, void* d_out, int out_size, void* d_ws, size_t ws_size, hipStream_t stream) {
  if (ws_size < WS_TOTAL || n_in < 28) return;
  static int grid_blocks = 0;
  if (!grid_blocks) {
    int dev = 0, cus = 0, per_cu = 0;
    hipGetDevice(&dev);
    hipDeviceGetAttribute(&cus, hipDeviceAttributeMultiprocessorCount, dev);
    hipFuncSetAttribute((const void*)fwd_megakernel, hipFuncAttributeMaxDynamicSharedMemorySize, (int)DYN_LDS);
    hipOccupancyMaxActiveBlocksPerMultiprocessor(&per_cu, fwd_megakernel, 512, DYN_LDS);
    if (per_cu < 1) per_cu = 1;
    grid_blocks = cus * 1;
  }
  Params p{};
  const float** pp = (const float**)&p;
  for (int i = 0; i < 28; ++i) pp[i] = (const float*)d_in[i];
  p.out = (float*)d_out; p.ws = (unsigned char*)d_ws;
  void* args[] = {&p};
  hipLaunchCooperativeKernel((const void*)fwd_megakernel, dim3(grid_blocks), dim3(512), args, DYN_LDS, stream);
}
```

```cpp
#include <hip/hip_runtime.h>
#include <hip/hip_cooperative_groups.h>
namespace cg = cooperative_groups;
#define DI __device__ __forceinline__

__device__ __forceinline__ int otid() { int t = threadIdx.x; asm volatile("" : "+v"(t)); return t; }
namespace pg8 {
#define PG8_LAS __attribute__((address_space(3)))
typedef unsigned short bf16_t;
typedef short bf16x8 __attribute__((ext_vector_type(8)));
typedef float f32x4 __attribute__((ext_vector_type(4)));
typedef unsigned u32x4 __attribute__((ext_vector_type(4)));
constexpr int BM = 256, BK = 64, HALF = 128, HTB = HALF * BK * 2  , STAGE_BYTES = 8 * HTB, NXCD = 8, WGM = 8;

__host__ __device__ __forceinline__ int lds_byte(int r, int c) { const int st = (r >> 4) * 2 + (c >> 5), rr = r & 15, cc = c & 31, ob = rr * 64 + cc * 2; return st * 1024 + (ob ^ (((ob >> 9) & 1) << 5)); }
__host__ __device__ __forceinline__ void stage_rc(int b, int& R, int& C) { const int st = b / 1024, sb = b % 1024, swz = sb ^ (((sb >> 9) & 1) << 5); R = (st >> 1) * 16 + swz / 64; C = (st & 1) * 32 + (swz % 64) / 2; }
__host__ __device__ __forceinline__ int perm32(int rho) { const int n = rho >> 4, i = rho & 15; return 8 * (i >> 2) + 4 * n + (i & 3); }

struct Unit { int pm, pn; };
struct Gemm { const bf16_t* A; const bf16_t* Bt; int M, N, K; };
struct StaticOrder {
    int nM, nN, nwg, G, c;
    __host__ __device__ void init(int M, int N, int G_, int c_) { nM = M / BM; nN = N / BM; nwg = nM * nN; G = G_; c = c_; }
    __host__ __device__ bool next(int i, Unit& u) const {
        const long L = (long)i * G + c; if (L >= nwg) return false;
        int wgid = (int)L; { const int q = nwg / NXCD, r = nwg % NXCD, xcd = wgid % NXCD, off = wgid / NXCD; wgid = (xcd < r ? xcd * (q + 1) : r * (q + 1) + (xcd - r) * q) + off; }
        const int nig = WGM * nN, gid = wgid / nig, fm = gid * WGM, gsz = (nM - fm) < WGM ? (nM - fm) : WGM;
        u.pm = fm + ((wgid % nig) % gsz); u.pn = (wgid % nig) / gsz; return true;
    }
    __device__ __forceinline__ void a_ready(const Unit&) const {}
    __device__ __forceinline__ void done(const Unit&) const {}
};
__device__ __forceinline__ unsigned cvt_pk_bf16(float lo, float hi) { unsigned r; asm volatile("v_cvt_pk_bf16_f32 %0, %1, %2" : "=v"(r) : "v"(lo), "v"(hi)); return r; }
template <class Epi, class Sched, bool STAMP = false>
__device__ __forceinline__ void gemm_phase(PG8_LAS unsigned char* lds, const Gemm g, const Sched& S, const Epi& E, unsigned long long* stamps) {
    const int tid = otid(), wid = __builtin_amdgcn_readfirstlane(tid >> 6), lane = tid & 63, wr = wid >> 2, wc = wid & 3, fr = lane & 15, fq = lane >> 4;
    const int K = g.K, nt = K / BK;
    int ts_lo = 0, ts_hi = 0, nts = 0; const unsigned long long rt_entry = STAMP ? (unsigned long long)wall_clock64() : 0ull;
#define PG8_STAMP() do { if (STAMP && wid == 0 && nts < 64) { const unsigned long long _c = (unsigned long long)clock64(); \
        ts_lo = (lane == nts) ? (int)(unsigned)_c : ts_lo; ts_hi = (lane == nts) ? (int)(unsigned)(_c >> 32) : ts_hi; ++nts; } } while (0)
    PG8_STAMP();
    unsigned voffA[2], voffB[2];
#pragma unroll
    for (int i = 0; i < 2; ++i) { int R, C; stage_rc(tid * 16 + i * 8192, R, C); const int Rb = Epi::PERM ? ((R & ~31) + perm32(R & 31)) : R;
        voffA[i] = (unsigned)(R * K + C) * 2u; voffB[i] = (unsigned)(Rb * K + C) * 2u; }
    const size_t kstep = (size_t)(BK * 2);
    const size_t hstep = (size_t)HALF * K * 2;
    const size_t tstep = 2 * hstep;
    const unsigned ldsw = (unsigned)wid * 1024u;
    const int aoff = lds_byte(wr * 64 + fr, fq * 8), boff = lds_byte(wc * 32 + fr, fq * 8);
#define PG8_SA(b, h) (((b) * 2 + (h)) * HTB)
#define PG8_SB(b, h) ((4 + (b) * 2 + (h)) * HTB)
#define PG8_STAGE(bufoff, gbase, voff) do { _Pragma("unroll") for (int _i = 0; _i < 2; ++_i) \
        __builtin_amdgcn_global_load_lds((const unsigned*)((const char*)(gbase) + (voff)[_i]), (PG8_LAS unsigned*)(lds + (bufoff) + ldsw + _i * 8192), 16, 0, 0); } while (0)
#define PG8_LDA(dst, b, h) do { _Pragma("unroll") for (int m = 0; m < 4; ++m) _Pragma("unroll") for (int k = 0; k < 2; ++k) dst[m][k] = *(const PG8_LAS bf16x8*)(lds + PG8_SA(b, h) + aoff + m * 2048 + k * 1024); } while (0)
#define PG8_LDB(dst, b, h) do { _Pragma("unroll") for (int n = 0; n < 2; ++n) _Pragma("unroll") for (int k = 0; k < 2; ++k) dst[n][k] = *(const PG8_LAS bf16x8*)(lds + PG8_SB(b, h) + boff + n * 2048 + k * 1024); } while (0)
#define PG8_MMA(ai, bj, At, Bt) do { __builtin_amdgcn_s_setprio(1); _Pragma("unroll") for (int m = 0; m < 4; ++m) _Pragma("unroll") for (int n = 0; n < 2; ++n) _Pragma("unroll") for (int k = 0; k < 2; ++k) \
        acc[ai][bj][m][n] = __builtin_amdgcn_mfma_f32_16x16x32_bf16(Bt[n][k], At[m][k], acc[ai][bj][m][n], 0, 0, 0); __builtin_amdgcn_s_setprio(0); } while (0)
#define PG8_WAIT_V(n) asm volatile("s_waitcnt vmcnt(" #n ")" ::: "memory")
#define PG8_WAIT_L(n) asm volatile("s_waitcnt lgkmcnt(" #n ")" ::: "memory")
#define PG8_BAR __builtin_amdgcn_s_barrier()
#define PG8_SCHED __builtin_amdgcn_sched_barrier(0)
    Unit cur, nxt; int ui = 0;
    if (!S.next(0, cur)) return;
    f32x4 acc[2][2][4][2];
#pragma unroll
    for (int a = 0; a < 2; ++a)
#pragma unroll
        for (int b = 0; b < 2; ++b)
#pragma unroll
            for (int m = 0; m < 4; ++m)
#pragma unroll
                for (int n = 0; n < 2; ++n) acc[a][b][m][n] = (f32x4){0.f, 0.f, 0.f, 0.f};
    bf16x8 At[4][2], B0[2][2], B1[2][2];
    const char* cA = (const char*)g.A + (size_t)cur.pm * tstep; const char* cB = (const char*)g.Bt + (size_t)cur.pn * tstep;
    S.a_ready(cur);
    PG8_STAGE(PG8_SB(0, 0), cB, voffB); PG8_STAGE(PG8_SA(0, 0), cA, voffA); PG8_STAGE(PG8_SB(0, 1), cB + hstep, voffB); PG8_STAGE(PG8_SA(0, 1), cA + hstep, voffA);
    if (wr == 1) PG8_BAR;
    PG8_WAIT_V(4); PG8_BAR;
    PG8_STAGE(PG8_SB(1, 0), cB + kstep, voffB); PG8_STAGE(PG8_SA(1, 0), cA + kstep, voffA); PG8_STAGE(PG8_SB(1, 1), cB + hstep + kstep, voffB);
    PG8_WAIT_V(6); PG8_BAR;
    PG8_STAMP();
    for (;;) {
        const bool has_next = S.next(ui + 1, nxt);
        const char* nA = has_next ? (const char*)g.A + (size_t)nxt.pm * tstep : cA; const char* nB = has_next ? (const char*)g.Bt + (size_t)nxt.pn * tstep : cB;
        for (int t = 0; t < nt; t += 2) {
            const bool last = (t == nt - 2);
            const char* a1 = cA + (size_t)(t + 1) * kstep;
            const char* a2 = last ? nA : cA + (size_t)(t + 2) * kstep; const char* b2 = last ? nB : cB + (size_t)(t + 2) * kstep;
            const char* a3 = a2 + kstep; const char* b3 = b2 + kstep;
            if (last && has_next) S.a_ready(nxt);
            PG8_LDB(B0, 0, 0); PG8_SCHED; PG8_LDA(At, 0, 0); PG8_STAGE(PG8_SA(1, 1), a1 + hstep, voffA);
            PG8_WAIT_L(8); PG8_BAR; PG8_WAIT_L(0); PG8_MMA(0, 0, At, B0); PG8_BAR; PG8_SCHED;
            PG8_LDB(B1, 0, 1); PG8_STAGE(PG8_SB(0, 0), b2, voffB);
            PG8_BAR; PG8_WAIT_L(0); PG8_MMA(0, 1, At, B1); PG8_BAR;
            PG8_LDA(At, 0, 1); PG8_STAGE(PG8_SA(0, 0), a2, voffA);
            PG8_BAR; PG8_WAIT_L(0); PG8_MMA(1, 0, At, B0); PG8_BAR; PG8_SCHED;
            PG8_STAGE(PG8_SB(0, 1), b2 + hstep, voffB);
            PG8_WAIT_V(6); PG8_BAR; PG8_MMA(1, 1, At, B1); PG8_BAR;
            PG8_LDB(B0, 1, 0); PG8_SCHED; PG8_LDA(At, 1, 0); PG8_STAGE(PG8_SA(0, 1), a2 + hstep, voffA);
            PG8_WAIT_L(8); PG8_BAR; PG8_WAIT_L(0); PG8_MMA(0, 0, At, B0); PG8_BAR; PG8_SCHED;
            PG8_LDB(B1, 1, 1); PG8_STAGE(PG8_SB(1, 0), b3, voffB);
            PG8_BAR; PG8_WAIT_L(0); PG8_MMA(0, 1, At, B1); PG8_BAR;
            PG8_LDA(At, 1, 1); PG8_STAGE(PG8_SA(1, 0), a3, voffA);
            PG8_BAR; PG8_WAIT_L(0); PG8_MMA(1, 0, At, B0); PG8_BAR; PG8_SCHED;
            PG8_STAGE(PG8_SB(1, 1), b3 + hstep, voffB);
            PG8_WAIT_V(6); PG8_BAR; PG8_MMA(1, 1, At, B1); PG8_BAR;
        }
        PG8_STAMP();
        if constexpr (!Epi::AFTER_DRAIN) { E(acc, cur, wr, wc, fr, fq); S.done(cur); }
        PG8_STAMP();
        if (!has_next) break;
#pragma unroll
        for (int a = 0; a < 2; ++a)
#pragma unroll
            for (int b = 0; b < 2; ++b)
#pragma unroll
                for (int m = 0; m < 4; ++m)
#pragma unroll
                    for (int n = 0; n < 2; ++n) acc[a][b][m][n] = (f32x4){0.f, 0.f, 0.f, 0.f};
        cur = nxt; cA = nA; cB = nB; ++ui;
    }
    PG8_WAIT_V(0);
    if (wr == 0) PG8_BAR;
    PG8_BAR;
    if constexpr (Epi::AFTER_DRAIN) { E.fused(acc, cur, wr, wc, fr, fq, lds, wid, lane); S.done(cur); }
    PG8_STAMP();
    if (STAMP && wid == 0) { stamps[lane] = lane < nts ? (((unsigned long long)(unsigned)ts_hi << 32) | (unsigned)ts_lo) : 0ull;
        if (lane == 62) stamps[62] = rt_entry; if (lane == 63) stamps[63] = (unsigned long long)wall_clock64(); }
#undef PG8_STAMP
#undef PG8_SA
#undef PG8_SB
#undef PG8_STAGE
#undef PG8_LDA
#undef PG8_LDB
#undef PG8_MMA
#undef PG8_WAIT_V
#undef PG8_WAIT_L
#undef PG8_BAR
#undef PG8_SCHED
}
}

using pg8::bf16_t; using pg8::bf16x8; using pg8::f32x4; using pg8::u32x4;
typedef float f32x16 __attribute__((ext_vector_type(16)));
typedef _Float16 h16x2 __attribute__((ext_vector_type(2)));
typedef unsigned u32x2 __attribute__((ext_vector_type(2)));
#define LAS __attribute__((address_space(3)))

constexpr int NTOK = 17408, NLAT = 16384, DM = 1024, NTH = 512;
constexpr float EPSF = 1e-6f;
constexpr float HSCALE = 64.f;

constexpr size_t SZ_H = (size_t)NTOK * 1024 * 2;
constexpr size_t OFF_X = 0;
constexpr size_t OFF_WIN = OFF_X + SZ_H;
constexpr size_t OFF_WBHY = OFF_WIN + (size_t)8448 * 1024 * 2;
constexpr size_t OFF_WBGLA = OFF_WBHY + 2097152;
constexpr size_t OFF_WOUT = OFF_WBGLA + 2097152;
constexpr size_t OFF_W1 = OFF_WOUT + 2097152;
constexpr size_t OFF_W2 = OFF_W1 + 8388608;
constexpr size_t OFF_XT = OFF_W2 + 8388608;
constexpr size_t SZ_XT = (size_t)4096 * NTOK * 2;
constexpr size_t OFF_PB = OFF_XT + SZ_XT;
constexpr size_t OFF_LR = OFF_PB + SZ_XT;
constexpr size_t OFF_QF = OFF_LR + (size_t)NTOK * 32 * 4;
constexpr size_t SZ_Q = (size_t)NTOK * 512 * 2;
constexpr size_t OFF_QB = OFF_QF + SZ_Q;
constexpr size_t OFF_KEF = OFF_QB + SZ_Q;
constexpr size_t OFF_KEB = OFF_KEF + SZ_Q;
constexpr size_t OFF_ATT = OFF_KEB + SZ_Q;
constexpr size_t OFF_DEC = OFF_ATT + SZ_Q;
constexpr size_t OFF_HP = OFF_DEC + (size_t)272 * 4 * 2 * 128 * 4;
constexpr size_t OFF_CTXS = OFF_HP + (size_t)1024 * 8192 * 4;
constexpr size_t OFF_MOD = OFF_CTXS + 4194304;
constexpr size_t OFF_A2L = OFF_MOD + 491520;
constexpr size_t OFF_A2C = OFF_A2L + 4194304;
constexpr size_t OFF_HTC = OFF_A2C + 262144;
constexpr size_t OFF_HP2 = OFF_HTC + 2097152;
constexpr size_t OFF_HTC2 = OFF_HP2 + (size_t)1024 * 8192 * 4;
constexpr size_t OFF_CNT = OFF_HTC2 + 2097152;
constexpr size_t OFF_BAR = OFF_CNT + 1024;
constexpr size_t WS_TOTAL = OFF_BAR + 16384;

struct Params {
  const float *x, *c, *ctx, *c_ctx, *ada_w, *ada_b, *norm1_g, *norm2_g, *w_in, *conv_w, *conv_b, *fw1, *fb1, *fw2, *fb2, *fw3, *ffreq,
      *decay, *skip, *gate_w, *gate_b, *gla_ng, *w_bhy, *w_bgla, *w_out, *mlp_w1, *mlp_w2, *final_g;
  float* out; unsigned char* ws;
};

typedef float f32x2_t __attribute__((ext_vector_type(2)));
typedef __bf16 bf16x2_t __attribute__((ext_vector_type(2)));
DI bf16_t f2bf(float f) { const __bf16 b = (__bf16)f; return __builtin_bit_cast(bf16_t, b); }
DI float bf2f(bf16_t b) { return __uint_as_float(((unsigned)b) << 16); }
DI unsigned pk2(float lo, float hi) { f32x2_t v; v.x = lo; v.y = hi; const bf16x2_t b = __builtin_convertvector(v, bf16x2_t); return __builtin_bit_cast(unsigned, b); }
DI float bflo(unsigned w) { return __uint_as_float(w << 16); }
DI float bfhi(unsigned w) { return __uint_as_float(w & 0xffff0000u); }
DI float sigm(float x) { return __builtin_amdgcn_rcpf(1.f + __expf(-x)); }
DI float my_sin(float x) { float r = x * 0.15915494309189535f; r -= rintf(r); return __builtin_amdgcn_sinf(r); }
DI float wave_sum(float v) {
#pragma unroll
  for (int o = 32; o >= 1; o >>= 1) v += __shfl_xor(v, o);
  return v;
}
DI float* xrow(const Params& p, int row) { return row < NLAT ? p.out + (size_t)row * DM : (float*)(p.ws + OFF_CTXS) + (size_t)(row - NLAT) * DM; }
DI const float* xrow_in(const Params& p, int row) { return row < NLAT ? p.x + (size_t)row * DM : p.ctx + (size_t)(row - NLAT) * DM; }
DI const float* modp(const Params& p, int l, int s) { return (const float*)(p.ws + OFF_MOD) + ((size_t)l * 5 + s) * 6144; }

DI void phase_copy(const Params& p) {
  if (blockIdx.x == 0) { unsigned* z = (unsigned*)(p.ws + OFF_CNT); for (int i = otid(); i < (1024 + 16384) / 4; i += NTH) z[i] = 0u; }
}

DI void phase_mod(const Params& p, LAS unsigned char* lds) {
  LAS float* sv = (LAS float*)lds;
  LAS float* red = sv + 5 * 1024;
  const int tid = otid();
  bool loaded = false;
  for (int it = blockIdx.x; it < 4 * 48; it += gridDim.x) {
    if (!loaded) {
      for (int i = tid; i < 5 * 1024; i += NTH) { const int s = i >> 10, k = i & 1023; const float v = s < 4 ? p.c[s * 1024 + k] : p.c_ctx[k]; sv[i] = v * sigm(v); }
      loaded = true;
    }
    __syncthreads();
    const int l = it / 48, cb = it % 48, cg4 = tid & 31, kq = tid >> 5;
    const float* W = p.ada_w + (size_t)l * 1024 * 6144 + cb * 128 + 4 * cg4;
    f32x4 a0 = {0.f, 0.f, 0.f, 0.f}, a1 = a0, a2 = a0, a3 = a0, a4 = a0;
#pragma unroll 8
    for (int k = kq * 64; k < kq * 64 + 64; ++k) { const f32x4 w = __builtin_nontemporal_load((const f32x4*)(W + (size_t)k * 6144)); a0 += w * sv[k]; a1 += w * sv[1024 + k]; a2 += w * sv[2048 + k]; a3 += w * sv[3072 + k]; a4 += w * sv[4096 + k]; }
    LAS float* r = red + kq * 5 * 128 + 4 * cg4;
    *(LAS f32x4*)(r) = a0; *(LAS f32x4*)(r + 128) = a1; *(LAS f32x4*)(r + 256) = a2; *(LAS f32x4*)(r + 384) = a3; *(LAS f32x4*)(r + 512) = a4;
    __syncthreads();
    if (tid < 128) {
      const int col = cb * 128 + tid;
      const float bias = p.ada_b[l * 6144 + col];
      float* mo = (float*)(p.ws + OFF_MOD) + (size_t)l * 5 * 6144 + col;
#pragma unroll
      for (int s = 0; s < 5; ++s) { float t = bias;
#pragma unroll
        for (int q = 0; q < 16; ++q) t += red[q * 5 * 128 + s * 128 + tid]; mo[(size_t)s * 6144] = t; }
    }
    __syncthreads();
  }
}

DI void phase_a2(const Params& p, LAS unsigned char* lds) {
  LAS float* zf = (LAS float*)lds;
  LAS float* a1s = zf + 64 * 36;
  const int tid = otid(), tl = tid >> 6, m = tid & 63;
  const int per = (4096 + 256) / 64;
  for (int it = blockIdx.x; it < 4 * per; it += gridDim.x) {
    const int l = it / per, r = it % per;
    const bool isc = r >= 64; const int Lq = isc ? 256 : 4096; const int i0 = (isc ? (r - 64) : r) * 64;
    for (int e = tid; e < 64 * 33; e += NTH) {
      const int tt = e / 33, f = e % 33, i = i0 + tt; float v;
      if (f == 0) v = (float)i / (float)(Lq - 1);
      else { const int j = (f - 1) & 15; const float band = 1e-4f + (float)j * ((15.f - 1e-4f) / 15.f); float rev = (float)i * band / (float)Lq; rev -= floorf(rev);
             v = (f <= 16) ? __builtin_amdgcn_cosf(rev) : -__builtin_amdgcn_sinf(rev); }
      zf[tt * 36 + f] = v;
    }
    const float fr = p.ffreq[l * 64 + m], b1v = p.fb1[l * 64 + m], b2v = p.fb2[l * 64 + m];
    float w1r[33];
#pragma unroll
    for (int f = 0; f < 33; ++f) w1r[f] = p.fw1[((size_t)l * 33 + f) * 64 + m];
    __syncthreads();
#pragma unroll 1
    for (int q = 0; q < 8; ++q) { const int tt = tl * 8 + q; float acc = b1v;
#pragma unroll
      for (int f = 0; f < 33; ++f) acc += zf[tt * 36 + f] * w1r[f];
      a1s[tt * 64 + m] = my_sin(fr * acc); }
    float w2r[64];
#pragma unroll
    for (int j = 0; j < 64; ++j) w2r[j] = p.fw2[((size_t)l * 64 + j) * 64 + m];
    __syncthreads();
    float* dst = isc ? (float*)(p.ws + OFF_A2C) + ((size_t)l * 256 + i0) * 64 : (float*)(p.ws + OFF_A2L) + ((size_t)l * 4096 + i0) * 64;
#pragma unroll 1
    for (int q = 0; q < 8; ++q) { const int tt = tl * 8 + q; float acc = b2v;
#pragma unroll
      for (int j4 = 0; j4 < 16; ++j4) { const f32x4 a = *(const LAS f32x4*)(a1s + tt * 64 + 4 * j4); acc += a.x * w2r[4 * j4] + a.y * w2r[4 * j4 + 1] + a.z * w2r[4 * j4 + 2] + a.w * w2r[4 * j4 + 3]; }
      dst[(size_t)tt * 64 + m] = my_sin(fr * acc); }
    __syncthreads();
  }
}

DI void wt_load(const float* src, int ld_src, int k0, int n0, f32x4 (&v)[2]) {
  const int tid = otid();
#pragma unroll
  for (int q = 0; q < 2; ++q) { const int kk = (tid >> 3) + 64 * q, nq = tid & 7; v[q] = __builtin_nontemporal_load((const f32x4*)(src + (size_t)(k0 + kk) * ld_src + n0 + 4 * nq)); }
}
DI void wt_store(const f32x4 (&v)[2], int k0, bf16_t* dst, int ld_dst, int drow0, LAS unsigned char* lds) {
  LAS bf16_t* t = (LAS bf16_t*)lds;
  const int tid = otid();
#pragma unroll
  for (int q = 0; q < 2; ++q) {
    const int kk = (tid >> 3) + 64 * q, nq = tid & 7;
    t[(4 * nq + 0) * 136 + kk] = f2bf(v[q].x); t[(4 * nq + 1) * 136 + kk] = f2bf(v[q].y); t[(4 * nq + 2) * 136 + kk] = f2bf(v[q].z); t[(4 * nq + 3) * 136 + kk] = f2bf(v[q].w);
  }
  __syncthreads();
  { const int n = tid >> 4, kq = tid & 15;
    const u32x4 o = *(const LAS u32x4*)(t + n * 136 + 8 * kq);
    *(u32x4*)(dst + (size_t)(drow0 + n) * ld_dst + k0 + 8 * kq) = o; }
  __syncthreads();
}
DI int win_dst_row(int n) {
  if (n < 3072) return n;
  if (n < 4096) return 4096 + (n - 3072);
  if (n < 5120) return 3072 + (n - 4096);
  if (n < 6144) return 4096 + 1024 + (n - 5120);
  if (n < 6176) return 8192 + (n - 6144);
  if (n < 7200) return 4096 + 2048 + (n - 6176);
  return 4096 + 3072 + (n - 7200);
}
struct WtItem { const float* src; int ld_src, k0, n0; bf16_t* dst; int ld_dst, drow0; };
DI WtItem wt_decode(const Params& p, int l, int part, int it) {
  unsigned char* ws = p.ws; WtItem w;
  const int n_win = 8 * 257, n_sq = 8 * 32, n_w1 = 8 * 128;
  if (part == 0) {
    if (it < n_win) { const int kt = it & 7, nt = it >> 3; w.src = p.w_in + (size_t)l * 1024 * 8224; w.ld_src = 8224; w.k0 = kt * 128; w.n0 = nt * 32; w.dst = (bf16_t*)(ws + OFF_WIN); w.ld_dst = 1024; w.drow0 = win_dst_row(nt * 32); }
    else { const int r = it - n_win, which = r / n_sq, q = r % n_sq, kt = q & 7, nt = q >> 3;
      w.src = (which == 0 ? p.w_bhy : which == 1 ? p.w_bgla : p.w_out) + (size_t)l * 1024 * 1024; w.ld_src = 1024; w.k0 = kt * 128; w.n0 = nt * 32;
      w.dst = (bf16_t*)(ws + (which == 0 ? OFF_WBHY : which == 1 ? OFF_WBGLA : OFF_WOUT)); w.ld_dst = 1024; w.drow0 = nt * 32; }
  } else {
    if (it < n_w1) { const int kt = it & 7, nt = it >> 3; w.src = p.mlp_w1 + (size_t)l * 1024 * 4096; w.ld_src = 4096; w.k0 = kt * 128; w.n0 = nt * 32; w.dst = (bf16_t*)(ws + OFF_W1); w.ld_dst = 1024; w.drow0 = nt * 32; }
    else { const int r = it - n_w1, kt = r & 31, nt = r >> 5; w.src = p.mlp_w2 + (size_t)l * 4096 * 1024; w.ld_src = 1024; w.k0 = kt * 128; w.n0 = nt * 32; w.dst = (bf16_t*)(ws + OFF_W2); w.ld_dst = 4096; w.drow0 = nt * 32; }
  }
  return w;
}
DI void phase_wconv(const Params& p, int l, LAS unsigned char* lds, int part, int blk, int nblk) {
  unsigned char* ws = p.ws;
  const int total = part == 0 ? (8 * 257 + 3 * 8 * 32) : (8 * 128 + 32 * 32);
  f32x4 v[2];
  if (blk < total) { const WtItem w = wt_decode(p, l, part, blk); wt_load(w.src, w.ld_src, w.k0, w.n0, v); }
  for (int it = blk; it < total; it += nblk) {
    const WtItem w = wt_decode(p, l, part, it);
    f32x4 cur[2] = {v[0], v[1]};
    if (it + nblk < total) { const WtItem w2 = wt_decode(p, l, part, it + nblk); wt_load(w2.src, w2.ld_src, w2.k0, w2.n0, v); }
    wt_store(cur, w.k0, w.dst, w.ld_dst, w.drow0, lds);
  }
  if (part == 0) { u32x4* z = (u32x4*)(ws + OFF_WIN + (size_t)8224 * 1024 * 2); const int n = 224 * 1024 * 2 / 16;
    for (int i = blk * NTH + otid(); i < n; i += nblk * NTH) z[i] = (u32x4){0u, 0u, 0u, 0u}; }
}

DI void phase_norm(const Params& p, int l, const float* g, int sh_off, int sc_off, int nrows, bool from_input) {
  const int lane = otid() & 63, gw = blockIdx.x * 8 + (otid() >> 6), nw = gridDim.x * 8;
  bf16_t* hb = (bf16_t*)(p.ws + OFF_X);
  const int rp = (nrows + nw - 1) / nw, r0 = gw * rp, r1 = min(nrows, r0 + rp);
  f32x4 A[4], B[4]; int scur = -1;
  f32x4 pa[4], pb2[4];
#define NORM_LOAD(rw) do { const int ra_ = (rw), rb_ = ((rw) + 1 < r1) ? (rw) + 1 : (rw); const float* xa_ = from_input ? xrow_in(p, ra_) : xrow(p, ra_); const float* xb_ = from_input ? xrow_in(p, rb_) : xrow(p, rb_); \
    _Pragma("unroll") for (int i = 0; i < 4; ++i) { pa[i] = *(const f32x4*)(xa_ + 4 * lane + 256 * i); pb2[i] = *(const f32x4*)(xb_ + 4 * lane + 256 * i); } } while (0)
  if (r0 < r1) NORM_LOAD(r0);
  for (int row = r0; row < r1; row += 2) {
    const bool two = row + 1 < r1;
    const int s = row < NLAT ? (row >> 12) : 4;
    if (s != scur) { scur = s; const float* mo = modp(p, l, s);
#pragma unroll
      for (int i = 0; i < 4; ++i) { const int c = 4 * lane + 256 * i; const f32x4 gg = *(const f32x4*)(g + c), sc = *(const f32x4*)(mo + sc_off + c); A[i] = gg * (sc + 1.f); B[i] = *(const f32x4*)(mo + sh_off + c); } }
    f32x4 va[4], vb[4]; float sa = 0.f, sb = 0.f;
#pragma unroll
    for (int i = 0; i < 4; ++i) { va[i] = pa[i]; vb[i] = pb2[i]; }
    if (row + 2 < r1) NORM_LOAD(row + 2);
#pragma unroll
    for (int i = 0; i < 4; ++i) { sa += va[i].x * va[i].x + va[i].y * va[i].y + va[i].z * va[i].z + va[i].w * va[i].w; sb += vb[i].x * vb[i].x + vb[i].y * vb[i].y + vb[i].z * vb[i].z + vb[i].w * vb[i].w; }
#pragma unroll
    for (int o = 32; o >= 1; o >>= 1) { sa += __shfl_xor(sa, o); sb += __shfl_xor(sb, o); }
    const float ra = rsqrtf(sa * (1.f / 1024.f) + EPSF), rb = rsqrtf(sb * (1.f / 1024.f) + EPSF);
    const int s2 = (row + 1) < NLAT ? ((row + 1) >> 12) : 4;
#pragma unroll
    for (int i = 0; i < 4; ++i) { const int c = 4 * lane + 256 * i; const f32x4 ya = va[i] * ra * A[i] + B[i];
      *(u32x2*)(hb + (size_t)row * 1024 + c) = (u32x2){pk2(ya.x, ya.y), pk2(ya.z, ya.w)}; }
    if (two) {
      if (s2 != scur) { scur = s2; const float* mo = modp(p, l, s2);
#pragma unroll
        for (int i = 0; i < 4; ++i) { const int c = 4 * lane + 256 * i; const f32x4 gg = *(const f32x4*)(g + c), sc = *(const f32x4*)(mo + sc_off + c); A[i] = gg * (sc + 1.f); B[i] = *(const f32x4*)(mo + sh_off + c); } }
#pragma unroll
      for (int i = 0; i < 4; ++i) { const int c = 4 * lane + 256 * i; const f32x4 yb = vb[i] * rb * A[i] + B[i];
        *(u32x2*)(hb + (size_t)(row + 1) * 1024 + c) = (u32x2){pk2(yb.x, yb.y), pk2(yb.z, yb.w)}; }
    }
  }
}
#undef NORM_LOAD
DI void phase_final_norm(const Params& p) {
  const int lane = otid() & 63, gw = blockIdx.x * 8 + (otid() >> 6), nw = gridDim.x * 8;
  for (int row = gw; row < NLAT; row += nw) {
    float* xr = p.out + (size_t)row * DM;
    float4 v[4]; float ss = 0.f;
#pragma unroll
    for (int i = 0; i < 4; ++i) { v[i] = *(const float4*)(xr + 4 * lane + 256 * i); ss += v[i].x * v[i].x + v[i].y * v[i].y + v[i].z * v[i].z + v[i].w * v[i].w; }
    ss = wave_sum(ss);
    const float rstd = rsqrtf(ss * (1.f / 1024.f) + EPSF);
#pragma unroll
    for (int i = 0; i < 4; ++i) { const int c = 4 * lane + 256 * i; const float4 gg = *(const float4*)(p.final_g + c);
      *(float4*)(xr + c) = make_float4(v[i].x * rstd * gg.x, v[i].y * rstd * gg.y, v[i].z * rstd * gg.z, v[i].w * rstd * gg.w); }
  }
}

DI void phase_filt_gemm(const Params& p, int l, LAS unsigned char* lds, int blk, int nblk) {
  LAS float* w3s = (LAS float*)lds;
  LAS float* a2s = w3s + 64 * 64;
  const int tid = otid();
  const int nL = 32 * 32, nC = 32 * 2;
  for (int it = blk; it < nL + nC; it += nblk) {
    const bool isc = it >= nL; const int r = isc ? it - nL : it; const int Lq = isc ? 256 : 4096;
    const int ntt = Lq / 128, dt = r / ntt, tt0 = (r % ntt) * 128, d0 = dt * 64;
    const float* A2 = isc ? (const float*)(p.ws + OFF_A2C) + (size_t)l * 256 * 64 : (const float*)(p.ws + OFF_A2L) + (size_t)l * 4096 * 64;
    float* hT = isc ? (float*)(p.ws + ((l & 1) ? OFF_HTC2 : OFF_HTC)) : (float*)(p.ws + ((l & 1) ? OFF_HP2 : OFF_HP));
    { const int m = tid >> 3, q = tid & 7; const float* s = p.fw3 + ((size_t)l * 64 + m) * 2048 + d0;
      *(LAS f32x4*)(w3s + m * 64 + 4 * q) = *(const f32x4*)(s + 4 * q); *(LAS f32x4*)(w3s + m * 64 + 32 + 4 * q) = *(const f32x4*)(s + 32 + 4 * q); }
    { const int tt = tid >> 2, mq = tid & 3; const float* s = A2 + (size_t)(tt0 + tt) * 64 + 16 * mq;
#pragma unroll
      for (int q = 0; q < 4; ++q) { const float4 v = *(const float4*)(s + 4 * q);
        a2s[(16 * mq + 4 * q + 0) * 132 + tt] = v.x; a2s[(16 * mq + 4 * q + 1) * 132 + tt] = v.y; a2s[(16 * mq + 4 * q + 2) * 132 + tt] = v.z; a2s[(16 * mq + 4 * q + 3) * 132 + tt] = v.w; } }
    __syncthreads();
    const int cx = tid & 15, ty = tid >> 4;
    float acc[4][4];
#pragma unroll
    for (int a = 0; a < 4; ++a)
#pragma unroll
      for (int b = 0; b < 4; ++b) acc[a][b] = 0.f;
#pragma unroll 8
    for (int m = 0; m < 64; ++m) {
      const f32x4 wv = *(const LAS f32x4*)(w3s + m * 64 + 4 * cx), av = *(const LAS f32x4*)(a2s + m * 132 + 4 * ty);
      const float w[4] = {wv.x, wv.y, wv.z, wv.w}, a[4] = {av.x, av.y, av.z, av.w};
#pragma unroll
      for (int ci = 0; ci < 4; ++ci)
#pragma unroll
        for (int ti = 0; ti < 4; ++ti) acc[ci][ti] += w[ci] * a[ti];
    }
    const float inv = 1.f / (float)(Lq - 1);
#pragma unroll
    for (int ci = 0; ci < 4; ++ci) {
      const int dirch = d0 + 4 * cx + ci; const float dc = fabsf(p.decay[l * 1024 + (dirch & 1023)]);
      float o[4];
#pragma unroll
      for (int ti = 0; ti < 4; ++ti) { const float tl = (float)(tt0 + 4 * ty + ti) * inv; o[ti] = acc[ci][ti] * __expf(-tl * dc); }
      *(float4*)(hT + (size_t)dirch * Lq + tt0 + 4 * ty) = make_float4(o[0], o[1], o[2], o[3]);
    }
    __syncthreads();
  }
}
#define XB_TMO      128
#define XB_XCNT(j)  (256  + 64 * (j))
#define XB_XSUB(j)  (1280 + 64 * (j))
#define XB_XGEN(j)  (2304 + 64 * (j))
#define XB_TOP      3328
#define XB_TOPGEN   3392
#define XCD_BAR_WORDS 3456
#define XB_SPIN_CAP (1u << 18)

__device__ __forceinline__ unsigned xb_ld(unsigned* p)              { return __hip_atomic_load(p, __ATOMIC_RELAXED, __HIP_MEMORY_SCOPE_AGENT); }
__device__ __forceinline__ unsigned xb_add(unsigned* p, unsigned v) { return __hip_atomic_fetch_add(p, v, __ATOMIC_RELAXED, __HIP_MEMORY_SCOPE_AGENT); }
__device__ __forceinline__ unsigned xb_xcc_id() { return (unsigned)__builtin_amdgcn_s_getreg((3 << 11) | 20) & 0xFu; }
#define XB_SPIN(cond, bar) do { unsigned _sp = 0; while (cond) { __builtin_amdgcn_s_sleep(1); \
    if ((++_sp & 255u) == 0u) { if (xb_ld(&(bar)[XB_TMO])) break; if (_sp > XB_SPIN_CAP) { atomicAdd(&(bar)[XB_TMO], 1u); break; } } } } while (0)
struct XcdBarrier {
    unsigned* bar; unsigned x;
    volatile LAS unsigned* st;
};

__device__ __forceinline__ XcdBarrier xcd_barrier_post(unsigned* bar, volatile LAS unsigned* st) {
    XcdBarrier b; b.bar = bar; b.x = xb_xcc_id(); b.st = st;
    if (threadIdx.x == 0) (void)xb_add(&bar[XB_XCNT(b.x)], 1u);
    return b;
}
__device__ __forceinline__ void xcd_barrier_complete(unsigned* bar, unsigned x, unsigned& nloc, unsigned& nx) {
    const unsigned G = gridDim.x * gridDim.y * gridDim.z;
    unsigned sum, cnt, mine, sp = 0u;
    for (;;) {
        sum = 0u; cnt = 0u; mine = 0u;
#pragma unroll
        for (unsigned j = 0; j < 16; ++j) { const unsigned c = xb_ld(&bar[XB_XCNT(j)]); sum += c; cnt += (c > 0u) ? 1u : 0u; mine = (j == x) ? c : mine; }
        if (sum == G) break;
        __builtin_amdgcn_s_sleep(1);
        if ((++sp & 255u) == 0u) { if (xb_ld(&bar[XB_TMO])) break; if (sp > XB_SPIN_CAP) { atomicAdd(&bar[XB_TMO], 1u); break; } }
    }
    nloc = mine > 0u ? mine : 1u; nx = cnt > 0u ? cnt : 1u;
}

__device__ __forceinline__ void xcd_barrier(const XcdBarrier& b) {
    asm volatile("s_waitcnt vmcnt(0)" ::: "memory");
    __syncthreads();
    if (threadIdx.x == 0) {
        unsigned* bar = b.bar;
        __builtin_amdgcn_s_waitcnt(0);
        unsigned nloc = b.st[0], nx = b.st[1];
        if (nloc == 0u) { xcd_barrier_complete(bar, b.x, nloc, nx); b.st[0] = nloc; b.st[1] = nx; }
        const unsigned old = xb_add(&bar[XB_XSUB(b.x)], 1u);
        const unsigned gen = old / nloc;
        if (old + 1u == (gen + 1u) * nloc) {
            __builtin_amdgcn_fence(__ATOMIC_RELEASE, "agent");
            asm volatile("s_waitcnt vmcnt(0)" ::: "memory");
            const unsigned og = xb_add(&bar[XB_TOP], 1u);
            const unsigned tg = og / nx;
            if (og + 1u == (tg + 1u) * nx) xb_add(&bar[XB_TOPGEN], 1u);
            else XB_SPIN(xb_ld(&bar[XB_TOPGEN]) == tg, bar);
            __builtin_amdgcn_fence(__ATOMIC_ACQUIRE, "agent");
            xb_add(&bar[XB_XGEN(b.x)], 1u);
            asm volatile("s_waitcnt vmcnt(0)" ::: "memory");
        } else {
            XB_SPIN(xb_ld(&bar[XB_XGEN(b.x)]) == gen, bar);
            __builtin_amdgcn_fence(__ATOMIC_ACQUIRE, "agent");
            asm volatile("s_waitcnt vmcnt(0)" ::: "memory");
        }
    }
    __syncthreads();
}

typedef float cplx __attribute__((ext_vector_type(2)));
DI cplx mk2(float a, float b) { cplx r; r.x = a; r.y = b; return r; }
DI constexpr float cos32(int m) { constexpr float t[16] = {1.f, 0.98078528040323043f, 0.92387953251128674f, 0.83146961230254524f, 0.70710678118654752f, 0.55557023301960218f, 0.38268343236508977f, 0.19509032201612825f,
    0.f, -0.19509032201612825f, -0.38268343236508977f, -0.55557023301960218f, -0.70710678118654752f, -0.83146961230254524f, -0.92387953251128674f, -0.98078528040323043f}; return t[m]; }
DI constexpr float sin32(int m) { constexpr float t[16] = {0.f, 0.19509032201612825f, 0.38268343236508977f, 0.55557023301960218f, 0.70710678118654752f, 0.83146961230254524f, 0.92387953251128674f, 0.98078528040323043f,
    1.f, 0.98078528040323043f, 0.92387953251128674f, 0.83146961230254524f, 0.70710678118654752f, 0.55557023301960218f, 0.38268343236508977f, 0.19509032201612825f}; return t[m]; }
DI constexpr int brev(int k, int bits) { int r = 0; for (int i = 0; i < bits; ++i) r |= ((k >> i) & 1) << (bits - 1 - i); return r; }
DI cplx cmul_c(cplx a, cplx b) { return mk2(a.x * b.x - a.y * b.y, a.x * b.y + a.y * b.x); }
DI cplx cmulc_c(cplx a, cplx b) { return mk2(a.x * b.x + a.y * b.y, a.y * b.x - a.x * b.y); }
DI cplx cmul(cplx a, cplx b) { cplx r; asm("v_pk_mul_f32 %0, %1, %2 op_sel_hi:[1,0]\n\tv_pk_fma_f32 %0, %1, %2, %0 op_sel:[1,1,0] op_sel_hi:[0,1,1] neg_lo:[1,0,0]" : "=&v"(r) : "v"(a), "v"(b)); return r; }
DI cplx cmulc(cplx a, cplx b) { cplx r; asm("v_pk_mul_f32 %0, %1, %2 op_sel_hi:[1,0]\n\tv_pk_fma_f32 %0, %1, %2, %0 op_sel:[1,1,0] op_sel_hi:[0,1,1] neg_hi:[1,0,0]" : "=&v"(r) : "v"(a), "v"(b)); return r; }
DI cplx cmul_s(cplx a, cplx b) { cplx r; asm("v_pk_mul_f32 %0, %1, %2 op_sel_hi:[1,0]\n\tv_pk_fma_f32 %0, %1, %2, %0 op_sel:[1,1,0] op_sel_hi:[0,1,1] neg_lo:[1,0,0]" : "=&v"(r) : "v"(a), "s"(b)); return r; }
DI cplx cmulc_s(cplx a, cplx b) { cplx r; asm("v_pk_mul_f32 %0, %1, %2 op_sel_hi:[1,0]\n\tv_pk_fma_f32 %0, %1, %2, %0 op_sel:[1,1,0] op_sel_hi:[0,1,1] neg_hi:[1,0,0]" : "=&v"(r) : "v"(a), "s"(b)); return r; }
DI cplx mul_mi(cplx a) { cplx r; asm("v_pk_mul_f32 %0, %1, 1.0 op_sel:[1,0] op_sel_hi:[0,0] neg_hi:[1,0]" : "=v"(r) : "v"(a)); return r; }
DI cplx mul_pi(cplx a) { cplx r; asm("v_pk_mul_f32 %0, %1, 1.0 op_sel:[1,0] op_sel_hi:[0,0] neg_lo:[1,0]" : "=v"(r) : "v"(a)); return r; }

template <int R, bool INV> DI void dft_reg(cplx (&v)[R]) {
#pragma unroll
  for (int len = R; len >= 2; len >>= 1) {
    const int half = len >> 1;
#pragma unroll
    for (int s = 0; s < R; s += len) {
#pragma unroll
      for (int j = 0; j < half; ++j) {
        const cplx a = v[s + j], b = v[s + j + half];
        v[s + j] = mk2(a.x + b.x, a.y + b.y);
        const cplx d = mk2(a.x - b.x, a.y - b.y);
        const int m = j * (32 / len);
        if (m == 0) v[s + j + half] = d;
        else if (m == 8) v[s + j + half] = INV ? mul_pi(d) : mul_mi(d);
        else { const cplx K = mk2(cos32(m), sin32(m));
          v[s + j + half] = INV ? cmul_s(d, K) : cmulc_s(d, K); }
      }
    }
  }
}
constexpr int FFT_REGION_F2 = 8704;

template <int NV> DI void fft_fwd3(cplx (&v)[NV][16], LAS cplx* L, int tid) {

#pragma unroll
  for (int i = 0; i < NV; ++i) dft_reg<16, false>(v[i]);

  { float rev = (float)tid * (1.f / 8192.f); asm volatile("" : "+v"(rev)); const cplx w1 = mk2(__builtin_amdgcn_cosf(rev), -__builtin_amdgcn_sinf(rev)); cplx w = mk2(1.f, 0.f);
    const int pb = tid + 2 * (tid >> 5);
#pragma unroll
    for (int k = 0; k < 16; ++k) {
#pragma unroll
      for (int i = 0; i < NV; ++i) L[i * FFT_REGION_F2 + pb + 544 * k] = cmul(v[i][brev(k, 4)], w);
      w = cmul(w, w1); } }
  __syncthreads();
  { const int sb = tid >> 5, ii = tid & 31, pb = 544 * sb + ii;
    cplx u[NV][16];
#pragma unroll
    for (int i = 0; i < NV; ++i)
#pragma unroll
      for (int j = 0; j < 16; ++j) u[i][j] = L[i * FFT_REGION_F2 + pb + 34 * j];

#pragma unroll
    for (int i = 0; i < NV; ++i) dft_reg<16, false>(u[i]);

    float rev = (float)ii * (1.f / 512.f); asm volatile("" : "+v"(rev)); const cplx w1 = mk2(__builtin_amdgcn_cosf(rev), -__builtin_amdgcn_sinf(rev)); cplx w = mk2(1.f, 0.f);
#pragma unroll
    for (int k = 0; k < 16; ++k) {
#pragma unroll
      for (int i = 0; i < NV; ++i) L[i * FFT_REGION_F2 + pb + 34 * k] = cmul(u[i][brev(k, 4)], w);
      w = cmul(w, w1); } }
  __syncthreads();
  { const int sb = tid >> 1, ii = tid & 1, pb = 34 * sb + ii;
    cplx u[NV][16];
#pragma unroll
    for (int i = 0; i < NV; ++i)
#pragma unroll
      for (int j = 0; j < 16; ++j) u[i][j] = L[i * FFT_REGION_F2 + pb + 2 * j];

#pragma unroll
    for (int i = 0; i < NV; ++i) dft_reg<16, false>(u[i]);

#pragma unroll
    for (int k = 0; k < 16; ++k)
#pragma unroll
      for (int i = 0; i < NV; ++i) { const cplx y = u[i][brev(k, 4)]; const cplx yw = cmul_c(y, mk2(cos32(k), -sin32(k))); L[i * FFT_REGION_F2 + pb + 2 * k] = ii ? yw : y; } }
  __syncthreads();
}
template <int NV> DI void fft_inv3(cplx (&v)[NV][16], LAS cplx* L, int tid) {
  { const int sb = tid >> 1, ii = tid & 1, pb = 34 * sb + ii;
    cplx u[NV][16];
#pragma unroll
    for (int i = 0; i < NV; ++i)
#pragma unroll
      for (int k = 0; k < 16; ++k) { const cplx y = L[i * FFT_REGION_F2 + pb + 2 * k]; const cplx yw = cmulc_c(y, mk2(cos32(k), -sin32(k))); u[i][k] = ii ? yw : y; }

#pragma unroll
    for (int i = 0; i < NV; ++i) dft_reg<16, true>(u[i]);

#pragma unroll
    for (int i = 0; i < NV; ++i)
#pragma unroll
      for (int j = 0; j < 16; ++j) L[i * FFT_REGION_F2 + pb + 2 * j] = u[i][brev(j, 4)]; }
  __syncthreads();
  { const int sb = tid >> 5, ii = tid & 31, pb = 544 * sb + ii;
    cplx u[NV][16];
    float rev = (float)ii * (1.f / 512.f); asm volatile("" : "+v"(rev)); const cplx w1 = mk2(__builtin_amdgcn_cosf(rev), -__builtin_amdgcn_sinf(rev)); cplx w = mk2(1.f, 0.f);
#pragma unroll
    for (int k = 0; k < 16; ++k) {
#pragma unroll
      for (int i = 0; i < NV; ++i) u[i][k] = cmulc(L[i * FFT_REGION_F2 + pb + 34 * k], w);
      w = cmul(w, w1); }

#pragma unroll
    for (int i = 0; i < NV; ++i) dft_reg<16, true>(u[i]);

#pragma unroll
    for (int i = 0; i < NV; ++i)
#pragma unroll
      for (int j = 0; j < 16; ++j) L[i * FFT_REGION_F2 + pb + 34 * j] = u[i][brev(j, 4)]; }
  __syncthreads();
  { float rev = (float)tid * (1.f / 8192.f); asm volatile("" : "+v"(rev)); const cplx w1 = mk2(__builtin_amdgcn_cosf(rev), -__builtin_amdgcn_sinf(rev)); cplx w = mk2(1.f, 0.f);
    const int pb = tid + 2 * (tid >> 5);
#pragma unroll
    for (int k = 0; k < 16; ++k) {
#pragma unroll
      for (int i = 0; i < NV; ++i) v[i][k] = cmulc(L[i * FFT_REGION_F2 + pb + 544 * k], w);
      w = cmul(w, w1); }

#pragma unroll
    for (int i = 0; i < NV; ++i) dft_reg<16, true>(v[i]);
     }
}

DI float shl1(float x, int lane) { const float t = __shfl_up(x, 1); return lane == 0 ? 0.f : t; }
DI float shr1(float x, int lane) { const float t = __shfl_down(x, 1); return lane == 63 ? 0.f : t; }
DI void hy_conv8(const bf16_t* XT, int c, int bt, int tl, int lane, const float (&cw)[3][3], const float (&cb)[3], float (&x0c)[8], float (&zz)[8]) {
  float uc[3][8];
#pragma unroll
  for (int g = 0; g < 3; ++g) {
    const u32x4 raw = *(const u32x4*)(XT + (size_t)(g * 1024 + c) * NTOK + (size_t)bt * 4096 + 8 * tl);
    float pv[10];
#pragma unroll
    for (int q = 0; q < 4; ++q) { pv[1 + 2 * q] = bflo(raw[q]); pv[2 + 2 * q] = bfhi(raw[q]); }
    { const float t0 = __shfl_up(pv[8], 1), t1 = __shfl_down(pv[1], 1); pv[0] = (lane & 7) == 0 ? 0.f : t0; pv[9] = (lane & 7) == 7 ? 0.f : t1; }
#pragma unroll
    for (int e2 = 0; e2 < 8; ++e2) uc[g][e2] = cw[g][0] * pv[e2] + cw[g][1] * pv[e2 + 1] + cw[g][2] * pv[e2 + 2] + cb[g];
  }
#pragma unroll
  for (int e2 = 0; e2 < 8; ++e2) { x0c[e2] = uc[0][e2]; zz[e2] = uc[1][e2] * uc[2][e2]; }
}
template <int NV> DI void hyena_chan(const Params& p, int l, int c, LAS cplx* L, int tid) {
  bf16_t* XT = (bf16_t*)(p.ws + OFF_XT);
  const int lane = tid & 63;
  const int pb4 = 16 * tid + 2 * (tid >> 1);
  h16x2 Hr[5]; LAS h16x2* Hl = (LAS h16x2*)(L + 2 * FFT_REGION_F2) + tid;
  {
    const float* hT = (const float*)(p.ws + ((l & 1) ? OFF_HP2 : OFF_HP));
    const float* hf = hT + (size_t)c * 4096, * hbk = hT + (size_t)(1024 + c) * 4096;
    cplx f[1][16];
#pragma unroll
    for (int j = 0; j < 8; ++j) f[0][j] = mk2(__builtin_nontemporal_load(hf + tid + 512 * j), 0.f);
#pragma unroll
    for (int j = 8; j < 16; ++j) { const int n = tid + 512 * j; f[0][j] = mk2(n == 4096 ? 0.f : __builtin_nontemporal_load(hbk + (n == 4096 ? 0 : 8192 - n)), 0.f); }
    fft_fwd3<1>(f, L, tid);
#pragma unroll
    for (int m = 0; m < 8; ++m) { const cplx a = L[pb4 + 2 * m], b = L[pb4 + 2 * m + 1];
      h16x2 h0, h1; h0.x = (_Float16)((a.x + b.x) * HSCALE); h0.y = (_Float16)((a.y + b.y) * HSCALE); h1.x = (_Float16)((a.x - b.x) * HSCALE); h1.y = (_Float16)((a.y - b.y) * HSCALE);
      if (2 * m < 11) Hl[(2 * m) * 512] = h0; else Hr[2 * m - 11 < 0 ? 0 : 2 * m - 11] = h0;
      if (2 * m + 1 < 11) Hl[(2 * m + 1) * 512] = h1; else Hr[2 * m + 1 - 11 < 0 ? 0 : 2 * m + 1 - 11] = h1; }
    __syncthreads();
  }
  float cw[3][3], cb[3];
#pragma unroll
  for (int g = 0; g < 3; ++g) { cb[g] = p.conv_b[l * 3072 + g * 1024 + c];
#pragma unroll
    for (int t = 0; t < 3; ++t) cw[g][t] = p.conv_w[((size_t)l * 3 + t) * 3072 + g * 1024 + c]; }
  const float sk = p.skip[l * 1024 + c], sc = 1.f / (8192.f * HSCALE);
#pragma unroll 1
  for (int bp0 = 0; bp0 < 2; bp0 += NV) {
    int tl = tid; asm volatile("" : "+v"(tl));
#pragma unroll
    for (int i = 0; i < NV; ++i) {
      float xa[8], za[8], xb[8], zb[8];
      hy_conv8(XT, c, 2 * (bp0 + i), tl, lane, cw, cb, xa, za);
      hy_conv8(XT, c, 2 * (bp0 + i) + 1, tl, lane, cw, cb, xb, zb);
      LAS cplx* X = L + i * FFT_REGION_F2 + 8 * tl + 2 * (tl >> 2);
#pragma unroll
      for (int e2 = 0; e2 < 8; ++e2) X[e2] = mk2(za[e2], zb[e2]);

    }
    __syncthreads();
    cplx v[NV][16];
    { const int pb = tl + 2 * (tl >> 5);
#pragma unroll
      for (int i = 0; i < NV; ++i) {
#pragma unroll
        for (int j = 0; j < 8; ++j) v[i][j] = L[i * FFT_REGION_F2 + pb + 544 * j];
#pragma unroll
        for (int j = 8; j < 16; ++j) v[i][j] = mk2(0.f, 0.f); } }
    __syncthreads();

    fft_fwd3<NV>(v, L, tid);

#pragma unroll
    for (int i = 0; i < NV; ++i) {
      LAS cplx* Li = L + i * FFT_REGION_F2;
#pragma unroll
      for (int m = 0; m < 8; ++m) { const cplx a = Li[pb4 + 2 * m], b = Li[pb4 + 2 * m + 1];
        const h16x2 h0 = (2 * m < 11) ? Hl[(2 * m) * 512] : Hr[2 * m - 11 < 0 ? 0 : 2 * m - 11], h1 = (2 * m + 1 < 11) ? Hl[(2 * m + 1) * 512] : Hr[2 * m + 1 - 11 < 0 ? 0 : 2 * m + 1 - 11];
        const cplx y0 = cmul(mk2(a.x + b.x, a.y + b.y), mk2((float)h0.x, (float)h0.y)), y1 = cmul(mk2(a.x - b.x, a.y - b.y), mk2((float)h1.x, (float)h1.y));
        Li[pb4 + 2 * m] = mk2(y0.x + y1.x, y0.y + y1.y); Li[pb4 + 2 * m + 1] = mk2(y0.x - y1.x, y0.y - y1.y); }
       }
    __syncthreads();
    fft_inv3<NV>(v, L, tid);

    { const int pb = tl + 2 * (tl >> 5);
#pragma unroll
      for (int i = 0; i < NV; ++i)
#pragma unroll
        for (int j = 0; j < 8; ++j) L[i * FFT_REGION_F2 + pb + 544 * j] = v[i][brev(j, 4)]; }
    __syncthreads();
#pragma unroll
    for (int i = 0; i < NV; ++i) {
      float xa[8], za[8], xb[8], zb[8];
      hy_conv8(XT, c, 2 * (bp0 + i), tl, lane, cw, cb, xa, za);
      hy_conv8(XT, c, 2 * (bp0 + i) + 1, tl, lane, cw, cb, xb, zb);
      const LAS cplx* X = L + i * FFT_REGION_F2 + 8 * tl + 2 * (tl >> 2);
      float ya[8], yb[8];
#pragma unroll
      for (int e2 = 0; e2 < 8; ++e2) { const cplx cv = X[e2]; ya[e2] = xa[e2] * (cv.x * sc + sk * za[e2]); yb[e2] = xb[e2] * (cv.y * sc + sk * zb[e2]); }
      *(u32x4*)(XT + (size_t)c * NTOK + (size_t)(2 * (bp0 + i)) * 4096 + 8 * tl) = (u32x4){pk2(ya[0], ya[1]), pk2(ya[2], ya[3]), pk2(ya[4], ya[5]), pk2(ya[6], ya[7])};
      *(u32x4*)(XT + (size_t)c * NTOK + (size_t)(2 * (bp0 + i) + 1) * 4096 + 8 * tl) = (u32x4){pk2(yb[0], yb[1]), pk2(yb[2], yb[3]), pk2(yb[4], yb[5]), pk2(yb[6], yb[7])};

    }
    __syncthreads();
  }
}

DI void hyena_ctx_item(const Params& p, int l, int c, LAS unsigned char* lds) {
  LAS float* zs = (LAS float*)lds;
  LAS float* hc = zs + 1024;
  LAS float* part = hc + 512;
  bf16_t* XT = (bf16_t*)(p.ws + OFF_XT);
  const float* hTc = (const float*)(p.ws + ((l & 1) ? OFF_HTC2 : OFF_HTC));
  const int tid = otid();
  { const int i = tid - 256; hc[tid] = i >= 0 ? hTc[(size_t)c * 256 + i] : (tid == 0 ? 0.f : hTc[(size_t)(1024 + c) * 256 + (-i)]); }
  float u0[2];
  { const int b = tid >> 7, tq = tid & 127;
#pragma unroll
    for (int e = 0; e < 2; ++e) {
      const int t = tq + 128 * e;
      float uu[3];
#pragma unroll
      for (int g = 0; g < 3; ++g) {
        const bf16_t* row = XT + (size_t)(g * 1024 + c) * NTOK + NLAT + b * 256;
        const float pm = t > 0 ? bf2f(row[t - 1]) : 0.f, p0 = bf2f(row[t]), pp = t < 255 ? bf2f(row[t + 1]) : 0.f;
        const size_t wb = (size_t)l * 3 * 3072 + g * 1024 + c;
        uu[g] = p.conv_w[wb] * pm + p.conv_w[wb + 3072] * p0 + p.conv_w[wb + 6144] * pp + p.conv_b[l * 3072 + g * 1024 + c];
      }
      u0[e] = uu[0]; zs[b * 256 + t] = uu[1] * uu[2];
    } }
  __syncthreads();
  const int t0 = 4 * (tid & 63), cbatch = (tid >> 6) & 3, sh = tid >> 8;
  float y[4] = {0.f, 0.f, 0.f, 0.f};
#pragma unroll 4
  for (int s0 = 128 * sh; s0 < 128 * sh + 128; s0 += 4) {
    const int base = 256 + t0 - s0 - 4;
    const f32x4 H0 = *(const LAS f32x4*)(hc + base), H1 = *(const LAS f32x4*)(hc + base + 4), z4 = *(const LAS f32x4*)(zs + cbatch * 256 + s0);
    const float hw[8] = {H0.x, H0.y, H0.z, H0.w, H1.x, H1.y, H1.z, H1.w}, zv[4] = {z4.x, z4.y, z4.z, z4.w};
#pragma unroll
    for (int j = 0; j < 4; ++j)
#pragma unroll
      for (int u = 0; u < 4; ++u) y[j] += hw[4 + j - u] * zv[u];
  }
  if (sh) *(LAS f32x4*)(part + cbatch * 256 + t0) = (f32x4){y[0], y[1], y[2], y[3]};
  __syncthreads();
  if (!sh) { const f32x4 o = *(const LAS f32x4*)(part + cbatch * 256 + t0); part[cbatch * 256 + t0] = y[0] + o.x; part[cbatch * 256 + t0 + 1] = y[1] + o.y; part[cbatch * 256 + t0 + 2] = y[2] + o.z; part[cbatch * 256 + t0 + 3] = y[3] + o.w; }
  __syncthreads();
  { const int b = tid >> 7, tq = tid & 127; const float sk = p.skip[l * 1024 + c];
#pragma unroll
    for (int e = 0; e < 2; ++e) { const int t = tq + 128 * e;
      XT[(size_t)c * NTOK + NLAT + b * 256 + t] = f2bf(u0[e] * (part[b * 256 + t] + sk * zs[b * 256 + t])); } }
  __syncthreads();
}

#ifndef HY_NV
#define HY_NV 2
#endif
#define MFMA32(a, b, c) __builtin_amdgcn_mfma_f32_32x32x16_bf16((a), (b), (c), 0, 0, 0)
DI float logsig(float x) { return fminf(x, 0.f) - __logf(1.f + __expf(-fabsf(x))); }
DI void phase_gla_prep(const Params& p, int l, LAS unsigned char* lds) {
  LAS float* lrs = (LAS float*)lds;
  LAS float* tots = lrs + 64 * 32;
  LAS bf16_t* qs = (LAS bf16_t*)(tots + 2 * 4 * 128);
  LAS bf16_t* kes = qs + 4 * 64 * 136;
  LAS bf16_t* ats = kes + 2 * 128 * 72;
  const int tid = otid(), d = tid & 127, tq = tid >> 7, wid = tid >> 6, lane = tid & 63;
  const bf16_t* PB = (const bf16_t*)(p.ws + OFF_PB);
  const float* LR = (const float*)(p.ws + OFF_LR);
  bf16_t* QF = (bf16_t*)(p.ws + OFF_QF); bf16_t* QB = (bf16_t*)(p.ws + OFF_QB);
  bf16_t* KEF = (bf16_t*)(p.ws + OFF_KEF); bf16_t* KEB = (bf16_t*)(p.ws + OFF_KEB);
  bf16_t* ATT = (bf16_t*)(p.ws + OFF_ATT); float* DEC = (float*)(p.ws + OFF_DEC);
  const float qscale = 0.08838834764831845f;
  f32x4 lrv; bf16_t qv[16], kv[16];
#define PREP_LOAD(it_) do { const int ch_ = (it_) >> 2, hh_ = (it_) & 3; const size_t t0_ = (size_t)ch_ * 64; lrv = *(const f32x4*)(LR + t0_ * 32 + 4 * tid); \
    _Pragma("unroll") for (int i = 0; i < 16; ++i) { const size_t tk_ = t0_ + tq * 16 + i; qv[i] = PB[tk_ * 4096 + hh_ * 128 + d]; kv[i] = PB[tk_ * 4096 + 512 + hh_ * 128 + d]; } } while (0)
  float gwf[16], gwb[16], gbf = 0.f, gbb = 0.f;
#define PREP_LOADG(it_) do { const int hh_ = (it_) & 3; \
    _Pragma("unroll") for (int r = 0; r < 16; ++r) { gwf[r] = p.gate_w[(((size_t)l * 2 + 0) * 16 + r) * 512 + hh_ * 128 + d]; gwb[r] = p.gate_w[(((size_t)l * 2 + 1) * 16 + r) * 512 + hh_ * 128 + d]; } \
    gbf = p.gate_b[((size_t)l * 2 + 0) * 512 + hh_ * 128 + d]; gbb = p.gate_b[((size_t)l * 2 + 1) * 512 + hh_ * 128 + d]; } while (0)
  if ((int)blockIdx.x < 272 * 4) PREP_LOAD((int)blockIdx.x);
  for (int it = blockIdx.x; it < 272 * 4; it += gridDim.x) {
    const int chunk = it >> 2, h = it & 3, tok0 = chunk * 64;
    *(LAS f32x4*)(lrs + 4 * tid) = lrv;
    PREP_LOADG(it);
    __syncthreads();
    float cf[16], cb[16];
#pragma unroll
    for (int i = 0; i < 16; ++i) {
      const int t = tq * 16 + i; float pf = gbf, pb = gbb;
#pragma unroll
      for (int r4 = 0; r4 < 4; ++r4) { const f32x4 lf = *(const LAS f32x4*)(lrs + t * 32 + 4 * r4), lb = *(const LAS f32x4*)(lrs + t * 32 + 16 + 4 * r4);
        pf += lf.x * gwf[4 * r4] + lf.y * gwf[4 * r4 + 1] + lf.z * gwf[4 * r4 + 2] + lf.w * gwf[4 * r4 + 3]; pb += lb.x * gwb[4 * r4] + lb.y * gwb[4 * r4 + 1] + lb.z * gwb[4 * r4 + 2] + lb.w * gwb[4 * r4 + 3]; }
      cf[i] = logsig(pf) * (1.f / 16.f); cb[i] = logsig(pb) * (1.f / 16.f);
    }
    { float run = 0.f;
#pragma unroll
      for (int i = 0; i < 16; ++i) { run += cf[i]; cf[i] = run; }
      tots[(0 * 4 + tq) * 128 + d] = run; run = 0.f;
#pragma unroll
      for (int i = 15; i >= 0; --i) { run += cb[i]; cb[i] = run; }
      tots[(1 * 4 + tq) * 128 + d] = run; }
    __syncthreads();
    float offf = 0.f, offb = 0.f, cendf = 0.f, cendb = 0.f;
#pragma unroll
    for (int q = 0; q < 4; ++q) { const float a = tots[(0 * 4 + q) * 128 + d], b = tots[(1 * 4 + q) * 128 + d]; cendf += a; cendb += b; if (q < tq) offf += a; if (q > tq) offb += b; }
    const int o16 = d & 15, grp = o16 >> 2, ngrp = (grp == 1) ? 2 : (grp == 2) ? 1 : grp, permd = (d & ~15) | (ngrp << 2) | (o16 & 3);
    unsigned kef[8], keb[8];
    const float ecf = __expf(cendf), ecb = __expf(cendb);
#pragma unroll
    for (int i = 0; i < 16; ++i) {
      const int t = tq * 16 + i; const size_t tok = (size_t)tok0 + t;
      const float q = bf2f(qv[i]) * qscale, k = bf2f(kv[i]);
      const float ea = __expf(cf[i] + offf), eb2 = __expf(cb[i] + offb);
      const float kia = k * __builtin_amdgcn_rcpf(ea), kib = k * __builtin_amdgcn_rcpf(eb2);
      const bf16_t qf = f2bf(q * ea), kf = f2bf(kia), qb = f2bf(q * eb2), kb = f2bf(kib);
      const bf16_t ef = f2bf(kia * ecf), eb = f2bf(kib * ecb);
      qs[(0 * 64 + t) * 136 + d] = qf; qs[(1 * 64 + t) * 136 + d] = kf; qs[(2 * 64 + t) * 136 + d] = qb; qs[(3 * 64 + t) * 136 + d] = kb;
      QF[tok * 512 + h * 128 + permd] = qf; QB[tok * 512 + h * 128 + permd] = qb;
      if (i & 1) { kef[i >> 1] |= (unsigned)ef << 16; keb[i >> 1] |= (unsigned)eb << 16; } else { kef[i >> 1] = ef; keb[i >> 1] = eb; }
    }
    if (it + (int)gridDim.x < 272 * 4) PREP_LOAD(it + (int)gridDim.x);
    { LAS u32x4* d1 = (LAS u32x4*)(kes + (0 * 128 + d) * 72 + tq * 16); d1[0] = (u32x4){kef[0], kef[1], kef[2], kef[3]}; d1[1] = (u32x4){kef[4], kef[5], kef[6], kef[7]};
      LAS u32x4* d2 = (LAS u32x4*)(kes + (1 * 128 + d) * 72 + tq * 16); d2[0] = (u32x4){keb[0], keb[1], keb[2], keb[3]}; d2[1] = (u32x4){keb[4], keb[5], keb[6], keb[7]}; }
    if (tq == 0) { DEC[(((size_t)chunk * 4 + h) * 2 + 0) * 128 + d] = ecf; DEC[(((size_t)chunk * 4 + h) * 2 + 1) * 128 + d] = ecb; }
    __syncthreads();
    {
      const int dir = wid >> 2, ti = (wid >> 1) & 1, si = wid & 1, r = lane & 31, hh = lane >> 5;
      const LAS bf16_t* ka = qs + ((dir * 2 + 1) * 64 + 32 * si + r) * 136 + 8 * hh;
      const LAS bf16_t* qa = qs + ((dir * 2 + 0) * 64 + 32 * ti + r) * 136 + 8 * hh;
      f32x16 acc;
#pragma unroll
      for (int i = 0; i < 16; ++i) acc[i] = 0.f;
#pragma unroll
      for (int ks = 0; ks < 8; ++ks) acc = MFMA32(*(const LAS bf16x8*)(ka + 16 * ks), *(const LAS bf16x8*)(qa + 16 * ks), acc);
      const int t = 32 * ti + r;
      LAS bf16_t* dst = ats + (dir * 64 + t) * 72 + 32 * si + 4 * hh;
#pragma unroll
      for (int g = 0; g < 4; ++g) {
        float vv[4];
#pragma unroll
        for (int e = 0; e < 4; ++e) { const int s = 32 * si + 8 * g + 4 * hh + e; const bool keep = dir ? (s >= t) : (s <= t); vv[e] = keep ? acc[4 * g + e] : 0.f; }
        *(LAS u32x2*)(dst + 8 * g) = (u32x2){pk2(vv[0], vv[1]), pk2(vv[2], vv[3])};
      }
    }
    __syncthreads();
    {
      const size_t chh = (size_t)chunk * 4 + h;
#pragma unroll
      for (int q = 0; q < 2; ++q) { const int pc = tid + 512 * q, row = pc >> 3, cc = pc & 7;
        *(u32x4*)(KEF + (chh * 128 + row) * 64 + 8 * cc) = *(const LAS u32x4*)(kes + (0 * 128 + row) * 72 + 8 * cc);
        *(u32x4*)(KEB + (chh * 128 + row) * 64 + 8 * cc) = *(const LAS u32x4*)(kes + (1 * 128 + row) * 72 + 8 * cc);
        const int rr = row & 63, dd = row >> 6;
        *(u32x4*)(ATT + ((chh * 2 + dd) * 64 + rr) * 64 + 8 * cc) = *(const LAS u32x4*)(ats + (dd * 64 + rr) * 72 + 8 * cc); }
    }
    __syncthreads();
  }
}

#undef PREP_LOAD
#undef PREP_LOADG
DI bf16x8 pack8(const f32x16& x, int s) {
  u32x4 r; r[0] = pk2(x[8 * s + 0], x[8 * s + 1]); r[1] = pk2(x[8 * s + 2], x[8 * s + 3]); r[2] = pk2(x[8 * s + 4], x[8 * s + 5]); r[3] = pk2(x[8 * s + 6], x[8 * s + 7]);
  return __builtin_bit_cast(bf16x8, r);
}
DI void phase_gla_scan(const Params& p, LAS unsigned char* lds) {
  constexpr int BUFB = 64 * 136 * 2 + 128 * 72 * 2 + 64 * 72 * 2 + 512;
  const int tid = otid(), wid = tid >> 6, lane = tid & 63, r = lane & 31, hh = lane >> 5;
  const int bid = blockIdx.x, b = bid >> 4, h = (bid >> 2) & 3, dir = (bid >> 1) & 1, dvh = bid & 1;
  const bool cwave = wid < 4;
  const bf16_t* Qg = (const bf16_t*)(p.ws + (dir ? OFF_QB : OFF_QF));
  const bf16_t* Kg = (const bf16_t*)(p.ws + (dir ? OFF_KEB : OFF_KEF));
  const bf16_t* ATT = (const bf16_t*)(p.ws + OFF_ATT); const float* DEC = (const float*)(p.ws + OFF_DEC);
  const bf16_t* VT = (const bf16_t*)(p.ws + OFF_XT) + (size_t)(3072 + h * 256 + 128 * dvh + 32 * (wid & 3) + r) * NTOK + 8 * hh;
  bf16_t* Og = (dir ? (bf16_t*)(p.ws + OFF_X) : (bf16_t*)(p.ws + OFF_PB)) + h * 256 + 128 * dvh;
  const int ldo = dir ? 1024 : 4096;
  const int qrow0 = tid >> 4, qcc = tid & 15, krow0 = tid >> 3, kcc = tid & 7;
  constexpr int OBUF = 64 * 264 * 2;
  LAS unsigned char* obase = lds + 2 * BUFB;
  f32x16 S[4];
#pragma unroll
  for (int m = 0; m < 4; ++m)
#pragma unroll
    for (int i = 0; i < 16; ++i) S[m][i] = 0.f;
  u32x4 pq0, pq1, pk0, pk1, pa; float pdc = 0.f; bf16x8 vf[4];
#define SCAN_CIDX(st) ((st) < 4 ? (256 + 4 * b + (dir ? 3 - (st) : (st))) : (64 * b + (dir ? 67 - (st) : (st) - 4)))
#define SCAN_LOAD(st) do { const int ci_ = SCAN_CIDX(st); const size_t tk_ = (size_t)ci_ * 64, ch_ = (size_t)ci_ * 4 + h; \
    pq0 = *(const u32x4*)(Qg + (tk_ + qrow0) * 512 + h * 128 + 8 * qcc); pq1 = *(const u32x4*)(Qg + (tk_ + qrow0 + 32) * 512 + h * 128 + 8 * qcc); \
    pk0 = *(const u32x4*)(Kg + (ch_ * 128 + krow0) * 64 + 8 * kcc); pk1 = *(const u32x4*)(Kg + (ch_ * 128 + krow0 + 64) * 64 + 8 * kcc); \
    pa = *(const u32x4*)(ATT + ((ch_ * 2 + dir) * 64 + krow0) * 64 + 8 * kcc); if (tid < 128) pdc = DEC[(ch_ * 2 + dir) * 128 + tid]; \
 } while (0)
#define SCAN_LOADV(st) do { const size_t tkv_ = (size_t)SCAN_CIDX(st) * 64; _Pragma("unroll") for (int ks = 0; ks < 4; ++ks) vf[ks] = *(const bf16x8*)(VT + tkv_ + 16 * ks); } while (0)
#define SCAN_STORE(bufi) do { LAS unsigned char* bb_ = lds + (bufi) * BUFB; LAS bf16_t* QT_ = (LAS bf16_t*)bb_; LAS bf16_t* KE_ = QT_ + 64 * 136; LAS bf16_t* AT_ = KE_ + 128 * 72; LAS float* DC_ = (LAS float*)(AT_ + 64 * 72); \
    *(LAS u32x4*)(QT_ + qrow0 * 136 + 8 * qcc) = pq0; *(LAS u32x4*)(QT_ + (qrow0 + 32) * 136 + 8 * qcc) = pq1; \
    *(LAS u32x4*)(KE_ + krow0 * 72 + 8 * kcc) = pk0; *(LAS u32x4*)(KE_ + (krow0 + 64) * 72 + 8 * kcc) = pk1; \
    *(LAS u32x4*)(AT_ + krow0 * 72 + 8 * kcc) = pa; if (tid < 128) DC_[tid] = pdc; } while (0)
#define SCAN_WRITEOUT(st) do { const size_t tk_ = (size_t)SCAN_CIDX(st) * 64; const LAS bf16_t* ob_ = (const LAS bf16_t*)(obase + ((st) & 1) * OBUF); \
    _Pragma("unroll 1") for (int q = 0; q < 2; ++q) { const int pc_ = tid + 512 * q, row_ = pc_ >> 4, cc_ = pc_ & 15; \
      *(u32x4*)(Og + (tk_ + row_) * ldo + 8 * cc_) = *(const LAS u32x4*)(ob_ + row_ * 264 + 8 * cc_); } } while (0)
  SCAN_LOAD(0); SCAN_STORE(0); SCAN_LOADV(0); SCAN_LOAD(1);
  __syncthreads();
#pragma unroll 1
  for (int step = 0; step < 68; ++step) {
    const size_t tok0 = (size_t)SCAN_CIDX(step) * 64;
    if (step > 0) SCAN_WRITEOUT(step - 1);
    LAS unsigned char* bb = lds + (step & 1) * BUFB;
    const LAS bf16_t* QT = (const LAS bf16_t*)bb; const LAS bf16_t* KE = QT + 64 * 136; const LAS bf16_t* AT = KE + 128 * 72; const LAS float* DC = (const LAS float*)(AT + 64 * 72);
    if (cwave) {
    bf16x8 sp[8];
#pragma unroll
    for (int m = 0; m < 4; ++m) { sp[2 * m] = pack8(S[m], 0); sp[2 * m + 1] = pack8(S[m], 1); }
    f32x16 o0, o1;
#pragma unroll
    for (int i = 0; i < 16; ++i) { o0[i] = 0.f; o1[i] = 0.f; }
#pragma unroll
    for (int ks = 0; ks < 4; ++ks) {
      o0 = MFMA32(vf[ks], *(const LAS bf16x8*)(AT + r * 72 + 16 * ks + 8 * hh), o0);
      o1 = MFMA32(vf[ks], *(const LAS bf16x8*)(AT + (32 + r) * 72 + 16 * ks + 8 * hh), o1);
    }
#pragma unroll
    for (int k8 = 0; k8 < 8; ++k8) {
      o0 = MFMA32(sp[k8], *(const LAS bf16x8*)(QT + r * 136 + 16 * k8 + 8 * hh), o0);
      o1 = MFMA32(sp[k8], *(const LAS bf16x8*)(QT + (32 + r) * 136 + 16 * k8 + 8 * hh), o1);
    }
#pragma unroll
    for (int m = 0; m < 4; ++m) {
#pragma unroll
      for (int g = 0; g < 4; ++g) { const f32x4 dv = *(const LAS f32x4*)(DC + 32 * m + 8 * g + 4 * hh);
        S[m][4 * g] *= dv.x; S[m][4 * g + 1] *= dv.y; S[m][4 * g + 2] *= dv.z; S[m][4 * g + 3] *= dv.w; }
#pragma unroll
      for (int ks = 0; ks < 4; ++ks) S[m] = MFMA32(*(const LAS bf16x8*)(KE + (32 * m + r) * 72 + 16 * ks + 8 * hh), vf[ks], S[m]);
    }
    { LAS bf16_t* ob = (LAS bf16_t*)(obase + (step & 1) * OBUF) + r * 264 + 32 * wid + 4 * hh;
#pragma unroll
      for (int g = 0; g < 4; ++g) {
        *(LAS u32x2*)(ob + 8 * g) = (u32x2){pk2(o0[4 * g], o0[4 * g + 1]), pk2(o0[4 * g + 2], o0[4 * g + 3])};
        *(LAS u32x2*)(ob + 32 * 264 + 8 * g) = (u32x2){pk2(o1[4 * g], o1[4 * g + 1]), pk2(o1[4 * g + 2], o1[4 * g + 3])};
      } }
    }
    if (step + 1 < 68) { if (cwave) SCAN_LOADV(step + 1); SCAN_STORE((step + 1) & 1); }
    if (step + 2 < 68) SCAN_LOAD(step + 2);
    __syncthreads();
  }
  SCAN_WRITEOUT(67);
  __syncthreads();
#undef SCAN_WRITEOUT
#undef SCAN_CIDX
#undef SCAN_LOAD
#undef SCAN_LOADV
#undef SCAN_STORE
}

DI void phase_post(const Params& p, int l, int ntok, LAS unsigned char* lds) {
  const int tid = otid(), lane = tid & 63;
  { const int gw = blockIdx.x * 8 + (tid >> 6), nw = gridDim.x * 8, l32 = lane & 31, hsel = lane >> 5;
    const bf16_t* PB = (const bf16_t*)(p.ws + OFF_PB); bf16_t* HB = (bf16_t*)(p.ws + OFF_X);
    const f32x4 ng0 = *(const f32x4*)(p.gla_ng + l * 256 + 8 * l32), ng1 = *(const f32x4*)(p.gla_ng + l * 256 + 8 * l32 + 4);
    u32x4 na, nb, nr;
    if (gw < ntok * 2) { const size_t tk = gw >> 1; const int cl = ((gw & 1) * 2 + hsel) * 256 + 8 * l32; na = __builtin_nontemporal_load((const u32x4*)(PB + tk * 4096 + cl)); nb = __builtin_nontemporal_load((const u32x4*)(HB + tk * 1024 + cl)); nr = __builtin_nontemporal_load((const u32x4*)(PB + tk * 4096 + 1024 + cl)); }
    for (int it = gw; it < ntok * 2; it += nw) {
      const size_t tok = it >> 1; const int col = ((it & 1) * 2 + hsel) * 256 + 8 * l32;
      const u32x4 a = na, b = nb, rr = nr;
      if (it + nw < ntok * 2) { const int i2 = it + nw; const size_t tk = i2 >> 1; const int cl = ((i2 & 1) * 2 + hsel) * 256 + 8 * l32; na = __builtin_nontemporal_load((const u32x4*)(PB + tk * 4096 + cl)); nb = __builtin_nontemporal_load((const u32x4*)(HB + tk * 1024 + cl)); nr = __builtin_nontemporal_load((const u32x4*)(PB + tk * 4096 + 1024 + cl)); }
      float o[8], rv[8];
#pragma unroll
      for (int i = 0; i < 4; ++i) { o[2 * i] = bflo(a[i]) + bflo(b[i]); o[2 * i + 1] = bfhi(a[i]) + bfhi(b[i]); rv[2 * i] = bflo(rr[i]); rv[2 * i + 1] = bfhi(rr[i]); }
      float ss = 0.f;
#pragma unroll
      for (int i = 0; i < 8; ++i) ss += o[i] * o[i];
#pragma unroll
      for (int q = 16; q >= 1; q >>= 1) ss += __shfl_xor(ss, q);
      const float rstd = rsqrtf(ss * (1.f / 256.f) + EPSF);
      const float ngv[8] = {ng0.x, ng0.y, ng0.z, ng0.w, ng1.x, ng1.y, ng1.z, ng1.w};
      float y[8];
#pragma unroll
      for (int i = 0; i < 8; ++i) y[i] = o[i] * rstd * ngv[i] * (rv[i] * sigm(rv[i]));
      *(u32x4*)(HB + tok * 1024 + col) = (u32x4){pk2(y[0], y[1]), pk2(y[2], y[3]), pk2(y[4], y[5]), pk2(y[6], y[7])};
    } }
  { LAS bf16_t* t = (LAS bf16_t*)lds;
    const bf16_t* XT = (const bf16_t*)(p.ws + OFF_XT); bf16_t* YH = (bf16_t*)(p.ws + OFF_QF);
    const int ntt = ntok / 128;
    u32x4 pre[2];
#define POST_TLOAD(it_) do { const int c0_ = ((it_) / ntt) * 64, tk0_ = ((it_) % ntt) * 128; \
      _Pragma("unroll") for (int q = 0; q < 2; ++q) { const int pc = tid + 512 * q, cc = pc >> 4, tq = pc & 15; pre[q] = *(const u32x4*)(XT + (size_t)(c0_ + cc) * NTOK + tk0_ + 8 * tq); } } while (0)
    if ((int)blockIdx.x < 16 * ntt) POST_TLOAD((int)blockIdx.x);
    for (int it = blockIdx.x; it < 16 * ntt; it += gridDim.x) {
      const int c0 = (it / ntt) * 64, tok0 = (it % ntt) * 128;
#pragma unroll
      for (int q = 0; q < 2; ++q) { const int pc = tid + 512 * q, cc = pc >> 4, tq = pc & 15; *(LAS u32x4*)(t + cc * 136 + 8 * tq) = pre[q]; }
      if (it + (int)gridDim.x < 16 * ntt) POST_TLOAD(it + (int)gridDim.x);
      __syncthreads();
#pragma unroll
      for (int q = 0; q < 2; ++q) { const int pc = tid + 512 * q, tk = pc >> 3, cq = pc & 7; unsigned w[4];
#pragma unroll
        for (int i = 0; i < 4; ++i) w[i] = (unsigned)t[(8 * cq + 2 * i) * 136 + tk] | ((unsigned)t[(8 * cq + 2 * i + 1) * 136 + tk] << 16);
        *(u32x4*)(YH + (size_t)(tok0 + tk) * 1024 + c0 + 8 * cq) = (u32x4){w[0], w[1], w[2], w[3]}; }
      __syncthreads();
    } }
}

#undef POST_TLOAD
struct SchedG1 : pg8::StaticOrder {
  __device__ bool next(int i, pg8::Unit& u) const {
    pg8::Unit v; if (!pg8::StaticOrder::next(i, v)) return false;
    if (v.pn < 16) { u.pm = 68 + v.pn; u.pn = v.pm; } else { u.pm = v.pm; u.pn = 68 + v.pn; }
    return true;
  }
};
typedef const f32x4 (&AccRef)[2][2][4][2];
DI u32x4 pack_acc8(f32x4 v0, f32x4 v1) { return (u32x4){pk2(v0[0], v0[1]), pk2(v0[2], v0[3]), pk2(v1[0], v1[1]), pk2(v1[2], v1[3])}; }
struct EpiG1 {
  static constexpr bool PERM = true, AFTER_DRAIN = false;
  bf16_t* XT; bf16_t* PB; float* LR;
  DI void operator()(AccRef acc, const pg8::Unit& u, int wr, int wc, int fr, int fq) const {
    if (u.pm >= 68) {
      const int ch0 = (u.pm - 68) * 256 + wr * 64 + fr, tk0 = u.pn * 256 + wc * 32 + 8 * fq;
#pragma unroll
      for (int ai = 0; ai < 2; ++ai)
#pragma unroll
        for (int m = 0; m < 4; ++m) { bf16_t* rp = XT + (size_t)(ch0 + ai * 128 + m * 16) * NTOK + tk0;
#pragma unroll
          for (int bj = 0; bj < 2; ++bj) *(u32x4*)(rp + bj * 128) = pack_acc8(acc[ai][bj][m][0], acc[ai][bj][m][1]); }
    } else {
      const int wp = u.pn - 84, row0 = u.pm * 256 + wr * 64 + fr, col0 = wp * 256 + wc * 32 + 8 * fq;
      if (wp < 16) {
#pragma unroll
        for (int ai = 0; ai < 2; ++ai)
#pragma unroll
          for (int m = 0; m < 4; ++m) { bf16_t* rp = PB + (size_t)(row0 + ai * 128 + m * 16) * 4096 + col0;
#pragma unroll
            for (int bj = 0; bj < 2; ++bj) *(u32x4*)(rp + bj * 128) = pack_acc8(acc[ai][bj][m][0], acc[ai][bj][m][1]); }
      } else if (wc == 0) {
#pragma unroll
        for (int ai = 0; ai < 2; ++ai)
#pragma unroll
          for (int m = 0; m < 4; ++m) { float* rp = LR + (size_t)(row0 + ai * 128 + m * 16) * 32 + 8 * fq; *(f32x4*)rp = acc[ai][0][m][0]; *(f32x4*)(rp + 4) = acc[ai][0][m][1]; }
      }
    }
  }
};
template <int MODE> struct EpiGate {
  static constexpr bool PERM = true, AFTER_DRAIN = false;
  const bf16_t* PB; bf16_t* T1; bf16_t* MG;
  DI void operator()(AccRef acc, const pg8::Unit& u, int wr, int wc, int fr, int fq) const {
    const int row0 = u.pm * 256 + wr * 64 + fr, col0 = u.pn * 256 + wc * 32 + 8 * fq;
#pragma unroll
    for (int ai = 0; ai < 2; ++ai)
#pragma unroll
      for (int m = 0; m < 4; ++m) { const size_t row = (size_t)(row0 + ai * 128 + m * 16);
#pragma unroll
        for (int bj = 0; bj < 2; ++bj) { const int col = col0 + bj * 128;
          const u32x4 g = *(const u32x4*)(PB + row * 4096 + (MODE ? 3072 : 2048) + col);
          const f32x4 v0 = acc[ai][bj][m][0], v1 = acc[ai][bj][m][1];
          float o[8] = {v0[0] * sigm(bflo(g[0])), v0[1] * sigm(bfhi(g[0])), v0[2] * sigm(bflo(g[1])), v0[3] * sigm(bfhi(g[1])),
                        v1[0] * sigm(bflo(g[2])), v1[1] * sigm(bfhi(g[2])), v1[2] * sigm(bflo(g[3])), v1[3] * sigm(bfhi(g[3]))};
          if (MODE) { const u32x4 t = *(const u32x4*)(T1 + row * 1024 + col);
            o[0] += bflo(t[0]); o[1] += bfhi(t[0]); o[2] += bflo(t[1]); o[3] += bfhi(t[1]); o[4] += bflo(t[2]); o[5] += bfhi(t[2]); o[6] += bflo(t[3]); o[7] += bfhi(t[3]); }
          *(u32x4*)((MODE ? MG : T1) + row * 1024 + col) = (u32x4){pk2(o[0], o[1]), pk2(o[2], o[3]), pk2(o[4], o[5]), pk2(o[6], o[7])}; } }
  }
};
struct EpiRes {
  static constexpr bool PERM = false, AFTER_DRAIN = false;
  float* out; float* ctxs; const float* modl; int goff; const float* src_lat; const float* src_ctx;
  DI void operator()(AccRef acc, const pg8::Unit& u, int wr, int wc, int fr, int fq) const {
    const int row0 = u.pm * 256 + wr * 64 + fr, col0 = u.pn * 256 + wc * 32 + 4 * fq;
    const float* gv = modl + (size_t)(u.pm < 64 ? (u.pm >> 4) : 4) * 6144 + goff + col0;
    f32x4 gg[2][2];
#pragma unroll
    for (int bj = 0; bj < 2; ++bj)
#pragma unroll
      for (int n = 0; n < 2; ++n) gg[bj][n] = *(const f32x4*)(gv + bj * 128 + n * 16);
#pragma unroll
    for (int ai = 0; ai < 2; ++ai)
#pragma unroll
      for (int m = 0; m < 4; ++m) { const int row = row0 + ai * 128 + m * 16;
        float* rp = (row < NLAT ? out + (size_t)row * 1024 : ctxs + (size_t)(row - NLAT) * 1024) + col0;
        const float* sp = (row < NLAT ? src_lat + (size_t)row * 1024 : src_ctx + (size_t)(row - NLAT) * 1024) + col0;
#pragma unroll
        for (int bj = 0; bj < 2; ++bj)
#pragma unroll
          for (int n = 0; n < 2; ++n) { f32x4* q = (f32x4*)(rp + bj * 128 + n * 16); *q = *(const f32x4*)(sp + bj * 128 + n * 16) + gg[bj][n] * acc[ai][bj][m][n]; } }
  }
};
struct EpiRelu2 {
  static constexpr bool PERM = true, AFTER_DRAIN = false;
  bf16_t* O;
  DI void operator()(AccRef acc, const pg8::Unit& u, int wr, int wc, int fr, int fq) const {
    const int row0 = u.pm * 256 + wr * 64 + fr, col0 = u.pn * 256 + wc * 32 + 8 * fq;
#pragma unroll
    for (int ai = 0; ai < 2; ++ai)
#pragma unroll
      for (int m = 0; m < 4; ++m) { bf16_t* rp = O + (size_t)(row0 + ai * 128 + m * 16) * 4096 + col0;
#pragma unroll
        for (int bj = 0; bj < 2; ++bj) { f32x4 v0 = acc[ai][bj][m][0], v1 = acc[ai][bj][m][1];
#pragma unroll
          for (int e = 0; e < 4; ++e) { const float a = fmaxf(v0[e], 0.f), b = fmaxf(v1[e], 0.f); v0[e] = a * a; v1[e] = b * b; }
          *(u32x4*)(rp + bj * 128) = pack_acc8(v0, v1); } }
  }
};

#define MFMA16(a, b, c) __builtin_amdgcn_mfma_f32_16x16x32_bf16((a), (b), (c), 0, 0, 0)
template <class F> DI void ctx_gemm(const bf16_t* A, const bf16_t* Bt, int K, int N, LAS unsigned char* lds, const F& epi) {
  constexpr int LDT = 136, TILEB = 64 * LDT * 2;
  const int tid = otid(), wid = tid >> 6, lane = tid & 63, fr = lane & 15, fq = lane >> 4, wm = wid >> 1, wn = wid & 1;
  const int ntn = N / 64, ntiles = 16 * ntn, nk = K / 128;
  const int lrow = tid >> 4, lcc = tid & 15;
  for (int t0 = blockIdx.x; t0 < ntiles; t0 += gridDim.x) {
    int tile = t0;
    if (ntiles == 256 && gridDim.x == 256) { const int x = t0 & 7, idx = t0 >> 3; tile = (4 * (x >> 1) + (idx >> 3)) * 16 + 8 * (x & 1) + (idx & 7); }
    const int tm = tile / ntn, tn = tile % ntn;
    const bf16_t* Ab = A + (size_t)(tm * 64 + lrow) * K + 8 * lcc; const bf16_t* Bb = Bt + (size_t)(tn * 64 + lrow) * K + 8 * lcc;
    const size_t r32 = (size_t)32 * K;
    u32x4 ra0, ra1, rb0, rb1, sa0, sa1, sb0, sb1;
#define CG_LOAD(x0, x1, y0, y1, kt_) do { const int ko_ = (kt_) * 128; x0 = *(const u32x4*)(Ab + ko_); x1 = *(const u32x4*)(Ab + r32 + ko_); y0 = *(const u32x4*)(Bb + ko_); y1 = *(const u32x4*)(Bb + r32 + ko_); } while (0)
#define CG_STORE(x0, x1, y0, y1, bufi) do { LAS bf16_t* dA_ = (LAS bf16_t*)(lds + (bufi) * 2 * TILEB); LAS bf16_t* dB_ = (LAS bf16_t*)(lds + (bufi) * 2 * TILEB + TILEB); \
    *(LAS u32x4*)(dA_ + lrow * LDT + 8 * lcc) = x0; *(LAS u32x4*)(dA_ + (lrow + 32) * LDT + 8 * lcc) = x1; *(LAS u32x4*)(dB_ + lrow * LDT + 8 * lcc) = y0; *(LAS u32x4*)(dB_ + (lrow + 32) * LDT + 8 * lcc) = y1; } while (0)
#define CG_COMPUTE(bufi) do { const LAS bf16_t* sA_ = (const LAS bf16_t*)(lds + (bufi) * 2 * TILEB); const LAS bf16_t* sB_ = (const LAS bf16_t*)(lds + (bufi) * 2 * TILEB + TILEB); \
    _Pragma("unroll") for (int ks = 0; ks < 4; ++ks) { const bf16x8 af = *(const LAS bf16x8*)(sA_ + (16 * wm + fr) * LDT + 32 * ks + 8 * fq); \
      const bf16x8 b0 = *(const LAS bf16x8*)(sB_ + (32 * wn + fr) * LDT + 32 * ks + 8 * fq), b1 = *(const LAS bf16x8*)(sB_ + (32 * wn + 16 + fr) * LDT + 32 * ks + 8 * fq); \
      acc0 = MFMA16(b0, af, acc0); acc1 = MFMA16(b1, af, acc1); } } while (0)
    CG_LOAD(ra0, ra1, rb0, rb1, 0); CG_LOAD(sa0, sa1, sb0, sb1, 1);
    CG_STORE(ra0, ra1, rb0, rb1, 0);
    __syncthreads();
    f32x4 acc0 = {0.f, 0.f, 0.f, 0.f}, acc1 = {0.f, 0.f, 0.f, 0.f};
#pragma unroll 1
    for (int kt = 0; kt < nk; kt += 2) {
      if (kt + 2 < nk) CG_LOAD(ra0, ra1, rb0, rb1, kt + 2);
      CG_COMPUTE(0);
      CG_STORE(sa0, sa1, sb0, sb1, 1);
      __syncthreads();
      if (kt + 3 < nk) CG_LOAD(sa0, sa1, sb0, sb1, kt + 3);
      CG_COMPUTE(1);
      if (kt + 2 < nk) CG_STORE(ra0, ra1, rb0, rb1, 0);
      __syncthreads();
    }
#undef CG_LOAD
#undef CG_STORE
#undef CG_COMPUTE
    const int row = tm * 64 + 16 * wm + fr, col = tn * 64 + 32 * wn + 4 * fq;
    epi(row, col, acc0); epi(row, col + 16, acc1);
  }
}

__global__ void __launch_bounds__(512, 2) fwd_megakernel(Params p) {
  extern __shared__ __attribute__((aligned(16))) unsigned char shm[];
  LAS unsigned char* lds = (LAS unsigned char*)shm;
  cg::grid_group grid = cg::this_grid();
  unsigned char* ws = p.ws;
  const int G = gridDim.x, cblk = blockIdx.x;
  unsigned* cnt = (unsigned*)(ws + OFF_CNT);
  __shared__ unsigned xbw[4];
#define s_item (*(volatile int*)&xbw[2])
  if (threadIdx.x == 0) { xbw[0] = 0u; xbw[1] = 0u; xbw[2] = 0u; xbw[3] = 0u; }
  __syncthreads();
#ifndef TPROBE
#define TPROBE 0
#endif
  unsigned long long tacc = 0ull, tt0 = 0ull;
#define TB(g) do { if (TPROBE == (g) && blockIdx.x == 0) tt0 = __builtin_amdgcn_s_memrealtime(); } while (0)
#define TE(g) do { if (TPROBE == (g) && blockIdx.x == 0) tacc += __builtin_amdgcn_s_memrealtime() - tt0; } while (0)

  TB(5); phase_copy(p); phase_mod(p, lds); phase_a2(p, lds);
  phase_wconv(p, 0, lds, 0, cblk, G); phase_wconv(p, 0, lds, 1, cblk, G);
  grid.sync(); TE(5);
  const XcdBarrier xb = xcd_barrier_post((unsigned*)(ws + OFF_BAR), (volatile LAS unsigned*)xbw);
  for (int l = 0; l < 4; ++l) {
    const bool last = (l == 3);
    const int MR = last ? NLAT : NTOK;
    TB(3); TB(14); if (l > 0) phase_wconv(p, l, lds, 1, cblk, G);
    phase_norm(p, l, p.norm1_g + l * 1024, 0, 1024, NTOK, l == 0);
    if (l == 0) phase_filt_gemm(p, l, lds, cblk, G);
    xcd_barrier(xb); TE(14); TE(3);
    TB(1); TB(6);
    { pg8::Gemm g{(const bf16_t*)(ws + OFF_X), (const bf16_t*)(ws + OFF_X), NTOK, 8448, 1024};
      SchedG1 S; S.init(NTOK, 8448, G, cblk);
      EpiG1 E{(bf16_t*)(ws + OFF_XT), (bf16_t*)(ws + OFF_PB), (float*)(ws + OFF_LR)};
      pg8::gemm_phase<EpiG1, SchedG1, false>(lds, g, S, E, nullptr); }
    xcd_barrier(xb); TE(1); TE(6);
    TB(4); TB(11); phase_gla_prep(p, l, lds);
    if (!last && cblk >= 64) phase_filt_gemm(p, l + 1, lds, cblk - 64, G - 64);
    xcd_barrier(xb); TE(4); TE(11);
    TB(2); TB(7); if (cblk < 64) phase_gla_scan(p, lds); TE(7);
    { LAS cplx* L = (LAS cplx*)lds;
      if (otid() == 0) s_item = (int)atomicAdd(cnt + 2 * l, 1u);
      for (;;) {
        __syncthreads();
        const int it = s_item;
        __syncthreads();
        if (it >= 1024) break;
        if (otid() == 0) s_item = (int)atomicAdd(cnt + 2 * l, 1u);
        hyena_chan<HY_NV>(p, l, __builtin_amdgcn_readfirstlane(it), L, otid());
      }
      if (!last) for (;;) {
        if (otid() == 0) s_item = (int)atomicAdd(cnt + 2 * l + 1, 1u);
        __syncthreads();
        const int it = s_item;
        __syncthreads();
        if (it >= 1024) break;
        hyena_ctx_item(p, l, it, lds);
      } }
    xcd_barrier(xb);
    TE(2);
    TB(4); TB(12); phase_post(p, l, MR, lds);
    xcd_barrier(xb); TE(4); TE(12);
    TB(1); TB(8);
    { pg8::StaticOrder S; S.init(NLAT, 1024, G, cblk);
      const bf16_t* PBc = (const bf16_t*)(ws + OFF_PB); bf16_t* T1 = (bf16_t*)(ws + OFF_KEF); bf16_t* MGp = (bf16_t*)(ws + OFF_XT + (size_t)3072 * NTOK * 2);
      EpiGate<0> E0{PBc, T1, nullptr};
      pg8::Gemm g0{(const bf16_t*)(ws + OFF_QF), (const bf16_t*)(ws + OFF_WBHY), NLAT, 1024, 1024};
      pg8::gemm_phase<EpiGate<0>, pg8::StaticOrder, false>(lds, g0, S, E0, nullptr);
      EpiGate<1> E1{PBc, T1, MGp};
      pg8::Gemm g1{(const bf16_t*)(ws + OFF_X), (const bf16_t*)(ws + OFF_WBGLA), NLAT, 1024, 1024};
      pg8::gemm_phase<EpiGate<1>, pg8::StaticOrder, false>(lds, g1, S, E1, nullptr);
      if (!last) {
        ctx_gemm((const bf16_t*)(ws + OFF_QF) + (size_t)NLAT * 1024, (const bf16_t*)(ws + OFF_WBHY), 1024, 1024, lds, [&](int r, int c, f32x4 v) {
          const size_t row = (size_t)NLAT + r; const u32x2 gt = *(const u32x2*)(PBc + row * 4096 + 2048 + c);
          *(u32x2*)(T1 + row * 1024 + c) = (u32x2){pk2(v[0] * sigm(bflo(gt[0])), v[1] * sigm(bfhi(gt[0]))), pk2(v[2] * sigm(bflo(gt[1])), v[3] * sigm(bfhi(gt[1])))}; });
        ctx_gemm((const bf16_t*)(ws + OFF_X) + (size_t)NLAT * 1024, (const bf16_t*)(ws + OFF_WBGLA), 1024, 1024, lds, [&](int r, int c, f32x4 v) {
          const size_t row = (size_t)NLAT + r; const u32x2 gt = *(const u32x2*)(PBc + row * 4096 + 3072 + c); const u32x2 t1 = *(const u32x2*)(T1 + row * 1024 + c);
          *(u32x2*)(MGp + row * 1024 + c) = (u32x2){pk2(bflo(t1[0]) + v[0] * sigm(bflo(gt[0])), bfhi(t1[0]) + v[1] * sigm(bfhi(gt[0]))), pk2(bflo(t1[1]) + v[2] * sigm(bflo(gt[1])), bfhi(t1[1]) + v[3] * sigm(bfhi(gt[1])))}; });
      } }
    xcd_barrier(xb); TE(8);
    { pg8::StaticOrder S; S.init(NLAT, 1024, G, cblk);
      EpiRes E{p.out, (float*)(ws + OFF_CTXS), modp(p, l, 0), 2048, l == 0 ? p.x : p.out, l == 0 ? p.ctx : (const float*)(ws + OFF_CTXS)};
      pg8::Gemm g{(const bf16_t*)(ws + OFF_XT + (size_t)3072 * NTOK * 2), (const bf16_t*)(ws + OFF_WOUT), NLAT, 1024, 1024};
      pg8::gemm_phase<EpiRes, pg8::StaticOrder, false>(lds, g, S, E, nullptr);
      if (!last) { float* cs = (float*)(ws + OFF_CTXS); const float* gv = modp(p, l, 4) + 2048; const float* csrc = l == 0 ? p.ctx : (const float*)cs;
        ctx_gemm((const bf16_t*)(ws + OFF_XT + (size_t)3072 * NTOK * 2) + (size_t)NLAT * 1024, (const bf16_t*)(ws + OFF_WOUT), 1024, 1024, lds, [&](int r, int c, f32x4 v) {
          *(f32x4*)(cs + (size_t)r * 1024 + c) = *(const f32x4*)(csrc + (size_t)r * 1024 + c) + *(const f32x4*)(gv + c) * v; }); } }
    xcd_barrier(xb); TE(1);
    TB(4); TB(13); phase_norm(p, l, p.norm2_g + l * 1024, 3072, 4096, MR, false);
    xcd_barrier(xb); TE(4); TE(13);
    if (TPROBE == 20) { for (int q = 0; q < 8; ++q) xcd_barrier(xb); }
    TB(1); TB(9);
    { pg8::StaticOrder S; S.init(MR, 4096, G, cblk);
      EpiRelu2 E{(bf16_t*)(ws + OFF_PB)};
      pg8::Gemm g{(const bf16_t*)(ws + OFF_X), (const bf16_t*)(ws + OFF_W1), MR, 4096, 1024};
      pg8::gemm_phase<EpiRelu2, pg8::StaticOrder, false>(lds, g, S, E, nullptr);
      if (!last && cblk >= 64) phase_wconv(p, l + 1, lds, 0, cblk - 64, G - 64); }
    xcd_barrier(xb); TE(9); TB(10);
    { pg8::StaticOrder S; S.init(NLAT, 1024, G, cblk);
      EpiRes E{p.out, (float*)(ws + OFF_CTXS), modp(p, l, 0), 5120, p.out, (const float*)(ws + OFF_CTXS)};
      pg8::Gemm g{(const bf16_t*)(ws + OFF_PB), (const bf16_t*)(ws + OFF_W2), NLAT, 1024, 4096};
      pg8::gemm_phase<EpiRes, pg8::StaticOrder, false>(lds, g, S, E, nullptr);
      if (!last) { float* cs = (float*)(ws + OFF_CTXS); const float* gv = modp(p, l, 4) + 5120;
        ctx_gemm((const bf16_t*)(ws + OFF_PB) + (size_t)NLAT * 4096, (const bf16_t*)(ws + OFF_W2), 4096, 1024, lds, [&](int r, int c, f32x4 v) {
          f32x4* q = (f32x4*)(cs + (size_t)r * 1024 + c); *q = *q + *(const f32x4*)(gv + c) * v; }); } }
    xcd_barrier(xb); TE(1); TE(10);
  }
  phase_final_norm(p);
  if (TPROBE && TPROBE != 20 && blockIdx.x == 0) { const unsigned long long s0 = __builtin_amdgcn_s_memrealtime(); while (__builtin_amdgcn_s_memrealtime() - s0 < tacc) __builtin_amdgcn_s_sleep(8); }
}

#ifndef HY_NV
#define HY_NV 2
#endif
constexpr size_t DYN_LDS = 2 * FFT_REGION_F2 * 8 + 11 * 512 * 4;

extern "C" void kernel_launch(void* const* d_in, const int* in_sizes, int n_in, void* d_out, int out_size, void* d_ws, size_t ws_size, hipStream_t stream) {
  if (ws_size < WS_TOTAL || n_in < 28) return;
  static int grid_blocks = 0;
  if (!grid_blocks) {
    int dev = 0, cus = 0, per_cu = 0;
    hipGetDevice(&dev);
    hipDeviceGetAttribute(&cus, hipDeviceAttributeMultiprocessorCount, dev);
    hipFuncSetAttribute((const void*)fwd_megakernel, hipFuncAttributeMaxDynamicSharedMemorySize, (int)DYN_LDS);
    hipOccupancyMaxActiveBlocksPerMultiprocessor(&per_cu, fwd_megakernel, 512, DYN_LDS);
    if (per_cu < 1) per_cu = 1;
    grid_blocks = cus * 1;
  }
  Params p{};
  const float** pp = (const float**)&p;
  for (int i = 0; i < 28; ++i) pp[i] = (const float*)d_in[i];
  p.out = (float*)d_out; p.ws = (unsigned char*)d_ws;
  void* args[] = {&p};
  hipLaunchCooperativeKernel((const void*)fwd_megakernel, dim3(grid_blocks), dim3(512), args, DYN_LDS, stream);
}
```

```cpp
#include <hip/hip_runtime.h>
#include <hip/hip_cooperative_groups.h>
namespace cg = cooperative_groups;
#define DI __device__ __forceinline__

__device__ __forceinline__ int otid() { int t = threadIdx.x; asm volatile("" : "+v"(t)); return t; }
namespace pg8 {
#define PG8_LAS __attribute__((address_space(3)))
typedef unsigned short bf16_t;
typedef short bf16x8 __attribute__((ext_vector_type(8)));
typedef float f32x4 __attribute__((ext_vector_type(4)));
typedef unsigned u32x4 __attribute__((ext_vector_type(4)));
constexpr int BM = 256, BK = 64, HALF = 128, HTB = HALF * BK * 2  , STAGE_BYTES = 8 * HTB, NXCD = 8, WGM = 8;

__host__ __device__ __forceinline__ int lds_byte(int r, int c) { const int st = (r >> 4) * 2 + (c >> 5), rr = r & 15, cc = c & 31, ob = rr * 64 + cc * 2; return st * 1024 + (ob ^ (((ob >> 9) & 1) << 5)); }
__host__ __device__ __forceinline__ void stage_rc(int b, int& R, int& C) { const int st = b / 1024, sb = b % 1024, swz = sb ^ (((sb >> 9) & 1) << 5); R = (st >> 1) * 16 + swz / 64; C = (st & 1) * 32 + (swz % 64) / 2; }
__host__ __device__ __forceinline__ int perm32(int rho) { const int n = rho >> 4, i = rho & 15; return 8 * (i >> 2) + 4 * n + (i & 3); }

struct Unit { int pm, pn; };
struct Gemm { const bf16_t* A; const bf16_t* Bt; int M, N, K; };
struct StaticOrder {
    int nM, nN, nwg, G, c;
    __host__ __device__ void init(int M, int N, int G_, int c_) { nM = M / BM; nN = N / BM; nwg = nM * nN; G = G_; c = c_; }
    __host__ __device__ bool next(int i, Unit& u) const {
        const long L = (long)i * G + c; if (L >= nwg) return false;
        int wgid = (int)L; { const int q = nwg / NXCD, r = nwg % NXCD, xcd = wgid % NXCD, off = wgid / NXCD; wgid = (xcd < r ? xcd * (q + 1) : r * (q + 1) + (xcd - r) * q) + off; }
        const int nig = WGM * nN, gid = wgid / nig, fm = gid * WGM, gsz = (nM - fm) < WGM ? (nM - fm) : WGM;
        u.pm = fm + ((wgid % nig) % gsz); u.pn = (wgid % nig) / gsz; return true;
    }
    __device__ __forceinline__ void a_ready(const Unit&) const {}
    __device__ __forceinline__ void done(const Unit&) const {}
};
__device__ __forceinline__ unsigned cvt_pk_bf16(float lo, float hi) { unsigned r; asm volatile("v_cvt_pk_bf16_f32 %0, %1, %2" : "=v"(r) : "v"(lo), "v"(hi)); return r; }
template <class Epi, class Sched, bool STAMP = false>
__device__ __forceinline__ void gemm_phase(PG8_LAS unsigned char* lds, const Gemm g, const Sched& S, const Epi& E, unsigned long long* stamps) {
    const int tid = otid(), wid = __builtin_amdgcn_readfirstlane(tid >> 6), lane = tid & 63, wr = wid >> 2, wc = wid & 3, fr = lane & 15, fq = lane >> 4;
    const int K = g.K, nt = K / BK;
    int ts_lo = 0, ts_hi = 0, nts = 0; const unsigned long long rt_entry = STAMP ? (unsigned long long)wall_clock64() : 0ull;
#define PG8_STAMP() do { if (STAMP && wid == 0 && nts < 64) { const unsigned long long _c = (unsigned long long)clock64(); \
        ts_lo = (lane == nts) ? (int)(unsigned)_c : ts_lo; ts_hi = (lane == nts) ? (int)(unsigned)(_c >> 32) : ts_hi; ++nts; } } while (0)
    PG8_STAMP();
    unsigned voffA[2], voffB[2];
#pragma unroll
    for (int i = 0; i < 2; ++i) { int R, C; stage_rc(tid * 16 + i * 8192, R, C); const int Rb = Epi::PERM ? ((R & ~31) + perm32(R & 31)) : R;
        voffA[i] = (unsigned)(R * K + C) * 2u; voffB[i] = (unsigned)(Rb * K + C) * 2u; }
    const size_t kstep = (size_t)(BK * 2);
    const size_t hstep = (size_t)HALF * K * 2;
    const size_t tstep = 2 * hstep;
    const unsigned ldsw = (unsigned)wid * 1024u;
    const int aoff = lds_byte(wr * 64 + fr, fq * 8), boff = lds_byte(wc * 32 + fr, fq * 8);
#define PG8_SA(b, h) (((b) * 2 + (h)) * HTB)
#define PG8_SB(b, h) ((4 + (b) * 2 + (h)) * HTB)
#define PG8_STAGE(bufoff, gbase, voff) do { _Pragma("unroll") for (int _i = 0; _i < 2; ++_i) \
        __builtin_amdgcn_global_load_lds((const unsigned*)((const char*)(gbase) + (voff)[_i]), (PG8_LAS unsigned*)(lds + (bufoff) + ldsw + _i * 8192), 16, 0, 0); } while (0)
#define PG8_LDA(dst, b, h) do { _Pragma("unroll") for (int m = 0; m < 4; ++m) _Pragma("unroll") for (int k = 0; k < 2; ++k) dst[m][k] = *(const PG8_LAS bf16x8*)(lds + PG8_SA(b, h) + aoff + m * 2048 + k * 1024); } while (0)
#define PG8_LDB(dst, b, h) do { _Pragma("unroll") for (int n = 0; n < 2; ++n) _Pragma("unroll") for (int k = 0; k < 2; ++k) dst[n][k] = *(const PG8_LAS bf16x8*)(lds + PG8_SB(b, h) + boff + n * 2048 + k * 1024); } while (0)
#define PG8_MMA(ai, bj, At, Bt) do { __builtin_amdgcn_s_setprio(1); _Pragma("unroll") for (int m = 0; m < 4; ++m) _Pragma("unroll") for (int n = 0; n < 2; ++n) _Pragma("unroll") for (int k = 0; k < 2; ++k) \
        acc[ai][bj][m][n] = __builtin_amdgcn_mfma_f32_16x16x32_bf16(Bt[n][k], At[m][k], acc[ai][bj][m][n], 0, 0, 0); __builtin_amdgcn_s_setprio(0); } while (0)
#define PG8_WAIT_V(n) asm volatile("s_waitcnt vmcnt(" #n ")" ::: "memory")
#define PG8_WAIT_L(n) asm volatile("s_waitcnt lgkmcnt(" #n ")" ::: "memory")
#define PG8_BAR __builtin_amdgcn_s_barrier()
#define PG8_SCHED __builtin_amdgcn_sched_barrier(0)
    Unit cur, nxt; int ui = 0;
    if (!S.next(0, cur)) return;
    f32x4 acc[2][2][4][2];
#pragma unroll
    for (int a = 0; a < 2; ++a)
#pragma unroll
        for (int b = 0; b < 2; ++b)
#pragma unroll
            for (int m = 0; m < 4; ++m)
#pragma unroll
                for (int n = 0; n < 2; ++n) acc[a][b][m][n] = (f32x4){0.f, 0.f, 0.f, 0.f};
    bf16x8 At[4][2], B0[2][2], B1[2][2];
    const char* cA = (const char*)g.A + (size_t)cur.pm * tstep; const char* cB = (const char*)g.Bt + (size_t)cur.pn * tstep;
    S.a_ready(cur);
    PG8_STAGE(PG8_SB(0, 0), cB, voffB); PG8_STAGE(PG8_SA(0, 0), cA, voffA); PG8_STAGE(PG8_SB(0, 1), cB + hstep, voffB); PG8_STAGE(PG8_SA(0, 1), cA + hstep, voffA);
    if (wr == 1) PG8_BAR;
    PG8_WAIT_V(4); PG8_BAR;
    PG8_STAGE(PG8_SB(1, 0), cB + kstep, voffB); PG8_STAGE(PG8_SA(1, 0), cA + kstep, voffA); PG8_STAGE(PG8_SB(1, 1), cB + hstep + kstep, voffB);
    PG8_WAIT_V(6); PG8_BAR;
    PG8_STAMP();
    for (;;) {
        const bool has_next = S.next(ui + 1, nxt);
        const char* nA = has_next ? (const char*)g.A + (size_t)nxt.pm * tstep : cA; const char* nB = has_next ? (const char*)g.Bt + (size_t)nxt.pn * tstep : cB;
        for (int t = 0; t < nt; t += 2) {
            const bool last = (t == nt - 2);
            const char* a1 = cA + (size_t)(t + 1) * kstep;
            const char* a2 = last ? nA : cA + (size_t)(t + 2) * kstep; const char* b2 = last ? nB : cB + (size_t)(t + 2) * kstep;
            const char* a3 = a2 + kstep; const char* b3 = b2 + kstep;
            if (last && has_next) S.a_ready(nxt);
            PG8_LDB(B0, 0, 0); PG8_SCHED; PG8_LDA(At, 0, 0); PG8_STAGE(PG8_SA(1, 1), a1 + hstep, voffA);
            PG8_WAIT_L(8); PG8_BAR; PG8_WAIT_L(0); PG8_MMA(0, 0, At, B0); PG8_BAR; PG8_SCHED;
            PG8_LDB(B1, 0, 1); PG8_STAGE(PG8_SB(0, 0), b2, voffB);
            PG8_BAR; PG8_WAIT_L(0); PG8_MMA(0, 1, At, B1); PG8_BAR;
            PG8_LDA(At, 0, 1); PG8_STAGE(PG8_SA(0, 0), a2, voffA);
            PG8_BAR; PG8_WAIT_L(0); PG8_MMA(1, 0, At, B0); PG8_BAR; PG8_SCHED;
            PG8_STAGE(PG8_SB(0, 1), b2 + hstep, voffB);
            PG8_WAIT_V(6); PG8_BAR; PG8_MMA(1, 1, At, B1); PG8_BAR;
            PG8_LDB(B0, 1, 0); PG8_SCHED; PG8_LDA(At, 1, 0); PG8_STAGE(PG8_SA(0, 1), a2 + hstep, voffA);
            PG8_WAIT_L(8); PG8_BAR; PG8_WAIT_L(0); PG8_MMA(0, 0, At, B0); PG8_BAR; PG8_SCHED;
            PG8_LDB(B1, 1, 1); PG8_STAGE(PG8_SB(1, 0), b3, voffB);
            PG8_BAR; PG8_WAIT_L(0); PG8_MMA(0, 1, At, B1); PG8_BAR;
            PG8_LDA(At, 1, 1); PG8_STAGE(PG8_SA(1, 0), a3, voffA);
            PG8_BAR; PG8_WAIT_L(0); PG8_MMA(1, 0, At, B0); PG8_BAR; PG8_SCHED;
            PG8_STAGE(PG8_SB(1, 1), b3 + hstep, voffB);
            PG8_WAIT_V(6); PG8_BAR; PG8_MMA(1, 1, At, B1); PG8_BAR;
        }
        PG8_STAMP();
        if constexpr (!Epi::AFTER_DRAIN) { E(acc, cur, wr, wc, fr, fq); S.done(cur); }
        PG8_STAMP();
        if (!has_next) break;
#pragma unroll
        for (int a = 0; a < 2; ++a)
#pragma unroll
            for (int b = 0; b < 2; ++b)
#pragma unroll
                for (int m = 0; m < 4; ++m)
#pragma unroll
                    for (int n = 0; n < 2; ++n) acc[a][b][m][n] = (f32x4){0.f, 0.f, 0.f, 0.f};
        cur = nxt; cA = nA; cB = nB; ++ui;
    }
    PG8_WAIT_V(0);
    if (wr == 0) PG8_BAR;
    PG8_BAR;
    if constexpr (Epi::AFTER_DRAIN) { E.fused(acc, cur, wr, wc, fr, fq, lds, wid, lane); S.done(cur); }
    PG8_STAMP();
    if (STAMP && wid == 0) { stamps[lane] = lane < nts ? (((unsigned long long)(unsigned)ts_hi << 32) | (unsigned)ts_lo) : 0ull;
        if (lane == 62) stamps[62] = rt_entry; if (lane == 63) stamps[63] = (unsigned long long)wall_clock64(); }
#undef PG8_STAMP
#undef PG8_SA
#undef PG8_SB
#undef PG8_STAGE
#undef PG8_LDA
#undef PG8_LDB
#undef PG8_MMA
#undef PG8_WAIT_V
#undef PG8_WAIT_L
#undef PG8_BAR
#undef PG8_SCHED
}
}

using pg8::bf16_t; using pg8::bf16x8; using pg8::f32x4; using pg8::u32x4;
typedef float f32x16 __attribute__((ext_vector_type(16)));
typedef _Float16 h16x2 __attribute__((ext_vector_type(2)));
typedef unsigned u32x2 __attribute__((ext_vector_type(2)));
#define LAS __attribute__((address_space(3)))

constexpr int NTOK = 17408, NLAT = 16384, DM = 1024, NTH = 512;
constexpr float EPSF = 1e-6f;
constexpr float HSCALE = 64.f;

constexpr size_t SZ_H = (size_t)NTOK * 1024 * 2;
constexpr size_t OFF_X = 0;
constexpr size_t OFF_WIN = OFF_X + SZ_H;
constexpr size_t OFF_WBHY = OFF_WIN + (size_t)8448 * 1024 * 2;
constexpr size_t OFF_WBGLA = OFF_WBHY + 2097152;
constexpr size_t OFF_WOUT = OFF_WBGLA + 2097152;
constexpr size_t OFF_W1 = OFF_WOUT + 2097152;
constexpr size_t OFF_W2 = OFF_W1 + 8388608;
constexpr size_t OFF_XT = OFF_W2 + 8388608;
constexpr size_t SZ_XT = (size_t)4096 * NTOK * 2;
constexpr size_t OFF_PB = OFF_XT + SZ_XT;
constexpr size_t OFF_LR = OFF_PB + SZ_XT;
constexpr size_t OFF_QF = OFF_LR + (size_t)NTOK * 32 * 4;
constexpr size_t SZ_Q = (size_t)NTOK * 512 * 2;
constexpr size_t OFF_QB = OFF_QF + SZ_Q;
constexpr size_t OFF_KEF = OFF_QB + SZ_Q;
constexpr size_t OFF_KEB = OFF_KEF + SZ_Q;
constexpr size_t OFF_ATT = OFF_KEB + SZ_Q;
constexpr size_t OFF_DEC = OFF_ATT + SZ_Q;
constexpr size_t OFF_HP = OFF_DEC + (size_t)272 * 4 * 2 * 128 * 4;
constexpr size_t OFF_CTXS = OFF_HP + (size_t)1024 * 8192 * 4;
constexpr size_t OFF_MOD = OFF_CTXS + 4194304;
constexpr size_t OFF_A2L = OFF_MOD + 491520;
constexpr size_t OFF_A2C = OFF_A2L + 4194304;
constexpr size_t OFF_HTC = OFF_A2C + 262144;
constexpr size_t OFF_HP2 = OFF_HTC + 2097152;
constexpr size_t OFF_HTC2 = OFF_HP2 + (size_t)1024 * 8192 * 4;
constexpr size_t OFF_CNT = OFF_HTC2 + 2097152;
constexpr size_t OFF_BAR = OFF_CNT + 1024;
constexpr size_t WS_TOTAL = OFF_BAR + 16384;

struct Params {
  const float *x, *c, *ctx, *c_ctx, *ada_w, *ada_b, *norm1_g, *norm2_g, *w_in, *conv_w, *conv_b, *fw1, *fb1, *fw2, *fb2, *fw3, *ffreq,
      *decay, *skip, *gate_w, *gate_b, *gla_ng, *w_bhy, *w_bgla, *w_out, *mlp_w1, *mlp_w2, *final_g;
  float* out; unsigned char* ws;
};

typedef float f32x2_t __attribute__((ext_vector_type(2)));
typedef __bf16 bf16x2_t __attribute__((ext_vector_type(2)));
DI bf16_t f2bf(float f) { const __bf16 b = (__bf16)f; return __builtin_bit_cast(bf16_t, b); }
DI float bf2f(bf16_t b) { return __uint_as_float(((unsigned)b) << 16); }
DI unsigned pk2(float lo, float hi) { f32x2_t v; v.x = lo; v.y = hi; const bf16x2_t b = __builtin_convertvector(v, bf16x2_t); return __builtin_bit_cast(unsigned, b); }
DI float bflo(unsigned w) { return __uint_as_float(w << 16); }
DI float bfhi(unsigned w) { return __uint_as_float(w & 0xffff0000u); }
DI float sigm(float x) { return __builtin_amdgcn_rcpf(1.f + __expf(-x)); }
DI float my_sin(float x) { float r = x * 0.15915494309189535f; r -= rintf(r); return __builtin_amdgcn_sinf(r); }
DI float wave_sum(float v) {
#pragma unroll
  for (int o = 32; o >= 1; o >>= 1) v += __shfl_xor(v, o);
  return v;
}
DI float* xrow(const Params& p, int row) { return row < NLAT ? p.out + (size_t)row * DM : (float*)(p.ws + OFF_CTXS) + (size_t)(row - NLAT) * DM; }
DI const float* xrow_in(const Params& p, int row) { return row < NLAT ? p.x + (size_t)row * DM : p.ctx + (size_t)(row - NLAT) * DM; }
DI const float* modp(const Params& p, int l, int s) { return (const float*)(p.ws + OFF_MOD) + ((size_t)l * 5 + s) * 6144; }

DI void phase_copy(const Params& p) {
  if (blockIdx.x == 0) { unsigned* z = (unsigned*)(p.ws + OFF_CNT); for (int i = otid(); i < (1024 + 16384) / 4; i += NTH) z[i] = 0u; }
}

DI void phase_mod(const Params& p, LAS unsigned char* lds) {
  LAS float* sv = (LAS float*)lds;
  LAS float* red = sv + 5 * 1024;
  const int tid = otid();
  bool loaded = false;
  for (int it = blockIdx.x; it < 4 * 48; it += gridDim.x) {
    if (!loaded) {
      for (int i = tid; i < 5 * 1024; i += NTH) { const int s = i >> 10, k = i & 1023; const float v = s < 4 ? p.c[s * 1024 + k] : p.c_ctx[k]; sv[i] = v * sigm(v); }
      loaded = true;
    }
    __syncthreads();
    const int l = it / 48, cb = it % 48, cg4 = tid & 31, kq = tid >> 5;
    const float* W = p.ada_w + (size_t)l * 1024 * 6144 + cb * 128 + 4 * cg4;
    f32x4 a0 = {0.f, 0.f, 0.f, 0.f}, a1 = a0, a2 = a0, a3 = a0, a4 = a0;
#pragma unroll 8
    for (int k = kq * 64; k < kq * 64 + 64; ++k) { const f32x4 w = __builtin_nontemporal_load((const f32x4*)(W + (size_t)k * 6144)); a0 += w * sv[k]; a1 += w * sv[1024 + k]; a2 += w * sv[2048 + k]; a3 += w * sv[3072 + k]; a4 += w * sv[4096 + k]; }
    LAS float* r = red + kq * 5 * 128 + 4 * cg4;
    *(LAS f32x4*)(r) = a0; *(LAS f32x4*)(r + 128) = a1; *(LAS f32x4*)(r + 256) = a2; *(LAS f32x4*)(r + 384) = a3; *(LAS f32x4*)(r + 512) = a4;
    __syncthreads();
    if (tid < 128) {
      const int col = cb * 128 + tid;
      const float bias = p.ada_b[l * 6144 + col];
      float* mo = (float*)(p.ws + OFF_MOD) + (size_t)l * 5 * 6144 + col;
#pragma unroll
      for (int s = 0; s < 5; ++s) { float t = bias;
#pragma unroll
        for (int q = 0; q < 16; ++q) t += red[q * 5 * 128 + s * 128 + tid]; mo[(size_t)s * 6144] = t; }
    }
    __syncthreads();
  }
}

DI void phase_a2(const Params& p, LAS unsigned char* lds) {
  LAS float* zf = (LAS float*)lds;
  LAS float* a1s = zf + 64 * 36;
  const int tid = otid(), tl = tid >> 6, m = tid & 63;
  const int per = (4096 + 256) / 64;
  for (int it = blockIdx.x; it < 4 * per; it += gridDim.x) {
    const int l = it / per, r = it % per;
    const bool isc = r >= 64; const int Lq = isc ? 256 : 4096; const int i0 = (isc ? (r - 64) : r) * 64;
    for (int e = tid; e < 64 * 33; e += NTH) {
      const int tt = e / 33, f = e % 33, i = i0 + tt; float v;
      if (f == 0) v = (float)i / (float)(Lq - 1);
      else { const int j = (f - 1) & 15; const float band = 1e-4f + (float)j * ((15.f - 1e-4f) / 15.f); float rev = (float)i * band / (float)Lq; rev -= floorf(rev);
             v = (f <= 16) ? __builtin_amdgcn_cosf(rev) : -__builtin_amdgcn_sinf(rev); }
      zf[tt * 36 + f] = v;
    }
    const float fr = p.ffreq[l * 64 + m], b1v = p.fb1[l * 64 + m], b2v = p.fb2[l * 64 + m];
    float w1r[33];
#pragma unroll
    for (int f = 0; f < 33; ++f) w1r[f] = p.fw1[((size_t)l * 33 + f) * 64 + m];
    __syncthreads();
#pragma unroll 1
    for (int q = 0; q < 8; ++q) { const int tt = tl * 8 + q; float acc = b1v;
#pragma unroll
      for (int f = 0; f < 33; ++f) acc += zf[tt * 36 + f] * w1r[f];
      a1s[tt * 64 + m] = my_sin(fr * acc); }
    float w2r[64];
#pragma unroll
    for (int j = 0; j < 64; ++j) w2r[j] = p.fw2[((size_t)l * 64 + j) * 64 + m];
    __syncthreads();
    float* dst = isc ? (float*)(p.ws + OFF_A2C) + ((size_t)l * 256 + i0) * 64 : (float*)(p.ws + OFF_A2L) + ((size_t)l * 4096 + i0) * 64;
#pragma unroll 1
    for (int q = 0; q < 8; ++q) { const int tt = tl * 8 + q; float acc = b2v;
#pragma unroll
      for (int j4 = 0; j4 < 16; ++j4) { const f32x4 a = *(const LAS f32x4*)(a1s + tt * 64 + 4 * j4); acc += a.x * w2r[4 * j4] + a.y * w2r[4 * j4 + 1] + a.z * w2r[4 * j4 + 2] + a.w * w2r[4 * j4 + 3]; }
      dst[(size_t)tt * 64 + m] = my_sin(fr * acc); }
    __syncthreads();
  }
}

DI void wt_load(const float* src, int ld_src, int k0, int n0, f32x4 (&v)[2]) {
  const int tid = otid();
#pragma unroll
  for (int q = 0; q < 2; ++q) { const int kk = (tid >> 3) + 64 * q, nq = tid & 7; v[q] = __builtin_nontemporal_load((const f32x4*)(src + (size_t)(k0 + kk) * ld_src + n0 + 4 * nq)); }
}
DI void wt_store(const f32x4 (&v)[2], int k0, bf16_t* dst, int ld_dst, int drow0, LAS unsigned char* lds) {
  LAS bf16_t* t = (LAS bf16_t*)lds;
  const int tid = otid();
#pragma unroll
  for (int q = 0; q < 2; ++q) {
    const int kk = (tid >> 3) + 64 * q, nq = tid & 7;
    t[(4 * nq + 0) * 136 + kk] = f2bf(v[q].x); t[(4 * nq + 1) * 136 + kk] = f2bf(v[q].y); t[(4 * nq + 2) * 136 + kk] = f2bf(v[q].z); t[(4 * nq + 3) * 136 + kk] = f2bf(v[q].w);
  }
  __syncthreads();
  { const int n = tid >> 4, kq = tid & 15;
    const u32x4 o = *(const LAS u32x4*)(t + n * 136 + 8 * kq);
    *(u32x4*)(dst + (size_t)(drow0 + n) * ld_dst + k0 + 8 * kq) = o; }
  __syncthreads();
}
DI int win_dst_row(int n) {
  if (n < 3072) return n;
  if (n < 4096) return 4096 + (n - 3072);
  if (n < 5120) return 3072 + (n - 4096);
  if (n < 6144) return 4096 + 1024 + (n - 5120);
  if (n < 6176) return 8192 + (n - 6144);
  if (n < 7200) return 4096 + 2048 + (n - 6176);
  return 4096 + 3072 + (n - 7200);
}
struct WtItem { const float* src; int ld_src, k0, n0; bf16_t* dst; int ld_dst, drow0; };
DI WtItem wt_decode(const Params& p, int l, int part, int it) {
  unsigned char* ws = p.ws; WtItem w;
  const int n_win = 8 * 257, n_sq = 8 * 32, n_w1 = 8 * 128;
  if (part == 0) {
    if (it < n_win) { const int kt = it & 7, nt = it >> 3; w.src = p.w_in + (size_t)l * 1024 * 8224; w.ld_src = 8224; w.k0 = kt * 128; w.n0 = nt * 32; w.dst = (bf16_t*)(ws + OFF_WIN); w.ld_dst = 1024; w.drow0 = win_dst_row(nt * 32); }
    else { const int r = it - n_win, which = r / n_sq, q = r % n_sq, kt = q & 7, nt = q >> 3;
      w.src = (which == 0 ? p.w_bhy : which == 1 ? p.w_bgla : p.w_out) + (size_t)l * 1024 * 1024; w.ld_src = 1024; w.k0 = kt * 128; w.n0 = nt * 32;
      w.dst = (bf16_t*)(ws + (which == 0 ? OFF_WBHY : which == 1 ? OFF_WBGLA : OFF_WOUT)); w.ld_dst = 1024; w.drow0 = nt * 32; }
  } else {
    if (it < n_w1) { const int kt = it & 7, nt = it >> 3; w.src = p.mlp_w1 + (size_t)l * 1024 * 4096; w.ld_src = 4096; w.k0 = kt * 128; w.n0 = nt * 32; w.dst = (bf16_t*)(ws + OFF_W1); w.ld_dst = 1024; w.drow0 = nt * 32; }
    else { const int r = it - n_w1, kt = r & 31, nt = r >> 5; w.src = p.mlp_w2 + (size_t)l * 4096 * 1024; w.ld_src = 1024; w.k0 = kt * 128; w.n0 = nt * 32; w.dst = (bf16_t*)(ws + OFF_W2); w.ld_dst = 4096; w.drow0 = nt * 32; }
  }
  return w;
}
DI void phase_wconv(const Params& p, int l, LAS unsigned char* lds, int part, int blk, int nblk) {
  unsigned char* ws = p.ws;
  const int total = part == 0 ? (8 * 257 + 3 * 8 * 32) : (8 * 128 + 32 * 32);
  f32x4 v[2];
  if (blk < total) { const WtItem w = wt_decode(p, l, part, blk); wt_load(w.src, w.ld_src, w.k0, w.n0, v); }
  for (int it = blk; it < total; it += nblk) {
    const WtItem w = wt_decode(p, l, part, it);
    f32x4 cur[2] = {v[0], v[1]};
    if (it + nblk < total) { const WtItem w2 = wt_decode(p, l, part, it + nblk); wt_load(w2.src, w2.ld_src, w2.k0, w2.n0, v); }
    wt_store(cur, w.k0, w.dst, w.ld_dst, w.drow0, lds);
  }
  if (part == 0) { u32x4* z = (u32x4*)(ws + OFF_WIN + (size_t)8224 * 1024 * 2); const int n = 224 * 1024 * 2 / 16;
    for (int i = blk * NTH + otid(); i < n; i += nblk * NTH) z[i] = (u32x4){0u, 0u, 0u, 0u}; }
}

DI void phase_norm(const Params& p, int l, const float* g, int sh_off, int sc_off, int nrows, bool from_input) {
  const int lane = otid() & 63, gw = blockIdx.x * 8 + (otid() >> 6), nw = gridDim.x * 8;
  bf16_t* hb = (bf16_t*)(p.ws + OFF_X);
  const int rp = (nrows + nw - 1) / nw, r0 = gw * rp, r1 = min(nrows, r0 + rp);
  f32x4 A[4], B[4]; int scur = -1;
  f32x4 pa[4], pb2[4];
#define NORM_LOAD(rw) do { const int ra_ = (rw), rb_ = ((rw) + 1 < r1) ? (rw) + 1 : (rw); const float* xa_ = from_input ? xrow_in(p, ra_) : xrow(p, ra_); const float* xb_ = from_input ? xrow_in(p, rb_) : xrow(p, rb_); \
    _Pragma("unroll") for (int i = 0; i < 4; ++i) { pa[i] = *(const f32x4*)(xa_ + 4 * lane + 256 * i); pb2[i] = *(const f32x4*)(xb_ + 4 * lane + 256 * i); } } while (0)
  if (r0 < r1) NORM_LOAD(r0);
  for (int row = r0; row < r1; row += 2) {
    const bool two = row + 1 < r1;
    const int s = row < NLAT ? (row >> 12) : 4;
    if (s != scur) { scur = s; const float* mo = modp(p, l, s);
#pragma unroll
      for (int i = 0; i < 4; ++i) { const int c = 4 * lane + 256 * i; const f32x4 gg = *(const f32x4*)(g + c), sc = *(const f32x4*)(mo + sc_off + c); A[i] = gg * (sc + 1.f); B[i] = *(const f32x4*)(mo + sh_off + c); } }
    f32x4 va[4], vb[4]; float sa = 0.f, sb = 0.f;
#pragma unroll
    for (int i = 0; i < 4; ++i) { va[i] = pa[i]; vb[i] = pb2[i]; }
    if (row + 2 < r1) NORM_LOAD(row + 2);
#pragma unroll
    for (int i = 0; i < 4; ++i) { sa += va[i].x * va[i].x + va[i].y * va[i].y + va[i].z * va[i].z + va[i].w * va[i].w; sb += vb[i].x * vb[i].x + vb[i].y * vb[i].y + vb[i].z * vb[i].z + vb[i].w * vb[i].w; }
#pragma unroll
    for (int o = 32; o >= 1; o >>= 1) { sa += __shfl_xor(sa, o); sb += __shfl_xor(sb, o); }
    const float ra = rsqrtf(sa * (1.f / 1024.f) + EPSF), rb = rsqrtf(sb * (1.f / 1024.f) + EPSF);
    const int s2 = (row + 1) < NLAT ? ((row + 1) >> 12) : 4;
#pragma unroll
    for (int i = 0; i < 4; ++i) { const int c = 4 * lane + 256 * i; const f32x4 ya = va[i] * ra * A[i] + B[i];
      *(u32x2*)(hb + (size_t)row * 1024 + c) = (u32x2){pk2(ya.x, ya.y), pk2(ya.z, ya.w)}; }
    if (two) {
      if (s2 != scur) { scur = s2; const float* mo = modp(p, l, s2);
#pragma unroll
        for (int i = 0; i < 4; ++i) { const int c = 4 * lane + 256 * i; const f32x4 gg = *(const f32x4*)(g + c), sc = *(const f32x4*)(mo + sc_off + c); A[i] = gg * (sc + 1.f); B[i] = *(const f32x4*)(mo + sh_off + c); } }
#pragma unroll
      for (int i = 0; i < 4; ++i) { const int c = 4 * lane + 256 * i; const f32x4 yb = vb[i] * rb * A[i] + B[i];
        *(u32x2*)(hb + (size_t)(row + 1) * 1024 + c) = (u32x2){pk2(yb.x, yb.y), pk2(yb.z, yb.w)}; }
    }
  }
}
#undef NORM_LOAD
DI void phase_final_norm(const Params& p) {
  const int lane = otid() & 63, gw = blockIdx.x * 8 + (otid() >> 6), nw = gridDim.x * 8;
  for (int row = gw; row < NLAT; row += nw) {
    float* xr = p.out + (size_t)row * DM;
    float4 v[4]; float ss = 0.f;
#pragma unroll
    for (int i = 0; i < 4; ++i) { v[i] = *(const float4*)(xr + 4 * lane + 256 * i); ss += v[i].x * v[i].x + v[i].y * v[i].y + v[i].z * v[i].z + v[i].w * v[i].w; }
    ss = wave_sum(ss);
    const float rstd = rsqrtf(ss * (1.f / 1024.f) + EPSF);
#pragma unroll
    for (int i = 0; i < 4; ++i) { const int c = 4 * lane + 256 * i; const float4 gg = *(const float4*)(p.final_g + c);
      *(float4*)(xr + c) = make_float4(v[i].x * rstd * gg.x, v[i].y * rstd * gg.y, v[i].z * rstd * gg.z, v[i].w * rstd * gg.w); }
  }
}

DI void phase_filt_gemm(const Params& p, int l, LAS unsigned char* lds, int blk, int nblk) {
  LAS float* w3s = (LAS float*)lds;
  LAS float* a2s = w3s + 64 * 64;
  const int tid = otid();
  const int nL = 32 * 32, nC = 32 * 2;
  for (int it = blk; it < nL + nC; it += nblk) {
    const bool isc = it >= nL; const int r = isc ? it - nL : it; const int Lq = isc ? 256 : 4096;
    const int ntt = Lq / 128, dt = r / ntt, tt0 = (r % ntt) * 128, d0 = dt * 64;
    const float* A2 = isc ? (const float*)(p.ws + OFF_A2C) + (size_t)l * 256 * 64 : (const float*)(p.ws + OFF_A2L) + (size_t)l * 4096 * 64;
    float* hT = isc ? (float*)(p.ws + ((l & 1) ? OFF_HTC2 : OFF_HTC)) : (float*)(p.ws + ((l & 1) ? OFF_HP2 : OFF_HP));
    { const int m = tid >> 3, q = tid & 7; const float* s = p.fw3 + ((size_t)l * 64 + m) * 2048 + d0;
      *(LAS f32x4*)(w3s + m * 64 + 4 * q) = *(const f32x4*)(s + 4 * q); *(LAS f32x4*)(w3s + m * 64 + 32 + 4 * q) = *(const f32x4*)(s + 32 + 4 * q); }
    { const int tt = tid >> 2, mq = tid & 3; const float* s = A2 + (size_t)(tt0 + tt) * 64 + 16 * mq;
#pragma unroll
      for (int q = 0; q < 4; ++q) { const float4 v = *(const float4*)(s + 4 * q);
        a2s[(16 * mq + 4 * q + 0) * 132 + tt] = v.x; a2s[(16 * mq + 4 * q + 1) * 132 + tt] = v.y; a2s[(16 * mq + 4 * q + 2) * 132 + tt] = v.z; a2s[(16 * mq + 4 * q + 3) * 132 + tt] = v.w; } }
    __syncthreads();
    const int cx = tid & 15, ty = tid >> 4;
    float acc[4][4];
#pragma unroll
    for (int a = 0; a < 4; ++a)
#pragma unroll
      for (int b = 0; b < 4; ++b) acc[a][b] = 0.f;
#pragma unroll 8
    for (int m = 0; m < 64; ++m) {
      const f32x4 wv = *(const LAS f32x4*)(w3s + m * 64 + 4 * cx), av = *(const LAS f32x4*)(a2s + m * 132 + 4 * ty);
      const float w[4] = {wv.x, wv.y, wv.z, wv.w}, a[4] = {av.x, av.y, av.z, av.w};
#pragma unroll
      for (int ci = 0; ci < 4; ++ci)
#pragma unroll
        for (int ti = 0; ti < 4; ++ti) acc[ci][ti] += w[ci] * a[ti];
    }
    const float inv = 1.f / (float)(Lq - 1);
#pragma unroll
    for (int ci = 0; ci < 4; ++ci) {
      const int dirch = d0 + 4 * cx + ci; const float dc = fabsf(p.decay[l * 1024 + (dirch & 1023)]);
      float o[4];
#pragma unroll
      for (int ti = 0; ti < 4; ++ti) { const float tl = (float)(tt0 + 4 * ty + ti) * inv; o[ti] = acc[ci][ti] * __expf(-tl * dc); }
      *(float4*)(hT + (size_t)dirch * Lq + tt0 + 4 * ty) = make_float4(o[0], o[1], o[2], o[3]);
    }
    __syncthreads();
  }
}
#define XB_TMO      128
#define XB_XCNT(j)  (256  + 64 * (j))
#define XB_XSUB(j)  (1280 + 64 * (j))
#define XB_XGEN(j)  (2304 + 64 * (j))
#define XB_TOP      3328
#define XB_TOPGEN   3392
#define XCD_BAR_WORDS 3456
#define XB_SPIN_CAP (1u << 18)

__device__ __forceinline__ unsigned xb_ld(unsigned* p)              { return __hip_atomic_load(p, __ATOMIC_RELAXED, __HIP_MEMORY_SCOPE_AGENT); }
__device__ __forceinline__ unsigned xb_add(unsigned* p, unsigned v) { return __hip_atomic_fetch_add(p, v, __ATOMIC_RELAXED, __HIP_MEMORY_SCOPE_AGENT); }
__device__ __forceinline__ unsigned xb_xcc_id() { return (unsigned)__builtin_amdgcn_s_getreg((3 << 11) | 20) & 0xFu; }
#define XB_SPIN(cond, bar) do { unsigned _sp = 0; while (cond) { __builtin_amdgcn_s_sleep(1); \
    if ((++_sp & 255u) == 0u) { if (xb_ld(&(bar)[XB_TMO])) break; if (_sp > XB_SPIN_CAP) { atomicAdd(&(bar)[XB_TMO], 1u); break; } } } } while (0)
struct XcdBarrier {
    unsigned* bar; unsigned x;
    volatile LAS unsigned* st;
};

__device__ __forceinline__ XcdBarrier xcd_barrier_post(unsigned* bar, volatile LAS unsigned* st) {
    XcdBarrier b; b.bar = bar; b.x = xb_xcc_id(); b.st = st;
    if (threadIdx.x == 0) (void)xb_add(&bar[XB_XCNT(b.x)], 1u);
    return b;
}
__device__ __forceinline__ void xcd_barrier_complete(unsigned* bar, unsigned x, unsigned& nloc, unsigned& nx) {
    const unsigned G = gridDim.x * gridDim.y * gridDim.z;
    unsigned sum, cnt, mine, sp = 0u;
    for (;;) {
        sum = 0u; cnt = 0u; mine = 0u;
#pragma unroll
        for (unsigned j = 0; j < 16; ++j) { const unsigned c = xb_ld(&bar[XB_XCNT(j)]); sum += c; cnt += (c > 0u) ? 1u : 0u; mine = (j == x) ? c : mine; }
        if (sum == G) break;
        __builtin_amdgcn_s_sleep(1);
        if ((++sp & 255u) == 0u) { if (xb_ld(&bar[XB_TMO])) break; if (sp > XB_SPIN_CAP) { atomicAdd(&bar[XB_TMO], 1u); break; } }
    }
    nloc = mine > 0u ? mine : 1u; nx = cnt > 0u ? cnt : 1u;
}

__device__ __forceinline__ void xcd_barrier(const XcdBarrier& b) {
    asm volatile("s_waitcnt vmcnt(0)" ::: "memory");
    __syncthreads();
    if (threadIdx.x == 0) {
        unsigned* bar = b.bar;
        __builtin_amdgcn_s_waitcnt(0);
        unsigned nloc = b.st[0], nx = b.st[1];
        if (nloc == 0u) { xcd_barrier_complete(bar, b.x, nloc, nx); b.st[0] = nloc; b.st[1] = nx; }
        const unsigned old = xb_add(&bar[XB_XSUB(b.x)], 1u);
        const unsigned gen = old / nloc;
        if (old + 1u == (gen + 1u) * nloc) {
            __builtin_amdgcn_fence(__ATOMIC_RELEASE, "agent");
            asm volatile("s_waitcnt vmcnt(0)" ::: "memory");
            const unsigned og = xb_add(&bar[XB_TOP], 1u);
            const unsigned tg = og / nx;
            if (og + 1u == (tg + 1u) * nx) xb_add(&bar[XB_TOPGEN], 1u);
            else XB_SPIN(xb_ld(&bar[XB_TOPGEN]) == tg, bar);
            __builtin_amdgcn_fence(__ATOMIC_ACQUIRE, "agent");
            xb_add(&bar[XB_XGEN(b.x)], 1u);
            asm volatile("s_waitcnt vmcnt(0)" ::: "memory");
        } else {
            XB_SPIN(xb_ld(&bar[XB_XGEN(b.x)]) == gen, bar);
            __builtin_amdgcn_fence(__ATOMIC_ACQUIRE, "agent");
            asm volatile("s_waitcnt vmcnt(0)" ::: "memory");
        }
    }
    __syncthreads();
}

typedef float cplx __attribute__((ext_vector_type(2)));
DI cplx mk2(float a, float b) { cplx r; r.x = a; r.y = b; return r; }
DI constexpr float cos32(int m) { constexpr float t[16] = {1.f, 0.98078528040323043f, 0.92387953251128674f, 0.83146961230254524f, 0.70710678118654752f, 0.55557023301960218f, 0.38268343236508977f, 0.19509032201612825f,
    0.f, -0.19509032201612825f, -0.38268343236508977f, -0.55557023301960218f, -0.70710678118654752f, -0.83146961230254524f, -0.92387953251128674f, -0.98078528040323043f}; return t[m]; }
DI constexpr float sin32(int m) { constexpr float t[16] = {0.f, 0.19509032201612825f, 0.38268343236508977f, 0.55557023301960218f, 0.70710678118654752f, 0.83146961230254524f, 0.92387953251128674f, 0.98078528040323043f,
    1.f, 0.98078528040323043f, 0.92387953251128674f, 0.83146961230254524f, 0.70710678118654752f, 0.55557023301960218f, 0.38268343236508977f, 0.19509032201612825f}; return t[m]; }
DI constexpr int brev(int k, int bits) { int r = 0; for (int i = 0; i < bits; ++i) r |= ((k >> i) & 1) << (bits - 1 - i); return r; }
DI cplx cmul_c(cplx a, cplx b) { return mk2(a.x * b.x - a.y * b.y, a.x * b.y + a.y * b.x); }
DI cplx cmulc_c(cplx a, cplx b) { return mk2(a.x * b.x + a.y * b.y, a.y * b.x - a.x * b.y); }
DI cplx cmul(cplx a, cplx b) { cplx r; asm("v_pk_mul_f32 %0, %1, %2 op_sel_hi:[1,0]\n\tv_pk_fma_f32 %0, %1, %2, %0 op_sel:[1,1,0] op_sel_hi:[0,1,1] neg_lo:[1,0,0]" : "=&v"(r) : "v"(a), "v"(b)); return r; }
DI cplx cmulc(cplx a, cplx b) { cplx r; asm("v_pk_mul_f32 %0, %1, %2 op_sel_hi:[1,0]\n\tv_pk_fma_f32 %0, %1, %2, %0 op_sel:[1,1,0] op_sel_hi:[0,1,1] neg_hi:[1,0,0]" : "=&v"(r) : "v"(a), "v"(b)); return r; }
DI cplx cmul_s(cplx a, cplx b) { cplx r; asm("v_pk_mul_f32 %0, %1, %2 op_sel_hi:[1,0]\n\tv_pk_fma_f32 %0, %1, %2, %0 op_sel:[1,1,0] op_sel_hi:[0,1,1] neg_lo:[1,0,0]" : "=&v"(r) : "v"(a), "s"(b)); return r; }
DI cplx cmulc_s(cplx a, cplx b) { cplx r; asm("v_pk_mul_f32 %0, %1, %2 op_sel_hi:[1,0]\n\tv_pk_fma_f32 %0, %1, %2, %0 op_sel:[1,1,0] op_sel_hi:[0,1,1] neg_hi:[1,0,0]" : "=&v"(r) : "v"(a), "s"(b)); return r; }
DI cplx mul_mi(cplx a) { cplx r; asm("v_pk_mul_f32 %0, %1, 1.0 op_sel:[1,0] op_sel_hi:[0,0] neg_hi:[1,0]" : "=v"(r) : "v"(a)); return r; }
DI cplx mul_pi(cplx a) { cplx r; asm("v_pk_mul_f32 %0, %1, 1.0 op_sel:[1,0] op_sel_hi:[0,0] neg_lo:[1,0]" : "=v"(r) : "v"(a)); return r; }

template <int R, bool INV> DI void dft_reg(cplx (&v)[R]) {
#pragma unroll
  for (int len = R; len >= 2; len >>= 1) {
    const int half = len >> 1;
#pragma unroll
    for (int s = 0; s < R; s += len) {
#pragma unroll
      for (int j = 0; j < half; ++j) {
        const cplx a = v[s + j], b = v[s + j + half];
        v[s + j] = mk2(a.x + b.x, a.y + b.y);
        const cplx d = mk2(a.x - b.x, a.y - b.y);
        const int m = j * (32 / len);
        if (m == 0) v[s + j + half] = d;
        else if (m == 8) v[s + j + half] = INV ? mul_pi(d) : mul_mi(d);
        else { const cplx K = mk2(cos32(m), sin32(m));
          v[s + j + half] = INV ? cmul_s(d, K) : cmulc_s(d, K); }
      }
    }
  }
}
constexpr int FFT_REGION_F2 = 8704;

template <int NV> DI void fft_fwd3(cplx (&v)[NV][16], LAS cplx* L, int tid) {

#pragma unroll
  for (int i = 0; i < NV; ++i) dft_reg<16, false>(v[i]);

  { float rev = (float)tid * (1.f / 8192.f); asm volatile("" : "+v"(rev)); const cplx w1 = mk2(__builtin_amdgcn_cosf(rev), -__builtin_amdgcn_sinf(rev)); cplx w = mk2(1.f, 0.f);
    const int pb = tid + 2 * (tid >> 5);
#pragma unroll
    for (int k = 0; k < 16; ++k) {
#pragma unroll
      for (int i = 0; i < NV; ++i) L[i * FFT_REGION_F2 + pb + 544 * k] = cmul(v[i][brev(k, 4)], w);
      w = cmul(w, w1); } }
  __syncthreads();
  { const int sb = tid >> 5, ii = tid & 31, pb = 544 * sb + ii;
    cplx u[NV][16];
#pragma unroll
    for (int i = 0; i < NV; ++i)
#pragma unroll
      for (int j = 0; j < 16; ++j) u[i][j] = L[i * FFT_REGION_F2 + pb + 34 * j];

#pragma unroll
    for (int i = 0; i < NV; ++i) dft_reg<16, false>(u[i]);

    float rev = (float)ii * (1.f / 512.f); asm volatile("" : "+v"(rev)); const cplx w1 = mk2(__builtin_amdgcn_cosf(rev), -__builtin_amdgcn_sinf(rev)); cplx w = mk2(1.f, 0.f);
#pragma unroll
    for (int k = 0; k < 16; ++k) {
#pragma unroll
      for (int i = 0; i < NV; ++i) L[i * FFT_REGION_F2 + pb + 34 * k] = cmul(u[i][brev(k, 4)], w);
      w = cmul(w, w1); } }
  __syncthreads();
  { const int sb = tid >> 1, ii = tid & 1, pb = 34 * sb + ii;
    cplx u[NV][16];
#pragma unroll
    for (int i = 0; i < NV; ++i)
#pragma unroll
      for (int j = 0; j < 16; ++j) u[i][j] = L[i * FFT_REGION_F2 + pb + 2 * j];

#pragma unroll
    for (int i = 0; i < NV; ++i) dft_reg<16, false>(u[i]);

#pragma unroll
    for (int k = 0; k < 16; ++k)
#pragma unroll
      for (int i = 0; i < NV; ++i) { const cplx y = u[i][brev(k, 4)]; const cplx yw = cmul_c(y, mk2(cos32(k), -sin32(k))); L[i * FFT_REGION_F2 + pb + 2 * k] = ii ? yw : y; } }
  __syncthreads();
}
template <int NV> DI void fft_inv3(cplx (&v)[NV][16], LAS cplx* L, int tid) {
  { const int sb = tid >> 1, ii = tid & 1, pb = 34 * sb + ii;
    cplx u[NV][16];
#pragma unroll
    for (int i = 0; i < NV; ++i)
#pragma unroll
      for (int k = 0; k < 16; ++k) { const cplx y = L[i * FFT_REGION_F2 + pb + 2 * k]; const cplx yw = cmulc_c(y, mk2(cos32(k), -sin32(k))); u[i][k] = ii ? yw : y; }

#pragma unroll
    for (int i = 0; i < NV; ++i) dft_reg<16, true>(u[i]);

#pragma unroll
    for (int i = 0; i < NV; ++i)
#pragma unroll
      for (int j = 0; j < 16; ++j) L[i * FFT_REGION_F2 + pb + 2 * j] = u[i][brev(j, 4)]; }
  __syncthreads();
  { const int sb = tid >> 5, ii = tid & 31, pb = 544 * sb + ii;
    cplx u[NV][16];
    float rev = (float)ii * (1.f / 512.f); asm volatile("" : "+v"(rev)); const cplx w1 = mk2(__builtin_amdgcn_cosf(rev), -__builtin_amdgcn_sinf(rev)); cplx w = mk2(1.f, 0.f);
#pragma unroll
    for (int k = 0; k < 16; ++k) {
#pragma unroll
      for (int i = 0; i < NV; ++i) u[i][k] = cmulc(L[i * FFT_REGION_F2 + pb + 34 * k], w);
      w = cmul(w, w1); }

#pragma unroll
    for (int i = 0; i < NV; ++i) dft_reg<16, true>(u[i]);

#pragma unroll
    for (int i = 0; i < NV; ++i)
#pragma unroll
      for (int j = 0; j < 16; ++j) L[i * FFT_REGION_F2 + pb + 34 * j] = u[i][brev(j, 4)]; }
  __syncthreads();
  { float rev = (float)tid * (1.f / 8192.f); asm volatile("" : "+v"(rev)); const cplx w1 = mk2(__builtin_amdgcn_cosf(rev), -__builtin_amdgcn_sinf(rev)); cplx w = mk2(1.f, 0.f);
    const int pb = tid + 2 * (tid >> 5);
#pragma unroll
    for (int k = 0; k < 16; ++k) {
#pragma unroll
      for (int i = 0; i < NV; ++i) v[i][k] = cmulc(L[i * FFT_REGION_F2 + pb + 544 * k], w);
      w = cmul(w, w1); }

#pragma unroll
    for (int i = 0; i < NV; ++i) dft_reg<16, true>(v[i]);
     }
}

DI float shl1(float x, int lane) { const float t = __shfl_up(x, 1); return lane == 0 ? 0.f : t; }
DI float shr1(float x, int lane) { const float t = __shfl_down(x, 1); return lane == 63 ? 0.f : t; }
DI void hy_conv8(const bf16_t* XT, int c, int bt, int tl, int lane, const float (&cw)[3][3], const float (&cb)[3], float (&x0c)[8], float (&zz)[8]) {
  float uc[3][8];
#pragma unroll
  for (int g = 0; g < 3; ++g) {
    const u32x4 raw = *(const u32x4*)(XT + (size_t)(g * 1024 + c) * NTOK + (size_t)bt * 4096 + 8 * tl);
    float pv[10];
#pragma unroll
    for (int q = 0; q < 4; ++q) { pv[1 + 2 * q] = bflo(raw[q]); pv[2 + 2 * q] = bfhi(raw[q]); }
    { const float t0 = __shfl_up(pv[8], 1), t1 = __shfl_down(pv[1], 1); pv[0] = (lane & 7) == 0 ? 0.f : t0; pv[9] = (lane & 7) == 7 ? 0.f : t1; }
#pragma unroll
    for (int e2 = 0; e2 < 8; ++e2) uc[g][e2] = cw[g][0] * pv[e2] + cw[g][1] * pv[e2 + 1] + cw[g][2] * pv[e2 + 2] + cb[g];
  }
#pragma unroll
  for (int e2 = 0; e2 < 8; ++e2) { x0c[e2] = uc[0][e2]; zz[e2] = uc[1][e2] * uc[2][e2]; }
}
template <int NV> DI void hyena_chan(const Params& p, int l, int c, LAS cplx* L, int tid) {
  bf16_t* XT = (bf16_t*)(p.ws + OFF_XT);
  const int lane = tid & 63;
  const int pb4 = 16 * tid + 2 * (tid >> 1);
  h16x2 Hr[5]; LAS h16x2* Hl = (LAS h16x2*)(L + 2 * FFT_REGION_F2) + tid;
  {
    const float* hT = (const float*)(p.ws + ((l & 1) ? OFF_HP2 : OFF_HP));
    const float* hf = hT + (size_t)c * 4096, * hbk = hT + (size_t)(1024 + c) * 4096;
    cplx f[1][16];
#pragma unroll
    for (int j = 0; j < 8; ++j) f[0][j] = mk2(__builtin_nontemporal_load(hf + tid + 512 * j), 0.f);
#pragma unroll
    for (int j = 8; j < 16; ++j) { const int n = tid + 512 * j; f[0][j] = mk2(n == 4096 ? 0.f : __builtin_nontemporal_load(hbk + (n == 4096 ? 0 : 8192 - n)), 0.f); }
    fft_fwd3<1>(f, L, tid);
#pragma unroll
    for (int m = 0; m < 8; ++m) { const cplx a = L[pb4 + 2 * m], b = L[pb4 + 2 * m + 1];
      h16x2 h0, h1; h0.x = (_Float16)((a.x + b.x) * HSCALE); h0.y = (_Float16)((a.y + b.y) * HSCALE); h1.x = (_Float16)((a.x - b.x) * HSCALE); h1.y = (_Float16)((a.y - b.y) * HSCALE);
      if (2 * m < 11) Hl[(2 * m) * 512] = h0; else Hr[2 * m - 11 < 0 ? 0 : 2 * m - 11] = h0;
      if (2 * m + 1 < 11) Hl[(2 * m + 1) * 512] = h1; else Hr[2 * m + 1 - 11 < 0 ? 0 : 2 * m + 1 - 11] = h1; }
    __syncthreads();
  }
  float cw[3][3], cb[3];
#pragma unroll
  for (int g = 0; g < 3; ++g) { cb[g] = p.conv_b[l * 3072 + g * 1024 + c];
#pragma unroll
    for (int t = 0; t < 3; ++t) cw[g][t] = p.conv_w[((size_t)l * 3 + t) * 3072 + g * 1024 + c]; }
  const float sk = p.skip[l * 1024 + c], sc = 1.f / (8192.f * HSCALE);
#pragma unroll 1
  for (int bp0 = 0; bp0 < 2; bp0 += NV) {
    int tl = tid; asm volatile("" : "+v"(tl));
#pragma unroll
    for (int i = 0; i < NV; ++i) {
      float xa[8], za[8], xb[8], zb[8];
      hy_conv8(XT, c, 2 * (bp0 + i), tl, lane, cw, cb, xa, za);
      hy_conv8(XT, c, 2 * (bp0 + i) + 1, tl, lane, cw, cb, xb, zb);
      LAS cplx* X = L + i * FFT_REGION_F2 + 8 * tl + 2 * (tl >> 2);
#pragma unroll
      for (int e2 = 0; e2 < 8; ++e2) X[e2] = mk2(za[e2], zb[e2]);

    }
    __syncthreads();
    cplx v[NV][16];
    { const int pb = tl + 2 * (tl >> 5);
#pragma unroll
      for (int i = 0; i < NV; ++i) {
#pragma unroll
        for (int j = 0; j < 8; ++j) v[i][j] = L[i * FFT_REGION_F2 + pb + 544 * j];
#pragma unroll
        for (int j = 8; j < 16; ++j) v[i][j] = mk2(0.f, 0.f); } }
    __syncthreads();

    fft_fwd3<NV>(v, L, tid);

#pragma unroll
    for (int i = 0; i < NV; ++i) {
      LAS cplx* Li = L + i * FFT_REGION_F2;
#pragma unroll
      for (int m = 0; m < 8; ++m) { const cplx a = Li[pb4 + 2 * m], b = Li[pb4 + 2 * m + 1];
        const h16x2 h0 = (2 * m < 11) ? Hl[(2 * m) * 512] : Hr[2 * m - 11 < 0 ? 0 : 2 * m - 11], h1 = (2 * m + 1 < 11) ? Hl[(2 * m + 1) * 512] : Hr[2 * m + 1 - 11 < 0 ? 0 : 2 * m + 1 - 11];
        const cplx y0 = cmul(mk2(a.x + b.x, a.y + b.y), mk2((float)h0.x, (float)h0.y)), y1 = cmul(mk2(a.x - b.x, a.y - b.y), mk2((float)h1.x, (float)h1.y));
        Li[pb4 + 2 * m] = mk2(y0.x + y1.x, y0.y + y1.y); Li[pb4 + 2 * m + 1] = mk2(y0.x - y1.x, y0.y - y1.y); }
       }
    __syncthreads();
    fft_inv3<NV>(v, L, tid);

    { const int pb = tl + 2 * (tl >> 5);
#pragma unroll
      for (int i = 0; i < NV; ++i)
#pragma unroll
        for (int j = 0; j < 8; ++j) L[i * FFT_REGION_F2 + pb + 544 * j] = v[i][brev(j, 4)]; }
    __syncthreads();
#pragma unroll
    for (int i = 0; i < NV; ++i) {
      float xa[8], za[8], xb[8], zb[8];
      hy_conv8(XT, c, 2 * (bp0 + i), tl, lane, cw, cb, xa, za);
      hy_conv8(XT, c, 2 * (bp0 + i) + 1, tl, lane, cw, cb, xb, zb);
      const LAS cplx* X = L + i * FFT_REGION_F2 + 8 * tl + 2 * (tl >> 2);
      float ya[8], yb[8];
#pragma unroll
      for (int e2 = 0; e2 < 8; ++e2) { const cplx cv = X[e2]; ya[e2] = xa[e2] * (cv.x * sc + sk * za[e2]); yb[e2] = xb[e2] * (cv.y * sc + sk * zb[e2]); }
      *(u32x4*)(XT + (size_t)c * NTOK + (size_t)(2 * (bp0 + i)) * 4096 + 8 * tl) = (u32x4){pk2(ya[0], ya[1]), pk2(ya[2], ya[3]), pk2(ya[4], ya[5]), pk2(ya[6], ya[7])};
      *(u32x4*)(XT + (size_t)c * NTOK + (size_t)(2 * (bp0 + i) + 1) * 4096 + 8 * tl) = (u32x4){pk2(yb[0], yb[1]), pk2(yb[2], yb[3]), pk2(yb[4], yb[5]), pk2(yb[6], yb[7])};

    }
    __syncthreads();
  }
}

DI void hyena_ctx_item(const Params& p, int l, int c, LAS unsigned char* lds) {
  LAS float* zs = (LAS float*)lds;
  LAS float* hc = zs + 1024;
  LAS float* part = hc + 512;
  bf16_t* XT = (bf16_t*)(p.ws + OFF_XT);
  const float* hTc = (const float*)(p.ws + ((l & 1) ? OFF_HTC2 : OFF_HTC));
  const int tid = otid();
  { const int i = tid - 256; hc[tid] = i >= 0 ? hTc[(size_t)c * 256 + i] : (tid == 0 ? 0.f : hTc[(size_t)(1024 + c) * 256 + (-i)]); }
  float u0[2];
  { const int b = tid >> 7, tq = tid & 127;
#pragma unroll
    for (int e = 0; e < 2; ++e) {
      const int t = tq + 128 * e;
      float uu[3];
#pragma unroll
      for (int g = 0; g < 3; ++g) {
        const bf16_t* row = XT + (size_t)(g * 1024 + c) * NTOK + NLAT + b * 256;
        const float pm = t > 0 ? bf2f(row[t - 1]) : 0.f, p0 = bf2f(row[t]), pp = t < 255 ? bf2f(row[t + 1]) : 0.f;
        const size_t wb = (size_t)l * 3 * 3072 + g * 1024 + c;
        uu[g] = p.conv_w[wb] * pm + p.conv_w[wb + 3072] * p0 + p.conv_w[wb + 6144] * pp + p.conv_b[l * 3072 + g * 1024 + c];
      }
      u0[e] = uu[0]; zs[b * 256 + t] = uu[1] * uu[2];
    } }
  __syncthreads();
  const int t0 = 4 * (tid & 63), cbatch = (tid >> 6) & 3, sh = tid >> 8;
  float y[4] = {0.f, 0.f, 0.f, 0.f};
#pragma unroll 4
  for (int s0 = 128 * sh; s0 < 128 * sh + 128; s0 += 4) {
    const int base = 256 + t0 - s0 - 4;
    const f32x4 H0 = *(const LAS f32x4*)(hc + base), H1 = *(const LAS f32x4*)(hc + base + 4), z4 = *(const LAS f32x4*)(zs + cbatch * 256 + s0);
    const float hw[8] = {H0.x, H0.y, H0.z, H0.w, H1.x, H1.y, H1.z, H1.w}, zv[4] = {z4.x, z4.y, z4.z, z4.w};
#pragma unroll
    for (int j = 0; j < 4; ++j)
#pragma unroll
      for (int u = 0; u < 4; ++u) y[j] += hw[4 + j - u] * zv[u];
  }
  if (sh) *(LAS f32x4*)(part + cbatch * 256 + t0) = (f32x4){y[0], y[1], y[2], y[3]};
  __syncthreads();
  if (!sh) { const f32x4 o = *(const LAS f32x4*)(part + cbatch * 256 + t0); part[cbatch * 256 + t0] = y[0] + o.x; part[cbatch * 256 + t0 + 1] = y[1] + o.y; part[cbatch * 256 + t0 + 2] = y[2] + o.z; part[cbatch * 256 + t0 + 3] = y[3] + o.w; }
  __syncthreads();
  { const int b = tid >> 7, tq = tid & 127; const float sk = p.skip[l * 1024 + c];
#pragma unroll
    for (int e = 0; e < 2; ++e) { const int t = tq + 128 * e;
      XT[(size_t)c * NTOK + NLAT + b * 256 + t] = f2bf(u0[e] * (part[b * 256 + t] + sk * zs[b * 256 + t])); } }
  __syncthreads();
}

#ifndef HY_NV
#define HY_NV 2
#endif
#define MFMA32(a, b, c) __builtin_amdgcn_mfma_f32_32x32x16_bf16((a), (b), (c), 0, 0, 0)
DI float logsig(float x) { return fminf(x, 0.f) - __logf(1.f + __expf(-fabsf(x))); }
DI void phase_gla_prep(const Params& p, int l, LAS unsigned char* lds) {
  LAS float* lrs = (LAS float*)lds;
  LAS float* tots = lrs + 64 * 32;
  LAS bf16_t* qs = (LAS bf16_t*)(tots + 2 * 4 * 128);
  LAS bf16_t* kes = qs + 4 * 64 * 136;
  LAS bf16_t* ats = kes + 2 * 128 * 72;
  const int tid = otid(), d = tid & 127, tq = tid >> 7, wid = tid >> 6, lane = tid & 63;
  const bf16_t* PB = (const bf16_t*)(p.ws + OFF_PB);
  const float* LR = (const float*)(p.ws + OFF_LR);
  bf16_t* QF = (bf16_t*)(p.ws + OFF_QF); bf16_t* QB = (bf16_t*)(p.ws + OFF_QB);
  bf16_t* KEF = (bf16_t*)(p.ws + OFF_KEF); bf16_t* KEB = (bf16_t*)(p.ws + OFF_KEB);
  bf16_t* ATT = (bf16_t*)(p.ws + OFF_ATT); float* DEC = (float*)(p.ws + OFF_DEC);
  const float qscale = 0.08838834764831845f;
  f32x4 lrv; bf16_t qv[16], kv[16];
#define PREP_LOAD(it_) do { const int ch_ = (it_) >> 2, hh_ = (it_) & 3; const size_t t0_ = (size_t)ch_ * 64; lrv = *(const f32x4*)(LR + t0_ * 32 + 4 * tid); \
    _Pragma("unroll") for (int i = 0; i < 16; ++i) { const size_t tk_ = t0_ + tq * 16 + i; qv[i] = PB[tk_ * 4096 + hh_ * 128 + d]; kv[i] = PB[tk_ * 4096 + 512 + hh_ * 128 + d]; } } while (0)
  float gwf[16], gwb[16], gbf = 0.f, gbb = 0.f;
#define PREP_LOADG(it_) do { const int hh_ = (it_) & 3; \
    _Pragma("unroll") for (int r = 0; r < 16; ++r) { gwf[r] = p.gate_w[(((size_t)l * 2 + 0) * 16 + r) * 512 + hh_ * 128 + d]; gwb[r] = p.gate_w[(((size_t)l * 2 + 1) * 16 + r) * 512 + hh_ * 128 + d]; } \
    gbf = p.gate_b[((size_t)l * 2 + 0) * 512 + hh_ * 128 + d]; gbb = p.gate_b[((size_t)l * 2 + 1) * 512 + hh_ * 128 + d]; } while (0)
  if ((int)blockIdx.x < 272 * 4) PREP_LOAD((int)blockIdx.x);
  for (int it = blockIdx.x; it < 272 * 4; it += gridDim.x) {
    const int chunk = it >> 2, h = it & 3, tok0 = chunk * 64;
    *(LAS f32x4*)(lrs + 4 * tid) = lrv;
    PREP_LOADG(it);
    __syncthreads();
    float cf[16], cb[16];
#pragma unroll
    for (int i = 0; i < 16; ++i) {
      const int t = tq * 16 + i; float pf = gbf, pb = gbb;
#pragma unroll
      for (int r4 = 0; r4 < 4; ++r4) { const f32x4 lf = *(const LAS f32x4*)(lrs + t * 32 + 4 * r4), lb = *(const LAS f32x4*)(lrs + t * 32 + 16 + 4 * r4);
        pf += lf.x * gwf[4 * r4] + lf.y * gwf[4 * r4 + 1] + lf.z * gwf[4 * r4 + 2] + lf.w * gwf[4 * r4 + 3]; pb += lb.x * gwb[4 * r4] + lb.y * gwb[4 * r4 + 1] + lb.z * gwb[4 * r4 + 2] + lb.w * gwb[4 * r4 + 3]; }
      cf[i] = logsig(pf) * (1.f / 16.f); cb[i] = logsig(pb) * (1.f / 16.f);
    }
    { float run = 0.f;
#pragma unroll
      for (int i = 0; i < 16; ++i) { run += cf[i]; cf[i] = run; }
      tots[(0 * 4 + tq) * 128 + d] = run; run = 0.f;
#pragma unroll
      for (int i = 15; i >= 0; --i) { run += cb[i]; cb[i] = run; }
      tots[(1 * 4 + tq) * 128 + d] = run; }
    __syncthreads();
    float offf = 0.f, offb = 0.f, cendf = 0.f, cendb = 0.f;
#pragma unroll
    for (int q = 0; q < 4; ++q) { const float a = tots[(0 * 4 + q) * 128 + d], b = tots[(1 * 4 + q) * 128 + d]; cendf += a; cendb += b; if (q < tq) offf += a; if (q > tq) offb += b; }
    const int o16 = d & 15, grp = o16 >> 2, ngrp = (grp == 1) ? 2 : (grp == 2) ? 1 : grp, permd = (d & ~15) | (ngrp << 2) | (o16 & 3);
    unsigned kef[8], keb[8];
    const float ecf = __expf(cendf), ecb = __expf(cendb);
#pragma unroll
    for (int i = 0; i < 16; ++i) {
      const int t = tq * 16 + i; const size_t tok = (size_t)tok0 + t;
      const float q = bf2f(qv[i]) * qscale, k = bf2f(kv[i]);
      const float ea = __expf(cf[i] + offf), eb2 = __expf(cb[i] + offb);
      const float kia = k * __builtin_amdgcn_rcpf(ea), kib = k * __builtin_amdgcn_rcpf(eb2);
      const bf16_t qf = f2bf(q * ea), kf = f2bf(kia), qb = f2bf(q * eb2), kb = f2bf(kib);
      const bf16_t ef = f2bf(kia * ecf), eb = f2bf(kib * ecb);
      qs[(0 * 64 + t) * 136 + d] = qf; qs[(1 * 64 + t) * 136 + d] = kf; qs[(2 * 64 + t) * 136 + d] = qb; qs[(3 * 64 + t) * 136 + d] = kb;
      QF[tok * 512 + h * 128 + permd] = qf; QB[tok * 512 + h * 128 + permd] = qb;
      if (i & 1) { kef[i >> 1] |= (unsigned)ef << 16; keb[i >> 1] |= (unsigned)eb << 16; } else { kef[i >> 1] = ef; keb[i >> 1] = eb; }
    }
    if (it + (int)gridDim.x < 272 * 4) PREP_LOAD(it + (int)gridDim.x);
    { LAS u32x4* d1 = (LAS u32x4*)(kes + (0 * 128 + d) * 72 + tq * 16); d1[0] = (u32x4){kef[0], kef[1], kef[2], kef[3]}; d1[1] = (u32x4){kef[4], kef[5], kef[6], kef[7]};
      LAS u32x4* d2 = (LAS u32x4*)(kes + (1 * 128 + d) * 72 + tq * 16); d2[0] = (u32x4){keb[0], keb[1], keb[2], keb[3]}; d2[1] = (u32x4){keb[4], keb[5], keb[6], keb[7]}; }
    if (tq == 0) { DEC[(((size_t)chunk * 4 + h) * 2 + 0) * 128 + d] = ecf; DEC[(((size_t)chunk * 4 + h) * 2 + 1) * 128 + d] = ecb; }
    __syncthreads();
    {
      const int dir = wid >> 2, ti = (wid >> 1) & 1, si = wid & 1, r = lane & 31, hh = lane >> 5;
      const LAS bf16_t* ka = qs + ((dir * 2 + 1) * 64 + 32 * si + r) * 136 + 8 * hh;
      const LAS bf16_t* qa = qs + ((dir * 2 + 0) * 64 + 32 * ti + r) * 136 + 8 * hh;
      f32x16 acc;
#pragma unroll
      for (int i = 0; i < 16; ++i) acc[i] = 0.f;
#pragma unroll
      for (int ks = 0; ks < 8; ++ks) acc = MFMA32(*(const LAS bf16x8*)(ka + 16 * ks), *(const LAS bf16x8*)(qa + 16 * ks), acc);
      const int t = 32 * ti + r;
      LAS bf16_t* dst = ats + (dir * 64 + t) * 72 + 32 * si + 4 * hh;
#pragma unroll
      for (int g = 0; g < 4; ++g) {
        float vv[4];
#pragma unroll
        for (int e = 0; e < 4; ++e) { const int s = 32 * si + 8 * g + 4 * hh + e; const bool keep = dir ? (s >= t) : (s <= t); vv[e] = keep ? acc[4 * g + e] : 0.f; }
        *(LAS u32x2*)(dst + 8 * g) = (u32x2){pk2(vv[0], vv[1]), pk2(vv[2], vv[3])};
      }
    }
    __syncthreads();
    {
      const size_t chh = (size_t)chunk * 4 + h;
#pragma unroll
      for (int q = 0; q < 2; ++q) { const int pc = tid + 512 * q, row = pc >> 3, cc = pc & 7;
        *(u32x4*)(KEF + (chh * 128 + row) * 64 + 8 * cc) = *(const LAS u32x4*)(kes + (0 * 128 + row) * 72 + 8 * cc);
        *(u32x4*)(KEB + (chh * 128 + row) * 64 + 8 * cc) = *(const LAS u32x4*)(kes + (1 * 128 + row) * 72 + 8 * cc);
        const int rr = row & 63, dd = row >> 6;
        *(u32x4*)(ATT + ((chh * 2 + dd) * 64 + rr) * 64 + 8 * cc) = *(const LAS u32x4*)(ats + (dd * 64 + rr) * 72 + 8 * cc); }
    }
    __syncthreads();
  }
}

#undef PREP_LOAD
#undef PREP_LOADG
DI bf16x8 pack8(const f32x16& x, int s) {
  u32x4 r; r[0] = pk2(x[8 * s + 0], x[8 * s + 1]); r[1] = pk2(x[8 * s + 2], x[8 * s + 3]); r[2] = pk2(x[8 * s + 4], x[8 * s + 5]); r[3] = pk2(x[8 * s + 6], x[8 * s + 7]);
  return __builtin_bit_cast(bf16x8, r);
}
DI void phase_gla_scan(const Params& p, LAS unsigned char* lds) {
  constexpr int BUFB = 64 * 136 * 2 + 128 * 72 * 2 + 64 * 72 * 2 + 512;
  const int tid = otid(), wid = tid >> 6, lane = tid & 63, r = lane & 31, hh = lane >> 5;
  const int bid = blockIdx.x, b = bid >> 4, h = (bid >> 2) & 3, dir = (bid >> 1) & 1, dvh = bid & 1;
  const bool cwave = wid < 4;
  const bf16_t* Qg = (const bf16_t*)(p.ws + (dir ? OFF_QB : OFF_QF));
  const bf16_t* Kg = (const bf16_t*)(p.ws + (dir ? OFF_KEB : OFF_KEF));
  const bf16_t* ATT = (const bf16_t*)(p.ws + OFF_ATT); const float* DEC = (const float*)(p.ws + OFF_DEC);
  const bf16_t* VT = (const bf16_t*)(p.ws + OFF_XT) + (size_t)(3072 + h * 256 + 128 * dvh + 32 * (wid & 3) + r) * NTOK + 8 * hh;
  bf16_t* Og = (dir ? (bf16_t*)(p.ws + OFF_X) : (bf16_t*)(p.ws + OFF_PB)) + h * 256 + 128 * dvh;
  const int ldo = dir ? 1024 : 4096;
  const int qrow0 = tid >> 4, qcc = tid & 15, krow0 = tid >> 3, kcc = tid & 7;
  constexpr int OBUF = 64 * 264 * 2;
  LAS unsigned char* obase = lds + 2 * BUFB;
  f32x16 S[4];
#pragma unroll
  for (int m = 0; m < 4; ++m)
#pragma unroll
    for (int i = 0; i < 16; ++i) S[m][i] = 0.f;
  u32x4 pq0, pq1, pk0, pk1, pa; float pdc = 0.f; bf16x8 vf[4], vn[2];
#define SCAN_CIDX(st) ((st) < 4 ? (256 + 4 * b + (dir ? 3 - (st) : (st))) : (64 * b + (dir ? 67 - (st) : (st) - 4)))
#define SCAN_LOAD(st) do { const int ci_ = SCAN_CIDX(st); const size_t tk_ = (size_t)ci_ * 64, ch_ = (size_t)ci_ * 4 + h; \
    pq0 = *(const u32x4*)(Qg + (tk_ + qrow0) * 512 + h * 128 + 8 * qcc); pq1 = *(const u32x4*)(Qg + (tk_ + qrow0 + 32) * 512 + h * 128 + 8 * qcc); \
    pk0 = *(const u32x4*)(Kg + (ch_ * 128 + krow0) * 64 + 8 * kcc); pk1 = *(const u32x4*)(Kg + (ch_ * 128 + krow0 + 64) * 64 + 8 * kcc); \
    pa = *(const u32x4*)(ATT + ((ch_ * 2 + dir) * 64 + krow0) * 64 + 8 * kcc); if (tid < 128) pdc = DEC[(ch_ * 2 + dir) * 128 + tid]; \
 } while (0)
#define SCAN_LOADV(st, vv, k0_, k1_) do { const size_t tkv_ = (size_t)SCAN_CIDX(st) * 64; _Pragma("unroll") for (int ks = (k0_); ks < (k1_); ++ks) vv[ks - (k0_)] = *(const bf16x8*)(VT + tkv_ + 16 * ks); } while (0)
#define SCAN_STORE(bufi) do { LAS unsigned char* bb_ = lds + (bufi) * BUFB; LAS bf16_t* QT_ = (LAS bf16_t*)bb_; LAS bf16_t* KE_ = QT_ + 64 * 136; LAS bf16_t* AT_ = KE_ + 128 * 72; LAS float* DC_ = (LAS float*)(AT_ + 64 * 72); \
    *(LAS u32x4*)(QT_ + qrow0 * 136 + 8 * qcc) = pq0; *(LAS u32x4*)(QT_ + (qrow0 + 32) * 136 + 8 * qcc) = pq1; \
    *(LAS u32x4*)(KE_ + krow0 * 72 + 8 * kcc) = pk0; *(LAS u32x4*)(KE_ + (krow0 + 64) * 72 + 8 * kcc) = pk1; \
    *(LAS u32x4*)(AT_ + krow0 * 72 + 8 * kcc) = pa; if (tid < 128) DC_[tid] = pdc; } while (0)
#define SCAN_WRITEOUT(st) do { const size_t tk_ = (size_t)SCAN_CIDX(st) * 64; const LAS bf16_t* ob_ = (const LAS bf16_t*)(obase + ((st) & 1) * OBUF); \
    _Pragma("unroll 1") for (int q = 0; q < 2; ++q) { const int pc_ = tid + 512 * q, row_ = pc_ >> 4, cc_ = pc_ & 15; \
      *(u32x4*)(Og + (tk_ + row_) * ldo + 8 * cc_) = *(const LAS u32x4*)(ob_ + row_ * 264 + 8 * cc_); } } while (0)
  SCAN_LOAD(0); SCAN_STORE(0); SCAN_LOADV(0, vf, 0, 4); SCAN_LOAD(1);
  __syncthreads();
#pragma unroll 1
  for (int step = 0; step < 68; ++step) {
    const size_t tok0 = (size_t)SCAN_CIDX(step) * 64;
    if (step > 0) SCAN_WRITEOUT(step - 1);
    if (cwave && step + 1 < 68) SCAN_LOADV(step + 1, vn, 0, 2);
    LAS unsigned char* bb = lds + (step & 1) * BUFB;
    const LAS bf16_t* QT = (const LAS bf16_t*)bb; const LAS bf16_t* KE = QT + 64 * 136; const LAS bf16_t* AT = KE + 128 * 72; const LAS float* DC = (const LAS float*)(AT + 64 * 72);
    if (cwave) {
    f32x16 o0, o1;
#pragma unroll
    for (int i = 0; i < 16; ++i) { o0[i] = 0.f; o1[i] = 0.f; }
#pragma unroll
    for (int ks = 0; ks < 4; ++ks) {
      o0 = MFMA32(vf[ks], *(const LAS bf16x8*)(AT + r * 72 + 16 * ks + 8 * hh), o0);
      o1 = MFMA32(vf[ks], *(const LAS bf16x8*)(AT + (32 + r) * 72 + 16 * ks + 8 * hh), o1);
    }
#pragma unroll
    for (int k8 = 0; k8 < 8; ++k8) {
      const bf16x8 spk = pack8(S[k8 >> 1], k8 & 1);
      o0 = MFMA32(spk, *(const LAS bf16x8*)(QT + r * 136 + 16 * k8 + 8 * hh), o0);
      o1 = MFMA32(spk, *(const LAS bf16x8*)(QT + (32 + r) * 136 + 16 * k8 + 8 * hh), o1);
    }
#pragma unroll
    for (int m = 0; m < 4; ++m) {
#pragma unroll
      for (int g = 0; g < 4; ++g) { const f32x4 dv = *(const LAS f32x4*)(DC + 32 * m + 8 * g + 4 * hh);
        S[m][4 * g] *= dv.x; S[m][4 * g + 1] *= dv.y; S[m][4 * g + 2] *= dv.z; S[m][4 * g + 3] *= dv.w; }
#pragma unroll
      for (int ks = 0; ks < 4; ++ks) S[m] = MFMA32(*(const LAS bf16x8*)(KE + (32 * m + r) * 72 + 16 * ks + 8 * hh), vf[ks], S[m]);
    }
    { LAS bf16_t* ob = (LAS bf16_t*)(obase + (step & 1) * OBUF) + r * 264 + 32 * wid + 4 * hh;
#pragma unroll
      for (int g = 0; g < 4; ++g) {
        *(LAS u32x2*)(ob + 8 * g) = (u32x2){pk2(o0[4 * g], o0[4 * g + 1]), pk2(o0[4 * g + 2], o0[4 * g + 3])};
        *(LAS u32x2*)(ob + 32 * 264 + 8 * g) = (u32x2){pk2(o1[4 * g], o1[4 * g + 1]), pk2(o1[4 * g + 2], o1[4 * g + 3])};
      } }
    }
    if (step + 1 < 68) { if (cwave) { vf[0] = vn[0]; vf[1] = vn[1]; const size_t tkv2 = (size_t)SCAN_CIDX(step + 1) * 64; vf[2] = *(const bf16x8*)(VT + tkv2 + 32); vf[3] = *(const bf16x8*)(VT + tkv2 + 48); }
      SCAN_STORE((step + 1) & 1); }
    if (step + 2 < 68) SCAN_LOAD(step + 2);
    __syncthreads();
  }
  SCAN_WRITEOUT(67);
  __syncthreads();
#undef SCAN_WRITEOUT
#undef SCAN_CIDX
#undef SCAN_LOAD
#undef SCAN_LOADV
#undef SCAN_STORE
}

DI void phase_post(const Params& p, int l, int ntok, LAS unsigned char* lds) {
  const int tid = otid(), lane = tid & 63;
  { const int gw = blockIdx.x * 8 + (tid >> 6), nw = gridDim.x * 8, l32 = lane & 31, hsel = lane >> 5;
    const bf16_t* PB = (const bf16_t*)(p.ws + OFF_PB); bf16_t* HB = (bf16_t*)(p.ws + OFF_X);
    const f32x4 ng0 = *(const f32x4*)(p.gla_ng + l * 256 + 8 * l32), ng1 = *(const f32x4*)(p.gla_ng + l * 256 + 8 * l32 + 4);
    u32x4 na, nb, nr;
    if (gw < ntok * 2) { const size_t tk = gw >> 1; const int cl = ((gw & 1) * 2 + hsel) * 256 + 8 * l32; na = __builtin_nontemporal_load((const u32x4*)(PB + tk * 4096 + cl)); nb = __builtin_nontemporal_load((const u32x4*)(HB + tk * 1024 + cl)); nr = __builtin_nontemporal_load((const u32x4*)(PB + tk * 4096 + 1024 + cl)); }
    for (int it = gw; it < ntok * 2; it += nw) {
      const size_t tok = it >> 1; const int col = ((it & 1) * 2 + hsel) * 256 + 8 * l32;
      const u32x4 a = na, b = nb, rr = nr;
      if (it + nw < ntok * 2) { const int i2 = it + nw; const size_t tk = i2 >> 1; const int cl = ((i2 & 1) * 2 + hsel) * 256 + 8 * l32; na = __builtin_nontemporal_load((const u32x4*)(PB + tk * 4096 + cl)); nb = __builtin_nontemporal_load((const u32x4*)(HB + tk * 1024 + cl)); nr = __builtin_nontemporal_load((const u32x4*)(PB + tk * 4096 + 1024 + cl)); }
      float o[8], rv[8];
#pragma unroll
      for (int i = 0; i < 4; ++i) { o[2 * i] = bflo(a[i]) + bflo(b[i]); o[2 * i + 1] = bfhi(a[i]) + bfhi(b[i]); rv[2 * i] = bflo(rr[i]); rv[2 * i + 1] = bfhi(rr[i]); }
      float ss = 0.f;
#pragma unroll
      for (int i = 0; i < 8; ++i) ss += o[i] * o[i];
#pragma unroll
      for (int q = 16; q >= 1; q >>= 1) ss += __shfl_xor(ss, q);
      const float rstd = rsqrtf(ss * (1.f / 256.f) + EPSF);
      const float ngv[8] = {ng0.x, ng0.y, ng0.z, ng0.w, ng1.x, ng1.y, ng1.z, ng1.w};
      float y[8];
#pragma unroll
      for (int i = 0; i < 8; ++i) y[i] = o[i] * rstd * ngv[i] * (rv[i] * sigm(rv[i]));
      *(u32x4*)(HB + tok * 1024 + col) = (u32x4){pk2(y[0], y[1]), pk2(y[2], y[3]), pk2(y[4], y[5]), pk2(y[6], y[7])};
    } }
  { LAS bf16_t* t = (LAS bf16_t*)lds;
    const bf16_t* XT = (const bf16_t*)(p.ws + OFF_XT); bf16_t* YH = (bf16_t*)(p.ws + OFF_QF);
    const int ntt = ntok / 128;
    u32x4 pre[2];
#define POST_TLOAD(it_) do { const int c0_ = ((it_) / ntt) * 64, tk0_ = ((it_) % ntt) * 128; \
      _Pragma("unroll") for (int q = 0; q < 2; ++q) { const int pc = tid + 512 * q, cc = pc >> 4, tq = pc & 15; pre[q] = *(const u32x4*)(XT + (size_t)(c0_ + cc) * NTOK + tk0_ + 8 * tq); } } while (0)
    if ((int)blockIdx.x < 16 * ntt) POST_TLOAD((int)blockIdx.x);
    for (int it = blockIdx.x; it < 16 * ntt; it += gridDim.x) {
      const int c0 = (it / ntt) * 64, tok0 = (it % ntt) * 128;
#pragma unroll
      for (int q = 0; q < 2; ++q) { const int pc = tid + 512 * q, cc = pc >> 4, tq = pc & 15; *(LAS u32x4*)(t + cc * 136 + 8 * tq) = pre[q]; }
      if (it + (int)gridDim.x < 16 * ntt) POST_TLOAD(it + (int)gridDim.x);
      __syncthreads();
#pragma unroll
      for (int q = 0; q < 2; ++q) { const int pc = tid + 512 * q, tk = pc >> 3, cq = pc & 7; unsigned w[4];
#pragma unroll
        for (int i = 0; i < 4; ++i) w[i] = (unsigned)t[(8 * cq + 2 * i) * 136 + tk] | ((unsigned)t[(8 * cq + 2 * i + 1) * 136 + tk] << 16);
        *(u32x4*)(YH + (size_t)(tok0 + tk) * 1024 + c0 + 8 * cq) = (u32x4){w[0], w[1], w[2], w[3]}; }
      __syncthreads();
    } }
}

#undef POST_TLOAD
struct SchedG1 : pg8::StaticOrder {
  __device__ bool next(int i, pg8::Unit& u) const {
    pg8::Unit v; if (!pg8::StaticOrder::next(i, v)) return false;
    if (v.pn < 16) { u.pm = 68 + v.pn; u.pn = v.pm; } else { u.pm = v.pm; u.pn = 68 + v.pn; }
    return true;
  }
};
typedef const f32x4 (&AccRef)[2][2][4][2];
DI u32x4 pack_acc8(f32x4 v0, f32x4 v1) { return (u32x4){pk2(v0[0], v0[1]), pk2(v0[2], v0[3]), pk2(v1[0], v1[1]), pk2(v1[2], v1[3])}; }
struct EpiG1 {
  static constexpr bool PERM = true, AFTER_DRAIN = false;
  bf16_t* XT; bf16_t* PB; float* LR;
  DI void operator()(AccRef acc, const pg8::Unit& u, int wr, int wc, int fr, int fq) const {
    if (u.pm >= 68) {
      const int ch0 = (u.pm - 68) * 256 + wr * 64 + fr, tk0 = u.pn * 256 + wc * 32 + 8 * fq;
#pragma unroll
      for (int ai = 0; ai < 2; ++ai)
#pragma unroll
        for (int m = 0; m < 4; ++m) { bf16_t* rp = XT + (size_t)(ch0 + ai * 128 + m * 16) * NTOK + tk0;
#pragma unroll
          for (int bj = 0; bj < 2; ++bj) *(u32x4*)(rp + bj * 128) = pack_acc8(acc[ai][bj][m][0], acc[ai][bj][m][1]); }
    } else {
      const int wp = u.pn - 84, row0 = u.pm * 256 + wr * 64 + fr, col0 = wp * 256 + wc * 32 + 8 * fq;
      if (wp < 16) {
#pragma unroll
        for (int ai = 0; ai < 2; ++ai)
#pragma unroll
          for (int m = 0; m < 4; ++m) { bf16_t* rp = PB + (size_t)(row0 + ai * 128 + m * 16) * 4096 + col0;
#pragma unroll
            for (int bj = 0; bj < 2; ++bj) *(u32x4*)(rp + bj * 128) = pack_acc8(acc[ai][bj][m][0], acc[ai][bj][m][1]); }
      } else if (wc == 0) {
#pragma unroll
        for (int ai = 0; ai < 2; ++ai)
#pragma unroll
          for (int m = 0; m < 4; ++m) { float* rp = LR + (size_t)(row0 + ai * 128 + m * 16) * 32 + 8 * fq; *(f32x4*)rp = acc[ai][0][m][0]; *(f32x4*)(rp + 4) = acc[ai][0][m][1]; }
      }
    }
  }
};
template <int MODE> struct EpiGate {
  static constexpr bool PERM = true, AFTER_DRAIN = false;
  const bf16_t* PB; bf16_t* T1; bf16_t* MG;
  DI void operator()(AccRef acc, const pg8::Unit& u, int wr, int wc, int fr, int fq) const {
    const int row0 = u.pm * 256 + wr * 64 + fr, col0 = u.pn * 256 + wc * 32 + 8 * fq;
#pragma unroll
    for (int ai = 0; ai < 2; ++ai)
#pragma unroll
      for (int m = 0; m < 4; ++m) { const size_t row = (size_t)(row0 + ai * 128 + m * 16);
#pragma unroll
        for (int bj = 0; bj < 2; ++bj) { const int col = col0 + bj * 128;
          const u32x4 g = *(const u32x4*)(PB + row * 4096 + (MODE ? 3072 : 2048) + col);
          const f32x4 v0 = acc[ai][bj][m][0], v1 = acc[ai][bj][m][1];
          float o[8] = {v0[0] * sigm(bflo(g[0])), v0[1] * sigm(bfhi(g[0])), v0[2] * sigm(bflo(g[1])), v0[3] * sigm(bfhi(g[1])),
                        v1[0] * sigm(bflo(g[2])), v1[1] * sigm(bfhi(g[2])), v1[2] * sigm(bflo(g[3])), v1[3] * sigm(bfhi(g[3]))};
          if (MODE) { const u32x4 t = *(const u32x4*)(T1 + row * 1024 + col);
            o[0] += bflo(t[0]); o[1] += bfhi(t[0]); o[2] += bflo(t[1]); o[3] += bfhi(t[1]); o[4] += bflo(t[2]); o[5] += bfhi(t[2]); o[6] += bflo(t[3]); o[7] += bfhi(t[3]); }
          *(u32x4*)((MODE ? MG : T1) + row * 1024 + col) = (u32x4){pk2(o[0], o[1]), pk2(o[2], o[3]), pk2(o[4], o[5]), pk2(o[6], o[7])}; } }
  }
};
struct EpiRes {
  static constexpr bool PERM = false, AFTER_DRAIN = false;
  float* out; float* ctxs; const float* modl; int goff; const float* src_lat; const float* src_ctx;
  DI void operator()(AccRef acc, const pg8::Unit& u, int wr, int wc, int fr, int fq) const {
    const int row0 = u.pm * 256 + wr * 64 + fr, col0 = u.pn * 256 + wc * 32 + 4 * fq;
    const float* gv = modl + (size_t)(u.pm < 64 ? (u.pm >> 4) : 4) * 6144 + goff + col0;
    f32x4 gg[2][2];
#pragma unroll
    for (int bj = 0; bj < 2; ++bj)
#pragma unroll
      for (int n = 0; n < 2; ++n) gg[bj][n] = *(const f32x4*)(gv + bj * 128 + n * 16);
#pragma unroll
    for (int ai = 0; ai < 2; ++ai)
#pragma unroll
      for (int m = 0; m < 4; ++m) { const int row = row0 + ai * 128 + m * 16;
        float* rp = (row < NLAT ? out + (size_t)row * 1024 : ctxs + (size_t)(row - NLAT) * 1024) + col0;
        const float* sp = (row < NLAT ? src_lat + (size_t)row * 1024 : src_ctx + (size_t)(row - NLAT) * 1024) + col0;
#pragma unroll
        for (int bj = 0; bj < 2; ++bj)
#pragma unroll
          for (int n = 0; n < 2; ++n) { f32x4* q = (f32x4*)(rp + bj * 128 + n * 16); *q = *(const f32x4*)(sp + bj * 128 + n * 16) + gg[bj][n] * acc[ai][bj][m][n]; } }
  }
};
struct EpiRelu2 {
  static constexpr bool PERM = true, AFTER_DRAIN = false;
  bf16_t* O;
  DI void operator()(AccRef acc, const pg8::Unit& u, int wr, int wc, int fr, int fq) const {
    const int row0 = u.pm * 256 + wr * 64 + fr, col0 = u.pn * 256 + wc * 32 + 8 * fq;
#pragma unroll
    for (int ai = 0; ai < 2; ++ai)
#pragma unroll
      for (int m = 0; m < 4; ++m) { bf16_t* rp = O + (size_t)(row0 + ai * 128 + m * 16) * 4096 + col0;
#pragma unroll
        for (int bj = 0; bj < 2; ++bj) { f32x4 v0 = acc[ai][bj][m][0], v1 = acc[ai][bj][m][1];
#pragma unroll
          for (int e = 0; e < 4; ++e) { const float a = fmaxf(v0[e], 0.f), b = fmaxf(v1[e], 0.f); v0[e] = a * a; v1[e] = b * b; }
          *(u32x4*)(rp + bj * 128) = pack_acc8(v0, v1); } }
  }
};

#define MFMA16(a, b, c) __builtin_amdgcn_mfma_f32_16x16x32_bf16((a), (b), (c), 0, 0, 0)
template <class F> DI void ctx_gemm(const bf16_t* A, const bf16_t* Bt, int K, int N, LAS unsigned char* lds, const F& epi) {
  constexpr int LDT = 136, TILEB = 64 * LDT * 2;
  const int tid = otid(), wid = tid >> 6, lane = tid & 63, fr = lane & 15, fq = lane >> 4, wm = wid >> 1, wn = wid & 1;
  const int ntn = N / 64, ntiles = 16 * ntn, nk = K / 128;
  const int lrow = tid >> 4, lcc = tid & 15;
  for (int t0 = blockIdx.x; t0 < ntiles; t0 += gridDim.x) {
    int tile = t0;
    if (ntiles == 256 && gridDim.x == 256) { const int x = t0 & 7, idx = t0 >> 3; tile = (4 * (x >> 1) + (idx >> 3)) * 16 + 8 * (x & 1) + (idx & 7); }
    const int tm = tile / ntn, tn = tile % ntn;
    const bf16_t* Ab = A + (size_t)(tm * 64 + lrow) * K + 8 * lcc; const bf16_t* Bb = Bt + (size_t)(tn * 64 + lrow) * K + 8 * lcc;
    const size_t r32 = (size_t)32 * K;
    u32x4 ra0, ra1, rb0, rb1, sa0, sa1, sb0, sb1;
#define CG_LOAD(x0, x1, y0, y1, kt_) do { const int ko_ = (kt_) * 128; x0 = *(const u32x4*)(Ab + ko_); x1 = *(const u32x4*)(Ab + r32 + ko_); y0 = *(const u32x4*)(Bb + ko_); y1 = *(const u32x4*)(Bb + r32 + ko_); } while (0)
#define CG_STORE(x0, x1, y0, y1, bufi) do { LAS bf16_t* dA_ = (LAS bf16_t*)(lds + (bufi) * 2 * TILEB); LAS bf16_t* dB_ = (LAS bf16_t*)(lds + (bufi) * 2 * TILEB + TILEB); \
    *(LAS u32x4*)(dA_ + lrow * LDT + 8 * lcc) = x0; *(LAS u32x4*)(dA_ + (lrow + 32) * LDT + 8 * lcc) = x1; *(LAS u32x4*)(dB_ + lrow * LDT + 8 * lcc) = y0; *(LAS u32x4*)(dB_ + (lrow + 32) * LDT + 8 * lcc) = y1; } while (0)
#define CG_COMPUTE(bufi) do { const LAS bf16_t* sA_ = (const LAS bf16_t*)(lds + (bufi) * 2 * TILEB); const LAS bf16_t* sB_ = (const LAS bf16_t*)(lds + (bufi) * 2 * TILEB + TILEB); \
    _Pragma("unroll") for (int ks = 0; ks < 4; ++ks) { const bf16x8 af = *(const LAS bf16x8*)(sA_ + (16 * wm + fr) * LDT + 32 * ks + 8 * fq); \
      const bf16x8 b0 = *(const LAS bf16x8*)(sB_ + (32 * wn + fr) * LDT + 32 * ks + 8 * fq), b1 = *(const LAS bf16x8*)(sB_ + (32 * wn + 16 + fr) * LDT + 32 * ks + 8 * fq); \
      acc0 = MFMA16(b0, af, acc0); acc1 = MFMA16(b1, af, acc1); } } while (0)
    CG_LOAD(ra0, ra1, rb0, rb1, 0); CG_LOAD(sa0, sa1, sb0, sb1, 1);
    CG_STORE(ra0, ra1, rb0, rb1, 0);
    __syncthreads();
    f32x4 acc0 = {0.f, 0.f, 0.f, 0.f}, acc1 = {0.f, 0.f, 0.f, 0.f};
#pragma unroll 1
    for (int kt = 0; kt < nk; kt += 2) {
      if (kt + 2 < nk) CG_LOAD(ra0, ra1, rb0, rb1, kt + 2);
      CG_COMPUTE(0);
      CG_STORE(sa0, sa1, sb0, sb1, 1);
      __syncthreads();
      if (kt + 3 < nk) CG_LOAD(sa0, sa1, sb0, sb1, kt + 3);
      CG_COMPUTE(1);
      if (kt + 2 < nk) CG_STORE(ra0, ra1, rb0, rb1, 0);
      __syncthreads();
    }
#undef CG_LOAD
#undef CG_STORE
#undef CG_COMPUTE
    const int row = tm * 64 + 16 * wm + fr, col = tn * 64 + 32 * wn + 4 * fq;
    epi(row, col, acc0); epi(row, col + 16, acc1);
  }
}

__global__ void __launch_bounds__(512, 2) fwd_megakernel(Params p) {
  extern __shared__ __attribute__((aligned(16))) unsigned char shm[];
  LAS unsigned char* lds = (LAS unsigned char*)shm;
  cg::grid_group grid = cg::this_grid();
  unsigned char* ws = p.ws;
  const int G = gridDim.x, cblk = blockIdx.x;
  unsigned* cnt = (unsigned*)(ws + OFF_CNT);
  __shared__ unsigned xbw[4];
#define s_item (*(volatile int*)&xbw[2])
  if (threadIdx.x == 0) { xbw[0] = 0u; xbw[1] = 0u; xbw[2] = 0u; xbw[3] = 0u; }
  __syncthreads();
#ifndef TPROBE
#define TPROBE 0
#endif
  unsigned long long tacc = 0ull, tt0 = 0ull;
#define TB(g) do { if (TPROBE == (g) && blockIdx.x == 0) tt0 = __builtin_amdgcn_s_memrealtime(); } while (0)
#define TE(g) do { if (TPROBE == (g) && blockIdx.x == 0) tacc += __builtin_amdgcn_s_memrealtime() - tt0; } while (0)

  TB(5); phase_copy(p); phase_mod(p, lds); phase_a2(p, lds);
  phase_wconv(p, 0, lds, 0, cblk, G); phase_wconv(p, 0, lds, 1, cblk, G);
  grid.sync(); TE(5);
  const XcdBarrier xb = xcd_barrier_post((unsigned*)(ws + OFF_BAR), (volatile LAS unsigned*)xbw);
  for (int l = 0; l < 4; ++l) {
    const bool last = (l == 3);
    const int MR = last ? NLAT : NTOK;
    TB(3); TB(14); if (l > 0) phase_wconv(p, l, lds, 1, cblk, G);
    phase_norm(p, l, p.norm1_g + l * 1024, 0, 1024, NTOK, l == 0);
    if (l == 0) phase_filt_gemm(p, l, lds, cblk, G);
    xcd_barrier(xb); TE(14); TE(3);
    TB(1); TB(6);
    { pg8::Gemm g{(const bf16_t*)(ws + OFF_X), (const bf16_t*)(ws + OFF_X), NTOK, 8448, 1024};
      SchedG1 S; S.init(NTOK, 8448, G, cblk);
      EpiG1 E{(bf16_t*)(ws + OFF_XT), (bf16_t*)(ws + OFF_PB), (float*)(ws + OFF_LR)};
      pg8::gemm_phase<EpiG1, SchedG1, false>(lds, g, S, E, nullptr); }
    xcd_barrier(xb); TE(1); TE(6);
    TB(4); TB(11); phase_gla_prep(p, l, lds);
    if (!last && cblk >= 64) phase_filt_gemm(p, l + 1, lds, cblk - 64, G - 64);
    xcd_barrier(xb); TE(4); TE(11);
    TB(2); TB(7); if (cblk < 64) phase_gla_scan(p, lds); TE(7);
    { LAS cplx* L = (LAS cplx*)lds;
      if (otid() == 0) s_item = (int)atomicAdd(cnt + 2 * l, 1u);
      for (;;) {
        __syncthreads();
        const int it = s_item;
        __syncthreads();
        if (it >= 1024) break;
        if (otid() == 0) s_item = (int)atomicAdd(cnt + 2 * l, 1u);
        hyena_chan<HY_NV>(p, l, __builtin_amdgcn_readfirstlane(it), L, otid());
      }
      if (!last) for (;;) {
        if (otid() == 0) s_item = (int)atomicAdd(cnt + 2 * l + 1, 1u);
        __syncthreads();
        const int it = s_item;
        __syncthreads();
        if (it >= 1024) break;
        hyena_ctx_item(p, l, it, lds);
      } }
    xcd_barrier(xb);
    TE(2);
    TB(4); TB(12); phase_post(p, l, MR, lds);
    xcd_barrier(xb); TE(4); TE(12);
    TB(1); TB(8);
    { pg8::StaticOrder S; S.init(NLAT, 1024, G, cblk);
      const bf16_t* PBc = (const bf16_t*)(ws + OFF_PB); bf16_t* T1 = (bf16_t*)(ws + OFF_KEF); bf16_t* MGp = (bf16_t*)(ws + OFF_XT + (size_t)3072 * NTOK * 2);
      EpiGate<0> E0{PBc, T1, nullptr};
      pg8::Gemm g0{(const bf16_t*)(ws + OFF_QF), (const bf16_t*)(ws + OFF_WBHY), NLAT, 1024, 1024};
      pg8::gemm_phase<EpiGate<0>, pg8::StaticOrder, false>(lds, g0, S, E0, nullptr);
      EpiGate<1> E1{PBc, T1, MGp};
      pg8::Gemm g1{(const bf16_t*)(ws + OFF_X), (const bf16_t*)(ws + OFF_WBGLA), NLAT, 1024, 1024};
      pg8::gemm_phase<EpiGate<1>, pg8::StaticOrder, false>(lds, g1, S, E1, nullptr);
      if (!last) {
        ctx_gemm((const bf16_t*)(ws + OFF_QF) + (size_t)NLAT * 1024, (const bf16_t*)(ws + OFF_WBHY), 1024, 1024, lds, [&](int r, int c, f32x4 v) {
          const size_t row = (size_t)NLAT + r; const u32x2 gt = *(const u32x2*)(PBc + row * 4096 + 2048 + c);
          *(u32x2*)(T1 + row * 1024 + c) = (u32x2){pk2(v[0] * sigm(bflo(gt[0])), v[1] * sigm(bfhi(gt[0]))), pk2(v[2] * sigm(bflo(gt[1])), v[3] * sigm(bfhi(gt[1])))}; });
        ctx_gemm((const bf16_t*)(ws + OFF_X) + (size_t)NLAT * 1024, (const bf16_t*)(ws + OFF_WBGLA), 1024, 1024, lds, [&](int r, int c, f32x4 v) {
          const size_t row = (size_t)NLAT + r; const u32x2 gt = *(const u32x2*)(PBc + row * 4096 + 3072 + c); const u32x2 t1 = *(const u32x2*)(T1 + row * 1024 + c);
          *(u32x2*)(MGp + row * 1024 + c) = (u32x2){pk2(bflo(t1[0]) + v[0] * sigm(bflo(gt[0])), bfhi(t1[0]) + v[1] * sigm(bfhi(gt[0]))), pk2(bflo(t1[1]) + v[2] * sigm(bflo(gt[1])), bfhi(t1[1]) + v[3] * sigm(bfhi(gt[1])))}; });
      } }
    xcd_barrier(xb); TE(8);
    { pg8::StaticOrder S; S.init(NLAT, 1024, G, cblk);
      EpiRes E{p.out, (float*)(ws + OFF_CTXS), modp(p, l, 0), 2048, l == 0 ? p.x : p.out, l == 0 ? p.ctx : (const float*)(ws + OFF_CTXS)};
      pg8::Gemm g{(const bf16_t*)(ws + OFF_XT + (size_t)3072 * NTOK * 2), (const bf16_t*)(ws + OFF_WOUT), NLAT, 1024, 1024};
      pg8::gemm_phase<EpiRes, pg8::StaticOrder, false>(lds, g, S, E, nullptr);
      if (!last) { float* cs = (float*)(ws + OFF_CTXS); const float* gv = modp(p, l, 4) + 2048; const float* csrc = l == 0 ? p.ctx : (const float*)cs;
        ctx_gemm((const bf16_t*)(ws + OFF_XT + (size_t)3072 * NTOK * 2) + (size_t)NLAT * 1024, (const bf16_t*)(ws + OFF_WOUT), 1024, 1024, lds, [&](int r, int c, f32x4 v) {
          *(f32x4*)(cs + (size_t)r * 1024 + c) = *(const f32x4*)(csrc + (size_t)r * 1024 + c) + *(const f32x4*)(gv + c) * v; }); } }
    xcd_barrier(xb); TE(1);
    TB(4); TB(13); phase_norm(p, l, p.norm2_g + l * 1024, 3072, 4096, MR, false);
    xcd_barrier(xb); TE(4); TE(13);
    if (TPROBE == 20) { for (int q = 0; q < 8; ++q) xcd_barrier(xb); }
    TB(1); TB(9);
    { pg8::StaticOrder S; S.init(MR, 4096, G, cblk);
      EpiRelu2 E{(bf16_t*)(ws + OFF_PB)};
      pg8::Gemm g{(const bf16_t*)(ws + OFF_X), (const bf16_t*)(ws + OFF_W1), MR, 4096, 1024};
      pg8::gemm_phase<EpiRelu2, pg8::StaticOrder, false>(lds, g, S, E, nullptr);
      if (!last && cblk >= 64) phase_wconv(p, l + 1, lds, 0, cblk - 64, G - 64); }
    xcd_barrier(xb); TE(9); TB(10);
    { pg8::StaticOrder S; S.init(NLAT, 1024, G, cblk);
      EpiRes E{p.out, (float*)(ws + OFF_CTXS), modp(p, l, 0), 5120, p.out, (const float*)(ws + OFF_CTXS)};
      pg8::Gemm g{(const bf16_t*)(ws + OFF_PB), (const bf16_t*)(ws + OFF_W2), NLAT, 1024, 4096};
      pg8::gemm_phase<EpiRes, pg8::StaticOrder, false>(lds, g, S, E, nullptr);
      if (!last) { float* cs = (float*)(ws + OFF_CTXS); const float* gv = modp(p, l, 4) + 5120;
        ctx_gemm((const bf16_t*)(ws + OFF_PB) + (size_t)NLAT * 4096, (const bf16_t*)(ws + OFF_W2), 4096, 1024, lds, [&](int r, int c, f32x4 v) {
          f32x4* q = (f32x4*)(cs + (size_t)r * 1024 + c); *q = *q + *(const f32x4*)(gv + c) * v; }); } }
    xcd_barrier(xb); TE(1); TE(10);
  }
  phase_final_norm(p);
  if (TPROBE && TPROBE != 20 && blockIdx.x == 0) { const unsigned long long s0 = __builtin_amdgcn_s_memrealtime(); while (__builtin_amdgcn_s_memrealtime() - s0 < tacc) __builtin_amdgcn_s_sleep(8); }
}

#ifndef HY_NV
#define HY_NV 2
#endif
constexpr size_t DYN_LDS = 2 * FFT_REGION_F2 * 8 + 11 * 512 * 4;

extern "C" void kernel_launch(void* const* d_in, const int* in_sizes, int n_in, void* d_out, int out_size, void* d_ws, size_t ws_size, hipStream_t stream) {
  if (ws_size < WS_TOTAL || n_in < 28) return;
  static int grid_blocks = 0;
  if (!grid_blocks) {
    int dev = 0, cus = 0, per_cu = 0;
    hipGetDevice(&dev);
    hipDeviceGetAttribute(&cus, hipDeviceAttributeMultiprocessorCount, dev);
    hipFuncSetAttribute((const void*)fwd_megakernel, hipFuncAttributeMaxDynamicSharedMemorySize, (int)DYN_LDS);
    hipOccupancyMaxActiveBlocksPerMultiprocessor(&per_cu, fwd_megakernel, 512, DYN_LDS);
    if (per_cu < 1) per_cu = 1;
    grid_blocks = cus * 1;
  }
  Params p{};
  const float** pp = (const float**)&p;
  for (int i = 0; i < 28; ++i) pp[i] = (const float*)d_in[i];
  p.out = (float*)d_out; p.ws = (unsigned char*)d_ws;
  void* args[] = {&p};
  hipLaunchCooperativeKernel((const void*)fwd_megakernel, dim3(grid_blocks), dim3(512), args, DYN_LDS, stream);
}
```

```cpp
#include <hip/hip_runtime.h>
#include <hip/hip_cooperative_groups.h>
namespace cg = cooperative_groups;
#define DI __device__ __forceinline__

__device__ __forceinline__ int otid() { int t = threadIdx.x; asm volatile("" : "+v"(t)); return t; }
namespace pg8 {
#define PG8_LAS __attribute__((address_space(3)))
typedef unsigned short bf16_t;
typedef short bf16x8 __attribute__((ext_vector_type(8)));
typedef float f32x4 __attribute__((ext_vector_type(4)));
typedef unsigned u32x4 __attribute__((ext_vector_type(4)));
constexpr int BM = 256, BK = 64, HALF = 128, HTB = HALF * BK * 2  , STAGE_BYTES = 8 * HTB, NXCD = 8, WGM = 8;

__host__ __device__ __forceinline__ int lds_byte(int r, int c) { const int st = (r >> 4) * 2 + (c >> 5), rr = r & 15, cc = c & 31, ob = rr * 64 + cc * 2; return st * 1024 + (ob ^ (((ob >> 9) & 1) << 5)); }
__host__ __device__ __forceinline__ void stage_rc(int b, int& R, int& C) { const int st = b / 1024, sb = b % 1024, swz = sb ^ (((sb >> 9) & 1) << 5); R = (st >> 1) * 16 + swz / 64; C = (st & 1) * 32 + (swz % 64) / 2; }
__host__ __device__ __forceinline__ int perm32(int rho) { const int n = rho >> 4, i = rho & 15; return 8 * (i >> 2) + 4 * n + (i & 3); }

struct Unit { int pm, pn; };
struct Gemm { const bf16_t* A; const bf16_t* Bt; int M, N, K; };
struct StaticOrder {
    int nM, nN, nwg, G, c;
    __host__ __device__ void init(int M, int N, int G_, int c_) { nM = M / BM; nN = N / BM; nwg = nM * nN; G = G_; c = c_; }
    __host__ __device__ bool next(int i, Unit& u) const {
        const long L = (long)i * G + c; if (L >= nwg) return false;
        int wgid = (int)L; { const int q = nwg / NXCD, r = nwg % NXCD, xcd = wgid % NXCD, off = wgid / NXCD; wgid = (xcd < r ? xcd * (q + 1) : r * (q + 1) + (xcd - r) * q) + off; }
        const int nig = WGM * nN, gid = wgid / nig, fm = gid * WGM, gsz = (nM - fm) < WGM ? (nM - fm) : WGM;
        u.pm = fm + ((wgid % nig) % gsz); u.pn = (wgid % nig) / gsz; return true;
    }
    __device__ __forceinline__ void a_ready(const Unit&) const {}
    __device__ __forceinline__ void done(const Unit&) const {}
};
__device__ __forceinline__ unsigned cvt_pk_bf16(float lo, float hi) { unsigned r; asm volatile("v_cvt_pk_bf16_f32 %0, %1, %2" : "=v"(r) : "v"(lo), "v"(hi)); return r; }
template <class Epi, class Sched, bool STAMP = false>
__device__ __forceinline__ void gemm_phase(PG8_LAS unsigned char* lds, const Gemm g, const Sched& S, const Epi& E, unsigned long long* stamps) {
    const int tid = otid(), wid = __builtin_amdgcn_readfirstlane(tid >> 6), lane = tid & 63, wr = wid >> 2, wc = wid & 3, fr = lane & 15, fq = lane >> 4;
    const int K = g.K, nt = K / BK;
    int ts_lo = 0, ts_hi = 0, nts = 0; const unsigned long long rt_entry = STAMP ? (unsigned long long)wall_clock64() : 0ull;
#define PG8_STAMP() do { if (STAMP && wid == 0 && nts < 64) { const unsigned long long _c = (unsigned long long)clock64(); \
        ts_lo = (lane == nts) ? (int)(unsigned)_c : ts_lo; ts_hi = (lane == nts) ? (int)(unsigned)(_c >> 32) : ts_hi; ++nts; } } while (0)
    PG8_STAMP();
    unsigned voffA[2], voffB[2];
#pragma unroll
    for (int i = 0; i < 2; ++i) { int R, C; stage_rc(tid * 16 + i * 8192, R, C); const int Rb = Epi::PERM ? ((R & ~31) + perm32(R & 31)) : R;
        voffA[i] = (unsigned)(R * K + C) * 2u; voffB[i] = (unsigned)(Rb * K + C) * 2u; }
    const size_t kstep = (size_t)(BK * 2);
    const size_t hstep = (size_t)HALF * K * 2;
    const size_t tstep = 2 * hstep;
    const unsigned ldsw = (unsigned)wid * 1024u;
    const int aoff = lds_byte(wr * 64 + fr, fq * 8), boff = lds_byte(wc * 32 + fr, fq * 8);
#define PG8_SA(b, h) (((b) * 2 + (h)) * HTB)
#define PG8_SB(b, h) ((4 + (b) * 2 + (h)) * HTB)
#define PG8_STAGE(bufoff, gbase, voff) do { _Pragma("unroll") for (int _i = 0; _i < 2; ++_i) \
        __builtin_amdgcn_global_load_lds((const unsigned*)((const char*)(gbase) + (voff)[_i]), (PG8_LAS unsigned*)(lds + (bufoff) + ldsw + _i * 8192), 16, 0, 0); } while (0)
#define PG8_LDA(dst, b, h) do { _Pragma("unroll") for (int m = 0; m < 4; ++m) _Pragma("unroll") for (int k = 0; k < 2; ++k) dst[m][k] = *(const PG8_LAS bf16x8*)(lds + PG8_SA(b, h) + aoff + m * 2048 + k * 1024); } while (0)
#define PG8_LDB(dst, b, h) do { _Pragma("unroll") for (int n = 0; n < 2; ++n) _Pragma("unroll") for (int k = 0; k < 2; ++k) dst[n][k] = *(const PG8_LAS bf16x8*)(lds + PG8_SB(b, h) + boff + n * 2048 + k * 1024); } while (0)
#define PG8_MMA(ai, bj, At, Bt) do { __builtin_amdgcn_s_setprio(1); _Pragma("unroll") for (int m = 0; m < 4; ++m) _Pragma("unroll") for (int n = 0; n < 2; ++n) _Pragma("unroll") for (int k = 0; k < 2; ++k) \
        acc[ai][bj][m][n] = __builtin_amdgcn_mfma_f32_16x16x32_bf16(Bt[n][k], At[m][k], acc[ai][bj][m][n], 0, 0, 0); __builtin_amdgcn_s_setprio(0); } while (0)
#define PG8_WAIT_V(n) asm volatile("s_waitcnt vmcnt(" #n ")" ::: "memory")
#define PG8_WAIT_L(n) asm volatile("s_waitcnt lgkmcnt(" #n ")" ::: "memory")
#define PG8_BAR __builtin_amdgcn_s_barrier()
#define PG8_SCHED __builtin_amdgcn_sched_barrier(0)
    Unit cur, nxt; int ui = 0;
    if (!S.next(0, cur)) return;
    f32x4 acc[2][2][4][2];
#pragma unroll
    for (int a = 0; a < 2; ++a)
#pragma unroll
        for (int b = 0; b < 2; ++b)
#pragma unroll
            for (int m = 0; m < 4; ++m)
#pragma unroll
                for (int n = 0; n < 2; ++n) acc[a][b][m][n] = (f32x4){0.f, 0.f, 0.f, 0.f};
    bf16x8 At[4][2], B0[2][2], B1[2][2];
    const char* cA = (const char*)g.A + (size_t)cur.pm * tstep; const char* cB = (const char*)g.Bt + (size_t)cur.pn * tstep;
    S.a_ready(cur);
    PG8_STAGE(PG8_SB(0, 0), cB, voffB); PG8_STAGE(PG8_SA(0, 0), cA, voffA); PG8_STAGE(PG8_SB(0, 1), cB + hstep, voffB); PG8_STAGE(PG8_SA(0, 1), cA + hstep, voffA);
    if (wr == 1) PG8_BAR;
    PG8_WAIT_V(4); PG8_BAR;
    PG8_STAGE(PG8_SB(1, 0), cB + kstep, voffB); PG8_STAGE(PG8_SA(1, 0), cA + kstep, voffA); PG8_STAGE(PG8_SB(1, 1), cB + hstep + kstep, voffB);
    PG8_WAIT_V(6); PG8_BAR;
    PG8_STAMP();
    for (;;) {
        const bool has_next = S.next(ui + 1, nxt);
        const char* nA = has_next ? (const char*)g.A + (size_t)nxt.pm * tstep : cA; const char* nB = has_next ? (const char*)g.Bt + (size_t)nxt.pn * tstep : cB;
        for (int t = 0; t < nt; t += 2) {
            const bool last = (t == nt - 2);
            const char* a1 = cA + (size_t)(t + 1) * kstep;
            const char* a2 = last ? nA : cA + (size_t)(t + 2) * kstep; const char* b2 = last ? nB : cB + (size_t)(t + 2) * kstep;
            const char* a3 = a2 + kstep; const char* b3 = b2 + kstep;
            if (last && has_next) S.a_ready(nxt);
            PG8_LDB(B0, 0, 0); PG8_SCHED; PG8_LDA(At, 0, 0); PG8_STAGE(PG8_SA(1, 1), a1 + hstep, voffA);
            PG8_WAIT_L(8); PG8_BAR; PG8_WAIT_L(0); PG8_MMA(0, 0, At, B0); PG8_BAR; PG8_SCHED;
            PG8_LDB(B1, 0, 1); PG8_STAGE(PG8_SB(0, 0), b2, voffB);
            PG8_BAR; PG8_WAIT_L(0); PG8_MMA(0, 1, At, B1); PG8_BAR;
            PG8_LDA(At, 0, 1); PG8_STAGE(PG8_SA(0, 0), a2, voffA);
            PG8_BAR; PG8_WAIT_L(0); PG8_MMA(1, 0, At, B0); PG8_BAR; PG8_SCHED;
            PG8_STAGE(PG8_SB(0, 1), b2 + hstep, voffB);
            PG8_WAIT_V(6); PG8_BAR; PG8_MMA(1, 1, At, B1); PG8_BAR;
            PG8_LDB(B0, 1, 0); PG8_SCHED; PG8_LDA(At, 1, 0); PG8_STAGE(PG8_SA(0, 1), a2 + hstep, voffA);
            PG8_WAIT_L(8); PG8_BAR; PG8_WAIT_L(0); PG8_MMA(0, 0, At, B0); PG8_BAR; PG8_SCHED;
            PG8_LDB(B1, 1, 1); PG8_STAGE(PG8_SB(1, 0), b3, voffB);
            PG8_BAR; PG8_WAIT_L(0); PG8_MMA(0, 1, At, B1); PG8_BAR;
            PG8_LDA(At, 1, 1); PG8_STAGE(PG8_SA(1, 0), a3, voffA);
            PG8_BAR; PG8_WAIT_L(0); PG8_MMA(1, 0, At, B0); PG8_BAR; PG8_SCHED;
            PG8_STAGE(PG8_SB(1, 1), b3 + hstep, voffB);
            PG8_WAIT_V(6); PG8_BAR; PG8_MMA(1, 1, At, B1); PG8_BAR;
        }
        PG8_STAMP();
        if constexpr (!Epi::AFTER_DRAIN) { E(acc, cur, wr, wc, fr, fq); S.done(cur); }
        PG8_STAMP();
        if (!has_next) break;
#pragma unroll
        for (int a = 0; a < 2; ++a)
#pragma unroll
            for (int b = 0; b < 2; ++b)
#pragma unroll
                for (int m = 0; m < 4; ++m)
#pragma unroll
                    for (int n = 0; n < 2; ++n) acc[a][b][m][n] = (f32x4){0.f, 0.f, 0.f, 0.f};
        cur = nxt; cA = nA; cB = nB; ++ui;
    }
    PG8_WAIT_V(0);
    if (wr == 0) PG8_BAR;
    PG8_BAR;
    if constexpr (Epi::AFTER_DRAIN) { E.fused(acc, cur, wr, wc, fr, fq, lds, wid, lane); S.done(cur); }
    PG8_STAMP();
    if (STAMP && wid == 0) { stamps[lane] = lane < nts ? (((unsigned long long)(unsigned)ts_hi << 32) | (unsigned)ts_lo) : 0ull;
        if (lane == 62) stamps[62] = rt_entry; if (lane == 63) stamps[63] = (unsigned long long)wall_clock64(); }
#undef PG8_STAMP
#undef PG8_SA
#undef PG8_SB
#undef PG8_STAGE
#undef PG8_LDA
#undef PG8_LDB
#undef PG8_MMA
#undef PG8_WAIT_V
#undef PG8_WAIT_L
#undef PG8_BAR
#undef PG8_SCHED
}
}

using pg8::bf16_t; using pg8::bf16x8; using pg8::f32x4; using pg8::u32x4;
typedef float f32x16 __attribute__((ext_vector_type(16)));
typedef _Float16 h16x2 __attribute__((ext_vector_type(2)));
typedef unsigned u32x2 __attribute__((ext_vector_type(2)));
#define LAS __attribute__((address_space(3)))

constexpr int NTOK = 17408, NLAT = 16384, DM = 1024, NTH = 512;
constexpr float EPSF = 1e-6f;
constexpr float HSCALE = 64.f;

constexpr size_t SZ_H = (size_t)NTOK * 1024 * 2;
constexpr size_t OFF_X = 0;
constexpr size_t OFF_WIN = OFF_X + SZ_H;
constexpr size_t OFF_WBHY = OFF_WIN + (size_t)8448 * 1024 * 2;
constexpr size_t OFF_WBGLA = OFF_WBHY + 2097152;
constexpr size_t OFF_WOUT = OFF_WBGLA + 2097152;
constexpr size_t OFF_W1 = OFF_WOUT + 2097152;
constexpr size_t OFF_W2 = OFF_W1 + 8388608;
constexpr size_t OFF_XT = OFF_W2 + 8388608;
constexpr size_t SZ_XT = (size_t)4096 * NTOK * 2;
constexpr size_t OFF_PB = OFF_XT + SZ_XT;
constexpr size_t OFF_LR = OFF_PB + SZ_XT;
constexpr size_t OFF_QF = OFF_LR + (size_t)NTOK * 32 * 4;
constexpr size_t SZ_Q = (size_t)NTOK * 512 * 2;
constexpr size_t OFF_QB = OFF_QF + SZ_Q;
constexpr size_t OFF_KEF = OFF_QB + SZ_Q;
constexpr size_t OFF_KEB = OFF_KEF + SZ_Q;
constexpr size_t OFF_ATT = OFF_KEB + SZ_Q;
constexpr size_t OFF_DEC = OFF_ATT + SZ_Q;
constexpr size_t OFF_HP = OFF_DEC + (size_t)272 * 4 * 2 * 128 * 4;
constexpr size_t OFF_CTXS = OFF_HP + (size_t)1024 * 8192 * 4;
constexpr size_t OFF_MOD = OFF_CTXS + 4194304;
constexpr size_t OFF_A2L = OFF_MOD + 491520;
constexpr size_t OFF_A2C = OFF_A2L + 4194304;
constexpr size_t OFF_HTC = OFF_A2C + 262144;
constexpr size_t OFF_HP2 = OFF_HTC + 2097152;
constexpr size_t OFF_HTC2 = OFF_HP2 + (size_t)1024 * 8192 * 4;
constexpr size_t OFF_CNT = OFF_HTC2 + 2097152;
constexpr size_t OFF_BAR = OFF_CNT + 1024;
constexpr size_t WS_TOTAL = OFF_BAR + 16384;

struct Params {
  const float *x, *c, *ctx, *c_ctx, *ada_w, *ada_b, *norm1_g, *norm2_g, *w_in, *conv_w, *conv_b, *fw1, *fb1, *fw2, *fb2, *fw3, *ffreq,
      *decay, *skip, *gate_w, *gate_b, *gla_ng, *w_bhy, *w_bgla, *w_out, *mlp_w1, *mlp_w2, *final_g;
  float* out; unsigned char* ws;
};

typedef float f32x2_t __attribute__((ext_vector_type(2)));
typedef __bf16 bf16x2_t __attribute__((ext_vector_type(2)));
DI bf16_t f2bf(float f) { const __bf16 b = (__bf16)f; return __builtin_bit_cast(bf16_t, b); }
DI float bf2f(bf16_t b) { return __uint_as_float(((unsigned)b) << 16); }
DI unsigned pk2(float lo, float hi) { f32x2_t v; v.x = lo; v.y = hi; const bf16x2_t b = __builtin_convertvector(v, bf16x2_t); return __builtin_bit_cast(unsigned, b); }
DI float bflo(unsigned w) { return __uint_as_float(w << 16); }
DI float bfhi(unsigned w) { return __uint_as_float(w & 0xffff0000u); }
DI float sigm(float x) { return __builtin_amdgcn_rcpf(1.f + __expf(-x)); }
DI float my_sin(float x) { float r = x * 0.15915494309189535f; r -= rintf(r); return __builtin_amdgcn_sinf(r); }
DI float wave_sum(float v) {
#pragma unroll
  for (int o = 32; o >= 1; o >>= 1) v += __shfl_xor(v, o);
  return v;
}
DI float* xrow(const Params& p, int row) { return row < NLAT ? p.out + (size_t)row * DM : (float*)(p.ws + OFF_CTXS) + (size_t)(row - NLAT) * DM; }
DI const float* xrow_in(const Params& p, int row) { return row < NLAT ? p.x + (size_t)row * DM : p.ctx + (size_t)(row - NLAT) * DM; }
DI const float* modp(const Params& p, int l, int s) { return (const float*)(p.ws + OFF_MOD) + ((size_t)l * 5 + s) * 6144; }

DI void phase_copy(const Params& p) {
  if (blockIdx.x == 0) { unsigned* z = (unsigned*)(p.ws + OFF_CNT); for (int i = otid(); i < (1024 + 16384) / 4; i += NTH) z[i] = 0u; }
}

DI void phase_mod(const Params& p, LAS unsigned char* lds) {
  LAS float* sv = (LAS float*)lds;
  LAS float* red = sv + 5 * 1024;
  const int tid = otid();
  bool loaded = false;
  for (int it = blockIdx.x; it < 4 * 48; it += gridDim.x) {
    if (!loaded) {
      for (int i = tid; i < 5 * 1024; i += NTH) { const int s = i >> 10, k = i & 1023; const float v = s < 4 ? p.c[s * 1024 + k] : p.c_ctx[k]; sv[i] = v * sigm(v); }
      loaded = true;
    }
    __syncthreads();
    const int l = it / 48, cb = it % 48, cg4 = tid & 31, kq = tid >> 5;
    const float* W = p.ada_w + (size_t)l * 1024 * 6144 + cb * 128 + 4 * cg4;
    f32x4 a0 = {0.f, 0.f, 0.f, 0.f}, a1 = a0, a2 = a0, a3 = a0, a4 = a0;
#pragma unroll 8
    for (int k = kq * 64; k < kq * 64 + 64; ++k) { const f32x4 w = __builtin_nontemporal_load((const f32x4*)(W + (size_t)k * 6144)); a0 += w * sv[k]; a1 += w * sv[1024 + k]; a2 += w * sv[2048 + k]; a3 += w * sv[3072 + k]; a4 += w * sv[4096 + k]; }
    LAS float* r = red + kq * 5 * 128 + 4 * cg4;
    *(LAS f32x4*)(r) = a0; *(LAS f32x4*)(r + 128) = a1; *(LAS f32x4*)(r + 256) = a2; *(LAS f32x4*)(r + 384) = a3; *(LAS f32x4*)(r + 512) = a4;
    __syncthreads();
    if (tid < 128) {
      const int col = cb * 128 + tid;
      const float bias = p.ada_b[l * 6144 + col];
      float* mo = (float*)(p.ws + OFF_MOD) + (size_t)l * 5 * 6144 + col;
#pragma unroll
      for (int s = 0; s < 5; ++s) { float t = bias;
#pragma unroll
        for (int q = 0; q < 16; ++q) t += red[q * 5 * 128 + s * 128 + tid]; mo[(size_t)s * 6144] = t; }
    }
    __syncthreads();
  }
}

DI void phase_a2(const Params& p, LAS unsigned char* lds) {
  LAS float* zf = (LAS float*)lds;
  LAS float* a1s = zf + 64 * 36;
  const int tid = otid(), tl = tid >> 6, m = tid & 63;
  const int per = (4096 + 256) / 64;
  for (int it = blockIdx.x; it < 4 * per; it += gridDim.x) {
    const int l = it / per, r = it % per;
    const bool isc = r >= 64; const int Lq = isc ? 256 : 4096; const int i0 = (isc ? (r - 64) : r) * 64;
    for (int e = tid; e < 64 * 33; e += NTH) {
      const int tt = e / 33, f = e % 33, i = i0 + tt; float v;
      if (f == 0) v = (float)i / (float)(Lq - 1);
      else { const int j = (f - 1) & 15; const float band = 1e-4f + (float)j * ((15.f - 1e-4f) / 15.f); float rev = (float)i * band / (float)Lq; rev -= floorf(rev);
             v = (f <= 16) ? __builtin_amdgcn_cosf(rev) : -__builtin_amdgcn_sinf(rev); }
      zf[tt * 36 + f] = v;
    }
    const float fr = p.ffreq[l * 64 + m], b1v = p.fb1[l * 64 + m], b2v = p.fb2[l * 64 + m];
    float w1r[33];
#pragma unroll
    for (int f = 0; f < 33; ++f) w1r[f] = p.fw1[((size_t)l * 33 + f) * 64 + m];
    __syncthreads();
#pragma unroll 1
    for (int q = 0; q < 8; ++q) { const int tt = tl * 8 + q; float acc = b1v;
#pragma unroll
      for (int f = 0; f < 33; ++f) acc += zf[tt * 36 + f] * w1r[f];
      a1s[tt * 64 + m] = my_sin(fr * acc); }
    float w2r[64];
#pragma unroll
    for (int j = 0; j < 64; ++j) w2r[j] = p.fw2[((size_t)l * 64 + j) * 64 + m];
    __syncthreads();
    float* dst = isc ? (float*)(p.ws + OFF_A2C) + ((size_t)l * 256 + i0) * 64 : (float*)(p.ws + OFF_A2L) + ((size_t)l * 4096 + i0) * 64;
#pragma unroll 1
    for (int q = 0; q < 8; ++q) { const int tt = tl * 8 + q; float acc = b2v;
#pragma unroll
      for (int j4 = 0; j4 < 16; ++j4) { const f32x4 a = *(const LAS f32x4*)(a1s + tt * 64 + 4 * j4); acc += a.x * w2r[4 * j4] + a.y * w2r[4 * j4 + 1] + a.z * w2r[4 * j4 + 2] + a.w * w2r[4 * j4 + 3]; }
      dst[(size_t)tt * 64 + m] = my_sin(fr * acc); }
    __syncthreads();
  }
}

DI void wt_load(const float* src, int ld_src, int k0, int n0, f32x4 (&v)[2]) {
  const int tid = otid();
#pragma unroll
  for (int q = 0; q < 2; ++q) { const int kk = (tid >> 3) + 64 * q, nq = tid & 7; v[q] = __builtin_nontemporal_load((const f32x4*)(src + (size_t)(k0 + kk) * ld_src + n0 + 4 * nq)); }
}
DI void wt_store(const f32x4 (&v)[2], int k0, bf16_t* dst, int ld_dst, int drow0, LAS unsigned char* lds) {
  LAS bf16_t* t = (LAS bf16_t*)lds;
  const int tid = otid();
#pragma unroll
  for (int q = 0; q < 2; ++q) {
    const int kk = (tid >> 3) + 64 * q, nq = tid & 7;
    t[(4 * nq + 0) * 136 + kk] = f2bf(v[q].x); t[(4 * nq + 1) * 136 + kk] = f2bf(v[q].y); t[(4 * nq + 2) * 136 + kk] = f2bf(v[q].z); t[(4 * nq + 3) * 136 + kk] = f2bf(v[q].w);
  }
  __syncthreads();
  { const int n = tid >> 4, kq = tid & 15;
    const u32x4 o = *(const LAS u32x4*)(t + n * 136 + 8 * kq);
    *(u32x4*)(dst + (size_t)(drow0 + n) * ld_dst + k0 + 8 * kq) = o; }
  __syncthreads();
}
DI int win_dst_row(int n) {
  if (n < 3072) return n;
  if (n < 4096) return 4096 + (n - 3072);
  if (n < 5120) return 3072 + (n - 4096);
  if (n < 6144) return 4096 + 1024 + (n - 5120);
  if (n < 6176) return 8192 + (n - 6144);
  if (n < 7200) return 4096 + 2048 + (n - 6176);
  return 4096 + 3072 + (n - 7200);
}
struct WtItem { const float* src; int ld_src, k0, n0; bf16_t* dst; int ld_dst, drow0; };
DI WtItem wt_decode(const Params& p, int l, int part, int it) {
  unsigned char* ws = p.ws; WtItem w;
  const int n_win = 8 * 257, n_sq = 8 * 32, n_w1 = 8 * 128;
  if (part == 0) {
    if (it < n_win) { const int kt = it & 7, nt = it >> 3; w.src = p.w_in + (size_t)l * 1024 * 8224; w.ld_src = 8224; w.k0 = kt * 128; w.n0 = nt * 32; w.dst = (bf16_t*)(ws + OFF_WIN); w.ld_dst = 1024; w.drow0 = win_dst_row(nt * 32); }
    else { const int r = it - n_win, which = r / n_sq, q = r % n_sq, kt = q & 7, nt = q >> 3;
      w.src = (which == 0 ? p.w_bhy : which == 1 ? p.w_bgla : p.w_out) + (size_t)l * 1024 * 1024; w.ld_src = 1024; w.k0 = kt * 128; w.n0 = nt * 32;
      w.dst = (bf16_t*)(ws + (which == 0 ? OFF_WBHY : which == 1 ? OFF_WBGLA : OFF_WOUT)); w.ld_dst = 1024; w.drow0 = nt * 32; }
  } else {
    if (it < n_w1) { const int kt = it & 7, nt = it >> 3; w.src = p.mlp_w1 + (size_t)l * 1024 * 4096; w.ld_src = 4096; w.k0 = kt * 128; w.n0 = nt * 32; w.dst = (bf16_t*)(ws + OFF_W1); w.ld_dst = 1024; w.drow0 = nt * 32; }
    else { const int r = it - n_w1, kt = r & 31, nt = r >> 5; w.src = p.mlp_w2 + (size_t)l * 4096 * 1024; w.ld_src = 1024; w.k0 = kt * 128; w.n0 = nt * 32; w.dst = (bf16_t*)(ws + OFF_W2); w.ld_dst = 4096; w.drow0 = nt * 32; }
  }
  return w;
}
DI void phase_wconv(const Params& p, int l, LAS unsigned char* lds, int part, int blk, int nblk) {
  unsigned char* ws = p.ws;
  const int total = part == 0 ? (8 * 257 + 3 * 8 * 32) : (8 * 128 + 32 * 32);
  f32x4 v[2];
  if (blk < total) { const WtItem w = wt_decode(p, l, part, blk); wt_load(w.src, w.ld_src, w.k0, w.n0, v); }
  for (int it = blk; it < total; it += nblk) {
    const WtItem w = wt_decode(p, l, part, it);
    f32x4 cur[2] = {v[0], v[1]};
    if (it + nblk < total) { const WtItem w2 = wt_decode(p, l, part, it + nblk); wt_load(w2.src, w2.ld_src, w2.k0, w2.n0, v); }
    wt_store(cur, w.k0, w.dst, w.ld_dst, w.drow0, lds);
  }
  if (part == 0) { u32x4* z = (u32x4*)(ws + OFF_WIN + (size_t)8224 * 1024 * 2); const int n = 224 * 1024 * 2 / 16;
    for (int i = blk * NTH + otid(); i < n; i += nblk * NTH) z[i] = (u32x4){0u, 0u, 0u, 0u}; }
}

DI void phase_norm(const Params& p, int l, const float* g, int sh_off, int sc_off, int nrows, bool from_input) {
  const int lane = otid() & 63, gw = blockIdx.x * 8 + (otid() >> 6), nw = gridDim.x * 8;
  bf16_t* hb = (bf16_t*)(p.ws + OFF_X);
  const int rp = (nrows + nw - 1) / nw, r0 = gw * rp, r1 = min(nrows, r0 + rp);
  f32x4 A[4], B[4]; int scur = -1;
  f32x4 pa[4], pb2[4];
#define NORM_LOAD(rw) do { const int ra_ = (rw), rb_ = ((rw) + 1 < r1) ? (rw) + 1 : (rw); const float* xa_ = from_input ? xrow_in(p, ra_) : xrow(p, ra_); const float* xb_ = from_input ? xrow_in(p, rb_) : xrow(p, rb_); \
    _Pragma("unroll") for (int i = 0; i < 4; ++i) { pa[i] = *(const f32x4*)(xa_ + 4 * lane + 256 * i); pb2[i] = *(const f32x4*)(xb_ + 4 * lane + 256 * i); } } while (0)
  if (r0 < r1) NORM_LOAD(r0);
  for (int row = r0; row < r1; row += 2) {
    const bool two = row + 1 < r1;
    const int s = row < NLAT ? (row >> 12) : 4;
    if (s != scur) { scur = s; const float* mo = modp(p, l, s);
#pragma unroll
      for (int i = 0; i < 4; ++i) { const int c = 4 * lane + 256 * i; const f32x4 gg = *(const f32x4*)(g + c), sc = *(const f32x4*)(mo + sc_off + c); A[i] = gg * (sc + 1.f); B[i] = *(const f32x4*)(mo + sh_off + c); } }
    f32x4 va[4], vb[4]; float sa = 0.f, sb = 0.f;
#pragma unroll
    for (int i = 0; i < 4; ++i) { va[i] = pa[i]; vb[i] = pb2[i]; }
    if (row + 2 < r1) NORM_LOAD(row + 2);
#pragma unroll
    for (int i = 0; i < 4; ++i) { sa += va[i].x * va[i].x + va[i].y * va[i].y + va[i].z * va[i].z + va[i].w * va[i].w; sb += vb[i].x * vb[i].x + vb[i].y * vb[i].y + vb[i].z * vb[i].z + vb[i].w * vb[i].w; }
#pragma unroll
    for (int o = 32; o >= 1; o >>= 1) { sa += __shfl_xor(sa, o); sb += __shfl_xor(sb, o); }
    const float ra = rsqrtf(sa * (1.f / 1024.f) + EPSF), rb = rsqrtf(sb * (1.f / 1024.f) + EPSF);
    const int s2 = (row + 1) < NLAT ? ((row + 1) >> 12) : 4;
#pragma unroll
    for (int i = 0; i < 4; ++i) { const int c = 4 * lane + 256 * i; const f32x4 ya = va[i] * ra * A[i] + B[i];
      *(u32x2*)(hb + (size_t)row * 1024 + c) = (u32x2){pk2(ya.x, ya.y), pk2(ya.z, ya.w)}; }
    if (two) {
      if (s2 != scur) { scur = s2; const float* mo = modp(p, l, s2);
#pragma unroll
        for (int i = 0; i < 4; ++i) { const int c = 4 * lane + 256 * i; const f32x4 gg = *(const f32x4*)(g + c), sc = *(const f32x4*)(mo + sc_off + c); A[i] = gg * (sc + 1.f); B[i] = *(const f32x4*)(mo + sh_off + c); } }
#pragma unroll
      for (int i = 0; i < 4; ++i) { const int c = 4 * lane + 256 * i; const f32x4 yb = vb[i] * rb * A[i] + B[i];
        *(u32x2*)(hb + (size_t)(row + 1) * 1024 + c) = (u32x2){pk2(yb.x, yb.y), pk2(yb.z, yb.w)}; }
    }
  }
}
#undef NORM_LOAD
DI void phase_final_norm(const Params& p) {
  const int lane = otid() & 63, gw = blockIdx.x * 8 + (otid() >> 6), nw = gridDim.x * 8;
  for (int row = gw; row < NLAT; row += nw) {
    float* xr = p.out + (size_t)row * DM;
    float4 v[4]; float ss = 0.f;
#pragma unroll
    for (int i = 0; i < 4; ++i) { v[i] = *(const float4*)(xr + 4 * lane + 256 * i); ss += v[i].x * v[i].x + v[i].y * v[i].y + v[i].z * v[i].z + v[i].w * v[i].w; }
    ss = wave_sum(ss);
    const float rstd = rsqrtf(ss * (1.f / 1024.f) + EPSF);
#pragma unroll
    for (int i = 0; i < 4; ++i) { const int c = 4 * lane + 256 * i; const float4 gg = *(const float4*)(p.final_g + c);
      *(float4*)(xr + c) = make_float4(v[i].x * rstd * gg.x, v[i].y * rstd * gg.y, v[i].z * rstd * gg.z, v[i].w * rstd * gg.w); }
  }
}

DI void phase_filt_gemm(const Params& p, int l, LAS unsigned char* lds, int blk, int nblk) {
  LAS float* w3s = (LAS float*)lds;
  LAS float* a2s = w3s + 64 * 64;
  const int tid = otid();
  const int nL = 32 * 32, nC = 32 * 2;
  for (int it = blk; it < nL + nC; it += nblk) {
    const bool isc = it >= nL; const int r = isc ? it - nL : it; const int Lq = isc ? 256 : 4096;
    const int ntt = Lq / 128, dt = r / ntt, tt0 = (r % ntt) * 128, d0 = dt * 64;
    const float* A2 = isc ? (const float*)(p.ws + OFF_A2C) + (size_t)l * 256 * 64 : (const float*)(p.ws + OFF_A2L) + (size_t)l * 4096 * 64;
    float* hT = isc ? (float*)(p.ws + ((l & 1) ? OFF_HTC2 : OFF_HTC)) : (float*)(p.ws + ((l & 1) ? OFF_HP2 : OFF_HP));
    { const int m = tid >> 3, q = tid & 7; const float* s = p.fw3 + ((size_t)l * 64 + m) * 2048 + d0;
      *(LAS f32x4*)(w3s + m * 64 + 4 * q) = *(const f32x4*)(s + 4 * q); *(LAS f32x4*)(w3s + m * 64 + 32 + 4 * q) = *(const f32x4*)(s + 32 + 4 * q); }
    { const int tt = tid >> 2, mq = tid & 3; const float* s = A2 + (size_t)(tt0 + tt) * 64 + 16 * mq;
#pragma unroll
      for (int q = 0; q < 4; ++q) { const float4 v = *(const float4*)(s + 4 * q);
        a2s[(16 * mq + 4 * q + 0) * 132 + tt] = v.x; a2s[(16 * mq + 4 * q + 1) * 132 + tt] = v.y; a2s[(16 * mq + 4 * q + 2) * 132 + tt] = v.z; a2s[(16 * mq + 4 * q + 3) * 132 + tt] = v.w; } }
    __syncthreads();
    const int cx = tid & 15, ty = tid >> 4;
    float acc[4][4];
#pragma unroll
    for (int a = 0; a < 4; ++a)
#pragma unroll
      for (int b = 0; b < 4; ++b) acc[a][b] = 0.f;
#pragma unroll 8
    for (int m = 0; m < 64; ++m) {
      const f32x4 wv = *(const LAS f32x4*)(w3s + m * 64 + 4 * cx), av = *(const LAS f32x4*)(a2s + m * 132 + 4 * ty);
      const float w[4] = {wv.x, wv.y, wv.z, wv.w}, a[4] = {av.x, av.y, av.z, av.w};
#pragma unroll
      for (int ci = 0; ci < 4; ++ci)
#pragma unroll
        for (int ti = 0; ti < 4; ++ti) acc[ci][ti] += w[ci] * a[ti];
    }
    const float inv = 1.f / (float)(Lq - 1);
#pragma unroll
    for (int ci = 0; ci < 4; ++ci) {
      const int dirch = d0 + 4 * cx + ci; const float dc = fabsf(p.decay[l * 1024 + (dirch & 1023)]);
      float o[4];
#pragma unroll
      for (int ti = 0; ti < 4; ++ti) { const float tl = (float)(tt0 + 4 * ty + ti) * inv; o[ti] = acc[ci][ti] * __expf(-tl * dc); }
      *(float4*)(hT + (size_t)dirch * Lq + tt0 + 4 * ty) = make_float4(o[0], o[1], o[2], o[3]);
    }
    __syncthreads();
  }
}
#define XB_TMO      128
#define XB_XCNT(j)  (256  + 64 * (j))
#define XB_XSUB(j)  (1280 + 64 * (j))
#define XB_XGEN(j)  (2304 + 64 * (j))
#define XB_TOP      3328
#define XB_TOPGEN   3392
#define XCD_BAR_WORDS 3456
#define XB_SPIN_CAP (1u << 18)

__device__ __forceinline__ unsigned xb_ld(unsigned* p)              { return __hip_atomic_load(p, __ATOMIC_RELAXED, __HIP_MEMORY_SCOPE_AGENT); }
__device__ __forceinline__ unsigned xb_add(unsigned* p, unsigned v) { return __hip_atomic_fetch_add(p, v, __ATOMIC_RELAXED, __HIP_MEMORY_SCOPE_AGENT); }
__device__ __forceinline__ unsigned xb_xcc_id() { return (unsigned)__builtin_amdgcn_s_getreg((3 << 11) | 20) & 0xFu; }
#define XB_SPIN(cond, bar) do { unsigned _sp = 0; while (cond) { __builtin_amdgcn_s_sleep(1); \
    if ((++_sp & 255u) == 0u) { if (xb_ld(&(bar)[XB_TMO])) break; if (_sp > XB_SPIN_CAP) { atomicAdd(&(bar)[XB_TMO], 1u); break; } } } } while (0)
struct XcdBarrier {
    unsigned* bar; unsigned x;
    volatile LAS unsigned* st;
};

__device__ __forceinline__ XcdBarrier xcd_barrier_post(unsigned* bar, volatile LAS unsigned* st) {
    XcdBarrier b; b.bar = bar; b.x = xb_xcc_id(); b.st = st;
    if (threadIdx.x == 0) (void)xb_add(&bar[XB_XCNT(b.x)], 1u);
    return b;
}
__device__ __forceinline__ void xcd_barrier_complete(unsigned* bar, unsigned x, unsigned& nloc, unsigned& nx) {
    const unsigned G = gridDim.x * gridDim.y * gridDim.z;
    unsigned sum, cnt, mine, sp = 0u;
    for (;;) {
        sum = 0u; cnt = 0u; mine = 0u;
#pragma unroll
        for (unsigned j = 0; j < 16; ++j) { const unsigned c = xb_ld(&bar[XB_XCNT(j)]); sum += c; cnt += (c > 0u) ? 1u : 0u; mine = (j == x) ? c : mine; }
        if (sum == G) break;
        __builtin_amdgcn_s_sleep(1);
        if ((++sp & 255u) == 0u) { if (xb_ld(&bar[XB_TMO])) break; if (sp > XB_SPIN_CAP) { atomicAdd(&bar[XB_TMO], 1u); break; } }
    }
    nloc = mine > 0u ? mine : 1u; nx = cnt > 0u ? cnt : 1u;
}

__device__ __forceinline__ void xcd_barrier(const XcdBarrier& b) {
    asm volatile("s_waitcnt vmcnt(0)" ::: "memory");
    __syncthreads();
    if (threadIdx.x == 0) {
        unsigned* bar = b.bar;
        __builtin_amdgcn_s_waitcnt(0);
        unsigned nloc = b.st[0], nx = b.st[1];
        if (nloc == 0u) { xcd_barrier_complete(bar, b.x, nloc, nx); b.st[0] = nloc; b.st[1] = nx; }
        const unsigned old = xb_add(&bar[XB_XSUB(b.x)], 1u);
        const unsigned gen = old / nloc;
        if (old + 1u == (gen + 1u) * nloc) {
            __builtin_amdgcn_fence(__ATOMIC_RELEASE, "agent");
            asm volatile("s_waitcnt vmcnt(0)" ::: "memory");
            const unsigned og = xb_add(&bar[XB_TOP], 1u);
            const unsigned tg = og / nx;
            if (og + 1u == (tg + 1u) * nx) xb_add(&bar[XB_TOPGEN], 1u);
            else XB_SPIN(xb_ld(&bar[XB_TOPGEN]) == tg, bar);
            __builtin_amdgcn_fence(__ATOMIC_ACQUIRE, "agent");
            xb_add(&bar[XB_XGEN(b.x)], 1u);
            asm volatile("s_waitcnt vmcnt(0)" ::: "memory");
        } else {
            XB_SPIN(xb_ld(&bar[XB_XGEN(b.x)]) == gen, bar);
            __builtin_amdgcn_fence(__ATOMIC_ACQUIRE, "agent");
            asm volatile("s_waitcnt vmcnt(0)" ::: "memory");
        }
    }
    __syncthreads();
}

typedef float cplx __attribute__((ext_vector_type(2)));
DI cplx mk2(float a, float b) { cplx r; r.x = a; r.y = b; return r; }
DI constexpr float cos32(int m) { constexpr float t[16] = {1.f, 0.98078528040323043f, 0.92387953251128674f, 0.83146961230254524f, 0.70710678118654752f, 0.55557023301960218f, 0.38268343236508977f, 0.19509032201612825f,
    0.f, -0.19509032201612825f, -0.38268343236508977f, -0.55557023301960218f, -0.70710678118654752f, -0.83146961230254524f, -0.92387953251128674f, -0.98078528040323043f}; return t[m]; }
DI constexpr float sin32(int m) { constexpr float t[16] = {0.f, 0.19509032201612825f, 0.38268343236508977f, 0.55557023301960218f, 0.70710678118654752f, 0.83146961230254524f, 0.92387953251128674f, 0.98078528040323043f,
    1.f, 0.98078528040323043f, 0.92387953251128674f, 0.83146961230254524f, 0.70710678118654752f, 0.55557023301960218f, 0.38268343236508977f, 0.19509032201612825f}; return t[m]; }
DI constexpr int brev(int k, int bits) { int r = 0; for (int i = 0; i < bits; ++i) r |= ((k >> i) & 1) << (bits - 1 - i); return r; }
DI cplx cmul_c(cplx a, cplx b) { return mk2(a.x * b.x - a.y * b.y, a.x * b.y + a.y * b.x); }
DI cplx cmulc_c(cplx a, cplx b) { return mk2(a.x * b.x + a.y * b.y, a.y * b.x - a.x * b.y); }
DI cplx cmul(cplx a, cplx b) { cplx r; asm("v_pk_mul_f32 %0, %1, %2 op_sel_hi:[1,0]\n\tv_pk_fma_f32 %0, %1, %2, %0 op_sel:[1,1,0] op_sel_hi:[0,1,1] neg_lo:[1,0,0]" : "=&v"(r) : "v"(a), "v"(b)); return r; }
DI cplx cmulc(cplx a, cplx b) { cplx r; asm("v_pk_mul_f32 %0, %1, %2 op_sel_hi:[1,0]\n\tv_pk_fma_f32 %0, %1, %2, %0 op_sel:[1,1,0] op_sel_hi:[0,1,1] neg_hi:[1,0,0]" : "=&v"(r) : "v"(a), "v"(b)); return r; }
DI cplx cmul_s(cplx a, cplx b) { cplx r; asm("v_pk_mul_f32 %0, %1, %2 op_sel_hi:[1,0]\n\tv_pk_fma_f32 %0, %1, %2, %0 op_sel:[1,1,0] op_sel_hi:[0,1,1] neg_lo:[1,0,0]" : "=&v"(r) : "v"(a), "s"(b)); return r; }
DI cplx cmulc_s(cplx a, cplx b) { cplx r; asm("v_pk_mul_f32 %0, %1, %2 op_sel_hi:[1,0]\n\tv_pk_fma_f32 %0, %1, %2, %0 op_sel:[1,1,0] op_sel_hi:[0,1,1] neg_hi:[1,0,0]" : "=&v"(r) : "v"(a), "s"(b)); return r; }
DI cplx mul_mi(cplx a) { cplx r; asm("v_pk_mul_f32 %0, %1, 1.0 op_sel:[1,0] op_sel_hi:[0,0] neg_hi:[1,0]" : "=v"(r) : "v"(a)); return r; }
DI cplx mul_pi(cplx a) { cplx r; asm("v_pk_mul_f32 %0, %1, 1.0 op_sel:[1,0] op_sel_hi:[0,0] neg_lo:[1,0]" : "=v"(r) : "v"(a)); return r; }

template <int R, bool INV> DI void dft_reg(cplx (&v)[R]) {
#pragma unroll
  for (int len = R; len >= 2; len >>= 1) {
    const int half = len >> 1;
#pragma unroll
    for (int s = 0; s < R; s += len) {
#pragma unroll
      for (int j = 0; j < half; ++j) {
        const cplx a = v[s + j], b = v[s + j + half];
        v[s + j] = mk2(a.x + b.x, a.y + b.y);
        const cplx d = mk2(a.x - b.x, a.y - b.y);
        const int m = j * (32 / len);
        if (m == 0) v[s + j + half] = d;
        else if (m == 8) v[s + j + half] = INV ? mul_pi(d) : mul_mi(d);
        else { const cplx K = mk2(cos32(m), sin32(m));
          v[s + j + half] = INV ? cmul_s(d, K) : cmulc_s(d, K); }
      }
    }
  }
}
constexpr int FFT_REGION_F2 = 8704;

template <int NV> DI void fft_fwd3(cplx (&v)[NV][16], LAS cplx* L, int tid) {

#pragma unroll
  for (int i = 0; i < NV; ++i) dft_reg<16, false>(v[i]);

  { float rev = (float)tid * (1.f / 8192.f); asm volatile("" : "+v"(rev)); const cplx w1 = mk2(__builtin_amdgcn_cosf(rev), -__builtin_amdgcn_sinf(rev)); cplx w = mk2(1.f, 0.f);
    const int pb = tid + 2 * (tid >> 5);
#pragma unroll
    for (int k = 0; k < 16; ++k) {
#pragma unroll
      for (int i = 0; i < NV; ++i) L[i * FFT_REGION_F2 + pb + 544 * k] = cmul(v[i][brev(k, 4)], w);
      w = cmul(w, w1); } }
  __syncthreads();
  { const int sb = tid >> 5, ii = tid & 31, pb = 544 * sb + ii;
    cplx u[NV][16];
#pragma unroll
    for (int i = 0; i < NV; ++i)
#pragma unroll
      for (int j = 0; j < 16; ++j) u[i][j] = L[i * FFT_REGION_F2 + pb + 34 * j];

#pragma unroll
    for (int i = 0; i < NV; ++i) dft_reg<16, false>(u[i]);

    float rev = (float)ii * (1.f / 512.f); asm volatile("" : "+v"(rev)); const cplx w1 = mk2(__builtin_amdgcn_cosf(rev), -__builtin_amdgcn_sinf(rev)); cplx w = mk2(1.f, 0.f);
#pragma unroll
    for (int k = 0; k < 16; ++k) {
#pragma unroll
      for (int i = 0; i < NV; ++i) L[i * FFT_REGION_F2 + pb + 34 * k] = cmul(u[i][brev(k, 4)], w);
      w = cmul(w, w1); } }
  __syncthreads();
  { const int sb = tid >> 1, ii = tid & 1, pb = 34 * sb + ii;
    cplx u[NV][16];
#pragma unroll
    for (int i = 0; i < NV; ++i)
#pragma unroll
      for (int j = 0; j < 16; ++j) u[i][j] = L[i * FFT_REGION_F2 + pb + 2 * j];

#pragma unroll
    for (int i = 0; i < NV; ++i) dft_reg<16, false>(u[i]);

#pragma unroll
    for (int k = 0; k < 16; ++k)
#pragma unroll
      for (int i = 0; i < NV; ++i) { const cplx y = u[i][brev(k, 4)]; const cplx yw = cmul_c(y, mk2(cos32(k), -sin32(k))); L[i * FFT_REGION_F2 + pb + 2 * k] = ii ? yw : y; } }
  __syncthreads();
}
template <int NV> DI void fft_inv3(cplx (&v)[NV][16], LAS cplx* L, int tid) {
  { const int sb = tid >> 1, ii = tid & 1, pb = 34 * sb + ii;
    cplx u[NV][16];
#pragma unroll
    for (int i = 0; i < NV; ++i)
#pragma unroll
      for (int k = 0; k < 16; ++k) { const cplx y = L[i * FFT_REGION_F2 + pb + 2 * k]; const cplx yw = cmulc_c(y, mk2(cos32(k), -sin32(k))); u[i][k] = ii ? yw : y; }

#pragma unroll
    for (int i = 0; i < NV; ++i) dft_reg<16, true>(u[i]);

#pragma unroll
    for (int i = 0; i < NV; ++i)
#pragma unroll
      for (int j = 0; j < 16; ++j) L[i * FFT_REGION_F2 + pb + 2 * j] = u[i][brev(j, 4)]; }
  __syncthreads();
  { const int sb = tid >> 5, ii = tid & 31, pb = 544 * sb + ii;
    cplx u[NV][16];
    float rev = (float)ii * (1.f / 512.f); asm volatile("" : "+v"(rev)); const cplx w1 = mk2(__builtin_amdgcn_cosf(rev), -__builtin_amdgcn_sinf(rev)); cplx w = mk2(1.f, 0.f);
#pragma unroll
    for (int k = 0; k < 16; ++k) {
#pragma unroll
      for (int i = 0; i < NV; ++i) u[i][k] = cmulc(L[i * FFT_REGION_F2 + pb + 34 * k], w);
      w = cmul(w, w1); }

#pragma unroll
    for (int i = 0; i < NV; ++i) dft_reg<16, true>(u[i]);

#pragma unroll
    for (int i = 0; i < NV; ++i)
#pragma unroll
      for (int j = 0; j < 16; ++j) L[i * FFT_REGION_F2 + pb + 34 * j] = u[i][brev(j, 4)]; }
  __syncthreads();
  { float rev = (float)tid * (1.f / 8192.f); asm volatile("" : "+v"(rev)); const cplx w1 = mk2(__builtin_amdgcn_cosf(rev), -__builtin_amdgcn_sinf(rev)); cplx w = mk2(1.f, 0.f);
    const int pb = tid + 2 * (tid >> 5);
#pragma unroll
    for (int k = 0; k < 16; ++k) {
#pragma unroll
      for (int i = 0; i < NV; ++i) v[i][k] = cmulc(L[i * FFT_REGION_F2 + pb + 544 * k], w);
      w = cmul(w, w1); }

#pragma unroll
    for (int i = 0; i < NV; ++i) dft_reg<16, true>(v[i]);
     }
}

DI float shl1(float x, int lane) { const float t = __shfl_up(x, 1); return lane == 0 ? 0.f : t; }
DI float shr1(float x, int lane) { const float t = __shfl_down(x, 1); return lane == 63 ? 0.f : t; }
DI void hy_conv8(const bf16_t* XT, int c, int bt, int tl, int lane, const float (&cw)[3][3], const float (&cb)[3], float (&x0c)[8], float (&zz)[8]) {
  float uc[3][8];
#pragma unroll
  for (int g = 0; g < 3; ++g) {
    const u32x4 raw = *(const u32x4*)(XT + (size_t)(g * 1024 + c) * NTOK + (size_t)bt * 4096 + 8 * tl);
    float pv[10];
#pragma unroll
    for (int q = 0; q < 4; ++q) { pv[1 + 2 * q] = bflo(raw[q]); pv[2 + 2 * q] = bfhi(raw[q]); }
    { const float t0 = __shfl_up(pv[8], 1), t1 = __shfl_down(pv[1], 1); pv[0] = (lane & 7) == 0 ? 0.f : t0; pv[9] = (lane & 7) == 7 ? 0.f : t1; }
#pragma unroll
    for (int e2 = 0; e2 < 8; ++e2) uc[g][e2] = cw[g][0] * pv[e2] + cw[g][1] * pv[e2 + 1] + cw[g][2] * pv[e2 + 2] + cb[g];
  }
#pragma unroll
  for (int e2 = 0; e2 < 8; ++e2) { x0c[e2] = uc[0][e2]; zz[e2] = uc[1][e2] * uc[2][e2]; }
}
template <int NV> DI void hyena_chan(const Params& p, int l, int c, LAS cplx* L, int tid) {
  bf16_t* XT = (bf16_t*)(p.ws + OFF_XT);
  const int lane = tid & 63;
  const int pb4 = 16 * tid + 2 * (tid >> 1);
  h16x2 Hr[5]; LAS h16x2* Hl = (LAS h16x2*)(L + 2 * FFT_REGION_F2) + tid;
  {
    const float* hT = (const float*)(p.ws + ((l & 1) ? OFF_HP2 : OFF_HP));
    const float* hf = hT + (size_t)c * 4096, * hbk = hT + (size_t)(1024 + c) * 4096;
    cplx f[1][16];
#pragma unroll
    for (int j = 0; j < 8; ++j) f[0][j] = mk2(__builtin_nontemporal_load(hf + tid + 512 * j), 0.f);
#pragma unroll
    for (int j = 8; j < 16; ++j) { const int n = tid + 512 * j; f[0][j] = mk2(n == 4096 ? 0.f : __builtin_nontemporal_load(hbk + (n == 4096 ? 0 : 8192 - n)), 0.f); }
    fft_fwd3<1>(f, L, tid);
#pragma unroll
    for (int m = 0; m < 8; ++m) { const cplx a = L[pb4 + 2 * m], b = L[pb4 + 2 * m + 1];
      h16x2 h0, h1; h0.x = (_Float16)((a.x + b.x) * HSCALE); h0.y = (_Float16)((a.y + b.y) * HSCALE); h1.x = (_Float16)((a.x - b.x) * HSCALE); h1.y = (_Float16)((a.y - b.y) * HSCALE);
      if (2 * m < 11) Hl[(2 * m) * 512] = h0; else Hr[2 * m - 11 < 0 ? 0 : 2 * m - 11] = h0;
      if (2 * m + 1 < 11) Hl[(2 * m + 1) * 512] = h1; else Hr[2 * m + 1 - 11 < 0 ? 0 : 2 * m + 1 - 11] = h1; }
    __syncthreads();
  }
  float cw[3][3], cb[3];
#pragma unroll
  for (int g = 0; g < 3; ++g) { cb[g] = p.conv_b[l * 3072 + g * 1024 + c];
#pragma unroll
    for (int t = 0; t < 3; ++t) cw[g][t] = p.conv_w[((size_t)l * 3 + t) * 3072 + g * 1024 + c]; }
  const float sk = p.skip[l * 1024 + c], sc = 1.f / (8192.f * HSCALE);
#pragma unroll 1
  for (int bp0 = 0; bp0 < 2; bp0 += NV) {
    int tl = tid; asm volatile("" : "+v"(tl));
#pragma unroll
    for (int i = 0; i < NV; ++i) {
      float xa[8], za[8], xb[8], zb[8];
      hy_conv8(XT, c, 2 * (bp0 + i), tl, lane, cw, cb, xa, za);
      hy_conv8(XT, c, 2 * (bp0 + i) + 1, tl, lane, cw, cb, xb, zb);
      LAS cplx* X = L + i * FFT_REGION_F2 + 8 * tl + 2 * (tl >> 2);
#pragma unroll
      for (int e2 = 0; e2 < 8; ++e2) X[e2] = mk2(za[e2], zb[e2]);

    }
    __syncthreads();
    cplx v[NV][16];
    { const int pb = tl + 2 * (tl >> 5);
#pragma unroll
      for (int i = 0; i < NV; ++i) {
#pragma unroll
        for (int j = 0; j < 8; ++j) v[i][j] = L[i * FFT_REGION_F2 + pb + 544 * j];
#pragma unroll
        for (int j = 8; j < 16; ++j) v[i][j] = mk2(0.f, 0.f); } }
    __syncthreads();

    fft_fwd3<NV>(v, L, tid);

#pragma unroll
    for (int i = 0; i < NV; ++i) {
      LAS cplx* Li = L + i * FFT_REGION_F2;
#pragma unroll
      for (int m = 0; m < 8; ++m) { const cplx a = Li[pb4 + 2 * m], b = Li[pb4 + 2 * m + 1];
        const h16x2 h0 = (2 * m < 11) ? Hl[(2 * m) * 512] : Hr[2 * m - 11 < 0 ? 0 : 2 * m - 11], h1 = (2 * m + 1 < 11) ? Hl[(2 * m + 1) * 512] : Hr[2 * m + 1 - 11 < 0 ? 0 : 2 * m + 1 - 11];
        const cplx y0 = cmul(mk2(a.x + b.x, a.y + b.y), mk2((float)h0.x, (float)h0.y)), y1 = cmul(mk2(a.x - b.x, a.y - b.y), mk2((float)h1.x, (float)h1.y));
        Li[pb4 + 2 * m] = mk2(y0.x + y1.x, y0.y + y1.y); Li[pb4 + 2 * m + 1] = mk2(y0.x - y1.x, y0.y - y1.y); }
       }
    __syncthreads();
    fft_inv3<NV>(v, L, tid);

    { const int pb = tl + 2 * (tl >> 5);
#pragma unroll
      for (int i = 0; i < NV; ++i)
#pragma unroll
        for (int j = 0; j < 8; ++j) L[i * FFT_REGION_F2 + pb + 544 * j] = v[i][brev(j, 4)]; }
    __syncthreads();
#pragma unroll
    for (int i = 0; i < NV; ++i) {
      float xa[8], za[8], xb[8], zb[8];
      hy_conv8(XT, c, 2 * (bp0 + i), tl, lane, cw, cb, xa, za);
      hy_conv8(XT, c, 2 * (bp0 + i) + 1, tl, lane, cw, cb, xb, zb);
      const LAS cplx* X = L + i * FFT_REGION_F2 + 8 * tl + 2 * (tl >> 2);
      float ya[8], yb[8];
#pragma unroll
      for (int e2 = 0; e2 < 8; ++e2) { const cplx cv = X[e2]; ya[e2] = xa[e2] * (cv.x * sc + sk * za[e2]); yb[e2] = xb[e2] * (cv.y * sc + sk * zb[e2]); }
      *(u32x4*)(XT + (size_t)c * NTOK + (size_t)(2 * (bp0 + i)) * 4096 + 8 * tl) = (u32x4){pk2(ya[0], ya[1]), pk2(ya[2], ya[3]), pk2(ya[4], ya[5]), pk2(ya[6], ya[7])};
      *(u32x4*)(XT + (size_t)c * NTOK + (size_t)(2 * (bp0 + i) + 1) * 4096 + 8 * tl) = (u32x4){pk2(yb[0], yb[1]), pk2(yb[2], yb[3]), pk2(yb[4], yb[5]), pk2(yb[6], yb[7])};

    }
    __syncthreads();
  }
}

DI void hyena_ctx_item(const Params& p, int l, int c, LAS unsigned char* lds) {
  LAS float* zs = (LAS float*)lds;
  LAS float* hc = zs + 1024;
  LAS float* part = hc + 512;
  bf16_t* XT = (bf16_t*)(p.ws + OFF_XT);
  const float* hTc = (const float*)(p.ws + ((l & 1) ? OFF_HTC2 : OFF_HTC));
  const int tid = otid();
  { const int i = tid - 256; hc[tid] = i >= 0 ? hTc[(size_t)c * 256 + i] : (tid == 0 ? 0.f : hTc[(size_t)(1024 + c) * 256 + (-i)]); }
  float u0[2];
  { const int b = tid >> 7, tq = tid & 127;
#pragma unroll
    for (int e = 0; e < 2; ++e) {
      const int t = tq + 128 * e;
      float uu[3];
#pragma unroll
      for (int g = 0; g < 3; ++g) {
        const bf16_t* row = XT + (size_t)(g * 1024 + c) * NTOK + NLAT + b * 256;
        const float pm = t > 0 ? bf2f(row[t - 1]) : 0.f, p0 = bf2f(row[t]), pp = t < 255 ? bf2f(row[t + 1]) : 0.f;
        const size_t wb = (size_t)l * 3 * 3072 + g * 1024 + c;
        uu[g] = p.conv_w[wb] * pm + p.conv_w[wb + 3072] * p0 + p.conv_w[wb + 6144] * pp + p.conv_b[l * 3072 + g * 1024 + c];
      }
      u0[e] = uu[0]; zs[b * 256 + t] = uu[1] * uu[2];
    } }
  __syncthreads();
  const int t0 = 4 * (tid & 63), cbatch = (tid >> 6) & 3, sh = tid >> 8;
  float y[4] = {0.f, 0.f, 0.f, 0.f};
#pragma unroll 4
  for (int s0 = 128 * sh; s0 < 128 * sh + 128; s0 += 4) {
    const int base = 256 + t0 - s0 - 4;
    const f32x4 H0 = *(const LAS f32x4*)(hc + base), H1 = *(const LAS f32x4*)(hc + base + 4), z4 = *(const LAS f32x4*)(zs + cbatch * 256 + s0);
    const float hw[8] = {H0.x, H0.y, H0.z, H0.w, H1.x, H1.y, H1.z, H1.w}, zv[4] = {z4.x, z4.y, z4.z, z4.w};
#pragma unroll
    for (int j = 0; j < 4; ++j)
#pragma unroll
      for (int u = 0; u < 4; ++u) y[j] += hw[4 + j - u] * zv[u];
  }
  if (sh) *(LAS f32x4*)(part + cbatch * 256 + t0) = (f32x4){y[0], y[1], y[2], y[3]};
  __syncthreads();
  if (!sh) { const f32x4 o = *(const LAS f32x4*)(part + cbatch * 256 + t0); part[cbatch * 256 + t0] = y[0] + o.x; part[cbatch * 256 + t0 + 1] = y[1] + o.y; part[cbatch * 256 + t0 + 2] = y[2] + o.z; part[cbatch * 256 + t0 + 3] = y[3] + o.w; }
  __syncthreads();
  { const int b = tid >> 7, tq = tid & 127; const float sk = p.skip[l * 1024 + c];
#pragma unroll
    for (int e = 0; e < 2; ++e) { const int t = tq + 128 * e;
      XT[(size_t)c * NTOK + NLAT + b * 256 + t] = f2bf(u0[e] * (part[b * 256 + t] + sk * zs[b * 256 + t])); } }
  __syncthreads();
}

#ifndef HY_NV
#define HY_NV 2
#endif
#define MFMA32(a, b, c) __builtin_amdgcn_mfma_f32_32x32x16_bf16((a), (b), (c), 0, 0, 0)
DI float logsig(float x) { return fminf(x, 0.f) - __logf(1.f + __expf(-fabsf(x))); }
DI void phase_gla_prep(const Params& p, int l, LAS unsigned char* lds) {
  LAS float* lrs = (LAS float*)lds;
  LAS float* tots = lrs + 64 * 32;
  LAS bf16_t* qs = (LAS bf16_t*)(tots + 2 * 4 * 128);
  LAS bf16_t* kes = qs + 4 * 64 * 136;
  LAS bf16_t* ats = kes + 2 * 128 * 72;
  const int tid = otid(), d = tid & 127, tq = tid >> 7, wid = tid >> 6, lane = tid & 63;
  const bf16_t* PB = (const bf16_t*)(p.ws + OFF_PB);
  const float* LR = (const float*)(p.ws + OFF_LR);
  bf16_t* QF = (bf16_t*)(p.ws + OFF_QF); bf16_t* QB = (bf16_t*)(p.ws + OFF_QB);
  bf16_t* KEF = (bf16_t*)(p.ws + OFF_KEF); bf16_t* KEB = (bf16_t*)(p.ws + OFF_KEB);
  bf16_t* ATT = (bf16_t*)(p.ws + OFF_ATT); float* DEC = (float*)(p.ws + OFF_DEC);
  const float qscale = 0.08838834764831845f;
  f32x4 lrv; bf16_t qv[16], kv[16];
#define PREP_LOAD(it_) do { const int ch_ = (it_) >> 2, hh_ = (it_) & 3; const size_t t0_ = (size_t)ch_ * 64; lrv = *(const f32x4*)(LR + t0_ * 32 + 4 * tid); \
    _Pragma("unroll") for (int i = 0; i < 16; ++i) { const size_t tk_ = t0_ + tq * 16 + i; qv[i] = PB[tk_ * 4096 + hh_ * 128 + d]; kv[i] = PB[tk_ * 4096 + 512 + hh_ * 128 + d]; } } while (0)
  float gwf[16], gwb[16], gbf = 0.f, gbb = 0.f;
#define PREP_LOADG(it_) do { const int hh_ = (it_) & 3; \
    _Pragma("unroll") for (int r = 0; r < 16; ++r) { gwf[r] = p.gate_w[(((size_t)l * 2 + 0) * 16 + r) * 512 + hh_ * 128 + d]; gwb[r] = p.gate_w[(((size_t)l * 2 + 1) * 16 + r) * 512 + hh_ * 128 + d]; } \
    gbf = p.gate_b[((size_t)l * 2 + 0) * 512 + hh_ * 128 + d]; gbb = p.gate_b[((size_t)l * 2 + 1) * 512 + hh_ * 128 + d]; } while (0)
  if ((int)blockIdx.x < 272 * 4) PREP_LOAD((int)blockIdx.x);
  for (int it = blockIdx.x; it < 272 * 4; it += gridDim.x) {
    const int chunk = it >> 2, h = it & 3, tok0 = chunk * 64;
    *(LAS f32x4*)(lrs + 4 * tid) = lrv;
    PREP_LOADG(it);
    __syncthreads();
    float cf[16], cb[16];
#pragma unroll
    for (int i = 0; i < 16; ++i) {
      const int t = tq * 16 + i; float pf = gbf, pb = gbb;
#pragma unroll
      for (int r4 = 0; r4 < 4; ++r4) { const f32x4 lf = *(const LAS f32x4*)(lrs + t * 32 + 4 * r4), lb = *(const LAS f32x4*)(lrs + t * 32 + 16 + 4 * r4);
        pf += lf.x * gwf[4 * r4] + lf.y * gwf[4 * r4 + 1] + lf.z * gwf[4 * r4 + 2] + lf.w * gwf[4 * r4 + 3]; pb += lb.x * gwb[4 * r4] + lb.y * gwb[4 * r4 + 1] + lb.z * gwb[4 * r4 + 2] + lb.w * gwb[4 * r4 + 3]; }
      cf[i] = logsig(pf) * (1.f / 16.f); cb[i] = logsig(pb) * (1.f / 16.f);
    }
    { float run = 0.f;
#pragma unroll
      for (int i = 0; i < 16; ++i) { run += cf[i]; cf[i] = run; }
      tots[(0 * 4 + tq) * 128 + d] = run; run = 0.f;
#pragma unroll
      for (int i = 15; i >= 0; --i) { run += cb[i]; cb[i] = run; }
      tots[(1 * 4 + tq) * 128 + d] = run; }
    __syncthreads();
    float offf = 0.f, offb = 0.f, cendf = 0.f, cendb = 0.f;
#pragma unroll
    for (int q = 0; q < 4; ++q) { const float a = tots[(0 * 4 + q) * 128 + d], b = tots[(1 * 4 + q) * 128 + d]; cendf += a; cendb += b; if (q < tq) offf += a; if (q > tq) offb += b; }
    const int o16 = d & 15, grp = o16 >> 2, ngrp = (grp == 1) ? 2 : (grp == 2) ? 1 : grp, permd = (d & ~15) | (ngrp << 2) | (o16 & 3);
    unsigned kef[8], keb[8];
    const float ecf = __expf(cendf), ecb = __expf(cendb);
#pragma unroll
    for (int i = 0; i < 16; ++i) {
      const int t = tq * 16 + i; const size_t tok = (size_t)tok0 + t;
      const float q = bf2f(qv[i]) * qscale, k = bf2f(kv[i]);
      const float ea = __expf(cf[i] + offf), eb2 = __expf(cb[i] + offb);
      const float kia = k * __builtin_amdgcn_rcpf(ea), kib = k * __builtin_amdgcn_rcpf(eb2);
      const bf16_t qf = f2bf(q * ea), kf = f2bf(kia), qb = f2bf(q * eb2), kb = f2bf(kib);
      const bf16_t ef = f2bf(kia * ecf), eb = f2bf(kib * ecb);
      qs[(0 * 64 + t) * 136 + d] = qf; qs[(1 * 64 + t) * 136 + d] = kf; qs[(2 * 64 + t) * 136 + d] = qb; qs[(3 * 64 + t) * 136 + d] = kb;
      QF[tok * 512 + h * 128 + permd] = qf; QB[tok * 512 + h * 128 + permd] = qb;
      if (i & 1) { kef[i >> 1] |= (unsigned)ef << 16; keb[i >> 1] |= (unsigned)eb << 16; } else { kef[i >> 1] = ef; keb[i >> 1] = eb; }
    }
    if (it + (int)gridDim.x < 272 * 4) PREP_LOAD(it + (int)gridDim.x);
    { LAS u32x4* d1 = (LAS u32x4*)(kes + (0 * 128 + d) * 72 + tq * 16); d1[0] = (u32x4){kef[0], kef[1], kef[2], kef[3]}; d1[1] = (u32x4){kef[4], kef[5], kef[6], kef[7]};
      LAS u32x4* d2 = (LAS u32x4*)(kes + (1 * 128 + d) * 72 + tq * 16); d2[0] = (u32x4){keb[0], keb[1], keb[2], keb[3]}; d2[1] = (u32x4){keb[4], keb[5], keb[6], keb[7]}; }
    if (tq == 0) { DEC[(((size_t)chunk * 4 + h) * 2 + 0) * 128 + d] = ecf; DEC[(((size_t)chunk * 4 + h) * 2 + 1) * 128 + d] = ecb; }
    __syncthreads();
    {
      const int dir = wid >> 2, ti = (wid >> 1) & 1, si = wid & 1, r = lane & 31, hh = lane >> 5;
      const LAS bf16_t* ka = qs + ((dir * 2 + 1) * 64 + 32 * si + r) * 136 + 8 * hh;
      const LAS bf16_t* qa = qs + ((dir * 2 + 0) * 64 + 32 * ti + r) * 136 + 8 * hh;
      f32x16 acc;
#pragma unroll
      for (int i = 0; i < 16; ++i) acc[i] = 0.f;
#pragma unroll
      for (int ks = 0; ks < 8; ++ks) acc = MFMA32(*(const LAS bf16x8*)(ka + 16 * ks), *(const LAS bf16x8*)(qa + 16 * ks), acc);
      const int t = 32 * ti + r;
      LAS bf16_t* dst = ats + (dir * 64 + t) * 72 + 32 * si + 4 * hh;
#pragma unroll
      for (int g = 0; g < 4; ++g) {
        float vv[4];
#pragma unroll
        for (int e = 0; e < 4; ++e) { const int s = 32 * si + 8 * g + 4 * hh + e; const bool keep = dir ? (s >= t) : (s <= t); vv[e] = keep ? acc[4 * g + e] : 0.f; }
        *(LAS u32x2*)(dst + 8 * g) = (u32x2){pk2(vv[0], vv[1]), pk2(vv[2], vv[3])};
      }
    }
    __syncthreads();
    {
      const size_t chh = (size_t)chunk * 4 + h;
#pragma unroll
      for (int q = 0; q < 2; ++q) { const int pc = tid + 512 * q, row = pc >> 3, cc = pc & 7;
        *(u32x4*)(KEF + (chh * 128 + row) * 64 + 8 * cc) = *(const LAS u32x4*)(kes + (0 * 128 + row) * 72 + 8 * cc);
        *(u32x4*)(KEB + (chh * 128 + row) * 64 + 8 * cc) = *(const LAS u32x4*)(kes + (1 * 128 + row) * 72 + 8 * cc);
        const int rr = row & 63, dd = row >> 6;
        *(u32x4*)(ATT + ((chh * 2 + dd) * 64 + rr) * 64 + 8 * cc) = *(const LAS u32x4*)(ats + (dd * 64 + rr) * 72 + 8 * cc); }
    }
    __syncthreads();
  }
}

#undef PREP_LOAD
#undef PREP_LOADG
DI bf16x8 pack8(const f32x16& x, int s) {
  u32x4 r; r[0] = pk2(x[8 * s + 0], x[8 * s + 1]); r[1] = pk2(x[8 * s + 2], x[8 * s + 3]); r[2] = pk2(x[8 * s + 4], x[8 * s + 5]); r[3] = pk2(x[8 * s + 6], x[8 * s + 7]);
  return __builtin_bit_cast(bf16x8, r);
}
DI void phase_gla_scan(const Params& p, LAS unsigned char* lds) {
  constexpr int BUFB = 64 * 136 * 2 + 128 * 72 * 2 + 64 * 72 * 2 + 512;
  const int tid = otid(), wid = tid >> 6, lane = tid & 63, r = lane & 31, hh = lane >> 5;
  const int bid = blockIdx.x, b = bid >> 4, h = (bid >> 2) & 3, dir = (bid >> 1) & 1, dvh = bid & 1;
  const bool cwave = wid < 4;
  const bf16_t* Qg = (const bf16_t*)(p.ws + (dir ? OFF_QB : OFF_QF));
  const bf16_t* Kg = (const bf16_t*)(p.ws + (dir ? OFF_KEB : OFF_KEF));
  const bf16_t* ATT = (const bf16_t*)(p.ws + OFF_ATT); const float* DEC = (const float*)(p.ws + OFF_DEC);
  const bf16_t* VT = (const bf16_t*)(p.ws + OFF_XT) + (size_t)(3072 + h * 256 + 128 * dvh + 32 * (wid & 3) + r) * NTOK + 8 * hh;
  bf16_t* Og = (dir ? (bf16_t*)(p.ws + OFF_X) : (bf16_t*)(p.ws + OFF_PB)) + h * 256 + 128 * dvh;
  const int ldo = dir ? 1024 : 4096;
  const int qrow0 = tid >> 4, qcc = tid & 15, krow0 = tid >> 3, kcc = tid & 7;
  constexpr int OBUF = 64 * 264 * 2;
  LAS unsigned char* obase = lds + 2 * BUFB;
  f32x16 S[4];
#pragma unroll
  for (int m = 0; m < 4; ++m)
#pragma unroll
    for (int i = 0; i < 16; ++i) S[m][i] = 0.f;
  u32x4 pq0, pq1, pk0, pk1, pa; float pdc = 0.f; bf16x8 vf[4], vn[2];
#define SCAN_CIDX(st) ((st) < 4 ? (256 + 4 * b + (dir ? 3 - (st) : (st))) : (64 * b + (dir ? 67 - (st) : (st) - 4)))
#define SCAN_LOAD(st) do { const int ci_ = SCAN_CIDX(st); const size_t tk_ = (size_t)ci_ * 64, ch_ = (size_t)ci_ * 4 + h; \
    pq0 = *(const u32x4*)(Qg + (tk_ + qrow0) * 512 + h * 128 + 8 * qcc); pq1 = *(const u32x4*)(Qg + (tk_ + qrow0 + 32) * 512 + h * 128 + 8 * qcc); \
    pk0 = *(const u32x4*)(Kg + (ch_ * 128 + krow0) * 64 + 8 * kcc); pk1 = *(const u32x4*)(Kg + (ch_ * 128 + krow0 + 64) * 64 + 8 * kcc); \
    pa = *(const u32x4*)(ATT + ((ch_ * 2 + dir) * 64 + krow0) * 64 + 8 * kcc); if (tid < 128) pdc = DEC[(ch_ * 2 + dir) * 128 + tid]; \
 } while (0)
#define SCAN_LOADV(st, vv, k0_, k1_) do { const size_t tkv_ = (size_t)SCAN_CIDX(st) * 64; _Pragma("unroll") for (int ks = (k0_); ks < (k1_); ++ks) vv[ks - (k0_)] = *(const bf16x8*)(VT + tkv_ + 16 * ks); } while (0)
#define SCAN_STORE(bufi) do { LAS unsigned char* bb_ = lds + (bufi) * BUFB; LAS bf16_t* QT_ = (LAS bf16_t*)bb_; LAS bf16_t* KE_ = QT_ + 64 * 136; LAS bf16_t* AT_ = KE_ + 128 * 72; LAS float* DC_ = (LAS float*)(AT_ + 64 * 72); \
    *(LAS u32x4*)(QT_ + qrow0 * 136 + 8 * qcc) = pq0; *(LAS u32x4*)(QT_ + (qrow0 + 32) * 136 + 8 * qcc) = pq1; \
    *(LAS u32x4*)(KE_ + krow0 * 72 + 8 * kcc) = pk0; *(LAS u32x4*)(KE_ + (krow0 + 64) * 72 + 8 * kcc) = pk1; \
    *(LAS u32x4*)(AT_ + krow0 * 72 + 8 * kcc) = pa; if (tid < 128) DC_[tid] = pdc; } while (0)
#define SCAN_WRITEOUT(st) do { if (!cwave) { const size_t tk_ = (size_t)SCAN_CIDX(st) * 64; const LAS bf16_t* ob_ = (const LAS bf16_t*)(obase + ((st) & 1) * OBUF); \
    _Pragma("unroll 1") for (int q = 0; q < 4; ++q) { const int pc_ = (tid - 256) + 256 * q, row_ = pc_ >> 4, cc_ = pc_ & 15; \
      *(u32x4*)(Og + (tk_ + row_) * ldo + 8 * cc_) = *(const LAS u32x4*)(ob_ + row_ * 264 + 8 * cc_); } } } while (0)
  SCAN_LOAD(0); SCAN_STORE(0); SCAN_LOADV(0, vf, 0, 4); SCAN_LOAD(1);
  __syncthreads();
#pragma unroll 1
  for (int step = 0; step < 68; ++step) {
    const size_t tok0 = (size_t)SCAN_CIDX(step) * 64;
    if (step > 0) SCAN_WRITEOUT(step - 1);
    if (cwave && step + 1 < 68) SCAN_LOADV(step + 1, vn, 0, 2);
    LAS unsigned char* bb = lds + (step & 1) * BUFB;
    const LAS bf16_t* QT = (const LAS bf16_t*)bb; const LAS bf16_t* KE = QT + 64 * 136; const LAS bf16_t* AT = KE + 128 * 72; const LAS float* DC = (const LAS float*)(AT + 64 * 72);
    if (cwave) {
    f32x16 o0, o1;
#pragma unroll
    for (int i = 0; i < 16; ++i) { o0[i] = 0.f; o1[i] = 0.f; }
#pragma unroll
    for (int ks = 0; ks < 4; ++ks) {
      o0 = MFMA32(vf[ks], *(const LAS bf16x8*)(AT + r * 72 + 16 * ks + 8 * hh), o0);
      o1 = MFMA32(vf[ks], *(const LAS bf16x8*)(AT + (32 + r) * 72 + 16 * ks + 8 * hh), o1);
    }
#pragma unroll
    for (int k8 = 0; k8 < 8; ++k8) {
      const bf16x8 spk = pack8(S[k8 >> 1], k8 & 1);
      o0 = MFMA32(spk, *(const LAS bf16x8*)(QT + r * 136 + 16 * k8 + 8 * hh), o0);
      o1 = MFMA32(spk, *(const LAS bf16x8*)(QT + (32 + r) * 136 + 16 * k8 + 8 * hh), o1);
    }
#pragma unroll
    for (int m = 0; m < 4; ++m) {
#pragma unroll
      for (int g = 0; g < 4; ++g) { const f32x4 dv = *(const LAS f32x4*)(DC + 32 * m + 8 * g + 4 * hh);
        S[m][4 * g] *= dv.x; S[m][4 * g + 1] *= dv.y; S[m][4 * g + 2] *= dv.z; S[m][4 * g + 3] *= dv.w; }
#pragma unroll
      for (int ks = 0; ks < 4; ++ks) S[m] = MFMA32(*(const LAS bf16x8*)(KE + (32 * m + r) * 72 + 16 * ks + 8 * hh), vf[ks], S[m]);
    }
    { LAS bf16_t* ob = (LAS bf16_t*)(obase + (step & 1) * OBUF) + r * 264 + 32 * wid + 4 * hh;
#pragma unroll
      for (int g = 0; g < 4; ++g) {
        *(LAS u32x2*)(ob + 8 * g) = (u32x2){pk2(o0[4 * g], o0[4 * g + 1]), pk2(o0[4 * g + 2], o0[4 * g + 3])};
        *(LAS u32x2*)(ob + 32 * 264 + 8 * g) = (u32x2){pk2(o1[4 * g], o1[4 * g + 1]), pk2(o1[4 * g + 2], o1[4 * g + 3])};
      } }
    }
    if (step + 1 < 68) { if (cwave) { vf[0] = vn[0]; vf[1] = vn[1]; const size_t tkv2 = (size_t)SCAN_CIDX(step + 1) * 64; vf[2] = *(const bf16x8*)(VT + tkv2 + 32); vf[3] = *(const bf16x8*)(VT + tkv2 + 48); }
      SCAN_STORE((step + 1) & 1); }
    if (step + 2 < 68) SCAN_LOAD(step + 2);
    __syncthreads();
  }
  SCAN_WRITEOUT(67);
  __syncthreads();
#undef SCAN_WRITEOUT
#undef SCAN_CIDX
#undef SCAN_LOAD
#undef SCAN_LOADV
#undef SCAN_STORE
}

DI void phase_post(const Params& p, int l, int ntok, LAS unsigned char* lds) {
  const int tid = otid(), lane = tid & 63;
  { const int gw = blockIdx.x * 8 + (tid >> 6), nw = gridDim.x * 8, l32 = lane & 31, hsel = lane >> 5;
    const bf16_t* PB = (const bf16_t*)(p.ws + OFF_PB); bf16_t* HB = (bf16_t*)(p.ws + OFF_X);
    const f32x4 ng0 = *(const f32x4*)(p.gla_ng + l * 256 + 8 * l32), ng1 = *(const f32x4*)(p.gla_ng + l * 256 + 8 * l32 + 4);
    u32x4 na, nb, nr;
    if (gw < ntok * 2) { const size_t tk = gw >> 1; const int cl = ((gw & 1) * 2 + hsel) * 256 + 8 * l32; na = __builtin_nontemporal_load((const u32x4*)(PB + tk * 4096 + cl)); nb = __builtin_nontemporal_load((const u32x4*)(HB + tk * 1024 + cl)); nr = __builtin_nontemporal_load((const u32x4*)(PB + tk * 4096 + 1024 + cl)); }
    for (int it = gw; it < ntok * 2; it += nw) {
      const size_t tok = it >> 1; const int col = ((it & 1) * 2 + hsel) * 256 + 8 * l32;
      const u32x4 a = na, b = nb, rr = nr;
      if (it + nw < ntok * 2) { const int i2 = it + nw; const size_t tk = i2 >> 1; const int cl = ((i2 & 1) * 2 + hsel) * 256 + 8 * l32; na = __builtin_nontemporal_load((const u32x4*)(PB + tk * 4096 + cl)); nb = __builtin_nontemporal_load((const u32x4*)(HB + tk * 1024 + cl)); nr = __builtin_nontemporal_load((const u32x4*)(PB + tk * 4096 + 1024 + cl)); }
      float o[8], rv[8];
#pragma unroll
      for (int i = 0; i < 4; ++i) { o[2 * i] = bflo(a[i]) + bflo(b[i]); o[2 * i + 1] = bfhi(a[i]) + bfhi(b[i]); rv[2 * i] = bflo(rr[i]); rv[2 * i + 1] = bfhi(rr[i]); }
      float ss = 0.f;
#pragma unroll
      for (int i = 0; i < 8; ++i) ss += o[i] * o[i];
#pragma unroll
      for (int q = 16; q >= 1; q >>= 1) ss += __shfl_xor(ss, q);
      const float rstd = rsqrtf(ss * (1.f / 256.f) + EPSF);
      const float ngv[8] = {ng0.x, ng0.y, ng0.z, ng0.w, ng1.x, ng1.y, ng1.z, ng1.w};
      float y[8];
#pragma unroll
      for (int i = 0; i < 8; ++i) y[i] = o[i] * rstd * ngv[i] * (rv[i] * sigm(rv[i]));
      *(u32x4*)(HB + tok * 1024 + col) = (u32x4){pk2(y[0], y[1]), pk2(y[2], y[3]), pk2(y[4], y[5]), pk2(y[6], y[7])};
    } }
  { LAS bf16_t* t = (LAS bf16_t*)lds;
    const bf16_t* XT = (const bf16_t*)(p.ws + OFF_XT); bf16_t* YH = (bf16_t*)(p.ws + OFF_QF);
    const int ntt = ntok / 128;
    u32x4 pre[2];
#define POST_TLOAD(it_) do { const int c0_ = ((it_) / ntt) * 64, tk0_ = ((it_) % ntt) * 128; \
      _Pragma("unroll") for (int q = 0; q < 2; ++q) { const int pc = tid + 512 * q, cc = pc >> 4, tq = pc & 15; pre[q] = *(const u32x4*)(XT + (size_t)(c0_ + cc) * NTOK + tk0_ + 8 * tq); } } while (0)
    if ((int)blockIdx.x < 16 * ntt) POST_TLOAD((int)blockIdx.x);
    for (int it = blockIdx.x; it < 16 * ntt; it += gridDim.x) {
      const int c0 = (it / ntt) * 64, tok0 = (it % ntt) * 128;
#pragma unroll
      for (int q = 0; q < 2; ++q) { const int pc = tid + 512 * q, cc = pc >> 4, tq = pc & 15; *(LAS u32x4*)(t + cc * 136 + 8 * tq) = pre[q]; }
      if (it + (int)gridDim.x < 16 * ntt) POST_TLOAD(it + (int)gridDim.x);
      __syncthreads();
#pragma unroll
      for (int q = 0; q < 2; ++q) { const int pc = tid + 512 * q, tk = pc >> 3, cq = pc & 7; unsigned w[4];
#pragma unroll
        for (int i = 0; i < 4; ++i) w[i] = (unsigned)t[(8 * cq + 2 * i) * 136 + tk] | ((unsigned)t[(8 * cq + 2 * i + 1) * 136 + tk] << 16);
        *(u32x4*)(YH + (size_t)(tok0 + tk) * 1024 + c0 + 8 * cq) = (u32x4){w[0], w[1], w[2], w[3]}; }
      __syncthreads();
    } }
}

#undef POST_TLOAD
struct SchedG1 : pg8::StaticOrder {
  __device__ bool next(int i, pg8::Unit& u) const {
    pg8::Unit v; if (!pg8::StaticOrder::next(i, v)) return false;
    if (v.pn < 16) { u.pm = 68 + v.pn; u.pn = v.pm; } else { u.pm = v.pm; u.pn = 68 + v.pn; }
    return true;
  }
};
typedef const f32x4 (&AccRef)[2][2][4][2];
DI u32x4 pack_acc8(f32x4 v0, f32x4 v1) { return (u32x4){pk2(v0[0], v0[1]), pk2(v0[2], v0[3]), pk2(v1[0], v1[1]), pk2(v1[2], v1[3])}; }
struct EpiG1 {
  static constexpr bool PERM = true, AFTER_DRAIN = false;
  bf16_t* XT; bf16_t* PB; float* LR;
  DI void operator()(AccRef acc, const pg8::Unit& u, int wr, int wc, int fr, int fq) const {
    if (u.pm >= 68) {
      const int ch0 = (u.pm - 68) * 256 + wr * 64 + fr, tk0 = u.pn * 256 + wc * 32 + 8 * fq;
#pragma unroll
      for (int ai = 0; ai < 2; ++ai)
#pragma unroll
        for (int m = 0; m < 4; ++m) { bf16_t* rp = XT + (size_t)(ch0 + ai * 128 + m * 16) * NTOK + tk0;
#pragma unroll
          for (int bj = 0; bj < 2; ++bj) *(u32x4*)(rp + bj * 128) = pack_acc8(acc[ai][bj][m][0], acc[ai][bj][m][1]); }
    } else {
      const int wp = u.pn - 84, row0 = u.pm * 256 + wr * 64 + fr, col0 = wp * 256 + wc * 32 + 8 * fq;
      if (wp < 16) {
#pragma unroll
        for (int ai = 0; ai < 2; ++ai)
#pragma unroll
          for (int m = 0; m < 4; ++m) { bf16_t* rp = PB + (size_t)(row0 + ai * 128 + m * 16) * 4096 + col0;
#pragma unroll
            for (int bj = 0; bj < 2; ++bj) *(u32x4*)(rp + bj * 128) = pack_acc8(acc[ai][bj][m][0], acc[ai][bj][m][1]); }
      } else if (wc == 0) {
#pragma unroll
        for (int ai = 0; ai < 2; ++ai)
#pragma unroll
          for (int m = 0; m < 4; ++m) { float* rp = LR + (size_t)(row0 + ai * 128 + m * 16) * 32 + 8 * fq; *(f32x4*)rp = acc[ai][0][m][0]; *(f32x4*)(rp + 4) = acc[ai][0][m][1]; }
      }
    }
  }
};
template <int MODE> struct EpiGate {
  static constexpr bool PERM = true, AFTER_DRAIN = false;
  const bf16_t* PB; bf16_t* T1; bf16_t* MG;
  DI void operator()(AccRef acc, const pg8::Unit& u, int wr, int wc, int fr, int fq) const {
    const int row0 = u.pm * 256 + wr * 64 + fr, col0 = u.pn * 256 + wc * 32 + 8 * fq;
#pragma unroll
    for (int ai = 0; ai < 2; ++ai)
#pragma unroll
      for (int m = 0; m < 4; ++m) { const size_t row = (size_t)(row0 + ai * 128 + m * 16);
#pragma unroll
        for (int bj = 0; bj < 2; ++bj) { const int col = col0 + bj * 128;
          const u32x4 g = *(const u32x4*)(PB + row * 4096 + (MODE ? 3072 : 2048) + col);
          const f32x4 v0 = acc[ai][bj][m][0], v1 = acc[ai][bj][m][1];
          float o[8] = {v0[0] * sigm(bflo(g[0])), v0[1] * sigm(bfhi(g[0])), v0[2] * sigm(bflo(g[1])), v0[3] * sigm(bfhi(g[1])),
                        v1[0] * sigm(bflo(g[2])), v1[1] * sigm(bfhi(g[2])), v1[2] * sigm(bflo(g[3])), v1[3] * sigm(bfhi(g[3]))};
          if (MODE) { const u32x4 t = *(const u32x4*)(T1 + row * 1024 + col);
            o[0] += bflo(t[0]); o[1] += bfhi(t[0]); o[2] += bflo(t[1]); o[3] += bfhi(t[1]); o[4] += bflo(t[2]); o[5] += bfhi(t[2]); o[6] += bflo(t[3]); o[7] += bfhi(t[3]); }
          *(u32x4*)((MODE ? MG : T1) + row * 1024 + col) = (u32x4){pk2(o[0], o[1]), pk2(o[2], o[3]), pk2(o[4], o[5]), pk2(o[6], o[7])}; } }
  }
};
struct EpiRes {
  static constexpr bool PERM = false, AFTER_DRAIN = false;
  float* out; float* ctxs; const float* modl; int goff; const float* src_lat; const float* src_ctx;
  DI void operator()(AccRef acc, const pg8::Unit& u, int wr, int wc, int fr, int fq) const {
    const int row0 = u.pm * 256 + wr * 64 + fr, col0 = u.pn * 256 + wc * 32 + 4 * fq;
    const float* gv = modl + (size_t)(u.pm < 64 ? (u.pm >> 4) : 4) * 6144 + goff + col0;
    f32x4 gg[2][2];
#pragma unroll
    for (int bj = 0; bj < 2; ++bj)
#pragma unroll
      for (int n = 0; n < 2; ++n) gg[bj][n] = *(const f32x4*)(gv + bj * 128 + n * 16);
#pragma unroll
    for (int ai = 0; ai < 2; ++ai)
#pragma unroll
      for (int m = 0; m < 4; ++m) { const int row = row0 + ai * 128 + m * 16;
        float* rp = (row < NLAT ? out + (size_t)row * 1024 : ctxs + (size_t)(row - NLAT) * 1024) + col0;
        const float* sp = (row < NLAT ? src_lat + (size_t)row * 1024 : src_ctx + (size_t)(row - NLAT) * 1024) + col0;
#pragma unroll
        for (int bj = 0; bj < 2; ++bj)
#pragma unroll
          for (int n = 0; n < 2; ++n) { f32x4* q = (f32x4*)(rp + bj * 128 + n * 16); *q = *(const f32x4*)(sp + bj * 128 + n * 16) + gg[bj][n] * acc[ai][bj][m][n]; } }
  }
};
struct EpiRelu2 {
  static constexpr bool PERM = true, AFTER_DRAIN = false;
  bf16_t* O;
  DI void operator()(AccRef acc, const pg8::Unit& u, int wr, int wc, int fr, int fq) const {
    const int row0 = u.pm * 256 + wr * 64 + fr, col0 = u.pn * 256 + wc * 32 + 8 * fq;
#pragma unroll
    for (int ai = 0; ai < 2; ++ai)
#pragma unroll
      for (int m = 0; m < 4; ++m) { bf16_t* rp = O + (size_t)(row0 + ai * 128 + m * 16) * 4096 + col0;
#pragma unroll
        for (int bj = 0; bj < 2; ++bj) { f32x4 v0 = acc[ai][bj][m][0], v1 = acc[ai][bj][m][1];
#pragma unroll
          for (int e = 0; e < 4; ++e) { const float a = fmaxf(v0[e], 0.f), b = fmaxf(v1[e], 0.f); v0[e] = a * a; v1[e] = b * b; }
          *(u32x4*)(rp + bj * 128) = pack_acc8(v0, v1); } }
  }
};

#define MFMA16(a, b, c) __builtin_amdgcn_mfma_f32_16x16x32_bf16((a), (b), (c), 0, 0, 0)
template <class F> DI void ctx_gemm(const bf16_t* A, const bf16_t* Bt, int K, int N, LAS unsigned char* lds, const F& epi) {
  constexpr int LDT = 136, TILEB = 64 * LDT * 2;
  const int tid = otid(), wid = tid >> 6, lane = tid & 63, fr = lane & 15, fq = lane >> 4, wm = wid >> 1, wn = wid & 1;
  const int ntn = N / 64, ntiles = 16 * ntn, nk = K / 128;
  const int lrow = tid >> 4, lcc = tid & 15;
  for (int t0 = blockIdx.x; t0 < ntiles; t0 += gridDim.x) {
    int tile = t0;
    if (ntiles == 256 && gridDim.x == 256) { const int x = t0 & 7, idx = t0 >> 3; tile = (4 * (x >> 1) + (idx >> 3)) * 16 + 8 * (x & 1) + (idx & 7); }
    const int tm = tile / ntn, tn = tile % ntn;
    const bf16_t* Ab = A + (size_t)(tm * 64 + lrow) * K + 8 * lcc; const bf16_t* Bb = Bt + (size_t)(tn * 64 + lrow) * K + 8 * lcc;
    const size_t r32 = (size_t)32 * K;
    u32x4 ra0, ra1, rb0, rb1, sa0, sa1, sb0, sb1;
#define CG_LOAD(x0, x1, y0, y1, kt_) do { const int ko_ = (kt_) * 128; x0 = *(const u32x4*)(Ab + ko_); x1 = *(const u32x4*)(Ab + r32 + ko_); y0 = *(const u32x4*)(Bb + ko_); y1 = *(const u32x4*)(Bb + r32 + ko_); } while (0)
#define CG_STORE(x0, x1, y0, y1, bufi) do { LAS bf16_t* dA_ = (LAS bf16_t*)(lds + (bufi) * 2 * TILEB); LAS bf16_t* dB_ = (LAS bf16_t*)(lds + (bufi) * 2 * TILEB + TILEB); \
    *(LAS u32x4*)(dA_ + lrow * LDT + 8 * lcc) = x0; *(LAS u32x4*)(dA_ + (lrow + 32) * LDT + 8 * lcc) = x1; *(LAS u32x4*)(dB_ + lrow * LDT + 8 * lcc) = y0; *(LAS u32x4*)(dB_ + (lrow + 32) * LDT + 8 * lcc) = y1; } while (0)
#define CG_COMPUTE(bufi) do { const LAS bf16_t* sA_ = (const LAS bf16_t*)(lds + (bufi) * 2 * TILEB); const LAS bf16_t* sB_ = (const LAS bf16_t*)(lds + (bufi) * 2 * TILEB + TILEB); \
    _Pragma("unroll") for (int ks = 0; ks < 4; ++ks) { const bf16x8 af = *(const LAS bf16x8*)(sA_ + (16 * wm + fr) * LDT + 32 * ks + 8 * fq); \
      const bf16x8 b0 = *(const LAS bf16x8*)(sB_ + (32 * wn + fr) * LDT + 32 * ks + 8 * fq), b1 = *(const LAS bf16x8*)(sB_ + (32 * wn + 16 + fr) * LDT + 32 * ks + 8 * fq); \
      acc0 = MFMA16(b0, af, acc0); acc1 = MFMA16(b1, af, acc1); } } while (0)
    CG_LOAD(ra0, ra1, rb0, rb1, 0); CG_LOAD(sa0, sa1, sb0, sb1, 1);
    CG_STORE(ra0, ra1, rb0, rb1, 0);
    __syncthreads();
    f32x4 acc0 = {0.f, 0.f, 0.f, 0.f}, acc1 = {0.f, 0.f, 0.f, 0.f};
#pragma unroll 1
    for (int kt = 0; kt < nk; kt += 2) {
      if (kt + 2 < nk) CG_LOAD(ra0, ra1, rb0, rb1, kt + 2);
      CG_COMPUTE(0);
      CG_STORE(sa0, sa1, sb0, sb1, 1);
      __syncthreads();
      if (kt + 3 < nk) CG_LOAD(sa0, sa1, sb0, sb1, kt + 3);
      CG_COMPUTE(1);
      if (kt + 2 < nk) CG_STORE(ra0, ra1, rb0, rb1, 0);
      __syncthreads();
    }
#undef CG_LOAD
#undef CG_STORE
#undef CG_COMPUTE
    const int row = tm * 64 + 16 * wm + fr, col = tn * 64 + 32 * wn + 4 * fq;
    epi(row, col, acc0); epi(row, col + 16, acc1);
  }
}

__global__ void __launch_bounds__(512, 2) fwd_megakernel(Params p) {
  extern __shared__ __attribute__((aligned(16))) unsigned char shm[];
  LAS unsigned char* lds = (LAS unsigned char*)shm;
  cg::grid_group grid = cg::this_grid();
  unsigned char* ws = p.ws;
  const int G = gridDim.x, cblk = blockIdx.x;
  unsigned* cnt = (unsigned*)(ws + OFF_CNT);
  __shared__ unsigned xbw[4];
#define s_item (*(volatile int*)&xbw[2])
  if (threadIdx.x == 0) { xbw[0] = 0u; xbw[1] = 0u; xbw[2] = 0u; xbw[3] = 0u; }
  __syncthreads();
#ifndef TPROBE
#define TPROBE 0
#endif
  unsigned long long tacc = 0ull, tt0 = 0ull;
#define TB(g) do { if (TPROBE == (g) && blockIdx.x == 0) tt0 = __builtin_amdgcn_s_memrealtime(); } while (0)
#define TE(g) do { if (TPROBE == (g) && blockIdx.x == 0) tacc += __builtin_amdgcn_s_memrealtime() - tt0; } while (0)

  TB(5); phase_copy(p); phase_mod(p, lds); phase_a2(p, lds);
  phase_wconv(p, 0, lds, 0, cblk, G); phase_wconv(p, 0, lds, 1, cblk, G);
  grid.sync(); TE(5);
  const XcdBarrier xb = xcd_barrier_post((unsigned*)(ws + OFF_BAR), (volatile LAS unsigned*)xbw);
  for (int l = 0; l < 4; ++l) {
    const bool last = (l == 3);
    const int MR = last ? NLAT : NTOK;
    TB(3); TB(14); if (l > 0) phase_wconv(p, l, lds, 1, cblk, G);
    phase_norm(p, l, p.norm1_g + l * 1024, 0, 1024, NTOK, l == 0);
    if (l == 0) phase_filt_gemm(p, l, lds, cblk, G);
    xcd_barrier(xb); TE(14); TE(3);
    TB(1); TB(6);
    { pg8::Gemm g{(const bf16_t*)(ws + OFF_X), (const bf16_t*)(ws + OFF_X), NTOK, 8448, 1024};
      SchedG1 S; S.init(NTOK, 8448, G, cblk);
      EpiG1 E{(bf16_t*)(ws + OFF_XT), (bf16_t*)(ws + OFF_PB), (float*)(ws + OFF_LR)};
      pg8::gemm_phase<EpiG1, SchedG1, false>(lds, g, S, E, nullptr); }
    xcd_barrier(xb); TE(1); TE(6);
    TB(4); TB(11); phase_gla_prep(p, l, lds);
    if (!last && cblk >= 64) phase_filt_gemm(p, l + 1, lds, cblk - 64, G - 64);
    xcd_barrier(xb); TE(4); TE(11);
    TB(2); TB(7); if (cblk < 64) phase_gla_scan(p, lds); TE(7);
    { LAS cplx* L = (LAS cplx*)lds;
      if (otid() == 0) s_item = (int)atomicAdd(cnt + 2 * l, 1u);
      for (;;) {
        __syncthreads();
        const int it = s_item;
        __syncthreads();
        if (it >= 1024) break;
        if (otid() == 0) s_item = (int)atomicAdd(cnt + 2 * l, 1u);
        hyena_chan<HY_NV>(p, l, __builtin_amdgcn_readfirstlane(it), L, otid());
      }
      if (!last) for (;;) {
        if (otid() == 0) s_item = (int)atomicAdd(cnt + 2 * l + 1, 1u);
        __syncthreads();
        const int it = s_item;
        __syncthreads();
        if (it >= 1024) break;
        hyena_ctx_item(p, l, it, lds);
      } }
    xcd_barrier(xb);
    TE(2);
    TB(4); TB(12); phase_post(p, l, MR, lds);
    xcd_barrier(xb); TE(4); TE(12);
    TB(1); TB(8);
    { pg8::StaticOrder S; S.init(NLAT, 1024, G, cblk);
      const bf16_t* PBc = (const bf16_t*)(ws + OFF_PB); bf16_t* T1 = (bf16_t*)(ws + OFF_KEF); bf16_t* MGp = (bf16_t*)(ws + OFF_XT + (size_t)3072 * NTOK * 2);
      EpiGate<0> E0{PBc, T1, nullptr};
      pg8::Gemm g0{(const bf16_t*)(ws + OFF_QF), (const bf16_t*)(ws + OFF_WBHY), NLAT, 1024, 1024};
      pg8::gemm_phase<EpiGate<0>, pg8::StaticOrder, false>(lds, g0, S, E0, nullptr);
      EpiGate<1> E1{PBc, T1, MGp};
      pg8::Gemm g1{(const bf16_t*)(ws + OFF_X), (const bf16_t*)(ws + OFF_WBGLA), NLAT, 1024, 1024};
      pg8::gemm_phase<EpiGate<1>, pg8::StaticOrder, false>(lds, g1, S, E1, nullptr);
      if (!last) {
        ctx_gemm((const bf16_t*)(ws + OFF_QF) + (size_t)NLAT * 1024, (const bf16_t*)(ws + OFF_WBHY), 1024, 1024, lds, [&](int r, int c, f32x4 v) {
          const size_t row = (size_t)NLAT + r; const u32x2 gt = *(const u32x2*)(PBc + row * 4096 + 2048 + c);
          *(u32x2*)(T1 + row * 1024 + c) = (u32x2){pk2(v[0] * sigm(bflo(gt[0])), v[1] * sigm(bfhi(gt[0]))), pk2(v[2] * sigm(bflo(gt[1])), v[3] * sigm(bfhi(gt[1])))}; });
        ctx_gemm((const bf16_t*)(ws + OFF_X) + (size_t)NLAT * 1024, (const bf16_t*)(ws + OFF_WBGLA), 1024, 1024, lds, [&](int r, int c, f32x4 v) {
          const size_t row = (size_t)NLAT + r; const u32x2 gt = *(const u32x2*)(PBc + row * 4096 + 3072 + c); const u32x2 t1 = *(const u32x2*)(T1 + row * 1024 + c);
          *(u32x2*)(MGp + row * 1024 + c) = (u32x2){pk2(bflo(t1[0]) + v[0] * sigm(bflo(gt[0])), bfhi(t1[0]) + v[1] * sigm(bfhi(gt[0]))), pk2(bflo(t1[1]) + v[2] * sigm(bflo(gt[1])), bfhi(t1[1]) + v[3] * sigm(bfhi(gt[1])))}; });
      } }
    xcd_barrier(xb); TE(8);
    { pg8::StaticOrder S; S.init(NLAT, 1024, G, cblk);
      EpiRes E{p.out, (float*)(ws + OFF_CTXS), modp(p, l, 0), 2048, l == 0 ? p.x : p.out, l == 0 ? p.ctx : (const float*)(ws + OFF_CTXS)};
      pg8::Gemm g{(const bf16_t*)(ws + OFF_XT + (size_t)3072 * NTOK * 2), (const bf16_t*)(ws + OFF_WOUT), NLAT, 1024, 1024};
      pg8::gemm_phase<EpiRes, pg8::StaticOrder, false>(lds, g, S, E, nullptr);
      if (!last) { float* cs = (float*)(ws + OFF_CTXS); const float* gv = modp(p, l, 4) + 2048; const float* csrc = l == 0 ? p.ctx : (const float*)cs;
        ctx_gemm((const bf16_t*)(ws + OFF_XT + (size_t)3072 * NTOK * 2) + (size_t)NLAT * 1024, (const bf16_t*)(ws + OFF_WOUT), 1024, 1024, lds, [&](int r, int c, f32x4 v) {
          *(f32x4*)(cs + (size_t)r * 1024 + c) = *(const f32x4*)(csrc + (size_t)r * 1024 + c) + *(const f32x4*)(gv + c) * v; }); } }
    xcd_barrier(xb); TE(1);
    TB(4); TB(13); phase_norm(p, l, p.norm2_g + l * 1024, 3072, 4096, MR, false);
    xcd_barrier(xb); TE(4); TE(13);
    if (TPROBE == 20) { for (int q = 0; q < 8; ++q) xcd_barrier(xb); }
    TB(1); TB(9);
    { pg8::StaticOrder S; S.init(MR, 4096, G, cblk);
      EpiRelu2 E{(bf16_t*)(ws + OFF_PB)};
      pg8::Gemm g{(const bf16_t*)(ws + OFF_X), (const bf16_t*)(ws + OFF_W1), MR, 4096, 1024};
      pg8::gemm_phase<EpiRelu2, pg8::StaticOrder, false>(lds, g, S, E, nullptr);
      if (!last && cblk >= 64) phase_wconv(p, l + 1, lds, 0, cblk - 64, G - 64); }
    xcd_barrier(xb); TE(9); TB(10);
    { pg8::StaticOrder S; S.init(NLAT, 1024, G, cblk);
      EpiRes E{p.out, (float*)(ws + OFF_CTXS), modp(p, l, 0), 5120, p.out, (const float*)(ws + OFF_CTXS)};
      pg8::Gemm g{(const bf16_t*)(ws + OFF_PB), (const bf16_t*)(ws + OFF_W2), NLAT, 1024, 4096};
      pg8::gemm_phase<EpiRes, pg8::StaticOrder, false>(lds, g, S, E, nullptr);
      if (!last) { float* cs = (float*)(ws + OFF_CTXS); const float* gv = modp(p, l, 4) + 5120;
        ctx_gemm((const bf16_t*)(ws + OFF_PB) + (size_t)NLAT * 4096, (const bf16_t*)(ws + OFF_W2), 4096, 1024, lds, [&](int r, int c, f32x4 v) {
          f32x4* q = (f32x4*)(cs + (size_t)r * 1024 + c); *q = *q + *(const f32x4*)(gv + c) * v; }); } }
    xcd_barrier(xb); TE(1); TE(10);
  }
  phase_final_norm(p);
  if (TPROBE && TPROBE != 20 && blockIdx.x == 0) { const unsigned long long s0 = __builtin_amdgcn_s_memrealtime(); while (__builtin_amdgcn_s_memrealtime() - s0 < tacc) __builtin_amdgcn_s_sleep(8); }
}

#ifndef HY_NV
#define HY_NV 2
#endif
constexpr size_t DYN_LDS = 2 * FFT_REGION_F2 * 8 + 11 * 512 * 4;

extern "C" void kernel_launch(void* const* d_in, const int* in_sizes, int n_in, void* d_out, int out_size, void* d_ws, size_t ws_size, hipStream_t stream) {
  if (ws_size < WS_TOTAL || n_in < 28) return;
  static int grid_blocks = 0;
  if (!grid_blocks) {
    int dev = 0, cus = 0, per_cu = 0;
    hipGetDevice(&dev);
    hipDeviceGetAttribute(&cus, hipDeviceAttributeMultiprocessorCount, dev);
    hipFuncSetAttribute((const void*)fwd_megakernel, hipFuncAttributeMaxDynamicSharedMemorySize, (int)DYN_LDS);
    hipOccupancyMaxActiveBlocksPerMultiprocessor(&per_cu, fwd_megakernel, 512, DYN_LDS);
    if (per_cu < 1) per_cu = 1;
    grid_blocks = cus * 1;
  }
  Params p{};
  const float** pp = (const float**)&p;
  for (int i = 0; i < 28; ++i) pp[i] = (const float*)d_in[i];
  p.out = (float*)d_out; p.ws = (unsigned char*)d_ws;
  void* args[] = {&p};
  hipLaunchCooperativeKernel((const void*)fwd_megakernel, dim3(grid_blocks), dim3(512), args, DYN_LDS, stream);
}
```
